# Optimizing an MI355X kernel written in HIP

```python
import math
import jax, jax.numpy as jnp
from jax import lax
import numpy as np

D_MODEL = 2048
BATCH = 4
SEQ = 4096
DEPTH = 1

CHUNK = 64
D_MIX = D_MODEL
NORM_EPS = 1e-6
DSA_WIDTH = D_MIX // 2
DSA_HEAD_DIM = 128
DSA_HEADS = DSA_WIDTH // DSA_HEAD_DIM
IDX_HEADS = 16
IDX_DIM = 64
TOPK_MAX = 256
ROPE_THETA = 10000.0
RWKV_WIDTH = D_MIX - DSA_WIDTH
RWKV_HEAD_DIM = 64
RWKV_HEADS = RWKV_WIDTH // RWKV_HEAD_DIM
DECAY_LORA = 64
AICL_LORA = 64
GATE_LORA = 160
GN_EPS = 64e-5
N_GROUPS = 4
EXPERTS_PER_GROUP = 4
N_EXPERTS = N_GROUPS * EXPERTS_PER_GROUP
TOP_K_IN_GROUP = 2
D_EXPERT = 512
DSA_SPLITS = (DSA_WIDTH, DSA_WIDTH, DSA_WIDTH, IDX_HEADS * IDX_DIM, IDX_DIM, IDX_HEADS)
RWKV_SPLITS = (RWKV_WIDTH, DECAY_LORA, RWKV_WIDTH, RWKV_WIDTH, AICL_LORA, GATE_LORA)
DSA_COLS = sum(DSA_SPLITS)
RWKV_COLS = sum(RWKV_SPLITS)
IN_COLS = DSA_COLS + RWKV_COLS

kernel_name = 'hybrid_dsa_rwkv7_hmoe_block'


def split_cols(p, sizes):
    cuts = np.cumsum(sizes)[:-1].tolist()
    return jnp.split(p, cuts, axis=-1)


def rms_norm(x, g, eps=NORM_EPS):
    xf = x.astype(jnp.float32)
    y = xf * lax.rsqrt(jnp.mean(xf * xf, axis=-1, keepdims=True) + eps)
    return (y * g.astype(jnp.float32)).astype(x.dtype)


def rope(x, pos):
    d = x.shape[-1]
    half = d // 2
    inv = ROPE_THETA ** (-jnp.arange(half, dtype=jnp.float32) * (2.0 / d))
    ang = pos.astype(jnp.float32)[:, None] * inv[None, :]
    cos = jnp.cos(ang)[None, :, None, :]
    sin = jnp.sin(ang)[None, :, None, :]
    xf = x.astype(jnp.float32)
    x1, x2 = xf[..., :half], xf[..., half:]
    out = jnp.concatenate([x1 * cos - x2 * sin, x2 * cos + x1 * sin], axis=-1)
    return out.astype(x.dtype)


def token_shift_mix(p, mu):
    prev = jnp.pad(p, ((0, 0), (1, 0), (0, 0)))[:, :-1]
    return p + (prev - p) * mu


def dsa_mixer(q, k, v, q_idx, k_idx, w_idx, q_gain, k_gain):
    B, S = q.shape[0], q.shape[1]
    f32 = jnp.float32
    pos = jnp.arange(S)
    q = rope(rms_norm(q.reshape(B, S, DSA_HEADS, DSA_HEAD_DIM), q_gain), pos)
    k = rope(rms_norm(k.reshape(B, S, DSA_HEADS, DSA_HEAD_DIM), k_gain), pos)
    v = v.reshape(B, S, DSA_HEADS, DSA_HEAD_DIM)
    q_idx = rope(q_idx.reshape(B, S, IDX_HEADS, IDX_DIM), pos)
    k_idx = rope(k_idx[:, :, None, :], pos)[:, :, 0]
    w_idx = w_idx.astype(f32) * (IDX_HEADS ** -0.5 * IDX_DIM ** -0.5)
    top_k = min(TOPK_MAX, S // 4)
    n_blocks = S // CHUNK
    key_pos = jnp.arange(S)
    scale = DSA_HEAD_DIM ** -0.5

    def block(i):
        start = i * CHUNK
        qi_idx = lax.dynamic_slice_in_dim(q_idx, start, CHUNK, axis=1)
        wi = lax.dynamic_slice_in_dim(w_idx, start, CHUNK, axis=1)
        qi = lax.dynamic_slice_in_dim(q, start, CHUNK, axis=1)
        iscore = jnp.einsum('bqhd,bsd->bqhs', qi_idx, k_idx, preferred_element_type=f32)
        iscore = jnp.einsum('bqhs,bqh->bqs', jax.nn.relu(iscore), wi)
        admissible = key_pos < start + CHUNK
        iscore = jnp.where(admissible[None, None, :], iscore, -jnp.inf)
        sel_score, sel = lax.top_k(iscore, top_k)
        valid = jnp.isfinite(sel_score)
        k_sel = jax.vmap(lambda kb, ib: kb[ib])(k, sel)
        v_sel = jax.vmap(lambda vb, ib: vb[ib])(v, sel)
        logits = jnp.einsum('bqhd,bqkhd->bhqk', qi, k_sel, preferred_element_type=f32) * scale
        logits = jnp.where(valid[:, None, :, :], logits, -jnp.inf)
        probs = jax.nn.softmax(logits, axis=-1)
        return jnp.einsum('bhqk,bqkhd->bqhd', probs.astype(v.dtype), v_sel)

    out = lax.map(block, jnp.arange(n_blocks))
    return out.transpose(1, 0, 2, 3, 4).reshape(B, S, DSA_WIDTH)


def rwkv7_mixer(r, d_w, k, v, d_a, d_g, w0, w_decay_up, a0, w_aicl_up, w_gate_lora_up,
                k_k, k_a, r_k, ln_x_w, ln_x_b, out_dtype):
    B, S = r.shape[0], r.shape[1]
    H, N = RWKV_HEADS, RWKV_HEAD_DIM
    f32 = jnp.float32
    w = -jax.nn.softplus(-(w0 + jnp.tanh(d_w) @ w_decay_up)) - 0.5
    decay = jnp.exp(-jnp.exp(w.astype(f32)))
    a = jax.nn.sigmoid((a0 + d_a @ w_aicl_up).astype(f32))
    g = (jax.nn.sigmoid(d_g) @ w_gate_lora_up).astype(f32)
    heads = lambda t: t.astype(f32).reshape(B, S, H, N)
    kk = heads(k * k_k)
    kk = kk / jnp.maximum(jnp.sqrt(jnp.sum(kk * kk, axis=-1, keepdims=True)), 1e-12)
    k = k.astype(f32) * (1.0 + (a - 1.0) * k_a.astype(f32))
    r_h, k_h, v_h, w_h, a_h = heads(r), heads(k), heads(v), heads(decay), heads(a)
    b_h = kk * a_h

    def step(state, inp):
        r_t, w_t, k_t, v_t, kk_t, b_t = inp
        sa = jnp.einsum('bhvk,bhk->bhv', state, -kk_t)
        state = (state * w_t[:, :, None, :] + sa[..., None] * b_t[:, :, None, :]
                 + v_t[..., None] * k_t[:, :, None, :])
        return state, jnp.einsum('bhvk,bhk->bhv', state, r_t)

    xs = tuple(t.transpose(1, 0, 2, 3) for t in (r_h, w_h, k_h, v_h, kk, b_h))
    _, ys = lax.scan(step, jnp.zeros((B, H, N, N), f32), xs)
    y = ys.transpose(1, 0, 2, 3)
    mu = jnp.mean(y, axis=-1, keepdims=True)
    var = jnp.mean(jnp.square(y - mu), axis=-1, keepdims=True)
    y = ((y - mu) * lax.rsqrt(var + GN_EPS)).reshape(B, S, RWKV_WIDTH)
    y = y * ln_x_w.astype(f32) + ln_x_b.astype(f32)
    bonus = jnp.sum(r_h * k_h * r_k.astype(f32), axis=-1, keepdims=True) * v_h
    y = (y + bonus.reshape(B, S, RWKV_WIDTH)) * g
    return y.astype(out_dtype)


def hier_moe(h, w_route_group, b_route_group, w_route_expert, b_route_expert,
             w_e_gate, w_e_up, w_e_down):
    B, S, D = h.shape
    f32 = jnp.float32
    t = h.reshape(B * S, D)
    grp_prob = jax.nn.softmax((t @ w_route_group).astype(f32) + b_route_group.astype(f32), axis=-1)
    p_grp, g_sel = lax.top_k(grp_prob, 1)
    exp_logits = ((t @ w_route_expert).astype(f32) + b_route_expert.astype(f32))
    exp_logits = exp_logits.reshape(-1, N_GROUPS, EXPERTS_PER_GROUP)
    exp_logits = jnp.take_along_axis(exp_logits, g_sel[:, :, None], axis=1)[:, 0]
    p_exp, e_sel = lax.top_k(jax.nn.softmax(exp_logits, axis=-1), TOP_K_IN_GROUP)
    p_exp = p_exp / jnp.sum(p_exp, axis=-1, keepdims=True)
    gate_w = p_grp * p_exp
    expert_id = g_sel * EXPERTS_PER_GROUP + e_sel
    combine = jnp.sum(jax.nn.one_hot(expert_id, N_EXPERTS, dtype=f32) * gate_w[..., None], axis=1)
    y = jnp.zeros((B * S, D), f32)
    for e in range(N_EXPERTS):
        he = jax.nn.silu(t @ w_e_gate[e]) * (t @ w_e_up[e])
        y = y + combine[:, e:e + 1] * (he @ w_e_down[e]).astype(f32)
    return y.reshape(B, S, D).astype(h.dtype)


def setup_inputs(seed: int = 0) -> dict:
    key = jax.random.key(seed)
    ks = jax.random.split(key, 32)
    f32 = jnp.float32
    nrm = lambda k, shape, s: jax.random.normal(k, shape, f32) * s
    L, D = DEPTH, D_MODEL
    return {
        'x': jax.random.normal(ks[0], (BATCH, SEQ, D), f32),
        'g_mix': 1.0 + nrm(ks[1], (L, D), 0.02),
        'w_in': nrm(ks[2], (L, D, IN_COLS), D ** -0.5),
        'rwkv_shift_mix': jax.random.uniform(ks[3], (L, RWKV_COLS), f32),
        'q_gain': 1.0 + nrm(ks[4], (L, DSA_HEAD_DIM), 0.02),
        'k_gain': 1.0 + nrm(ks[5], (L, DSA_HEAD_DIM), 0.02),
        'w0': jax.random.uniform(ks[6], (L, RWKV_WIDTH), f32, -6.0, -1.0),
        'w_decay_up': nrm(ks[7], (L, DECAY_LORA, RWKV_WIDTH), 0.1),
        'a0': nrm(ks[8], (L, RWKV_WIDTH), 0.1),
        'w_aicl_up': nrm(ks[9], (L, AICL_LORA, RWKV_WIDTH), 0.5 * AICL_LORA ** -0.5),
        'w_gate_lora_up': nrm(ks[10], (L, GATE_LORA, RWKV_WIDTH), GATE_LORA ** -0.5),
        'k_k': 0.85 + nrm(ks[11], (L, RWKV_WIDTH), 0.02),
        'k_a': 1.0 + nrm(ks[12], (L, RWKV_WIDTH), 0.02),
        'r_k': nrm(ks[13], (L, RWKV_HEADS, RWKV_HEAD_DIM), 0.1),
        'ln_x_w': 1.0 + nrm(ks[14], (L, RWKV_WIDTH), 0.02),
        'ln_x_b': nrm(ks[15], (L, RWKV_WIDTH), 0.01),
        'w_out': nrm(ks[16], (L, D_MIX, D), D_MIX ** -0.5),
        'g_ffn': 1.0 + nrm(ks[17], (L, D), 0.02),
        'w_route_group': nrm(ks[18], (L, D, N_GROUPS), D ** -0.5),
        'b_route_group': nrm(ks[19], (L, N_GROUPS), 0.01),
        'w_route_expert': nrm(ks[20], (L, D, N_EXPERTS), D ** -0.5),
        'b_route_expert': nrm(ks[21], (L, N_EXPERTS), 0.01),
        'w_e_gate': nrm(ks[22], (L, N_EXPERTS, D, D_EXPERT), D ** -0.5),
        'w_e_up': nrm(ks[23], (L, N_EXPERTS, D, D_EXPERT), D ** -0.5),
        'w_e_down': nrm(ks[24], (L, N_EXPERTS, D_EXPERT, D), D_EXPERT ** -0.5),
    }


def reference(x, g_mix, w_in, rwkv_shift_mix, q_gain, k_gain, w0, w_decay_up, a0, w_aicl_up,
              w_gate_lora_up, k_k, k_a, r_k, ln_x_w, ln_x_b, w_out, g_ffn, w_route_group,
              b_route_group, w_route_expert, b_route_expert, w_e_gate, w_e_up, w_e_down):
    for l in range(DEPTH):
        h = rms_norm(x, g_mix[l])
        proj = h @ w_in[l]
        p_dsa, p_rwkv = proj[..., :DSA_COLS], proj[..., DSA_COLS:]
        q, k, v, q_idx, k_idx, w_idx = split_cols(p_dsa, DSA_SPLITS)
        y_dsa = dsa_mixer(q, k, v, q_idx, k_idx, w_idx, q_gain[l], k_gain[l])
        p_rwkv = token_shift_mix(p_rwkv, rwkv_shift_mix[l])
        r, d_w, kr, vr, d_a, d_g = split_cols(p_rwkv, RWKV_SPLITS)
        y_rwkv = rwkv7_mixer(r, d_w, kr, vr, d_a, d_g, w0[l], w_decay_up[l], a0[l], w_aicl_up[l],
                             w_gate_lora_up[l], k_k[l], k_a[l], r_k[l], ln_x_w[l], ln_x_b[l],
                             x.dtype)
        x = x + jnp.concatenate([y_dsa.astype(x.dtype), y_rwkv], axis=-1) @ w_out[l]
        x = x + hier_moe(rms_norm(x, g_ffn[l]), w_route_group[l], b_route_group[l],
                         w_route_expert[l], b_route_expert[l], w_e_gate[l], w_e_up[l],
                         w_e_down[l])
    return x
```

```cpp
#include <hip/hip_runtime.h>
#include <hip/hip_cooperative_groups.h>
#include <cstdio>
#include <cstdint>
#include <cmath>

#ifndef MK_SINGLE
#define MK_SINGLE 1
#endif

#define GAS __attribute__((address_space(1)))
#define LAS __attribute__((address_space(3)))
typedef unsigned short bf16_t;
typedef short bf16x8 __attribute__((ext_vector_type(8)));
typedef float f32x4 __attribute__((ext_vector_type(4)));
typedef float f32x16 __attribute__((ext_vector_type(16)));
typedef float f32x2 __attribute__((ext_vector_type(2)));
typedef unsigned u32x4 __attribute__((ext_vector_type(4)));
typedef unsigned u32x2 __attribute__((ext_vector_type(2)));

constexpr int BATCH = 4, SEQ = 4096, DM = 2048, T = BATCH * SEQ;
constexpr int NP = 7680;
constexpr int PQ = 0, PK = 1024, PV = 2048, PQI = 3072, PKI = 4096, PWI = 4160, PDW = 4224, PDA = 4288, PR = 4352, PKR = 5376, PVR = 6400, PDG = 7424;
constexpr int IN_COLS = 7536, DSA_COLS = 4176;
constexpr int KL = 384, NL = 3072;
constexpr int MPAD = 22528;
constexpr int NCLS = 24;
constexpr float NORM_EPS = 1e-6f, GN_EPS = 64e-5f;
constexpr float QSCALE = 0.08838834764831845f * 1.4426950408889634f;

constexpr size_t MiB = 1u << 20;
constexpr size_t WS_CTL = 0, CTL_ZERO_BYTES = 1 * MiB;
constexpr size_t WS_WLORA = 1 * MiB;
constexpr size_t WS_WOUT = 4 * MiB;
constexpr size_t WS_MSK = 12 * MiB;
constexpr size_t WS_KI = 20 * MiB;
constexpr size_t WS_ROUTE = 22 * MiB;
constexpr size_t WS_ROWTOK = 23 * MiB;
constexpr size_t WS_ALORA = 24 * MiB;
constexpr size_t WS_WIN = 36 * MiB;
constexpr size_t WS_HN = 66 * MiB;
constexpr size_t WS_YCAT = WS_HN;
constexpr size_t WS_L3 = 130 * MiB;
constexpr size_t WS_P = 226 * MiB;
constexpr size_t WS_H2S = 226 * MiB;
constexpr size_t WS_HS = 314 * MiB;
constexpr size_t WS_WGU = 358 * MiB;
constexpr size_t WS_WDN = 422 * MiB;
constexpr size_t WS_END = 466 * MiB;
constexpr int CW_CNT = 64;
constexpr int CW_BAR = 4096;

constexpr int RING_BYTES = 131072;
constexpr int LDSCTL_OFF = RING_BYTES, MISC_OFF = LDSCTL_OFF + 320;
constexpr int LDS_BYTES = 147456;

#define LDS_WAIT() asm volatile("s_waitcnt lgkmcnt(0)" ::: "memory")
#define VM_WAIT() asm volatile("s_waitcnt vmcnt(0)" ::: "memory")
__device__ __forceinline__ unsigned f2bf(float f) { unsigned u = __builtin_bit_cast(unsigned, f); return (u + 0x7fffu + ((u >> 16) & 1u)) >> 16; }
__device__ __forceinline__ unsigned pk2(float lo, float hi) { return f2bf(lo) | (f2bf(hi) << 16); }
__device__ __forceinline__ float bf2f(unsigned short h) { return __builtin_bit_cast(float, (unsigned)h << 16); }
__device__ __forceinline__ float bflo(unsigned w) { return __builtin_bit_cast(float, w << 16); }
__device__ __forceinline__ float bfhi(unsigned w) { return __builtin_bit_cast(float, w & 0xffff0000u); }
__device__ __forceinline__ float wave_sum(float v) {
#pragma unroll
    for (int o = 1; o < 64; o <<= 1) v += __shfl_xor(v, o);
    return v;
}
__device__ __forceinline__ float half_sum(float v) {
#pragma unroll
    for (int o = 1; o < 32; o <<= 1) v += __shfl_xor(v, o);
    return v;
}
__device__ __forceinline__ float sigmoidf_(float x) { return 1.0f / (1.0f + __expf(-x)); }

namespace pg8 {
constexpr int BM = 256, BK = 64, HALF = 128, HTB = HALF * BK * 2, STAGE_BYTES = 8 * HTB, NXCD = 8, WGM = 8;
__host__ __device__ __forceinline__ int lds_byte(int r, int c) { const int st = (r >> 4) * 2 + (c >> 5), rr = r & 15, cc = c & 31, ob = rr * 64 + cc * 2; return st * 1024 + (ob ^ (((ob >> 9) & 1) << 5)); }
__host__ __device__ __forceinline__ void stage_rc(int b, int& R, int& C) { const int st = b / 1024, sb = b % 1024, swz = sb ^ (((sb >> 9) & 1) << 5); R = (st >> 1) * 16 + swz / 64; C = (st & 1) * 32 + (swz % 64) / 2; }
__host__ __device__ __forceinline__ int perm32(int rho) { const int n = rho >> 4, i = rho & 15; return 8 * (i >> 2) + 4 * n + (i & 3); }

struct Unit { int pm, pn, aux; };
struct Seg { const char* A; const char* B; Unit u; int last; };

struct TileOrder {
    int nM, nN, nwg, G, c;
    __device__ void init(int nM_, int nN_, int G_, int c_) { nM = nM_; nN = nN_; nwg = nM * nN; G = G_; c = c_; }
    __device__ bool next(int i, int& pm, int& pn) const {
        const long L = (long)i * G + c; if (L >= nwg) return false;
        int wgid = (int)L; { const int q = nwg / NXCD, r = nwg % NXCD, xcd = wgid % NXCD, off = wgid / NXCD; wgid = (xcd < r ? xcd * (q + 1) : r * (q + 1) + (xcd - r) * q) + off; }
        const int nig = WGM * nN, gid = wgid / nig, fm = gid * WGM, gsz = (nM - fm) < WGM ? (nM - fm) : WGM;
        pm = fm + ((wgid % nig) % gsz); pn = (wgid % nig) / gsz; return true;
    }
};
struct PlainSched {
    TileOrder o; const char* A; const char* B; size_t tA, tB;
    __device__ void init(const bf16_t* A_, const bf16_t* B_, int M, int N, int lda, int ldb, int G, int c) { o.init(M / BM, N / BM, G, c); A = (const char*)A_; B = (const char*)B_; tA = (size_t)BM * lda * 2; tB = (size_t)BM * ldb * 2; }
    __device__ bool seg(int i, Seg& s) const { int pm, pn; if (!o.next(i, pm, pn)) return false; s.A = A + pm * tA; s.B = B + pn * tB; s.u.pm = pm; s.u.pn = pn; s.u.aux = 0; s.last = 1; return true; }
};

__device__ __forceinline__ unsigned cvt_pk_bf16(float lo, float hi) { unsigned r; asm volatile("v_cvt_pk_bf16_f32 %0, %1, %2" : "=v"(r) : "v"(lo), "v"(hi)); return r; }

typedef f32x4 Acc[2][2][4][2];

template <class Epi, class Sched, bool ALIGN_EPI>
__device__ __forceinline__ void gemm_phase(LAS unsigned char* lds, const int lda, const int ldb, const int nt, const Sched& S, const Epi& E) {
    const int tid = threadIdx.x, wid = __builtin_amdgcn_readfirstlane(tid >> 6), lane = tid & 63, wr = wid >> 2, wc = wid & 3, fr = lane & 15, fq = lane >> 4;
    unsigned voffA[2], voffB[2];
#pragma unroll
    for (int i = 0; i < 2; ++i) { int R, C; stage_rc(tid * 16 + i * 8192, R, C); const int Rb = Epi::PERM ? ((R & ~31) + perm32(R & 31)) : R;
        voffA[i] = (unsigned)(R * lda + C) * 2u; voffB[i] = (unsigned)(Rb * ldb + C) * 2u; }
    const size_t kstep = (size_t)(BK * 2);
    const size_t hstepA = (size_t)HALF * lda * 2, hstepB = (size_t)HALF * ldb * 2;
    const unsigned ldsw = (unsigned)wid * 1024u;
    const int aoff = lds_byte(wr * 64 + fr, fq * 8), boff = lds_byte(wc * 32 + fr, fq * 8);
#define PG8_SA(b, h) (((b) * 2 + (h)) * HTB)
#define PG8_SB(b, h) ((4 + (b) * 2 + (h)) * HTB)
#define PG8_STAGE(bufoff, gbase, voff) do { _Pragma("unroll") for (int _i = 0; _i < 2; ++_i) \
        __builtin_amdgcn_global_load_lds((const unsigned*)((const char*)(gbase) + (voff)[_i]), (LAS unsigned*)(lds + (bufoff) + ldsw + _i * 8192), 16, 0, 0); } while (0)
#define PG8_LDA(dst, b, h) do { _Pragma("unroll") for (int m = 0; m < 4; ++m) _Pragma("unroll") for (int k = 0; k < 2; ++k) dst[m][k] = *(const LAS bf16x8*)(lds + PG8_SA(b, h) + aoff + m * 2048 + k * 1024); } while (0)
#define PG8_LDB(dst, b, h) do { _Pragma("unroll") for (int n = 0; n < 2; ++n) _Pragma("unroll") for (int k = 0; k < 2; ++k) dst[n][k] = *(const LAS bf16x8*)(lds + PG8_SB(b, h) + boff + n * 2048 + k * 1024); } while (0)
#define PG8_MMA(ai, bj, At, Bt) do { __builtin_amdgcn_s_setprio(1); _Pragma("unroll") for (int m = 0; m < 4; ++m) _Pragma("unroll") for (int n = 0; n < 2; ++n) _Pragma("unroll") for (int k = 0; k < 2; ++k) \
        acc[ai][bj][m][n] = __builtin_amdgcn_mfma_f32_16x16x32_bf16(Bt[n][k], At[m][k], acc[ai][bj][m][n], 0, 0, 0); __builtin_amdgcn_s_setprio(0); } while (0)
#define PG8_WAIT_V(n) asm volatile("s_waitcnt vmcnt(" #n ")" ::: "memory")
#define PG8_WAIT_L(n) asm volatile("s_waitcnt lgkmcnt(" #n ")" ::: "memory")
#define PG8_BAR __builtin_amdgcn_s_barrier()
#define PG8_SCHED __builtin_amdgcn_sched_barrier(0)
#define PG8_ZERO() do { _Pragma("unroll") for (int a = 0; a < 2; ++a) _Pragma("unroll") for (int b = 0; b < 2; ++b) _Pragma("unroll") for (int m = 0; m < 4; ++m) _Pragma("unroll") for (int n = 0; n < 2; ++n) acc[a][b][m][n] = (f32x4){0.f, 0.f, 0.f, 0.f}; } while (0)
    Seg cur, nxt; int qi = 0;
    if (!S.seg(0, cur)) return;
    Acc acc;
    PG8_ZERO();
    bf16x8 At[4][2], B0[2][2], B1[2][2];
    const char* cA = cur.A; const char* cB = cur.B;
    PG8_STAGE(PG8_SB(0, 0), cB, voffB); PG8_STAGE(PG8_SB(0, 1), cB + hstepB, voffB); PG8_STAGE(PG8_SA(0, 0), cA, voffA); PG8_STAGE(PG8_SA(0, 1), cA + hstepA, voffA);
    if (wr == 1) PG8_BAR;
    PG8_WAIT_V(2); PG8_BAR;
    PG8_STAGE(PG8_SB(1, 0), cB + kstep, voffB); PG8_STAGE(PG8_SA(1, 0), cA + kstep, voffA); PG8_STAGE(PG8_SB(1, 1), cB + hstepB + kstep, voffB);
    PG8_WAIT_V(6); PG8_BAR;
    for (;;) {
        bool has_next; const char* nA; const char* nB;
        for (;;) {
        has_next = S.seg(qi + 1, nxt);
        nA = has_next ? nxt.A : cA; nB = has_next ? nxt.B : cB;
#pragma unroll 1
        for (int t = 0; t < nt; t += 2) {
            const bool last = (t == nt - 2);
            const char* a1 = cA + (size_t)(t + 1) * kstep;
            const char* a2 = last ? nA : cA + (size_t)(t + 2) * kstep; const char* b2 = last ? nB : cB + (size_t)(t + 2) * kstep;
            const char* a3 = a2 + kstep; const char* b3 = b2 + kstep;
            PG8_LDB(B0, 0, 0); PG8_LDB(B1, 0, 1); PG8_SCHED; PG8_LDA(At, 0, 0); PG8_STAGE(PG8_SA(1, 1), a1 + hstepA, voffA);
            PG8_WAIT_V(8); PG8_WAIT_L(0); PG8_BAR; PG8_MMA(0, 0, At, B0); PG8_MMA(0, 1, At, B1); PG8_BAR; PG8_SCHED;
            PG8_LDA(At, 0, 1); PG8_STAGE(PG8_SB(0, 0), b2, voffB); PG8_STAGE(PG8_SB(0, 1), b2 + hstepB, voffB); PG8_STAGE(PG8_SA(0, 0), a2, voffA);
            PG8_WAIT_V(8); PG8_WAIT_L(0); PG8_BAR; PG8_MMA(1, 0, At, B0); PG8_MMA(1, 1, At, B1); PG8_BAR; PG8_SCHED;
            PG8_LDB(B0, 1, 0); PG8_LDB(B1, 1, 1); PG8_SCHED; PG8_LDA(At, 1, 0); PG8_STAGE(PG8_SA(0, 1), a2 + hstepA, voffA);
            PG8_WAIT_V(8); PG8_WAIT_L(0); PG8_BAR; PG8_MMA(0, 0, At, B0); PG8_MMA(0, 1, At, B1); PG8_BAR; PG8_SCHED;
            PG8_LDA(At, 1, 1); PG8_STAGE(PG8_SB(1, 0), b3, voffB); PG8_STAGE(PG8_SB(1, 1), b3 + hstepB, voffB); PG8_STAGE(PG8_SA(1, 0), a3, voffA);
            PG8_WAIT_V(8); PG8_WAIT_L(0); PG8_BAR; PG8_MMA(1, 0, At, B0); PG8_MMA(1, 1, At, B1); PG8_BAR; PG8_SCHED;
        }
        if (cur.last || !has_next) break;
        cur = nxt; cA = nA; cB = nB; ++qi;
        }
        if constexpr (ALIGN_EPI) { if (wr == 0) PG8_BAR; }
        E(acc, cur.u, wr, wc, fr, fq);
        if (!has_next) break;
        PG8_ZERO();
        cur = nxt; cA = nA; cB = nB; ++qi;
        if constexpr (ALIGN_EPI) { if (wr == 1) PG8_BAR; }
    }
    PG8_WAIT_V(0);
    if constexpr (!ALIGN_EPI) { if (wr == 0) PG8_BAR; }
    PG8_BAR;
#undef PG8_SA
#undef PG8_SB
#undef PG8_STAGE
#undef PG8_LDA
#undef PG8_LDB
#undef PG8_MMA
#undef PG8_WAIT_V
#undef PG8_WAIT_L
#undef PG8_BAR
#undef PG8_SCHED
#undef PG8_ZERO
}

struct EpiBf16 {
    static constexpr bool PERM = true;
    bf16_t* O; int ldc;
    __device__ __forceinline__ void operator()(const Acc& acc, const Unit& u, int wr, int wc, int fr, int fq) const {
        const int row0 = u.pm * BM + wr * 64 + fr; const int col0 = u.pn * BM + wc * 32 + 8 * fq;
#pragma unroll
        for (int ai = 0; ai < 2; ++ai)
#pragma unroll
            for (int m = 0; m < 4; ++m) { bf16_t* rowp = O + (size_t)(row0 + ai * HALF + m * 16) * ldc + col0;
#pragma unroll
                for (int bj = 0; bj < 2; ++bj) { const f32x4 v0 = acc[ai][bj][m][0], v1 = acc[ai][bj][m][1];
                    u32x4 w; w.x = cvt_pk_bf16(v0[0], v0[1]); w.y = cvt_pk_bf16(v0[2], v0[3]); w.z = cvt_pk_bf16(v1[0], v1[1]); w.w = cvt_pk_bf16(v1[2], v1[3]);
                    *(u32x4*)(rowp + bj * HALF) = w; } }
    }
};
struct EpiLora {
    static constexpr bool PERM = true;
    bf16_t* O; const float* w0; const float* a0;
    __device__ __forceinline__ void operator()(const Acc& acc, const Unit& u, int wr, int wc, int fr, int fq) const {
        const int row0 = u.pm * BM + wr * 64 + fr; const int col0 = u.pn * BM + wc * 32 + 8 * fq; const int typ = u.pn >> 2;
        const float* bsrc = (typ == 0) ? w0 : a0;
        const float mul = (typ == 0) ? -0.6065306597126334f : 1.0f; const bool lin = (typ == 2);
#pragma unroll
        for (int bj = 0; bj < 2; ++bj) {
            const int ch = (col0 + bj * HALF) & 1023;
            const f32x4 b0 = *(const f32x4*)(bsrc + ch), b1 = *(const f32x4*)(bsrc + ch + 4);
#pragma unroll
            for (int ai = 0; ai < 2; ++ai)
#pragma unroll
                for (int m = 0; m < 4; ++m) {
                    f32x4 v0 = acc[ai][bj][m][0], v1 = acc[ai][bj][m][1];
                    {
                        const f32x4 s0 = v0 + b0, s1 = v1 + b1;
                        v0.x = lin ? v0.x : mul * sigmoidf_(s0.x); v0.y = lin ? v0.y : mul * sigmoidf_(s0.y); v0.z = lin ? v0.z : mul * sigmoidf_(s0.z); v0.w = lin ? v0.w : mul * sigmoidf_(s0.w);
                        v1.x = lin ? v1.x : mul * sigmoidf_(s1.x); v1.y = lin ? v1.y : mul * sigmoidf_(s1.y); v1.z = lin ? v1.z : mul * sigmoidf_(s1.z); v1.w = lin ? v1.w : mul * sigmoidf_(s1.w);
                    }
                    u32x4 w; w.x = cvt_pk_bf16(v0.x, v0.y); w.y = cvt_pk_bf16(v0.z, v0.w); w.z = cvt_pk_bf16(v1.x, v1.y); w.w = cvt_pk_bf16(v1.z, v1.w);
                    *(u32x4*)(O + (size_t)(row0 + ai * HALF + m * 16) * NL + col0 + bj * HALF) = w;
                    asm volatile("" ::: "memory"); }
        }
    }
};
struct EpiResF32 {
    static constexpr bool PERM = false;
    const float* base; float* out; int ldc;
    __device__ __forceinline__ void operator()(const Acc& acc, const Unit& u, int wr, int wc, int fr, int fq) const {
        const int col0 = u.pn * BM + wc * 32 + 4 * fq;
#pragma unroll
        for (int ai = 0; ai < 2; ++ai)
#pragma unroll
            for (int m = 0; m < 4; ++m) { const size_t off = (size_t)(u.pm * BM + ai * HALF + wr * 64 + m * 16 + fr) * ldc + col0;
#pragma unroll
                for (int bj = 0; bj < 2; ++bj)
#pragma unroll
                    for (int n = 0; n < 2; ++n) { const f32x4 bs = *(const f32x4*)(base + off + bj * HALF + n * 16); *(f32x4*)(out + off + bj * HALF + n * 16) = bs + acc[ai][bj][m][n]; } }
    }
};
struct EpiMoe1 {
    static constexpr bool PERM = true;
    bf16_t* O; const float* gates;
    __device__ __forceinline__ void operator()(const Acc& acc, const Unit& u, int wr, int wc, int fr, int fq) const {
        const int row0 = u.pm * BM + wr * 64 + fr; const int half = u.pn >> 2; const int col0 = half * 512 + (u.pn & 3) * 128 + wc * 32 + 8 * fq;
#pragma unroll
        for (int ai = 0; ai < 2; ++ai)
#pragma unroll
            for (int m = 0; m < 4; ++m) { const int row = row0 + ai * HALF + m * 16; const float gw = gates[(size_t)row * 2 + half];
                float v[8];
#pragma unroll
                for (int e = 0; e < 8; ++e) { const float g = acc[ai][0][m][e >> 2][e & 3], up = acc[ai][1][m][e >> 2][e & 3]; v[e] = g * sigmoidf_(g) * up * gw; }
                u32x4 w; w.x = cvt_pk_bf16(v[0], v[1]); w.y = cvt_pk_bf16(v[2], v[3]); w.z = cvt_pk_bf16(v[4], v[5]); w.w = cvt_pk_bf16(v[6], v[7]);
                *(u32x4*)(O + (size_t)row * 1024 + col0) = w; }
    }
};
struct EpiMoe2 {
    static constexpr bool PERM = false;
    float* out; const int* rowtok;
    __device__ __forceinline__ void operator()(const Acc& acc, const Unit& u, int wr, int wc, int fr, int fq) const {
        const int col0 = u.pn * BM + wc * 32 + 4 * fq;
#pragma unroll
        for (int ai = 0; ai < 2; ++ai)
#pragma unroll
            for (int m = 0; m < 4; ++m) { const int row = u.pm * BM + ai * HALF + wr * 64 + m * 16 + fr; const int tok = rowtok[row];
                if (tok >= 0) { float* o = out + (size_t)tok * DM + col0;
#pragma unroll
                    for (int bj = 0; bj < 2; ++bj)
#pragma unroll
                        for (int n = 0; n < 2; ++n) { f32x4* p = (f32x4*)(o + bj * HALF + n * 16); *p = *p + acc[ai][bj][m][n]; } }
                asm volatile("" ::: "memory"); }
    }
};
}

#define XB_TMO      128
#define XB_XCNT(j)  (256  + 64 * (j))
#define XB_XSUB(j)  (1280 + 64 * (j))
#define XB_XGEN(j)  (2304 + 64 * (j))
#define XB_TOP      3328
#define XB_TOPGEN   3392
#define XCD_BAR_WORDS 3456
#define XB_SPIN_CAP (1u << 20)
__device__ __forceinline__ unsigned xb_ld(unsigned* p)              { return __hip_atomic_load(p, __ATOMIC_RELAXED, __HIP_MEMORY_SCOPE_AGENT); }
__device__ __forceinline__ unsigned xb_add(unsigned* p, unsigned v) { return __hip_atomic_fetch_add(p, v, __ATOMIC_RELAXED, __HIP_MEMORY_SCOPE_AGENT); }
__device__ __forceinline__ unsigned xb_xcc_id() { return (unsigned)__builtin_amdgcn_s_getreg((3 << 11) | 20) & 0xFu; }
#define XB_SPIN(cond, bar) do { unsigned _sp = 0; while (cond) { __builtin_amdgcn_s_sleep(1); \
    if ((++_sp & 255u) == 0u) { if (xb_ld(&(bar)[XB_TMO])) break; if (_sp > XB_SPIN_CAP) { atomicAdd(&(bar)[XB_TMO], 1u); break; } } } } while (0)
struct XcdBarrier { unsigned* bar; unsigned x; volatile LAS unsigned* st; };
__device__ __forceinline__ XcdBarrier xcd_barrier_post(unsigned* bar, volatile LAS unsigned* st) {
    XcdBarrier b; b.bar = bar; b.x = xb_xcc_id(); b.st = st;
    if (threadIdx.x == 0) (void)xb_add(&bar[XB_XCNT(b.x)], 1u);
    return b;
}
__device__ __forceinline__ void xcd_barrier_complete(unsigned* bar, unsigned x, unsigned& nloc, unsigned& nx) {
    const unsigned G = gridDim.x * gridDim.y * gridDim.z;
    unsigned sum, cnt, mine, sp = 0u;
    for (;;) {
        sum = 0u; cnt = 0u; mine = 0u;
#pragma unroll
        for (unsigned j = 0; j < 16; ++j) { const unsigned c = xb_ld(&bar[XB_XCNT(j)]); sum += c; cnt += (c > 0u) ? 1u : 0u; mine = (j == x) ? c : mine; }
        if (sum == G) break;
        __builtin_amdgcn_s_sleep(1);
        if ((++sp & 255u) == 0u) { if (xb_ld(&bar[XB_TMO])) break; if (sp > XB_SPIN_CAP) { atomicAdd(&bar[XB_TMO], 1u); break; } }
    }
    nloc = mine > 0u ? mine : 1u; nx = cnt > 0u ? cnt : 1u;
}
__device__ __forceinline__ void xcd_barrier(const XcdBarrier& b) {
    asm volatile("s_waitcnt vmcnt(0)" ::: "memory");
    __syncthreads();
    if (threadIdx.x == 0) {
        unsigned* bar = b.bar;
        __builtin_amdgcn_s_waitcnt(0);
        unsigned nloc = b.st[0], nx = b.st[1];
        if (nloc == 0u) { xcd_barrier_complete(bar, b.x, nloc, nx); b.st[0] = nloc; b.st[1] = nx; }
        const unsigned old = xb_add(&bar[XB_XSUB(b.x)], 1u);
        const unsigned gen = old / nloc;
        if (old + 1u == (gen + 1u) * nloc) {
            __builtin_amdgcn_fence(__ATOMIC_RELEASE, "agent");
            asm volatile("s_waitcnt vmcnt(0)" ::: "memory");
            const unsigned og = xb_add(&bar[XB_TOP], 1u);
            const unsigned tg = og / nx;
            if (og + 1u == (tg + 1u) * nx) xb_add(&bar[XB_TOPGEN], 1u);
            else XB_SPIN(xb_ld(&bar[XB_TOPGEN]) == tg, bar);
            __builtin_amdgcn_fence(__ATOMIC_ACQUIRE, "agent");
            xb_add(&bar[XB_XGEN(b.x)], 1u);
            asm volatile("s_waitcnt vmcnt(0)" ::: "memory");
        } else {
            XB_SPIN(xb_ld(&bar[XB_XGEN(b.x)]) == gen, bar);
            __builtin_amdgcn_fence(__ATOMIC_ACQUIRE, "agent");
            asm volatile("s_waitcnt vmcnt(0)" ::: "memory");
        }
    }
    __syncthreads();
}

struct Args { const float* in[25]; float* out; unsigned char* ws; int ph_lo, ph_hi; };
enum { I_X = 0, I_GMIX, I_WIN, I_MIX, I_QG, I_KG, I_W0, I_WDEC, I_A0, I_WAICL, I_WGATE, I_KK, I_KA, I_RK, I_LNW, I_LNB, I_WOUT, I_GFFN, I_WRG, I_BRG, I_WRE, I_BRE, I_WEG, I_WEU, I_WED };

struct Frame {
    LAS unsigned char* lds; unsigned char* ldsg;
    unsigned* ctl;
    int tid, lane, wave, vcu, G;
    const float* const* in; float* out; unsigned char* ws;
};

__device__ __forceinline__ int win_dmap(int n) {
    if (n < DSA_COLS) return n;
    const int m = n - DSA_COLS;
    if (m < 1024) return PR + m;
    if (m < 1088) return PDW + (m - 1024);
    if (m < 2112) return PKR + (m - 1088);
    if (m < 3136) return PVR + (m - 2112);
    if (m < 3200) return PDA + (m - 3136);
    return PDG + (m - 3200);
}
template <int MODE>
__device__ __forceinline__ void transpose_item(const float* W, int N, bf16_t* WT, int ldd, LAS float* scr, int kb, int nb, int lane) {
    const int k0 = 64 * kb, n0 = 32 * nb;
    const int nn = n0 + (lane & 31);
#pragma unroll 8
    for (int i = 0; i < 32; ++i) { const int kk = 2 * i + (lane >> 5); scr[kk * 33 + (lane & 31)] = (nn < N) ? W[(size_t)(k0 + kk) * N + nn] : 0.f; }
    LDS_WAIT(); asm volatile("" ::: "memory");
    const int c = lane & 7;
#pragma unroll
    for (int j = 0; j < 4; ++j) { const int nl = (lane >> 3) + 8 * j; const int n = n0 + nl; const LAS float* s = scr + (8 * c) * 33 + nl;
        u32x4 o; o.x = pk2(s[0 * 33], s[1 * 33]); o.y = pk2(s[2 * 33], s[3 * 33]); o.z = pk2(s[4 * 33], s[5 * 33]); o.w = pk2(s[6 * 33], s[7 * 33]);
        int dr = n;
        if (MODE == 1) dr = win_dmap(n);
        if (MODE == 2) dr = (n >> 7) * 256 + (n & 127);
        if (MODE == 3) dr = (n >> 7) * 256 + 128 + (n & 127);
        if (n < N) *(u32x4*)(WT + (size_t)dr * ldd + k0 + 8 * c) = o; }
    LDS_WAIT(); asm volatile("" ::: "memory");
}

__device__ __forceinline__ void phase0(Frame& F) {
    LAS float* scr = (LAS float*)(F.lds + F.wave * 16384);
    const int gw = F.vcu * 8 + F.wave, NGW = F.G * 8, lane = F.lane;
    constexpr int NB_IN = (IN_COLS + 31) / 32;
    constexpr int I_IN = (DM / 64) * NB_IN, I_OUT = (DM / 64) * (DM / 32);
    bf16_t* WIN = (bf16_t*)(F.ws + WS_WIN); bf16_t* WOUT = (bf16_t*)(F.ws + WS_WOUT);
    for (int it = gw; it < I_IN + I_OUT; it += NGW) {
        if (it < I_IN) transpose_item<1>(F.in[I_WIN], IN_COLS, WIN, DM, scr, it / NB_IN, it % NB_IN, lane);
        else { const int r = it - I_IN; transpose_item<0>(F.in[I_WOUT], DM, WOUT, DM, scr, r / (DM / 32), r % (DM / 32), lane); }
    }
    for (int i = gw; i < 144 * 4; i += NGW) { const int r = i >> 2, q = i & 3; const int row = r < 48 ? 4176 + r : 7584 + (r - 48);
        *(u32x4*)(WIN + (size_t)row * DM + q * 512 + lane * 8) = (u32x4){0u, 0u, 0u, 0u}; }
    { bf16_t* WL = (bf16_t*)(F.ws + WS_WLORA); const float* wd = F.in[I_WDEC]; const float* wa = F.in[I_WAICL]; const float* wg = F.in[I_WGATE];
      for (int i = gw * 64 + lane; i < NL * KL; i += NGW * 64) { const int n = i / KL, k = i % KL; const int typ = n >> 10, c = n & 1023; float v = 0.f;
          if (typ == 0 && k < 64) v = wd[k * 1024 + c];
          else if (typ == 1 && k >= 64 && k < 128) v = wa[(k - 64) * 1024 + c];
          else if (typ == 2 && k >= 128 && k < 288) v = wg[(k - 128) * 1024 + c];
          WL[i] = (bf16_t)f2bf(v); } }
    { const float* x = F.in[I_X]; const float* g = F.in[I_GMIX]; bf16_t* HN = (bf16_t*)(F.ws + WS_HN);
      f32x4 gv[8];
#pragma unroll
      for (int j = 0; j < 8; ++j) gv[j] = ((const f32x4*)g)[64 * j + lane];
      for (int m = gw; m < T; m += NGW) { const f32x4* xr = (const f32x4*)(x + (size_t)m * DM) + lane; f32x4 v[8]; float s = 0.f;
#pragma unroll
          for (int j = 0; j < 8; ++j) { v[j] = xr[64 * j]; s += (v[j].x * v[j].x + v[j].y * v[j].y) + (v[j].z * v[j].z + v[j].w * v[j].w); }
          const float rstd = rsqrtf(wave_sum(s) * (1.f / DM) + NORM_EPS);
          u32x2* o = (u32x2*)(HN + (size_t)m * DM) + lane;
#pragma unroll
          for (int j = 0; j < 8; ++j) { u32x2 w; w.x = pk2(v[j].x * rstd * gv[j].x, v[j].y * rstd * gv[j].y); w.y = pk2(v[j].z * rstd * gv[j].z, v[j].w * rstd * gv[j].w); o[64 * j] = w; } } }
}

__device__ __forceinline__ void rope4(float& y0, float& y1, float& y2, float& y3, float c0, float s0, float c1, float s1) {
    const float o0 = y0 * c0 - y2 * s0, o2 = y2 * c0 + y0 * s0, o1 = y1 * c1 - y3 * s1, o3 = y3 * c1 + y1 * s1; y0 = o0; y1 = o1; y2 = o2; y3 = o3;
}
__device__ __forceinline__ void phase2(Frame& F) {
    const int gw = F.vcu * 8 + F.wave, NGW = F.G * 8, lane = F.lane;
    bf16_t* P = (bf16_t*)(F.ws + WS_P); bf16_t* KI = (bf16_t*)(F.ws + WS_KI); bf16_t* AL = (bf16_t*)(F.ws + WS_ALORA);
    const float* mix = F.in[I_MIX];
    const int l5 = lane & 31, hsel = lane >> 5, l4 = lane & 15, hq = lane >> 4;
    float qg[4], kg[4];
    { const float* a = F.in[I_QG]; const float* b = F.in[I_KG];
      qg[0] = a[2 * l5]; qg[1] = a[2 * l5 + 1]; qg[2] = a[64 + 2 * l5]; qg[3] = a[65 + 2 * l5];
      kg[0] = b[2 * l5]; kg[1] = b[2 * l5 + 1]; kg[2] = b[64 + 2 * l5]; kg[3] = b[65 + 2 * l5]; }
    const float L2T = 13.287712379549449f;
    const float inv128_0 = exp2f(-(float)(2 * l5) * (1.0f / 64.0f) * L2T), inv128_1 = exp2f(-(float)(2 * l5 + 1) * (1.0f / 64.0f) * L2T);
    const float inv64_0 = exp2f(-(float)(2 * l4) * (1.0f / 32.0f) * L2T), inv64_1 = exp2f(-(float)(2 * l4 + 1) * (1.0f / 32.0f) * L2T);
    const float mu_dw = mix[1024 + lane], mu_da = mix[3136 + lane], mu_g0 = mix[3200 + lane], mu_g1 = mix[3264 + lane], mu_g2 = (lane < 32) ? mix[3328 + lane] : 0.f;
    for (int t = gw; t < T; t += NGW) {
        const int pos = t & (SEQ - 1); const float fp = (float)pos;
        bf16_t* row = P + (size_t)t * NP;
        float c0, s0, c1, s1, d0, e0, d1, e1;
        sincosf(fp * inv128_0, &s0, &c0); sincosf(fp * inv128_1, &s1, &c1);
        sincosf(fp * inv64_0, &e0, &d0); sincosf(fp * inv64_1, &e1, &d1);
#pragma unroll
        for (int which = 0; which < 2; ++which) {
#pragma unroll
            for (int hh = 0; hh < 4; ++hh) {
                unsigned* base = (unsigned*)(row + (which ? PK : PQ) + (2 * hh + hsel) * 128);
                const unsigned a = base[l5], b = base[32 + l5];
                float y0 = bflo(a), y1 = bfhi(a), y2 = bflo(b), y3 = bfhi(b);
                const float ss = half_sum((y0 * y0 + y1 * y1) + (y2 * y2 + y3 * y3));
                const float rstd = rsqrtf(ss * (1.0f / 128.0f) + NORM_EPS) * (which ? 1.0f : QSCALE);
                const float* gg = which ? kg : qg;
                y0 *= rstd * gg[0]; y1 *= rstd * gg[1]; y2 *= rstd * gg[2]; y3 *= rstd * gg[3];
                rope4(y0, y1, y2, y3, c0, s0, c1, s1);
                base[l5] = pk2(y0, y1); base[32 + l5] = pk2(y2, y3);
            }
        }
#pragma unroll
        for (int it = 0; it < 4; ++it) {
            unsigned* base = (unsigned*)(row + PQI + (4 * it + hq) * 64);
            const unsigned a = base[l4], b = base[16 + l4];
            float y0 = bflo(a), y1 = bfhi(a), y2 = bflo(b), y3 = bfhi(b);
            rope4(y0, y1, y2, y3, d0, e0, d1, e1);
            base[l4] = pk2(y0, y1); base[16 + l4] = pk2(y2, y3);
        }
        if (lane < 16) {
            const unsigned* base = (const unsigned*)(row + PKI);
            const unsigned a = base[l4], b = base[16 + l4];
            float y0 = bflo(a), y1 = bfhi(a), y2 = bflo(b), y3 = bfhi(b);
            rope4(y0, y1, y2, y3, d0, e0, d1, e1);
            unsigned* o = (unsigned*)(KI + (size_t)t * 64);
            o[l4] = pk2(y0, y1); o[16 + l4] = pk2(y2, y3);
        }
        {
            const bool hp = pos > 0; const bf16_t* prow = row - NP;
            bf16_t* al = AL + (size_t)t * KL;
            float p, pp, sh;
            p = bf2f(row[PDW + lane]); pp = hp ? bf2f(prow[PDW + lane]) : 0.f; sh = p + (pp - p) * mu_dw; al[lane] = (bf16_t)f2bf(tanhf(sh));
            p = bf2f(row[PDA + lane]); pp = hp ? bf2f(prow[PDA + lane]) : 0.f; sh = p + (pp - p) * mu_da; al[64 + lane] = (bf16_t)f2bf(sh);
            p = bf2f(row[PDG + lane]); pp = hp ? bf2f(prow[PDG + lane]) : 0.f; sh = p + (pp - p) * mu_g0; al[128 + lane] = (bf16_t)f2bf(sigmoidf_(sh));
            p = bf2f(row[PDG + 64 + lane]); pp = hp ? bf2f(prow[PDG + 64 + lane]) : 0.f; sh = p + (pp - p) * mu_g1; al[192 + lane] = (bf16_t)f2bf(sigmoidf_(sh));
            if (lane < 32) { p = bf2f(row[PDG + 128 + lane]); pp = hp ? bf2f(prow[PDG + 128 + lane]) : 0.f; sh = p + (pp - p) * mu_g2; al[256 + lane] = (bf16_t)f2bf(sigmoidf_(sh)); }
            al[288 + lane] = 0; if (lane < 32) al[352 + lane] = 0;
        }
    }
}

__device__ __forceinline__ unsigned fkey(float f) { const unsigned u = __builtin_bit_cast(unsigned, f); return (u & 0x80000000u) ? ~u : (u | 0x80000000u); }
__device__ __forceinline__ void phase4(Frame& F) {
    const int lane = F.lane, wave = F.wave;
    const bf16_t* P = (const bf16_t*)(F.ws + WS_P); const bf16_t* KI = (const bf16_t*)(F.ws + WS_KI); unsigned* MSK = (unsigned*)(F.ws + WS_MSK);
    const int r = lane & 31, h = lane >> 5;
    for (int u = F.vcu; u < 1024; u += F.G) {
        const int band = u >> 8, cc = u & 255, s4 = cc >> 4;
        const int i = (band == 0) ? 63 - s4 : (band == 1) ? 32 + s4 : (band == 2) ? 31 - s4 : s4;
        const int b = (cc & 15) >> 2, g = cc & 3;
        const int t0 = b * SEQ + i * 64 + g * 16 + 2 * wave;
        const int njt = 2 * (i + 1);
        bf16x8 a[4];
        { const bf16_t* ap = P + (size_t)(t0 + ((r >> 2) & 1)) * NP + PQI + ((r & 3) + 4 * (r >> 3)) * 64 + 8 * h;
#pragma unroll
          for (int s = 0; s < 4; ++s) a[s] = *(const bf16x8*)(ap + 16 * s); }
        float wq[16];
        { const bf16_t* wp = P + (size_t)(t0 + h) * NP + PWI;
#pragma unroll
          for (int e = 0; e < 16; ++e) wq[e] = bf2f(wp[e]) * (1.0f / 32.0f); }
        unsigned sc[128];
        const bf16_t* kp = KI + ((size_t)b * SEQ + r) * 64 + 8 * h;
#pragma unroll
        for (int j = 0; j < 128; ++j) {
            if (j < njt) {
                bf16x8 bb[4];
#pragma unroll
                for (int s = 0; s < 4; ++s) bb[s] = *(const bf16x8*)(kp + (size_t)j * 32 * 64 + 16 * s);
                f32x16 acc = {0.f, 0.f, 0.f, 0.f, 0.f, 0.f, 0.f, 0.f, 0.f, 0.f, 0.f, 0.f, 0.f, 0.f, 0.f, 0.f};
#pragma unroll
                for (int s = 0; s < 4; ++s) acc = __builtin_amdgcn_mfma_f32_32x32x16_bf16(a[s], bb[s], acc, 0, 0, 0);
                float sum = 0.f;
#pragma unroll
                for (int e = 0; e < 16; ++e) sum += wq[e] * fmaxf(acc[e], 0.f);
                sc[j] = fkey(sum);
            } else sc[j] = 0u;
        }
        unsigned thr = 0u;
        if (njt > 8) {
            for (int bit = 31; bit >= 0; --bit) {
                const unsigned cand = thr | (1u << bit);
                int cnt = 0;
#pragma unroll
                for (int j = 0; j < 128; ++j) if (j < njt) cnt += (sc[j] >= cand) ? 1 : 0;
#pragma unroll
                for (int o = 1; o < 32; o <<= 1) cnt += __shfl_xor(cnt, o);
                if (cnt >= 256) thr = cand;
            }
        }
        unsigned m0a = 0u, m0b = 0u, m1a = 0u, m1b = 0u;
#pragma unroll
        for (int j = 0; j < 128; ++j) {
            const bool pred = (j < njt) && (sc[j] >= thr);
            const unsigned long long bal = __ballot(pred);
            const unsigned lo = (unsigned)bal, hi = (unsigned)(bal >> 32);
            if (j < 64) { m0a = (lane == j) ? lo : m0a; m1a = (lane == j) ? hi : m1a; }
            else { m0b = (lane == j - 64) ? lo : m0b; m1b = (lane == j - 64) ? hi : m1b; }
        }
        MSK[(size_t)t0 * 128 + lane] = m0a; MSK[(size_t)t0 * 128 + 64 + lane] = m0b;
        MSK[(size_t)(t0 + 1) * 128 + lane] = m1a; MSK[(size_t)(t0 + 1) * 128 + 64 + lane] = m1b;
    }
}

__device__ __forceinline__ void attn_task_naive(Frame& F, int task, unsigned char* wl) {
    const int lane = F.lane;
    const bf16_t* P = (const bf16_t*)(F.ws + WS_P); const unsigned* MSK = (const unsigned*)(F.ws + WS_MSK); bf16_t* Y = (bf16_t*)(F.ws + WS_YCAT);
    int* list = (int*)wl; float* qs = (float*)(wl + 1024); float* ps = (float*)(wl + 1536);
    const int t = task >> 3, hd = task & 7, b = t >> 12, i = (t & (SEQ - 1)) >> 6;
    const int ntile = i + 1;
    int cnt = 0;
    for (int jj = 0; jj < ntile; ++jj) {
        const unsigned w0 = MSK[(size_t)t * 128 + 2 * jj], w1 = MSK[(size_t)t * 128 + 2 * jj + 1];
        const unsigned long long m = (unsigned long long)w0 | ((unsigned long long)w1 << 32);
        const int pre = __popcll(m & ((1ull << lane) - 1ull));
        if (((m >> lane) & 1ull) && (cnt + pre < 256)) list[cnt + pre] = 64 * jj + lane;
        cnt += __popcll(m);
    }
    const int nsel = cnt < 256 ? cnt : 256;
    { const bf16_t* qp = P + (size_t)t * NP + PQ + hd * 128; qs[lane] = bf2f(qp[lane]); qs[64 + lane] = bf2f(qp[64 + lane]); }
    LDS_WAIT(); asm volatile("" ::: "memory");
    float lg[4]; float mx = -INFINITY;
#pragma unroll
    for (int rr = 0; rr < 4; ++rr) {
        const int e = lane + 64 * rr; lg[rr] = -INFINITY;
        if (e < nsel) { const int key = list[e]; const u32x4* kp = (const u32x4*)(P + ((size_t)b * SEQ + key) * NP + PK + hd * 128); float d = 0.f;
#pragma unroll
            for (int c = 0; c < 16; ++c) { const u32x4 kv = kp[c]; const float* q = qs + 8 * c;
                d += q[0] * bflo(kv.x) + q[1] * bfhi(kv.x) + q[2] * bflo(kv.y) + q[3] * bfhi(kv.y) + q[4] * bflo(kv.z) + q[5] * bfhi(kv.z) + q[6] * bflo(kv.w) + q[7] * bfhi(kv.w); }
            lg[rr] = d; mx = fmaxf(mx, d); }
    }
#pragma unroll
    for (int o = 1; o < 64; o <<= 1) mx = fmaxf(mx, __shfl_xor(mx, o));
    float sum = 0.f;
#pragma unroll
    for (int rr = 0; rr < 4; ++rr) { const int e = lane + 64 * rr; const float p = (e < nsel) ? exp2f(lg[rr] - mx) : 0.f; ps[e] = p; sum += p; }
    sum = wave_sum(sum);
    LDS_WAIT(); asm volatile("" ::: "memory");
    float o0 = 0.f, o1 = 0.f;
    const bf16_t* vb = P + (size_t)b * SEQ * NP + PV + hd * 128 + 2 * lane;
    for (int e = 0; e < nsel; ++e) { const int key = list[e]; const float p = ps[e]; const unsigned v = *(const unsigned*)(vb + (size_t)key * NP); o0 += p * bflo(v); o1 += p * bfhi(v); }
    const float inv = 1.0f / sum;
    *(unsigned*)(Y + (size_t)t * DM + hd * 128 + 2 * lane) = pk2(o0 * inv, o1 * inv);
    LDS_WAIT(); asm volatile("" ::: "memory");
}

__device__ __forceinline__ void rwkv_scan_naive(Frame& F, int bh, unsigned char* wl) {
    const int lane = F.lane, b = bh >> 4, hd = bh & 15, ch = hd * 64 + lane;
    const bf16_t* P = (const bf16_t*)(F.ws + WS_P); const bf16_t* L3 = (const bf16_t*)(F.ws + WS_L3); bf16_t* Y = (bf16_t*)(F.ws + WS_YCAT);
    const float* mix = F.in[I_MIX];
    const float mu_r = mix[ch], mu_k = mix[1088 + ch], mu_v = mix[2112 + ch];
    const float kkc = F.in[I_KK][ch], kac = F.in[I_KA][ch], rkc = F.in[I_RK][ch], lnw = F.in[I_LNW][ch], lnb = F.in[I_LNB][ch];
    float* vec = (float*)wl;
    f32x4 S4[16];
#pragma unroll
    for (int k = 0; k < 16; ++k) S4[k] = (f32x4){0.f, 0.f, 0.f, 0.f};
    float prev_r = 0.f, prev_k = 0.f, prev_v = 0.f;
    constexpr int PF = 4;
    float in_r[PF], in_k[PF], in_v[PF], in_ld[PF], in_a[PF], in_g[PF];
    const bf16_t* prow = P + (size_t)b * SEQ * NP + ch; const bf16_t* lrow = L3 + (size_t)b * SEQ * NL + ch;
#pragma unroll
    for (int j = 0; j < PF; ++j) { const bf16_t* pr = prow + (size_t)j * NP; const bf16_t* lr = lrow + (size_t)j * NL;
        in_r[j] = bf2f(pr[PR]); in_k[j] = bf2f(pr[PKR]); in_v[j] = bf2f(pr[PVR]); in_ld[j] = bf2f(lr[0]); in_a[j] = bf2f(lr[1024]); in_g[j] = bf2f(lr[2048]); }
    const f32x4* vec4 = (const f32x4*)vec;
    for (int tb = 0; tb < SEQ; tb += PF) {
        float c_r[PF], c_k[PF], c_v[PF], c_ld[PF], c_a[PF], c_g[PF];
#pragma unroll
        for (int j = 0; j < PF; ++j) { c_r[j] = in_r[j]; c_k[j] = in_k[j]; c_v[j] = in_v[j]; c_ld[j] = in_ld[j]; c_a[j] = in_a[j]; c_g[j] = in_g[j]; }
        {
            const int tn = (tb + PF < SEQ) ? tb + PF : tb;
#pragma unroll
            for (int j = 0; j < PF; ++j) { const bf16_t* pr = prow + (size_t)(tn + j) * NP; const bf16_t* lr = lrow + (size_t)(tn + j) * NL;
                in_r[j] = bf2f(pr[PR]); in_k[j] = bf2f(pr[PKR]); in_v[j] = bf2f(pr[PVR]); in_ld[j] = bf2f(lr[0]); in_a[j] = bf2f(lr[1024]); in_g[j] = bf2f(lr[2048]); }
        }
#pragma unroll
        for (int j = 0; j < PF; ++j) {
            const float r_t = c_r[j] + (prev_r - c_r[j]) * mu_r, k_t = c_k[j] + (prev_k - c_k[j]) * mu_k, v_t = c_v[j] + (prev_v - c_v[j]) * mu_v;
            prev_r = c_r[j]; prev_k = c_k[j]; prev_v = c_v[j];
            const float a = c_a[j];
            const float kkr = k_t * kkc; const float n2 = wave_sum(kkr * kkr); const float kk = kkr * (1.0f / fmaxf(sqrtf(n2), 1e-12f));
            const float kp = k_t * (1.0f + (a - 1.0f) * kac); const float w = __expf(c_ld[j]); const float bb = kk * a;
            vec[lane] = -kk; vec[64 + lane] = w; vec[128 + lane] = bb; vec[192 + lane] = kp; vec[256 + lane] = r_t;
            LDS_WAIT(); asm volatile("" ::: "memory");
            f32x4 sa4 = (f32x4){0.f, 0.f, 0.f, 0.f};
#pragma unroll
            for (int k = 0; k < 16; ++k) { sa4 += S4[k] * vec4[k]; if ((k & 3) == 3) asm volatile("" ::: "memory"); }
            const float sa = (sa4.x + sa4.y) + (sa4.z + sa4.w);
            f32x4 y4 = (f32x4){0.f, 0.f, 0.f, 0.f};
#pragma unroll
            for (int k = 0; k < 16; ++k) {
                const f32x4 wv = vec4[16 + k], bv = vec4[32 + k], kv = vec4[48 + k], rv = vec4[64 + k];
                S4[k] = S4[k] * wv + bv * sa + kv * v_t; y4 += S4[k] * rv;
                if (k & 1) asm volatile("" ::: "memory"); }
            const float y = (y4.x + y4.y) + (y4.z + y4.w);
            const float mean = wave_sum(y) * (1.0f / 64.0f); const float dv = y - mean; const float var = wave_sum(dv * dv) * (1.0f / 64.0f);
            const float yn = dv * rsqrtf(var + GN_EPS) * lnw + lnb;
            const float bonus = wave_sum(r_t * kp * rkc) * v_t;
            const float o = (yn + bonus) * c_g[j];
            Y[((size_t)b * SEQ + tb + j) * DM + 1024 + ch] = (bf16_t)f2bf(o);
            asm volatile("" ::: "memory");
        }
    }
}

__device__ __forceinline__ void phase5(Frame& F) {
    unsigned char* wl = F.ldsg + F.wave * 4096;
    const int nscan = F.G >= 64 ? 64 : 0;
#ifndef NO_SCAN
    if (nscan && F.wave == 0 && F.vcu < 64) { rwkv_scan_naive(F, F.vcu, wl); return; }
#endif
    int idx, nw;
    if (nscan) { nw = 8 * F.G - 64; idx = (F.wave >= 1) ? F.vcu * 7 + (F.wave - 1) : 7 * F.G + (F.vcu - 64); }
    else { nw = 8 * F.G; idx = F.vcu * 8 + F.wave;
#ifndef NO_SCAN
        if (idx < 64) rwkv_scan_naive(F, idx, wl);
#endif
    }
#ifndef NO_ATTN
    for (int task = idx; task < T * 8; task += nw) attn_task_naive(F, task, wl);
#endif
}

struct RouteRec { int cls, pos; float g_lo, g_hi, rstd; int pad0, pad1, pad2; };
__device__ __forceinline__ void phase7(Frame& F) {
    const int gw = F.vcu * 8 + F.wave, NGW = F.G * 8, lane = F.lane;
    { int* rowtok = (int*)(F.ws + WS_ROWTOK); for (int i = gw * 64 + lane; i < MPAD; i += NGW * 64) rowtok[i] = -1; }
    { LAS float* scr = (LAS float*)(F.lds + F.wave * 16384);
      bf16_t* WGU = (bf16_t*)(F.ws + WS_WGU); bf16_t* WDN = (bf16_t*)(F.ws + WS_WDN);
      constexpr int IG = (DM / 64) * (512 / 32), ID = (512 / 64) * (DM / 32);
      for (int it = gw; it < 16 * (2 * IG + ID); it += NGW) { const int e = it / (2 * IG + ID); int r = it % (2 * IG + ID);
          if (r < IG) transpose_item<2>(F.in[I_WEG] + (size_t)e * DM * 512, 512, WGU + (size_t)e * 1024 * DM, DM, scr, r / 16, r % 16, lane);
          else if (r < 2 * IG) { r -= IG; transpose_item<3>(F.in[I_WEU] + (size_t)e * DM * 512, 512, WGU + (size_t)e * 1024 * DM, DM, scr, r / 16, r % 16, lane); }
          else { r -= 2 * IG; transpose_item<0>(F.in[I_WED] + (size_t)e * 512 * DM, DM, WDN + (size_t)e * DM * 512, 512, scr, r / 64, r % 64, lane); } } }
    const float* x1 = F.out; const float* gf = F.in[I_GFFN]; const f32x4* wrg = (const f32x4*)F.in[I_WRG]; const f32x4* wre = (const f32x4*)F.in[I_WRE];
    RouteRec* rr = (RouteRec*)(F.ws + WS_ROUTE); unsigned* cnt = F.ctl + CW_CNT;
    for (int t = gw; t < T; t += NGW) {
        const f32x4* xr = (const f32x4*)(x1 + (size_t)t * DM) + lane; f32x4 v[8]; float s = 0.f;
#pragma unroll
        for (int j = 0; j < 8; ++j) { v[j] = xr[64 * j]; s += (v[j].x * v[j].x + v[j].y * v[j].y) + (v[j].z * v[j].z + v[j].w * v[j].w); }
        const float rstd = rsqrtf(wave_sum(s) * (1.f / DM) + NORM_EPS);
        float lg[20];
#pragma unroll
        for (int o = 0; o < 20; ++o) lg[o] = 0.f;
#pragma unroll
        for (int j = 0; j < 8; ++j) { const f32x4 g4 = ((const f32x4*)gf)[64 * j + lane];
            asm volatile("" ::: "memory");
#pragma unroll
            for (int e = 0; e < 4; ++e) { const int k = 4 * (64 * j + lane) + e; const float hv = v[j][e] * rstd * g4[e];
                const f32x4 wg = wrg[k]; lg[0] += hv * wg.x; lg[1] += hv * wg.y; lg[2] += hv * wg.z; lg[3] += hv * wg.w;
#pragma unroll
                for (int q = 0; q < 4; ++q) { const f32x4 we = wre[4 * k + q]; lg[4 + 4 * q] += hv * we.x; lg[5 + 4 * q] += hv * we.y; lg[6 + 4 * q] += hv * we.z; lg[7 + 4 * q] += hv * we.w; } } }
#pragma unroll
        for (int o = 0; o < 20; ++o) lg[o] = wave_sum(lg[o]);
        float gl[4]; float gm = -INFINITY;
#pragma unroll
        for (int o = 0; o < 4; ++o) { gl[o] = lg[o] + F.in[I_BRG][o]; gm = fmaxf(gm, gl[o]); }
        float gs = 0.f; int gsel = 0; float gbest = -INFINITY;
#pragma unroll
        for (int o = 0; o < 4; ++o) { gs += __expf(gl[o] - gm); if (gl[o] > gbest) { gbest = gl[o]; gsel = o; } }
        const float pgrp = __expf(gbest - gm) / gs;
        float el[4]; float em = -INFINITY;
#pragma unroll
        for (int q = 0; q < 4; ++q) { float vsel = 0.f;
#pragma unroll
            for (int g2 = 0; g2 < 4; ++g2) vsel = (gsel == g2) ? lg[4 + 4 * g2 + q] + F.in[I_BRE][4 * g2 + q] : vsel;
            el[q] = vsel; em = fmaxf(em, vsel); }
        int i1 = 0; float b1 = -INFINITY;
#pragma unroll
        for (int q = 0; q < 4; ++q) if (el[q] > b1) { b1 = el[q]; i1 = q; }
        int i2 = 0; float b2 = -INFINITY;
#pragma unroll
        for (int q = 0; q < 4; ++q) if (q != i1 && el[q] > b2) { b2 = el[q]; i2 = q; }
        const float p1 = __expf(b1 - em), p2 = __expf(b2 - em); const float inv = 1.0f / (p1 + p2);
        const float gw1 = pgrp * p1 * inv, gw2 = pgrp * p2 * inv;
        const int elo = i1 < i2 ? i1 : i2, ehi = i1 < i2 ? i2 : i1; const float glo = i1 < i2 ? gw1 : gw2, ghi = i1 < i2 ? gw2 : gw1;
        const int pair = (elo == 0) ? (ehi - 1) : (elo == 1 ? ehi + 1 : 5);
        const int cls = gsel * 6 + pair;
        if (lane == 0) { const unsigned pos = atomicAdd(&cnt[cls], 1u); RouteRec r; r.cls = cls; r.pos = (int)pos; r.g_lo = glo; r.g_hi = ghi; r.rstd = rstd; r.pad0 = r.pad1 = r.pad2 = 0; rr[t] = r; }
    }
}

__device__ __forceinline__ void class_bases(Frame& F, volatile LAS int* tb) {
    if (F.tid == 0) { int acc = 0; for (int c = 0; c < NCLS; ++c) { tb[c] = acc; const int n = (int)__hip_atomic_load(F.ctl + CW_CNT + c, __ATOMIC_RELAXED, __HIP_MEMORY_SCOPE_AGENT); acc += (n + 255) & ~255; } tb[NCLS] = acc; }
    __syncthreads();
}

__device__ __forceinline__ void phase8(Frame& F) {
    const int gw = F.vcu * 8 + F.wave, NGW = F.G * 8, lane = F.lane;
    volatile LAS int* tb = (volatile LAS int*)(F.lds + MISC_OFF + 128);
    class_bases(F, tb);
    const float* x1 = F.out; const float* gf = F.in[I_GFFN];
    const RouteRec* rr = (const RouteRec*)(F.ws + WS_ROUTE); int* rowtok = (int*)(F.ws + WS_ROWTOK); float* gates = (float*)(F.ws + WS_ROWTOK + 128 * 1024);
    bf16_t* H2S = (bf16_t*)(F.ws + WS_H2S);
    f32x4 gv[8];
#pragma unroll
    for (int j = 0; j < 8; ++j) gv[j] = ((const f32x4*)gf)[64 * j + lane];
    for (int t = gw; t < T; t += NGW) {
        const RouteRec r = rr[t]; const int row = tb[r.cls] + r.pos;
        const f32x4* xr = (const f32x4*)(x1 + (size_t)t * DM) + lane; u32x2* o = (u32x2*)(H2S + (size_t)row * DM) + lane;
#pragma unroll
        for (int j = 0; j < 8; ++j) { const f32x4 v = xr[64 * j]; u32x2 w; w.x = pk2(v.x * r.rstd * gv[j].x, v.y * r.rstd * gv[j].y); w.y = pk2(v.z * r.rstd * gv[j].z, v.w * r.rstd * gv[j].w); o[64 * j] = w; }
        if (lane == 0) { rowtok[row] = t; gates[2 * row] = r.g_lo; gates[2 * row + 1] = r.g_hi; }
    }
    for (int idx = gw; idx < NCLS * 256; idx += NGW) { const int c = idx >> 8, off = idx & 255; const int n = (int)__hip_atomic_load(F.ctl + CW_CNT + c, __ATOMIC_RELAXED, __HIP_MEMORY_SCOPE_AGENT);
        const int row = tb[c] + n + off;
        if (row < tb[c + 1]) { u32x2* o = (u32x2*)(H2S + (size_t)row * DM) + lane;
#pragma unroll
            for (int j = 0; j < 8; ++j) o[64 * j] = (u32x2){0u, 0u};
            if (lane == 0) { gates[2 * row] = 0.f; gates[2 * row + 1] = 0.f; } } }
}

__device__ __forceinline__ int class_of_tile(volatile LAS int* tb, int rt) { int c = 0; const int r0 = rt * 256; for (int k = 1; k < NCLS; ++k) c = (r0 >= tb[k]) ? k : c; return c; }
__device__ __forceinline__ int class_expert(int cls, int half) { const int g = cls / 6, p = cls % 6; const int elo = p < 3 ? 0 : (p < 5 ? 1 : 2); const int ehi = p < 3 ? p + 1 : (p < 5 ? p - 1 : 3); return 4 * g + (half ? ehi : elo); }
struct Moe1Sched {
    volatile LAS int* tb; const char* A; const char* B; int G, c, nu;
    __device__ bool seg(int i, pg8::Seg& s) const { const int L = i * G + c; if (L >= nu) return false; const int rt = L >> 3, pn = L & 7; const int cls = class_of_tile(tb, rt); const int e = class_expert(cls, pn >> 2);
        s.A = A + (size_t)rt * 256 * DM * 2; s.B = B + ((size_t)e * 1024 + (pn & 3) * 256) * DM * 2; s.u.pm = rt; s.u.pn = pn; s.u.aux = 0; s.last = 1; return true; }
};
struct Moe2Sched {
    volatile LAS int* tb; const char* A; const char* B; int G, c, nu;
    __device__ bool seg(int i, pg8::Seg& s) const { const int ui = i >> 1, half = i & 1; const int L = ui * G + c; if (L >= nu) return false; const int rt = L >> 3, pn = L & 7; const int cls = class_of_tile(tb, rt); const int e = class_expert(cls, half);
        s.A = A + ((size_t)rt * 256 * 1024 + half * 512) * 2; s.B = B + ((size_t)e * DM + pn * 256) * 512 * 2; s.u.pm = rt; s.u.pn = pn; s.u.aux = 0; s.last = half; return true; }
};

constexpr int NPHASE = 11;
__global__ void __launch_bounds__(512, 2) fwd_kernel(Args args) {
    extern __shared__ __attribute__((aligned(16))) unsigned char lds_raw[];
    Frame F;
    F.lds = (LAS unsigned char*)lds_raw; F.ldsg = lds_raw;
    F.tid = threadIdx.x; F.lane = F.tid & 63; F.wave = __builtin_amdgcn_readfirstlane(F.tid >> 6);
    F.G = gridDim.x; { const int bx = blockIdx.x; F.vcu = (F.G % 8 == 0) ? (bx % 8) * (F.G / 8) + bx / 8 : bx; }
    F.in = args.in; F.out = args.out; F.ws = args.ws; F.ctl = (unsigned*)(args.ws + WS_CTL);
    volatile LAS unsigned* MISC = (volatile LAS unsigned*)(F.lds + MISC_OFF);
    for (int u = F.tid; u < (LDS_BYTES - LDSCTL_OFF) / 4; u += 512) ((LAS unsigned*)(F.lds + LDSCTL_OFF))[u] = 0u;
    __syncthreads();
    const int lo = args.ph_lo, hi = args.ph_hi;
    const bool multi = (hi - lo) > 1;
    XcdBarrier bar; bar.bar = F.ctl + CW_BAR; bar.x = 0; bar.st = nullptr;
    if (multi) bar = xcd_barrier_post(F.ctl + CW_BAR, MISC + 8);
#ifndef PH_MASK
#define PH_MASK 0x7ff
#endif
#define IN(k) (((PH_MASK >> (k)) & 1) && lo <= (k) && (k) < hi)
#define SEAM(k) do { if (IN(k) && IN((k) + 1)) xcd_barrier(bar); } while (0)
    unsigned char* ws = args.ws;
    bf16_t* P = (bf16_t*)(ws + WS_P);

    if (IN(0)) { phase0(F); SEAM(0); }
    if (IN(1)) {
        pg8::PlainSched S; S.init((const bf16_t*)(ws + WS_HN), (const bf16_t*)(ws + WS_WIN), T, NP, DM, DM, F.G, (int)blockIdx.x);
        pg8::EpiBf16 E{P, NP};
        pg8::gemm_phase<pg8::EpiBf16, pg8::PlainSched, true>(F.lds, DM, DM, DM / 64, S, E);
        SEAM(1);
    }
    if (IN(2)) { phase2(F); SEAM(2); }
    if (IN(3)) {
        pg8::PlainSched S; S.init((const bf16_t*)(ws + WS_ALORA), (const bf16_t*)(ws + WS_WLORA), T, NL, KL, KL, F.G, (int)blockIdx.x);
        pg8::EpiLora E{(bf16_t*)(ws + WS_L3), F.in[I_W0], F.in[I_A0]};
        pg8::gemm_phase<pg8::EpiLora, pg8::PlainSched, true>(F.lds, KL, KL, KL / 64, S, E);
        SEAM(3);
    }
    if (IN(4)) { phase4(F); SEAM(4); }
    if (IN(5)) { phase5(F); SEAM(5); }
    if (IN(6)) {
        pg8::PlainSched S; S.init((const bf16_t*)(ws + WS_YCAT), (const bf16_t*)(ws + WS_WOUT), T, DM, DM, DM, F.G, (int)blockIdx.x);
        pg8::EpiResF32 E{F.in[I_X], F.out, DM};
        pg8::gemm_phase<pg8::EpiResF32, pg8::PlainSched, true>(F.lds, DM, DM, DM / 64, S, E);
        SEAM(6);
    }
    if (IN(7)) { phase7(F); SEAM(7); }
    if (IN(8)) { phase8(F); SEAM(8); }
    if (IN(9)) {
        volatile LAS int* tb = (volatile LAS int*)(F.lds + MISC_OFF + 128);
        class_bases(F, tb);
        Moe1Sched S; S.tb = tb; S.A = (const char*)(ws + WS_H2S); S.B = (const char*)(ws + WS_WGU); S.G = F.G; S.c = (int)blockIdx.x; S.nu = (tb[NCLS] >> 8) * 8;
        pg8::EpiMoe1 E{(bf16_t*)(ws + WS_HS), (const float*)(ws + WS_ROWTOK + 128 * 1024)};
        pg8::gemm_phase<pg8::EpiMoe1, Moe1Sched, true>(F.lds, DM, DM, DM / 64, S, E);
        SEAM(9);
    }
    if (IN(10)) {
        volatile LAS int* tb = (volatile LAS int*)(F.lds + MISC_OFF + 128);
        class_bases(F, tb);
        Moe2Sched S; S.tb = tb; S.A = (const char*)(ws + WS_HS); S.B = (const char*)(ws + WS_WDN); S.G = F.G; S.c = (int)blockIdx.x; S.nu = (tb[NCLS] >> 8) * 8;
        pg8::EpiMoe2 E{F.out, (const int*)(ws + WS_ROWTOK)};
        pg8::gemm_phase<pg8::EpiMoe2, Moe2Sched, true>(F.lds, 1024, 512, 512 / 64, S, E);
    }
#undef IN
#undef SEAM
}

extern "C" void kernel_launch(void* const* d_in, const int* in_sizes, int n_in, void* d_out, int out_size, void* d_ws, size_t ws_size, hipStream_t stream) {
    static int grid = 0;
    if (grid == 0) {
        if (n_in != 25 || in_sizes[0] != T * DM || out_size != T * DM || ws_size < WS_END) { fprintf(stderr, "kernel_launch: unexpected shapes (n_in %d, in0 %d, out %d, ws %zu)\n", n_in, n_in > 0 ? in_sizes[0] : -1, out_size, ws_size); grid = -1; return; }
        int dev = 0, cus = 0, per_cu = 0;
        if (hipGetDevice(&dev) != hipSuccess || hipDeviceGetAttribute(&cus, hipDeviceAttributeMultiprocessorCount, dev) != hipSuccess) { grid = -1; return; }
        if (hipFuncSetAttribute((const void*)fwd_kernel, hipFuncAttributeMaxDynamicSharedMemorySize, LDS_BYTES) != hipSuccess) { fprintf(stderr, "kernel_launch: hipFuncSetAttribute failed\n"); grid = -1; return; }
        if (hipOccupancyMaxActiveBlocksPerMultiprocessor(&per_cu, (const void*)fwd_kernel, 512, LDS_BYTES) != hipSuccess || per_cu < 1) { fprintf(stderr, "kernel_launch: occupancy query says %d blocks per CU\n", per_cu); (void)hipGetLastError(); grid = -1; return; }
        grid = cus;
    }
    if (grid < 0) return;
    (void)hipMemsetAsync((char*)d_ws + WS_CTL, 0, CTL_ZERO_BYTES, stream);
    Args a{};
    for (int i = 0; i < 25; ++i) a.in[i] = (const float*)d_in[i];
    a.out = (float*)d_out; a.ws = (unsigned char*)d_ws;
#if MK_SINGLE
    a.ph_lo = 0; a.ph_hi = NPHASE;
    void* kargs[] = {&a};
    hipError_t e = hipLaunchCooperativeKernel((const void*)fwd_kernel, dim3(grid), dim3(512), kargs, LDS_BYTES, stream);
    if (e != hipSuccess) fprintf(stderr, "kernel_launch: cooperative launch failed: %s (grid %d)\n", hipGetErrorString(e), grid);
#else
    for (int p = 0; p < NPHASE; ++p) { a.ph_lo = p; a.ph_hi = p + 1; hipLaunchKernelGGL(fwd_kernel, dim3(grid), dim3(512), LDS_BYTES, stream, a); }
#endif
}
```

```cpp
#include <hip/hip_runtime.h>
#include <hip/hip_cooperative_groups.h>
#include <cstdio>
#include <cstdint>
#include <cmath>

#ifndef MK_SINGLE
#define MK_SINGLE 1
#endif

#define GAS __attribute__((address_space(1)))
#define LAS __attribute__((address_space(3)))
typedef unsigned short bf16_t;
typedef short bf16x8 __attribute__((ext_vector_type(8)));
typedef float f32x4 __attribute__((ext_vector_type(4)));
typedef float f32x16 __attribute__((ext_vector_type(16)));
typedef float f32x2 __attribute__((ext_vector_type(2)));
typedef unsigned u32x4 __attribute__((ext_vector_type(4)));
typedef unsigned u32x2 __attribute__((ext_vector_type(2)));

constexpr int BATCH = 4, SEQ = 4096, DM = 2048, T = BATCH * SEQ;
constexpr int NP = 7680;
constexpr int PQ = 0, PK = 1024, PV = 2048, PQI = 3072, PKI = 4096, PWI = 4160, PDW = 4224, PDA = 4288, PR = 4352, PKR = 5376, PVR = 6400, PDG = 7424;
constexpr int IN_COLS = 7536, DSA_COLS = 4176;
constexpr int KL = 384, NL = 3072;
constexpr int MPAD = 22528;
constexpr int NCLS = 24;
constexpr float NORM_EPS = 1e-6f, GN_EPS = 64e-5f;
constexpr float QSCALE = 0.08838834764831845f * 1.4426950408889634f;

constexpr size_t MiB = 1u << 20;
constexpr size_t WS_CTL = 0, CTL_ZERO_BYTES = 1 * MiB;
constexpr size_t WS_WLORA = 1 * MiB;
constexpr size_t WS_WOUT = 4 * MiB;
constexpr size_t WS_MSK = 12 * MiB;
constexpr size_t WS_KI = 20 * MiB;
constexpr size_t WS_ROUTE = 22 * MiB;
constexpr size_t WS_ROWTOK = 23 * MiB;
constexpr size_t WS_ALORA = 24 * MiB;
constexpr size_t WS_WIN = 36 * MiB;
constexpr size_t WS_HN = 66 * MiB;
constexpr size_t WS_YCAT = WS_HN;
constexpr size_t WS_L3 = 130 * MiB;
constexpr size_t WS_P = 226 * MiB;
constexpr size_t WS_H2S = 226 * MiB;
constexpr size_t WS_HS = 314 * MiB;
constexpr size_t WS_WGU = 358 * MiB;
constexpr size_t WS_WDN = 422 * MiB;
constexpr size_t WS_MT = 24 * MiB;
constexpr size_t WS_BON = 56 * MiB;
constexpr size_t WS_SA = 466 * MiB;
constexpr size_t WS_END = 498 * MiB;
constexpr int CW_CNT = 64;
constexpr int CW_BAR = 4096;

constexpr int RING_BYTES = 131072;
constexpr int LDSCTL_OFF = RING_BYTES, MISC_OFF = LDSCTL_OFF + 320;
constexpr int LDS_BYTES = 147456;

#define LDS_WAIT() asm volatile("s_waitcnt lgkmcnt(0)" ::: "memory")
#define VM_WAIT() asm volatile("s_waitcnt vmcnt(0)" ::: "memory")
__device__ __forceinline__ unsigned f2bf(float f) { unsigned u = __builtin_bit_cast(unsigned, f); return (u + 0x7fffu + ((u >> 16) & 1u)) >> 16; }
__device__ __forceinline__ unsigned pk2(float lo, float hi) { return f2bf(lo) | (f2bf(hi) << 16); }
__device__ __forceinline__ float bf2f(unsigned short h) { return __builtin_bit_cast(float, (unsigned)h << 16); }
__device__ __forceinline__ float bflo(unsigned w) { return __builtin_bit_cast(float, w << 16); }
__device__ __forceinline__ float bfhi(unsigned w) { return __builtin_bit_cast(float, w & 0xffff0000u); }
__device__ __forceinline__ float wave_sum(float v) {
#pragma unroll
    for (int o = 1; o < 64; o <<= 1) v += __shfl_xor(v, o);
    return v;
}
__device__ __forceinline__ float half_sum(float v) {
#pragma unroll
    for (int o = 1; o < 32; o <<= 1) v += __shfl_xor(v, o);
    return v;
}
__device__ __forceinline__ float sigmoidf_(float x) { return 1.0f / (1.0f + __expf(-x)); }

namespace pg8 {
constexpr int BM = 256, BK = 64, HALF = 128, HTB = HALF * BK * 2, STAGE_BYTES = 8 * HTB, NXCD = 8, WGM = 8;
__host__ __device__ __forceinline__ int lds_byte(int r, int c) { const int st = (r >> 4) * 2 + (c >> 5), rr = r & 15, cc = c & 31, ob = rr * 64 + cc * 2; return st * 1024 + (ob ^ (((ob >> 9) & 1) << 5)); }
__host__ __device__ __forceinline__ void stage_rc(int b, int& R, int& C) { const int st = b / 1024, sb = b % 1024, swz = sb ^ (((sb >> 9) & 1) << 5); R = (st >> 1) * 16 + swz / 64; C = (st & 1) * 32 + (swz % 64) / 2; }
__host__ __device__ __forceinline__ int perm32(int rho) { const int n = rho >> 4, i = rho & 15; return 8 * (i >> 2) + 4 * n + (i & 3); }

struct Unit { int pm, pn, aux; };
struct Seg { const char* A; const char* B; Unit u; int last; };

struct TileOrder {
    int nM, nN, nwg, G, c;
    __device__ void init(int nM_, int nN_, int G_, int c_) { nM = nM_; nN = nN_; nwg = nM * nN; G = G_; c = c_; }
    __device__ bool next(int i, int& pm, int& pn) const {
        const long L = (long)i * G + c; if (L >= nwg) return false;
        int wgid = (int)L; { const int q = nwg / NXCD, r = nwg % NXCD, xcd = wgid % NXCD, off = wgid / NXCD; wgid = (xcd < r ? xcd * (q + 1) : r * (q + 1) + (xcd - r) * q) + off; }
        const int nig = WGM * nN, gid = wgid / nig, fm = gid * WGM, gsz = (nM - fm) < WGM ? (nM - fm) : WGM;
        pm = fm + ((wgid % nig) % gsz); pn = (wgid % nig) / gsz; return true;
    }
};
struct PlainSched {
    TileOrder o; const char* A; const char* B; size_t tA, tB;
    __device__ void init(const bf16_t* A_, const bf16_t* B_, int M, int N, int lda, int ldb, int G, int c) { o.init(M / BM, N / BM, G, c); A = (const char*)A_; B = (const char*)B_; tA = (size_t)BM * lda * 2; tB = (size_t)BM * ldb * 2; }
    __device__ bool seg(int i, Seg& s) const { int pm, pn; if (!o.next(i, pm, pn)) return false; s.A = A + pm * tA; s.B = B + pn * tB; s.u.pm = pm; s.u.pn = pn; s.u.aux = 0; s.last = 1; return true; }
};

__device__ __forceinline__ unsigned cvt_pk_bf16(float lo, float hi) { unsigned r; asm volatile("v_cvt_pk_bf16_f32 %0, %1, %2" : "=v"(r) : "v"(lo), "v"(hi)); return r; }

typedef f32x4 Acc[2][2][4][2];

template <class Epi, class Sched, bool ALIGN_EPI>
__device__ __forceinline__ void gemm_phase(LAS unsigned char* lds, const int lda, const int ldb, const int nt, const Sched& S, const Epi& E) {
    const int tid = threadIdx.x, wid = __builtin_amdgcn_readfirstlane(tid >> 6), lane = tid & 63, wr = wid >> 2, wc = wid & 3, fr = lane & 15, fq = lane >> 4;
    unsigned voffA[2], voffB[2];
#pragma unroll
    for (int i = 0; i < 2; ++i) { int R, C; stage_rc(tid * 16 + i * 8192, R, C); const int Rb = Epi::PERM ? ((R & ~31) + perm32(R & 31)) : R;
        voffA[i] = (unsigned)(R * lda + C) * 2u; voffB[i] = (unsigned)(Rb * ldb + C) * 2u; }
    const size_t kstep = (size_t)(BK * 2);
    const size_t hstepA = (size_t)HALF * lda * 2, hstepB = (size_t)HALF * ldb * 2;
    const unsigned ldsw = (unsigned)wid * 1024u;
    const int aoff = lds_byte(wr * 64 + fr, fq * 8), boff = lds_byte(wc * 32 + fr, fq * 8);
#define PG8_SA(b, h) (((b) * 2 + (h)) * HTB)
#define PG8_SB(b, h) ((4 + (b) * 2 + (h)) * HTB)
#define PG8_STAGE(bufoff, gbase, voff) do { _Pragma("unroll") for (int _i = 0; _i < 2; ++_i) \
        __builtin_amdgcn_global_load_lds((const unsigned*)((const char*)(gbase) + (voff)[_i]), (LAS unsigned*)(lds + (bufoff) + ldsw + _i * 8192), 16, 0, 0); } while (0)
#define PG8_LDA(dst, b, h) do { _Pragma("unroll") for (int m = 0; m < 4; ++m) _Pragma("unroll") for (int k = 0; k < 2; ++k) dst[m][k] = *(const LAS bf16x8*)(lds + PG8_SA(b, h) + aoff + m * 2048 + k * 1024); } while (0)
#define PG8_LDB(dst, b, h) do { _Pragma("unroll") for (int n = 0; n < 2; ++n) _Pragma("unroll") for (int k = 0; k < 2; ++k) dst[n][k] = *(const LAS bf16x8*)(lds + PG8_SB(b, h) + boff + n * 2048 + k * 1024); } while (0)
#define PG8_MMA(ai, bj, At, Bt) do { __builtin_amdgcn_s_setprio(1); _Pragma("unroll") for (int m = 0; m < 4; ++m) _Pragma("unroll") for (int n = 0; n < 2; ++n) _Pragma("unroll") for (int k = 0; k < 2; ++k) \
        acc[ai][bj][m][n] = __builtin_amdgcn_mfma_f32_16x16x32_bf16(Bt[n][k], At[m][k], acc[ai][bj][m][n], 0, 0, 0); __builtin_amdgcn_s_setprio(0); } while (0)
#define PG8_WAIT_V(n) asm volatile("s_waitcnt vmcnt(" #n ")" ::: "memory")
#define PG8_WAIT_L(n) asm volatile("s_waitcnt lgkmcnt(" #n ")" ::: "memory")
#define PG8_BAR __builtin_amdgcn_s_barrier()
#define PG8_SCHED __builtin_amdgcn_sched_barrier(0)
#define PG8_ZERO() do { _Pragma("unroll") for (int a = 0; a < 2; ++a) _Pragma("unroll") for (int b = 0; b < 2; ++b) _Pragma("unroll") for (int m = 0; m < 4; ++m) _Pragma("unroll") for (int n = 0; n < 2; ++n) acc[a][b][m][n] = (f32x4){0.f, 0.f, 0.f, 0.f}; } while (0)
    Seg cur, nxt; int qi = 0;
    if (!S.seg(0, cur)) return;
    Acc acc;
    PG8_ZERO();
    bf16x8 At[4][2], B0[2][2], B1[2][2];
    const char* cA = cur.A; const char* cB = cur.B;
    PG8_STAGE(PG8_SB(0, 0), cB, voffB); PG8_STAGE(PG8_SB(0, 1), cB + hstepB, voffB); PG8_STAGE(PG8_SA(0, 0), cA, voffA); PG8_STAGE(PG8_SA(0, 1), cA + hstepA, voffA);
    if (wr == 1) PG8_BAR;
    PG8_WAIT_V(2); PG8_BAR;
    PG8_STAGE(PG8_SB(1, 0), cB + kstep, voffB); PG8_STAGE(PG8_SA(1, 0), cA + kstep, voffA); PG8_STAGE(PG8_SB(1, 1), cB + hstepB + kstep, voffB);
    PG8_WAIT_V(6); PG8_BAR;
    for (;;) {
        bool has_next; const char* nA; const char* nB;
        for (;;) {
        has_next = S.seg(qi + 1, nxt);
        nA = has_next ? nxt.A : cA; nB = has_next ? nxt.B : cB;
#pragma unroll 1
        for (int t = 0; t < nt; t += 2) {
            const bool last = (t == nt - 2);
            const char* a1 = cA + (size_t)(t + 1) * kstep;
            const char* a2 = last ? nA : cA + (size_t)(t + 2) * kstep; const char* b2 = last ? nB : cB + (size_t)(t + 2) * kstep;
            const char* a3 = a2 + kstep; const char* b3 = b2 + kstep;
            PG8_LDB(B0, 0, 0); PG8_LDB(B1, 0, 1); PG8_SCHED; PG8_LDA(At, 0, 0); PG8_STAGE(PG8_SA(1, 1), a1 + hstepA, voffA);
            PG8_WAIT_V(8); PG8_WAIT_L(0); PG8_BAR; PG8_MMA(0, 0, At, B0); PG8_MMA(0, 1, At, B1); PG8_BAR; PG8_SCHED;
            PG8_LDA(At, 0, 1); PG8_STAGE(PG8_SB(0, 0), b2, voffB); PG8_STAGE(PG8_SB(0, 1), b2 + hstepB, voffB); PG8_STAGE(PG8_SA(0, 0), a2, voffA);
            PG8_WAIT_V(8); PG8_WAIT_L(0); PG8_BAR; PG8_MMA(1, 0, At, B0); PG8_MMA(1, 1, At, B1); PG8_BAR; PG8_SCHED;
            PG8_LDB(B0, 1, 0); PG8_LDB(B1, 1, 1); PG8_SCHED; PG8_LDA(At, 1, 0); PG8_STAGE(PG8_SA(0, 1), a2 + hstepA, voffA);
            PG8_WAIT_V(8); PG8_WAIT_L(0); PG8_BAR; PG8_MMA(0, 0, At, B0); PG8_MMA(0, 1, At, B1); PG8_BAR; PG8_SCHED;
            PG8_LDA(At, 1, 1); PG8_STAGE(PG8_SB(1, 0), b3, voffB); PG8_STAGE(PG8_SB(1, 1), b3 + hstepB, voffB); PG8_STAGE(PG8_SA(1, 0), a3, voffA);
            PG8_WAIT_V(8); PG8_WAIT_L(0); PG8_BAR; PG8_MMA(1, 0, At, B0); PG8_MMA(1, 1, At, B1); PG8_BAR; PG8_SCHED;
        }
        if (cur.last || !has_next) break;
        cur = nxt; cA = nA; cB = nB; ++qi;
        }
        if constexpr (ALIGN_EPI) { if (wr == 0) PG8_BAR; }
        E(acc, cur.u, wr, wc, fr, fq);
        if (!has_next) break;
        PG8_ZERO();
        cur = nxt; cA = nA; cB = nB; ++qi;
        if constexpr (ALIGN_EPI) { if (wr == 1) PG8_BAR; }
    }
    PG8_WAIT_V(0);
    if constexpr (!ALIGN_EPI) { if (wr == 0) PG8_BAR; }
    PG8_BAR;
#undef PG8_SA
#undef PG8_SB
#undef PG8_STAGE
#undef PG8_LDA
#undef PG8_LDB
#undef PG8_MMA
#undef PG8_WAIT_V
#undef PG8_WAIT_L
#undef PG8_BAR
#undef PG8_SCHED
#undef PG8_ZERO
}

struct EpiBf16 {
    static constexpr bool PERM = true;
    bf16_t* O; int ldc;
    __device__ __forceinline__ void operator()(const Acc& acc, const Unit& u, int wr, int wc, int fr, int fq) const {
        const int row0 = u.pm * BM + wr * 64 + fr; const int col0 = u.pn * BM + wc * 32 + 8 * fq;
#pragma unroll
        for (int ai = 0; ai < 2; ++ai)
#pragma unroll
            for (int m = 0; m < 4; ++m) { bf16_t* rowp = O + (size_t)(row0 + ai * HALF + m * 16) * ldc + col0;
#pragma unroll
                for (int bj = 0; bj < 2; ++bj) { const f32x4 v0 = acc[ai][bj][m][0], v1 = acc[ai][bj][m][1];
                    u32x4 w; w.x = cvt_pk_bf16(v0[0], v0[1]); w.y = cvt_pk_bf16(v0[2], v0[3]); w.z = cvt_pk_bf16(v1[0], v1[1]); w.w = cvt_pk_bf16(v1[2], v1[3]);
                    *(u32x4*)(rowp + bj * HALF) = w; } }
    }
};
struct EpiLora {
    static constexpr bool PERM = true;
    bf16_t* O; const float* w0; const float* a0;
    __device__ __forceinline__ void operator()(const Acc& acc, const Unit& u, int wr, int wc, int fr, int fq) const {
        const int row0 = u.pm * BM + wr * 64 + fr; const int col0 = u.pn * BM + wc * 32 + 8 * fq; const int typ = u.pn >> 2;
        const float* bsrc = (typ == 0) ? w0 : a0;
        const float mul = (typ == 0) ? -0.6065306597126334f : 1.0f; const bool lin = (typ == 2);
#pragma unroll
        for (int bj = 0; bj < 2; ++bj) {
            const int ch = (col0 + bj * HALF) & 1023;
            const f32x4 b0 = *(const f32x4*)(bsrc + ch), b1 = *(const f32x4*)(bsrc + ch + 4);
#pragma unroll
            for (int ai = 0; ai < 2; ++ai)
#pragma unroll
                for (int m = 0; m < 4; ++m) {
                    f32x4 v0 = acc[ai][bj][m][0], v1 = acc[ai][bj][m][1];
                    {
                        const f32x4 s0 = v0 + b0, s1 = v1 + b1;
                        v0.x = lin ? v0.x : mul * sigmoidf_(s0.x); v0.y = lin ? v0.y : mul * sigmoidf_(s0.y); v0.z = lin ? v0.z : mul * sigmoidf_(s0.z); v0.w = lin ? v0.w : mul * sigmoidf_(s0.w);
                        v1.x = lin ? v1.x : mul * sigmoidf_(s1.x); v1.y = lin ? v1.y : mul * sigmoidf_(s1.y); v1.z = lin ? v1.z : mul * sigmoidf_(s1.z); v1.w = lin ? v1.w : mul * sigmoidf_(s1.w);
                    }
                    u32x4 w; w.x = cvt_pk_bf16(v0.x, v0.y); w.y = cvt_pk_bf16(v0.z, v0.w); w.z = cvt_pk_bf16(v1.x, v1.y); w.w = cvt_pk_bf16(v1.z, v1.w);
                    *(u32x4*)(O + (size_t)(row0 + ai * HALF + m * 16) * NL + col0 + bj * HALF) = w;
                    asm volatile("" ::: "memory"); }
        }
    }
};
struct EpiResF32 {
    static constexpr bool PERM = false;
    const float* base; float* out; int ldc;
    __device__ __forceinline__ void operator()(const Acc& acc, const Unit& u, int wr, int wc, int fr, int fq) const {
        const int col0 = u.pn * BM + wc * 32 + 4 * fq;
#pragma unroll
        for (int ai = 0; ai < 2; ++ai)
#pragma unroll
            for (int m = 0; m < 4; ++m) { const size_t off = (size_t)(u.pm * BM + ai * HALF + wr * 64 + m * 16 + fr) * ldc + col0;
#pragma unroll
                for (int bj = 0; bj < 2; ++bj)
#pragma unroll
                    for (int n = 0; n < 2; ++n) { const f32x4 bs = *(const f32x4*)(base + off + bj * HALF + n * 16); *(f32x4*)(out + off + bj * HALF + n * 16) = bs + acc[ai][bj][m][n]; } }
    }
};
struct EpiMoe1 {
    static constexpr bool PERM = true;
    bf16_t* O; const float* gates;
    __device__ __forceinline__ void operator()(const Acc& acc, const Unit& u, int wr, int wc, int fr, int fq) const {
        const int row0 = u.pm * BM + wr * 64 + fr; const int half = u.pn >> 2; const int col0 = half * 512 + (u.pn & 3) * 128 + wc * 32 + 8 * fq;
#pragma unroll
        for (int ai = 0; ai < 2; ++ai)
#pragma unroll
            for (int m = 0; m < 4; ++m) { const int row = row0 + ai * HALF + m * 16; const float gw = gates[(size_t)row * 2 + half];
                float v[8];
#pragma unroll
                for (int e = 0; e < 8; ++e) { const float g = acc[ai][0][m][e >> 2][e & 3], up = acc[ai][1][m][e >> 2][e & 3]; v[e] = g * sigmoidf_(g) * up * gw; }
                u32x4 w; w.x = cvt_pk_bf16(v[0], v[1]); w.y = cvt_pk_bf16(v[2], v[3]); w.z = cvt_pk_bf16(v[4], v[5]); w.w = cvt_pk_bf16(v[6], v[7]);
                *(u32x4*)(O + (size_t)row * 1024 + col0) = w; }
    }
};
struct EpiMoe2 {
    static constexpr bool PERM = false;
    float* out; const int* rowtok;
    __device__ __forceinline__ void operator()(const Acc& acc, const Unit& u, int wr, int wc, int fr, int fq) const {
        const int col0 = u.pn * BM + wc * 32 + 4 * fq;
#pragma unroll
        for (int ai = 0; ai < 2; ++ai)
#pragma unroll
            for (int m = 0; m < 4; ++m) { const int row = u.pm * BM + ai * HALF + wr * 64 + m * 16 + fr; const int tok = rowtok[row];
                if (tok >= 0) { float* o = out + (size_t)tok * DM + col0;
#pragma unroll
                    for (int bj = 0; bj < 2; ++bj)
#pragma unroll
                        for (int n = 0; n < 2; ++n) { f32x4* p = (f32x4*)(o + bj * HALF + n * 16); *p = *p + acc[ai][bj][m][n]; } }
                asm volatile("" ::: "memory"); }
    }
};
}

#define XB_TMO      128
#define XB_XCNT(j)  (256  + 64 * (j))
#define XB_XSUB(j)  (1280 + 64 * (j))
#define XB_XGEN(j)  (2304 + 64 * (j))
#define XB_TOP      3328
#define XB_TOPGEN   3392
#define XCD_BAR_WORDS 3456
#define XB_SPIN_CAP (1u << 20)
__device__ __forceinline__ unsigned xb_ld(unsigned* p)              { return __hip_atomic_load(p, __ATOMIC_RELAXED, __HIP_MEMORY_SCOPE_AGENT); }
__device__ __forceinline__ unsigned xb_add(unsigned* p, unsigned v) { return __hip_atomic_fetch_add(p, v, __ATOMIC_RELAXED, __HIP_MEMORY_SCOPE_AGENT); }
__device__ __forceinline__ unsigned xb_xcc_id() { return (unsigned)__builtin_amdgcn_s_getreg((3 << 11) | 20) & 0xFu; }
#define XB_SPIN(cond, bar) do { unsigned _sp = 0; while (cond) { __builtin_amdgcn_s_sleep(1); \
    if ((++_sp & 255u) == 0u) { if (xb_ld(&(bar)[XB_TMO])) break; if (_sp > XB_SPIN_CAP) { atomicAdd(&(bar)[XB_TMO], 1u); break; } } } } while (0)
struct XcdBarrier { unsigned* bar; unsigned x; volatile LAS unsigned* st; };
__device__ __forceinline__ XcdBarrier xcd_barrier_post(unsigned* bar, volatile LAS unsigned* st) {
    XcdBarrier b; b.bar = bar; b.x = xb_xcc_id(); b.st = st;
    if (threadIdx.x == 0) (void)xb_add(&bar[XB_XCNT(b.x)], 1u);
    return b;
}
__device__ __forceinline__ void xcd_barrier_complete(unsigned* bar, unsigned x, unsigned& nloc, unsigned& nx) {
    const unsigned G = gridDim.x * gridDim.y * gridDim.z;
    unsigned sum, cnt, mine, sp = 0u;
    for (;;) {
        sum = 0u; cnt = 0u; mine = 0u;
#pragma unroll
        for (unsigned j = 0; j < 16; ++j) { const unsigned c = xb_ld(&bar[XB_XCNT(j)]); sum += c; cnt += (c > 0u) ? 1u : 0u; mine = (j == x) ? c : mine; }
        if (sum == G) break;
        __builtin_amdgcn_s_sleep(1);
        if ((++sp & 255u) == 0u) { if (xb_ld(&bar[XB_TMO])) break; if (sp > XB_SPIN_CAP) { atomicAdd(&bar[XB_TMO], 1u); break; } }
    }
    nloc = mine > 0u ? mine : 1u; nx = cnt > 0u ? cnt : 1u;
}
__device__ __forceinline__ void xcd_barrier(const XcdBarrier& b) {
    asm volatile("s_waitcnt vmcnt(0)" ::: "memory");
    __syncthreads();
    if (threadIdx.x == 0) {
        unsigned* bar = b.bar;
        __builtin_amdgcn_s_waitcnt(0);
        unsigned nloc = b.st[0], nx = b.st[1];
        if (nloc == 0u) { xcd_barrier_complete(bar, b.x, nloc, nx); b.st[0] = nloc; b.st[1] = nx; }
        const unsigned old = xb_add(&bar[XB_XSUB(b.x)], 1u);
        const unsigned gen = old / nloc;
        if (old + 1u == (gen + 1u) * nloc) {
            __builtin_amdgcn_fence(__ATOMIC_RELEASE, "agent");
            asm volatile("s_waitcnt vmcnt(0)" ::: "memory");
            const unsigned og = xb_add(&bar[XB_TOP], 1u);
            const unsigned tg = og / nx;
            if (og + 1u == (tg + 1u) * nx) xb_add(&bar[XB_TOPGEN], 1u);
            else XB_SPIN(xb_ld(&bar[XB_TOPGEN]) == tg, bar);
            __builtin_amdgcn_fence(__ATOMIC_ACQUIRE, "agent");
            xb_add(&bar[XB_XGEN(b.x)], 1u);
            asm volatile("s_waitcnt vmcnt(0)" ::: "memory");
        } else {
            XB_SPIN(xb_ld(&bar[XB_XGEN(b.x)]) == gen, bar);
            __builtin_amdgcn_fence(__ATOMIC_ACQUIRE, "agent");
            asm volatile("s_waitcnt vmcnt(0)" ::: "memory");
        }
    }
    __syncthreads();
}

struct Args { const float* in[25]; float* out; unsigned char* ws; int ph_lo, ph_hi; };
enum { I_X = 0, I_GMIX, I_WIN, I_MIX, I_QG, I_KG, I_W0, I_WDEC, I_A0, I_WAICL, I_WGATE, I_KK, I_KA, I_RK, I_LNW, I_LNB, I_WOUT, I_GFFN, I_WRG, I_BRG, I_WRE, I_BRE, I_WEG, I_WEU, I_WED };

struct Frame {
    LAS unsigned char* lds; unsigned char* ldsg;
    unsigned* ctl;
    int tid, lane, wave, vcu, G;
    const float* const* in; float* out; unsigned char* ws;
};

__device__ __forceinline__ int win_dmap(int n) {
    if (n < DSA_COLS) return n;
    const int m = n - DSA_COLS;
    if (m < 1024) return PR + m;
    if (m < 1088) return PDW + (m - 1024);
    if (m < 2112) return PKR + (m - 1088);
    if (m < 3136) return PVR + (m - 2112);
    if (m < 3200) return PDA + (m - 3136);
    return PDG + (m - 3200);
}
template <int MODE>
__device__ __forceinline__ void transpose_item(const float* W, int N, bf16_t* WT, int ldd, LAS float* scr, int kb, int nb, int lane) {
    const int k0 = 64 * kb, n0 = 32 * nb;
    const int nn = n0 + (lane & 31);
#pragma unroll 8
    for (int i = 0; i < 32; ++i) { const int kk = 2 * i + (lane >> 5); scr[kk * 33 + (lane & 31)] = (nn < N) ? W[(size_t)(k0 + kk) * N + nn] : 0.f; }
    LDS_WAIT(); asm volatile("" ::: "memory");
    const int c = lane & 7;
#pragma unroll
    for (int j = 0; j < 4; ++j) { const int nl = (lane >> 3) + 8 * j; const int n = n0 + nl; const LAS float* s = scr + (8 * c) * 33 + nl;
        u32x4 o; o.x = pk2(s[0 * 33], s[1 * 33]); o.y = pk2(s[2 * 33], s[3 * 33]); o.z = pk2(s[4 * 33], s[5 * 33]); o.w = pk2(s[6 * 33], s[7 * 33]);
        int dr = n;
        if (MODE == 1) dr = win_dmap(n);
        if (MODE == 2) dr = (n >> 7) * 256 + (n & 127);
        if (MODE == 3) dr = (n >> 7) * 256 + 128 + (n & 127);
        if (n < N) *(u32x4*)(WT + (size_t)dr * ldd + k0 + 8 * c) = o; }
    LDS_WAIT(); asm volatile("" ::: "memory");
}

__device__ __forceinline__ void phase0(Frame& F) {
    LAS float* scr = (LAS float*)(F.lds + F.wave * 16384);
    const int gw = F.vcu * 8 + F.wave, NGW = F.G * 8, lane = F.lane;
    constexpr int NB_IN = (IN_COLS + 31) / 32;
    constexpr int I_IN = (DM / 64) * NB_IN, I_OUT = (DM / 64) * (DM / 32);
    bf16_t* WIN = (bf16_t*)(F.ws + WS_WIN); bf16_t* WOUT = (bf16_t*)(F.ws + WS_WOUT);
    for (int it = gw; it < I_IN + I_OUT; it += NGW) {
        if (it < I_IN) transpose_item<1>(F.in[I_WIN], IN_COLS, WIN, DM, scr, it / NB_IN, it % NB_IN, lane);
        else { const int r = it - I_IN; transpose_item<0>(F.in[I_WOUT], DM, WOUT, DM, scr, r / (DM / 32), r % (DM / 32), lane); }
    }
    for (int i = gw; i < 144 * 4; i += NGW) { const int r = i >> 2, q = i & 3; const int row = r < 48 ? 4176 + r : 7584 + (r - 48);
        *(u32x4*)(WIN + (size_t)row * DM + q * 512 + lane * 8) = (u32x4){0u, 0u, 0u, 0u}; }
    { bf16_t* WL = (bf16_t*)(F.ws + WS_WLORA); const float* wd = F.in[I_WDEC]; const float* wa = F.in[I_WAICL]; const float* wg = F.in[I_WGATE];
      for (int i = gw * 64 + lane; i < NL * KL; i += NGW * 64) { const int n = i / KL, k = i % KL; const int typ = n >> 10, c = n & 1023; float v = 0.f;
          if (typ == 0 && k < 64) v = wd[k * 1024 + c];
          else if (typ == 1 && k >= 64 && k < 128) v = wa[(k - 64) * 1024 + c];
          else if (typ == 2 && k >= 128 && k < 288) v = wg[(k - 128) * 1024 + c];
          WL[i] = (bf16_t)f2bf(v); } }
    { const float* x = F.in[I_X]; const float* g = F.in[I_GMIX]; bf16_t* HN = (bf16_t*)(F.ws + WS_HN);
      f32x4 gv[8];
#pragma unroll
      for (int j = 0; j < 8; ++j) gv[j] = ((const f32x4*)g)[64 * j + lane];
      for (int m = gw; m < T; m += NGW) { const f32x4* xr = (const f32x4*)(x + (size_t)m * DM) + lane; f32x4 v[8]; float s = 0.f;
#pragma unroll
          for (int j = 0; j < 8; ++j) { v[j] = xr[64 * j]; s += (v[j].x * v[j].x + v[j].y * v[j].y) + (v[j].z * v[j].z + v[j].w * v[j].w); }
          const float rstd = rsqrtf(wave_sum(s) * (1.f / DM) + NORM_EPS);
          u32x2* o = (u32x2*)(HN + (size_t)m * DM) + lane;
#pragma unroll
          for (int j = 0; j < 8; ++j) { u32x2 w; w.x = pk2(v[j].x * rstd * gv[j].x, v[j].y * rstd * gv[j].y); w.y = pk2(v[j].z * rstd * gv[j].z, v[j].w * rstd * gv[j].w); o[64 * j] = w; } } }
}

__device__ __forceinline__ void rope4(float& y0, float& y1, float& y2, float& y3, float c0, float s0, float c1, float s1) {
    const float o0 = y0 * c0 - y2 * s0, o2 = y2 * c0 + y0 * s0, o1 = y1 * c1 - y3 * s1, o3 = y3 * c1 + y1 * s1; y0 = o0; y1 = o1; y2 = o2; y3 = o3;
}
__device__ __forceinline__ void phase2(Frame& F) {
    const int gw = F.vcu * 8 + F.wave, NGW = F.G * 8, lane = F.lane;
    bf16_t* P = (bf16_t*)(F.ws + WS_P); bf16_t* KI = (bf16_t*)(F.ws + WS_KI); bf16_t* AL = (bf16_t*)(F.ws + WS_ALORA);
    const float* mix = F.in[I_MIX];
    const int l5 = lane & 31, hsel = lane >> 5, l4 = lane & 15, hq = lane >> 4;
    float qg[4], kg[4];
    { const float* a = F.in[I_QG]; const float* b = F.in[I_KG];
      qg[0] = a[2 * l5]; qg[1] = a[2 * l5 + 1]; qg[2] = a[64 + 2 * l5]; qg[3] = a[65 + 2 * l5];
      kg[0] = b[2 * l5]; kg[1] = b[2 * l5 + 1]; kg[2] = b[64 + 2 * l5]; kg[3] = b[65 + 2 * l5]; }
    const float L2T = 13.287712379549449f;
    const float inv128_0 = exp2f(-(float)(2 * l5) * (1.0f / 64.0f) * L2T), inv128_1 = exp2f(-(float)(2 * l5 + 1) * (1.0f / 64.0f) * L2T);
    const float inv64_0 = exp2f(-(float)(2 * l4) * (1.0f / 32.0f) * L2T), inv64_1 = exp2f(-(float)(2 * l4 + 1) * (1.0f / 32.0f) * L2T);
    const float mu_dw = mix[1024 + lane], mu_da = mix[3136 + lane], mu_g0 = mix[3200 + lane], mu_g1 = mix[3264 + lane], mu_g2 = (lane < 32) ? mix[3328 + lane] : 0.f;
    for (int t = gw; t < T; t += NGW) {
        const int pos = t & (SEQ - 1); const float fp = (float)pos;
        bf16_t* row = P + (size_t)t * NP;
        float c0, s0, c1, s1, d0, e0, d1, e1;
        sincosf(fp * inv128_0, &s0, &c0); sincosf(fp * inv128_1, &s1, &c1);
        sincosf(fp * inv64_0, &e0, &d0); sincosf(fp * inv64_1, &e1, &d1);
#pragma unroll
        for (int which = 0; which < 2; ++which) {
#pragma unroll
            for (int hh = 0; hh < 4; ++hh) {
                unsigned* base = (unsigned*)(row + (which ? PK : PQ) + (2 * hh + hsel) * 128);
                const unsigned a = base[l5], b = base[32 + l5];
                float y0 = bflo(a), y1 = bfhi(a), y2 = bflo(b), y3 = bfhi(b);
                const float ss = half_sum((y0 * y0 + y1 * y1) + (y2 * y2 + y3 * y3));
                const float rstd = rsqrtf(ss * (1.0f / 128.0f) + NORM_EPS) * (which ? 1.0f : QSCALE);
                const float* gg = which ? kg : qg;
                y0 *= rstd * gg[0]; y1 *= rstd * gg[1]; y2 *= rstd * gg[2]; y3 *= rstd * gg[3];
                rope4(y0, y1, y2, y3, c0, s0, c1, s1);
                base[l5] = pk2(y0, y1); base[32 + l5] = pk2(y2, y3);
            }
        }
#pragma unroll
        for (int it = 0; it < 4; ++it) {
            unsigned* base = (unsigned*)(row + PQI + (4 * it + hq) * 64);
            const unsigned a = base[l4], b = base[16 + l4];
            float y0 = bflo(a), y1 = bfhi(a), y2 = bflo(b), y3 = bfhi(b);
            rope4(y0, y1, y2, y3, d0, e0, d1, e1);
            base[l4] = pk2(y0, y1); base[16 + l4] = pk2(y2, y3);
        }
        if (lane < 16) {
            const unsigned* base = (const unsigned*)(row + PKI);
            const unsigned a = base[l4], b = base[16 + l4];
            float y0 = bflo(a), y1 = bfhi(a), y2 = bflo(b), y3 = bfhi(b);
            rope4(y0, y1, y2, y3, d0, e0, d1, e1);
            unsigned* o = (unsigned*)(KI + (size_t)t * 64);
            o[l4] = pk2(y0, y1); o[16 + l4] = pk2(y2, y3);
        }
        {
            const bool hp = pos > 0; const bf16_t* prow = row - NP;
            bf16_t* al = AL + (size_t)t * KL;
            float p, pp, sh;
            p = bf2f(row[PDW + lane]); pp = hp ? bf2f(prow[PDW + lane]) : 0.f; sh = p + (pp - p) * mu_dw; al[lane] = (bf16_t)f2bf(tanhf(sh));
            p = bf2f(row[PDA + lane]); pp = hp ? bf2f(prow[PDA + lane]) : 0.f; sh = p + (pp - p) * mu_da; al[64 + lane] = (bf16_t)f2bf(sh);
            p = bf2f(row[PDG + lane]); pp = hp ? bf2f(prow[PDG + lane]) : 0.f; sh = p + (pp - p) * mu_g0; al[128 + lane] = (bf16_t)f2bf(sigmoidf_(sh));
            p = bf2f(row[PDG + 64 + lane]); pp = hp ? bf2f(prow[PDG + 64 + lane]) : 0.f; sh = p + (pp - p) * mu_g1; al[192 + lane] = (bf16_t)f2bf(sigmoidf_(sh));
            if (lane < 32) { p = bf2f(row[PDG + 128 + lane]); pp = hp ? bf2f(prow[PDG + 128 + lane]) : 0.f; sh = p + (pp - p) * mu_g2; al[256 + lane] = (bf16_t)f2bf(sigmoidf_(sh)); }
            al[288 + lane] = 0; if (lane < 32) al[352 + lane] = 0;
        }
    }
}

__device__ __forceinline__ unsigned fkey(float f) { const unsigned u = __builtin_bit_cast(unsigned, f); return (u & 0x80000000u) ? ~u : (u | 0x80000000u); }
__device__ __forceinline__ void phase4(Frame& F) {
    const int lane = F.lane, wave = F.wave;
    const bf16_t* P = (const bf16_t*)(F.ws + WS_P); const bf16_t* KI = (const bf16_t*)(F.ws + WS_KI); unsigned* MSK = (unsigned*)(F.ws + WS_MSK);
    const int r = lane & 31, h = lane >> 5;
    for (int u = F.vcu; u < 1024; u += F.G) {
        const int band = u >> 8, cc = u & 255, s4 = cc >> 4;
        const int i = (band == 0) ? 63 - s4 : (band == 1) ? 32 + s4 : (band == 2) ? 31 - s4 : s4;
        const int b = (cc & 15) >> 2, g = cc & 3;
        const int t0 = b * SEQ + i * 64 + g * 16 + 2 * wave;
        const int njt = 2 * (i + 1);
        bf16x8 a[4];
        { const bf16_t* ap = P + (size_t)(t0 + ((r >> 2) & 1)) * NP + PQI + ((r & 3) + 4 * (r >> 3)) * 64 + 8 * h;
#pragma unroll
          for (int s = 0; s < 4; ++s) a[s] = *(const bf16x8*)(ap + 16 * s); }
        float wq[16];
        { const bf16_t* wp = P + (size_t)(t0 + h) * NP + PWI;
#pragma unroll
          for (int e = 0; e < 16; ++e) wq[e] = bf2f(wp[e]) * (1.0f / 32.0f); }
        unsigned sc[128];
        const bf16_t* kp = KI + ((size_t)b * SEQ + r) * 64 + 8 * h;
#pragma unroll
        for (int j = 0; j < 128; ++j) {
            if (j < njt) {
                bf16x8 bb[4];
#pragma unroll
                for (int s = 0; s < 4; ++s) bb[s] = *(const bf16x8*)(kp + (size_t)j * 32 * 64 + 16 * s);
                f32x16 acc = {0.f, 0.f, 0.f, 0.f, 0.f, 0.f, 0.f, 0.f, 0.f, 0.f, 0.f, 0.f, 0.f, 0.f, 0.f, 0.f};
#pragma unroll
                for (int s = 0; s < 4; ++s) acc = __builtin_amdgcn_mfma_f32_32x32x16_bf16(a[s], bb[s], acc, 0, 0, 0);
                float sum = 0.f;
#pragma unroll
                for (int e = 0; e < 16; ++e) sum += wq[e] * fmaxf(acc[e], 0.f);
                sc[j] = fkey(sum);
            } else sc[j] = 0u;
        }
        unsigned thr = 0u;
        if (njt > 8) {
            for (int bit = 31; bit >= 0; --bit) {
                const unsigned cand = thr | (1u << bit);
                int cnt = 0;
#pragma unroll
                for (int j = 0; j < 128; ++j) if (j < njt) cnt += (sc[j] >= cand) ? 1 : 0;
#pragma unroll
                for (int o = 1; o < 32; o <<= 1) cnt += __shfl_xor(cnt, o);
                if (cnt >= 256) thr = cand;
            }
        }
        unsigned m0a = 0u, m0b = 0u, m1a = 0u, m1b = 0u;
#pragma unroll
        for (int j = 0; j < 128; ++j) {
            const bool pred = (j < njt) && (sc[j] >= thr);
            const unsigned long long bal = __ballot(pred);
            const unsigned lo = (unsigned)bal, hi = (unsigned)(bal >> 32);
            if (j < 64) { m0a = (lane == j) ? lo : m0a; m1a = (lane == j) ? hi : m1a; }
            else { m0b = (lane == j - 64) ? lo : m0b; m1b = (lane == j - 64) ? hi : m1b; }
        }
        MSK[(size_t)t0 * 128 + lane] = m0a; MSK[(size_t)t0 * 128 + 64 + lane] = m0b;
        MSK[(size_t)(t0 + 1) * 128 + lane] = m1a; MSK[(size_t)(t0 + 1) * 128 + 64 + lane] = m1b;
    }
}

__device__ __forceinline__ void attn_task_naive(Frame& F, int task, unsigned char* wl) {
    const int lane = F.lane;
    const bf16_t* P = (const bf16_t*)(F.ws + WS_P); const unsigned* MSK = (const unsigned*)(F.ws + WS_MSK); bf16_t* Y = (bf16_t*)(F.ws + WS_YCAT);
    int* list = (int*)wl; float* qs = (float*)(wl + 1024); float* ps = (float*)(wl + 1536);
    const int t = task >> 3, hd = task & 7, b = t >> 12, i = (t & (SEQ - 1)) >> 6;
    const int ntile = i + 1;
    int cnt = 0;
    for (int jj = 0; jj < ntile; ++jj) {
        const unsigned w0 = MSK[(size_t)t * 128 + 2 * jj], w1 = MSK[(size_t)t * 128 + 2 * jj + 1];
        const unsigned long long m = (unsigned long long)w0 | ((unsigned long long)w1 << 32);
        const int pre = __popcll(m & ((1ull << lane) - 1ull));
        if (((m >> lane) & 1ull) && (cnt + pre < 256)) list[cnt + pre] = 64 * jj + lane;
        cnt += __popcll(m);
    }
    const int nsel = cnt < 256 ? cnt : 256;
    { const bf16_t* qp = P + (size_t)t * NP + PQ + hd * 128; qs[lane] = bf2f(qp[lane]); qs[64 + lane] = bf2f(qp[64 + lane]); }
    LDS_WAIT(); asm volatile("" ::: "memory");
    float lg[4]; float mx = -INFINITY;
#pragma unroll
    for (int rr = 0; rr < 4; ++rr) {
        const int e = lane + 64 * rr; lg[rr] = -INFINITY;
        if (e < nsel) { const int key = list[e]; const u32x4* kp = (const u32x4*)(P + ((size_t)b * SEQ + key) * NP + PK + hd * 128); float d = 0.f;
#pragma unroll
            for (int c = 0; c < 16; ++c) { const u32x4 kv = kp[c]; const float* q = qs + 8 * c;
                d += q[0] * bflo(kv.x) + q[1] * bfhi(kv.x) + q[2] * bflo(kv.y) + q[3] * bfhi(kv.y) + q[4] * bflo(kv.z) + q[5] * bfhi(kv.z) + q[6] * bflo(kv.w) + q[7] * bfhi(kv.w); }
            lg[rr] = d; mx = fmaxf(mx, d); }
    }
#pragma unroll
    for (int o = 1; o < 64; o <<= 1) mx = fmaxf(mx, __shfl_xor(mx, o));
    float sum = 0.f;
#pragma unroll
    for (int rr = 0; rr < 4; ++rr) { const int e = lane + 64 * rr; const float p = (e < nsel) ? exp2f(lg[rr] - mx) : 0.f; ps[e] = p; sum += p; }
    sum = wave_sum(sum);
    LDS_WAIT(); asm volatile("" ::: "memory");
    float o0 = 0.f, o1 = 0.f;
    const bf16_t* vb = P + (size_t)b * SEQ * NP + PV + hd * 128 + 2 * lane;
    for (int e = 0; e < nsel; ++e) { const int key = list[e]; const float p = ps[e]; const unsigned v = *(const unsigned*)(vb + (size_t)key * NP); o0 += p * bflo(v); o1 += p * bfhi(v); }
    const float inv = 1.0f / sum;
    *(unsigned*)(Y + (size_t)t * DM + hd * 128 + 2 * lane) = pk2(o0 * inv, o1 * inv);
    LDS_WAIT(); asm volatile("" ::: "memory");
}

__device__ __forceinline__ void rwkv_scan_naive(Frame& F, int bh, unsigned char* wl) {
    const int lane = F.lane, b = bh >> 4, hd = bh & 15, ch = hd * 64 + lane;
    const bf16_t* P = (const bf16_t*)(F.ws + WS_P); const bf16_t* L3 = (const bf16_t*)(F.ws + WS_L3); bf16_t* Y = (bf16_t*)(F.ws + WS_YCAT);
    const float* mix = F.in[I_MIX];
    const float mu_r = mix[ch], mu_k = mix[1088 + ch], mu_v = mix[2112 + ch];
    const float kkc = F.in[I_KK][ch], kac = F.in[I_KA][ch], rkc = F.in[I_RK][ch], lnw = F.in[I_LNW][ch], lnb = F.in[I_LNB][ch];
    float* vec = (float*)wl;
    f32x4 S4[16];
#pragma unroll
    for (int k = 0; k < 16; ++k) S4[k] = (f32x4){0.f, 0.f, 0.f, 0.f};
    float prev_r = 0.f, prev_k = 0.f, prev_v = 0.f;
    constexpr int PF = 4;
    float in_r[PF], in_k[PF], in_v[PF], in_ld[PF], in_a[PF], in_g[PF];
    const bf16_t* prow = P + (size_t)b * SEQ * NP + ch; const bf16_t* lrow = L3 + (size_t)b * SEQ * NL + ch;
#pragma unroll
    for (int j = 0; j < PF; ++j) { const bf16_t* pr = prow + (size_t)j * NP; const bf16_t* lr = lrow + (size_t)j * NL;
        in_r[j] = bf2f(pr[PR]); in_k[j] = bf2f(pr[PKR]); in_v[j] = bf2f(pr[PVR]); in_ld[j] = bf2f(lr[0]); in_a[j] = bf2f(lr[1024]); in_g[j] = bf2f(lr[2048]); }
    const f32x4* vec4 = (const f32x4*)vec;
    for (int tb = 0; tb < SEQ; tb += PF) {
        float c_r[PF], c_k[PF], c_v[PF], c_ld[PF], c_a[PF], c_g[PF];
#pragma unroll
        for (int j = 0; j < PF; ++j) { c_r[j] = in_r[j]; c_k[j] = in_k[j]; c_v[j] = in_v[j]; c_ld[j] = in_ld[j]; c_a[j] = in_a[j]; c_g[j] = in_g[j]; }
        {
            const int tn = (tb + PF < SEQ) ? tb + PF : tb;
#pragma unroll
            for (int j = 0; j < PF; ++j) { const bf16_t* pr = prow + (size_t)(tn + j) * NP; const bf16_t* lr = lrow + (size_t)(tn + j) * NL;
                in_r[j] = bf2f(pr[PR]); in_k[j] = bf2f(pr[PKR]); in_v[j] = bf2f(pr[PVR]); in_ld[j] = bf2f(lr[0]); in_a[j] = bf2f(lr[1024]); in_g[j] = bf2f(lr[2048]); }
        }
#pragma unroll
        for (int j = 0; j < PF; ++j) {
            const float r_t = c_r[j] + (prev_r - c_r[j]) * mu_r, k_t = c_k[j] + (prev_k - c_k[j]) * mu_k, v_t = c_v[j] + (prev_v - c_v[j]) * mu_v;
            prev_r = c_r[j]; prev_k = c_k[j]; prev_v = c_v[j];
            const float a = c_a[j];
            const float kkr = k_t * kkc; const float n2 = wave_sum(kkr * kkr); const float kk = kkr * (1.0f / fmaxf(sqrtf(n2), 1e-12f));
            const float kp = k_t * (1.0f + (a - 1.0f) * kac); const float w = __expf(c_ld[j]); const float bb = kk * a;
            vec[lane] = -kk; vec[64 + lane] = w; vec[128 + lane] = bb; vec[192 + lane] = kp; vec[256 + lane] = r_t;
            LDS_WAIT(); asm volatile("" ::: "memory");
            f32x4 sa4 = (f32x4){0.f, 0.f, 0.f, 0.f};
#pragma unroll
            for (int k = 0; k < 16; ++k) { sa4 += S4[k] * vec4[k]; if ((k & 3) == 3) asm volatile("" ::: "memory"); }
            const float sa = (sa4.x + sa4.y) + (sa4.z + sa4.w);
            f32x4 y4 = (f32x4){0.f, 0.f, 0.f, 0.f};
#pragma unroll
            for (int k = 0; k < 16; ++k) {
                const f32x4 wv = vec4[16 + k], bv = vec4[32 + k], kv = vec4[48 + k], rv = vec4[64 + k];
                S4[k] = S4[k] * wv + bv * sa + kv * v_t; y4 += S4[k] * rv;
                if (k & 1) asm volatile("" ::: "memory"); }
            const float y = (y4.x + y4.y) + (y4.z + y4.w);
            const float mean = wave_sum(y) * (1.0f / 64.0f); const float dv = y - mean; const float var = wave_sum(dv * dv) * (1.0f / 64.0f);
            const float yn = dv * rsqrtf(var + GN_EPS) * lnw + lnb;
            const float bonus = wave_sum(r_t * kp * rkc) * v_t;
            const float o = (yn + bonus) * c_g[j];
            Y[((size_t)b * SEQ + tb + j) * DM + 1024 + ch] = (bf16_t)f2bf(o);
            asm volatile("" ::: "memory");
        }
    }
}


namespace rw {
constexpr int TP = 72, TILE_B = 64 * TP * 2;
enum { T_ATM = 0, T_RTM, T_BTM, T_KTM, T_ACM, T_VCM, T_BCM, T_KCM, T_MAB, T_MAK, T_MRB, T_MRK, T_TINV, NTILE };
constexpr int T_G1 = T_ATM, T_AP = T_BTM, T_U0 = T_KTM;
constexpr int OFF_X11T = NTILE * TILE_B, OFF_T1T = OFF_X11T + 2560, OFF_SEG = OFF_T1T + 2560, OFF_PC = OFF_SEG + 2048, LDS_END = OFF_PC + 256;
static_assert(LDS_END <= RING_BYTES, "rwkv pass A LDS");
__device__ __forceinline__ int crow(int e, int h) { return (e & 3) + 8 * (e >> 2) + 4 * h; }
__device__ __forceinline__ f32x16 zero16() { return (f32x16){0.f, 0.f, 0.f, 0.f, 0.f, 0.f, 0.f, 0.f, 0.f, 0.f, 0.f, 0.f, 0.f, 0.f, 0.f, 0.f}; }
template <int KS>
__device__ __forceinline__ f32x16 mmt(const LAS bf16_t* A, int ap, int ar0, int ac0, const LAS bf16_t* B, int bp, int br0, int bc0, f32x16 acc, int r, int h) {
    const LAS bf16_t* pa = A + (ar0 + r) * ap + ac0 + 8 * h; const LAS bf16_t* pb = B + (br0 + r) * bp + bc0 + 8 * h;
#pragma unroll
    for (int s = 0; s < KS; ++s) acc = __builtin_amdgcn_mfma_f32_32x32x16_bf16(*(const LAS bf16x8*)(pa + 16 * s), *(const LAS bf16x8*)(pb + 16 * s), acc, 0, 0, 0);
    return acc;
}
__device__ __forceinline__ void store_rm(LAS bf16_t* D, int r0, int c0, const f32x16& acc, int r, int h) {
#pragma unroll
    for (int e = 0; e < 16; ++e) D[(r0 + crow(e, h)) * TP + c0 + r] = (bf16_t)f2bf(acc[e]);
}
__device__ __forceinline__ u32x4 pack8(const f32x16& a, int s) { u32x4 w; w.x = pk2(a[8 * s], a[8 * s + 1]); w.y = pk2(a[8 * s + 2], a[8 * s + 3]); w.z = pk2(a[8 * s + 4], a[8 * s + 5]); w.w = pk2(a[8 * s + 6], a[8 * s + 7]); return w; }
__device__ __forceinline__ void unpack8(const u32x4 w, f32x16& a, int s) { a[8 * s] = bflo(w.x); a[8 * s + 1] = bfhi(w.x); a[8 * s + 2] = bflo(w.y); a[8 * s + 3] = bfhi(w.y); a[8 * s + 4] = bflo(w.z); a[8 * s + 5] = bfhi(w.z); a[8 * s + 6] = bflo(w.w); a[8 * s + 7] = bfhi(w.w); }
__device__ __forceinline__ unsigned char* l3_slot(unsigned char* l3, int tg0, int col0, int bo) { return l3 + ((size_t)(tg0 + (bo >> 7)) * NL + col0) * 2 + (bo & 127); }

__device__ __forceinline__ void pass_a(Frame& F) {
    const int lane = F.lane, wave = F.wave, r = lane & 31, h = lane >> 5;
    LAS bf16_t* tiles = (LAS bf16_t*)F.lds;
#define TL(i) (tiles + (i) * (TILE_B / 2))
    LAS bf16_t* X11T = (LAS bf16_t*)(F.lds + OFF_X11T); LAS bf16_t* T1T = (LAS bf16_t*)(F.lds + OFF_T1T);
    LAS float* seg = (LAS float*)(F.lds + OFF_SEG); LAS float* pc = (LAS float*)(F.lds + OFF_PC);
    const bf16_t* P = (const bf16_t*)(F.ws + WS_P); unsigned char* L3 = F.ws + WS_L3;
    bf16_t* MT = (bf16_t*)(F.ws + WS_MT); bf16_t* SA = (bf16_t*)(F.ws + WS_SA); float* BON = (float*)(F.ws + WS_BON);
    const float* mix = F.in[I_MIX];
    for (int unit = F.vcu; unit < 4096; unit += F.G) {
        const int b = unit >> 10, hd = (unit >> 6) & 15, ci = unit & 63, tg0 = b * SEQ + ci * 64;
        {
            const int c = lane, ch = hd * 64 + c, sg = wave;
            const float mu_r = mix[ch], mu_k = mix[1088 + ch], mu_v = mix[2112 + ch];
            const float kkc = F.in[I_KK][ch], kac = F.in[I_KA][ch], rkc = F.in[I_RK][ch];
            const bf16_t* p0 = P + (size_t)(tg0 + 8 * sg) * NP + ch; const bf16_t* l0 = (const bf16_t*)L3 + (size_t)(tg0 + 8 * sg) * NL + ch;
            float pr, pk, pv;
            if (ci == 0 && sg == 0) { pr = 0.f; pk = 0.f; pv = 0.f; } else { pr = bf2f(p0[PR - NP]); pk = bf2f(p0[PKR - NP]); pv = bf2f(p0[PVR - NP]); }
            float rr[8], kp[8], vv[8], kk[8], bb[8], ld[8], cl[8];
            float run = 0.f;
#pragma unroll
            for (int j = 0; j < 8; ++j) {
                const float cr = bf2f(p0[(size_t)j * NP + PR]), ck = bf2f(p0[(size_t)j * NP + PKR]), cv = bf2f(p0[(size_t)j * NP + PVR]);
                const float l = bf2f(l0[(size_t)j * NL]), a = bf2f(l0[(size_t)j * NL + 1024]);
                const float r_t = cr + (pr - cr) * mu_r, k_t = ck + (pk - ck) * mu_k, v_t = cv + (pv - cv) * mu_v; pr = cr; pk = ck; pv = cv;
                const float kkr = k_t * kkc; const float n2 = wave_sum(kkr * kkr); const float kkn = kkr * (1.0f / fmaxf(sqrtf(n2), 1e-12f));
                const float kpp = k_t * (1.0f + (a - 1.0f) * kac);
                const float bon = wave_sum(r_t * kpp * rkc);
                if (lane == 0) BON[(size_t)(tg0 + 8 * sg + j) * 16 + hd] = bon;
                run += l; rr[j] = r_t; kp[j] = kpp; vv[j] = v_t; kk[j] = kkn; bb[j] = kkn * a; ld[j] = l; cl[j] = run;
            }
            seg[sg * 64 + c] = run;
            __syncthreads();
            float off = 0.f, tot = 0.f;
#pragma unroll
            for (int q = 0; q < 8; ++q) { const float v = seg[q * 64 + c]; tot += v; off += (q < sg) ? v : 0.f; }
            if (sg == 0) pc[c] = __expf(tot);
            float ta[8], tr[8], tb[8], tk[8];
#pragma unroll
            for (int j = 0; j < 8; ++j) { const float lp = off + cl[j]; const float ep = __expf(lp), em = __expf(-lp), epm = __expf(lp - ld[j]);
                ta[j] = -kk[j] * epm; tr[j] = rr[j] * ep; tb[j] = bb[j] * em; tk[j] = kp[j] * em; }
#pragma unroll
            for (int j = 0; j < 8; ++j) { const int o = (8 * sg + j) * TP + c;
                TL(T_ATM)[o] = (bf16_t)f2bf(ta[j]); TL(T_RTM)[o] = (bf16_t)f2bf(tr[j]); TL(T_BTM)[o] = (bf16_t)f2bf(tb[j]); TL(T_KTM)[o] = (bf16_t)f2bf(tk[j]); }
            { const int o = c * TP + 8 * sg;
              *(LAS u32x4*)(TL(T_ACM) + o) = (u32x4){pk2(ta[0], ta[1]), pk2(ta[2], ta[3]), pk2(ta[4], ta[5]), pk2(ta[6], ta[7])};
              *(LAS u32x4*)(TL(T_VCM) + o) = (u32x4){pk2(vv[0], vv[1]), pk2(vv[2], vv[3]), pk2(vv[4], vv[5]), pk2(vv[6], vv[7])};
              *(LAS u32x4*)(TL(T_BCM) + o) = (u32x4){pk2(tb[0], tb[1]), pk2(tb[2], tb[3]), pk2(tb[4], tb[5]), pk2(tb[6], tb[7])};
              *(LAS u32x4*)(TL(T_KCM) + o) = (u32x4){pk2(tk[0], tk[1]), pk2(tk[2], tk[3]), pk2(tk[4], tk[5]), pk2(tk[6], tk[7])}; }
        }
        __syncthreads();
#pragma unroll
        for (int q = 0; q < 2; ++q) {
            const int id = 2 * wave + q, rt = id >> 2, ct = id & 3;
            const LAS bf16_t* Z = (rt < 2) ? TL(T_ATM) : TL(T_RTM); const LAS bf16_t* X = (ct < 2) ? TL(T_BTM) : TL(T_KTM);
            LAS bf16_t* D = (rt < 2) ? ((ct < 2) ? TL(T_MAB) : TL(T_MAK)) : ((ct < 2) ? TL(T_MRB) : TL(T_MRK));
            const int zr0 = (rt & 1) * 32, xr0 = (ct & 1) * 32; const bool strict = rt < 2;
            f32x16 acc = zero16();
            if (xr0 <= zr0) acc = mmt<4>(Z, TP, zr0, 0, X, TP, xr0, 0, acc, r, h);
#pragma unroll
            for (int e = 0; e < 16; ++e) { const int t = zr0 + crow(e, h), i = xr0 + r; const bool keep = strict ? (i < t) : (i <= t); D[t * TP + i] = keep ? (bf16_t)f2bf(acc[e]) : (bf16_t)0; }
        }
        __syncthreads();
        if (wave == 0) {
            const LAS bf16_t* Lm = TL(T_MAB); LAS bf16_t* TI = TL(T_TINV);
            const int n = r, o = 32 * h;
            float x[32];
#pragma unroll
            for (int t = 0; t < 32; ++t) {
                float acc = (t == n) ? 1.0f : 0.0f;
#pragma unroll
                for (int i8 = 0; i8 < (t + 7) / 8; ++i8) { const u32x4 w = *(const LAS u32x4*)(Lm + (o + t) * TP + o + 8 * i8);
                    const float l0 = bflo(w.x), l1 = bfhi(w.x), l2 = bflo(w.y), l3 = bfhi(w.y), l4 = bflo(w.z), l5 = bfhi(w.z), l6 = bflo(w.w), l7 = bfhi(w.w);
                    if (8 * i8 + 0 < t) acc += l0 * x[8 * i8 + 0]; if (8 * i8 + 1 < t) acc += l1 * x[8 * i8 + 1]; if (8 * i8 + 2 < t) acc += l2 * x[8 * i8 + 2]; if (8 * i8 + 3 < t) acc += l3 * x[8 * i8 + 3];
                    if (8 * i8 + 4 < t) acc += l4 * x[8 * i8 + 4]; if (8 * i8 + 5 < t) acc += l5 * x[8 * i8 + 5]; if (8 * i8 + 6 < t) acc += l6 * x[8 * i8 + 6]; if (8 * i8 + 7 < t) acc += l7 * x[8 * i8 + 7]; }
                x[t] = acc;
            }
#pragma unroll
            for (int t = 0; t < 32; ++t) { TI[(o + t) * TP + o + n] = (bf16_t)f2bf(x[t]); if (h == 0) TI[t * TP + 32 + n] = (bf16_t)0; }
            if (h == 0) {
#pragma unroll
                for (int q = 0; q < 4; ++q) *(LAS u32x4*)(X11T + n * 40 + 8 * q) = (u32x4){pk2(x[8 * q], x[8 * q + 1]), pk2(x[8 * q + 2], x[8 * q + 3]), pk2(x[8 * q + 4], x[8 * q + 5]), pk2(x[8 * q + 6], x[8 * q + 7])};
            }
            LDS_WAIT(); asm volatile("" ::: "memory");
            f32x16 t1 = mmt<2>(Lm, TP, 32, 0, X11T, 40, 0, 0, zero16(), r, h);
#pragma unroll
            for (int g = 0; g < 4; ++g) *(LAS u32x2*)(T1T + r * 40 + 8 * g + 4 * h) = (u32x2){pk2(t1[4 * g], t1[4 * g + 1]), pk2(t1[4 * g + 2], t1[4 * g + 3])};
            LDS_WAIT(); asm volatile("" ::: "memory");
            f32x16 x21 = mmt<2>(TI, TP, 32, 32, T1T, 40, 0, 0, zero16(), r, h);
            store_rm(TI, 32, 0, x21, r, h);
        } else if (wave >= 4) {
            const int mi = (wave - 4) >> 1, ni = (wave - 4) & 1;
            f32x16 acc = mmt<4>(TL(T_VCM), TP, 32 * mi, 0, TL(T_MAK), TP, 32 * ni, 0, zero16(), r, h);
            store_rm(TL(T_G1), 32 * mi, 32 * ni, acc, r, h);
        }
        __syncthreads();
        {
            const int w4 = wave & 3, mi = w4 >> 1, ni = w4 & 1;
            if (wave < 4) { f32x16 acc = mmt<4>(TL(T_ACM), TP, 32 * mi, 0, TL(T_TINV), TP, 32 * ni, 0, zero16(), r, h); store_rm(TL(T_AP), 32 * mi, 32 * ni, acc, r, h); }
            else { f32x16 acc = mmt<4>(TL(T_G1), TP, 32 * mi, 0, TL(T_TINV), TP, 32 * ni, 0, zero16(), r, h); store_rm(TL(T_U0), 32 * mi, 32 * ni, acc, r, h); }
        }
        __syncthreads();
#pragma unroll
        for (int q = 0; q < 2; ++q) {
            const int id = 2 * wave + q, typ = id >> 2, xx = (id >> 1) & 1, yy = id & 1;
            if (typ == 0) {
                f32x16 acc = mmt<4>(TL(T_AP), TP, 32 * xx, 0, TL(T_MRB), TP, 32 * yy, 0, zero16(), r, h);
#pragma unroll
                for (int g = 0; g < 4; ++g) { const u32x2 w = *(const LAS u32x2*)(TL(T_RTM) + (32 * yy + r) * TP + 32 * xx + 8 * g + 4 * h);
                    acc[4 * g] += bflo(w.x); acc[4 * g + 1] += bfhi(w.x); acc[4 * g + 2] += bflo(w.y); acc[4 * g + 3] += bfhi(w.y); }
#pragma unroll
                for (int s = 0; s < 2; ++s) *(u32x4*)l3_slot(L3, tg0, hd * 64, (((xx * 2 + s) * 2 + yy) * 64 + lane) * 16) = pack8(acc, s);
            } else if (typ == 1) {
                f32x16 acc = mmt<4>(TL(T_U0), TP, 32 * xx, 0, TL(T_MRB), TP, 32 * yy, 0, zero16(), r, h);
                acc = mmt<4>(TL(T_VCM), TP, 32 * xx, 0, TL(T_MRK), TP, 32 * yy, 0, acc, r, h);
#pragma unroll
                for (int s = 0; s < 2; ++s) *(u32x4*)l3_slot(L3, tg0, 1024 + hd * 64, ((xx * 2 + yy) * 64 + lane) * 32 + 16 * s) = pack8(acc, s);
            } else if (typ == 2) {
                f32x16 acc = mmt<4>(TL(T_AP), TP, 32 * xx, 0, TL(T_BCM), TP, 32 * yy, 0, zero16(), r, h);
                const float pcc = pc[32 * yy + r];
#pragma unroll
                for (int e = 0; e < 16; ++e) acc[e] = (acc[e] + ((32 * xx + crow(e, h) == 32 * yy + r) ? 1.0f : 0.0f)) * pcc;
#pragma unroll
                for (int s = 0; s < 2; ++s) *(u32x4*)(MT + (size_t)unit * 4096 + (((yy * 2 + xx) * 2 + s) * 64 + lane) * 8) = pack8(acc, s);
            } else {
                f32x16 acc = mmt<4>(TL(T_BCM), TP, 32 * xx, 0, TL(T_U0), TP, 32 * yy, 0, zero16(), r, h);
                acc = mmt<4>(TL(T_KCM), TP, 32 * xx, 0, TL(T_VCM), TP, 32 * yy, 0, acc, r, h);
#pragma unroll
                for (int e = 0; e < 16; ++e) acc[e] *= pc[32 * xx + crow(e, h)];
#pragma unroll
                for (int s = 0; s < 2; ++s) *(u32x4*)(SA + (size_t)unit * 4096 + ((yy * 2 + xx) * 64 + lane) * 16 + 8 * s) = pack8(acc, s);
            }
        }
        __syncthreads();
    }
#undef TL
}

__device__ __forceinline__ void pass_b(Frame& F, int bh, int j) {
    const int lane = F.lane;
    const bf16_t* MT = (const bf16_t*)(F.ws + WS_MT) + (size_t)bh * 64 * 4096; bf16_t* SA = (bf16_t*)(F.ws + WS_SA) + (size_t)bh * 64 * 4096 + j * 2048;
    f32x16 X[2] = {zero16(), zero16()};
    bf16x8 Af[8]; u32x4 Sd[4];
#pragma unroll
    for (int f = 0; f < 8; ++f) Af[f] = *(const bf16x8*)(MT + (f * 64 + lane) * 8);
#pragma unroll
    for (int q = 0; q < 4; ++q) Sd[q] = *(const u32x4*)(SA + (q >> 1) * 1024 + lane * 16 + 8 * (q & 1));
    for (int c = 0; c < 64; ++c) {
        bf16x8 An[8]; u32x4 Sn[4];
        const int cn = (c < 63) ? c + 1 : c;
#pragma unroll
        for (int f = 0; f < 8; ++f) An[f] = *(const bf16x8*)(MT + (size_t)cn * 4096 + (f * 64 + lane) * 8);
#pragma unroll
        for (int q = 0; q < 4; ++q) Sn[q] = *(const u32x4*)(SA + (size_t)cn * 4096 + (q >> 1) * 1024 + lane * 16 + 8 * (q & 1));
        bf16x8 Bf[4];
#pragma unroll
        for (int kt = 0; kt < 2; ++kt)
#pragma unroll
            for (int s = 0; s < 2; ++s) { const u32x4 w = pack8(X[kt], s); Bf[kt * 2 + s] = __builtin_bit_cast(bf16x8, w); *(u32x4*)(SA + (size_t)c * 4096 + ((kt * 2 + s) * 64 + lane) * 8) = w; }
        f32x16 D[2];
#pragma unroll
        for (int ip = 0; ip < 2; ++ip) { unpack8(Sd[2 * ip], D[ip], 0); unpack8(Sd[2 * ip + 1], D[ip], 1);
#pragma unroll
            for (int ks = 0; ks < 4; ++ks) D[ip] = __builtin_amdgcn_mfma_f32_32x32x16_bf16(Af[ip * 4 + ks], Bf[ks], D[ip], 0, 0, 0); }
        X[0] = D[0]; X[1] = D[1];
#pragma unroll
        for (int f = 0; f < 8; ++f) Af[f] = An[f];
#pragma unroll
        for (int q = 0; q < 4; ++q) Sd[q] = Sn[q];
    }
}

__device__ __forceinline__ void pass_c(Frame& F) {
    const int lane = F.lane, r = lane & 31, h = lane >> 5;
    const int gw = F.vcu * 8 + F.wave, NGW = F.G * 8;
    const bf16_t* P = (const bf16_t*)(F.ws + WS_P); unsigned char* L3 = F.ws + WS_L3; const bf16_t* SA = (const bf16_t*)(F.ws + WS_SA); const float* BON = (const float*)(F.ws + WS_BON);
    bf16_t* Y = (bf16_t*)(F.ws + WS_YCAT); const float* mix = F.in[I_MIX];
    for (int unit = gw; unit < 4096; unit += NGW) {
        const int b = unit >> 10, hd = (unit >> 6) & 15, ci = unit & 63, tg0 = b * SEQ + ci * 64;
        bf16x8 Af[8], Bf[8];
#pragma unroll
        for (int f = 0; f < 8; ++f) Af[f] = *(const bf16x8*)(SA + (size_t)unit * 4096 + (f * 64 + lane) * 8);
#pragma unroll
        for (int f = 0; f < 8; ++f) Bf[f] = *(const bf16x8*)l3_slot(L3, tg0, hd * 64, (f * 64 + lane) * 16);
        f32x16 acc[2][2];
#pragma unroll
        for (int j = 0; j < 2; ++j)
#pragma unroll
            for (int tt = 0; tt < 2; ++tt) {
#pragma unroll
                for (int s = 0; s < 2; ++s) unpack8(*(const u32x4*)l3_slot(L3, tg0, 1024 + hd * 64, ((j * 2 + tt) * 64 + lane) * 32 + 16 * s), acc[j][tt], s);
#pragma unroll
                for (int ks = 0; ks < 4; ++ks) acc[j][tt] = __builtin_amdgcn_mfma_f32_32x32x16_bf16(Af[j * 4 + ks], Bf[ks * 2 + tt], acc[j][tt], 0, 0, 0);
            }
#pragma unroll
        for (int tt = 0; tt < 2; ++tt) {
            const int tl = 32 * tt + r, tg = tg0 + tl;
            float sm = 0.f;
#pragma unroll
            for (int e = 0; e < 16; ++e) sm += acc[0][tt][e] + acc[1][tt][e];
            sm += __shfl_xor(sm, 32); const float mean = sm * (1.0f / 64.0f);
            float sq = 0.f;
#pragma unroll
            for (int e = 0; e < 16; ++e) { const float d0 = acc[0][tt][e] - mean, d1 = acc[1][tt][e] - mean; sq += d0 * d0 + d1 * d1; }
            sq += __shfl_xor(sq, 32); const float rstd = rsqrtf(sq * (1.0f / 64.0f) + GN_EPS);
            const float bon = BON[(size_t)tg * 16 + hd];
            const bool hp = (ci > 0) || (tl > 0);
            const bf16_t* prow = P + (size_t)tg * NP + PVR + hd * 64; const bf16_t* lrow = (const bf16_t*)L3 + (size_t)tg * NL + 2048 + hd * 64; bf16_t* yrow = Y + (size_t)tg * DM + 1024 + hd * 64;
#pragma unroll
            for (int j = 0; j < 2; ++j)
#pragma unroll
                for (int g = 0; g < 4; ++g) { const int v0 = 32 * j + 8 * g + 4 * h, ch = hd * 64 + v0;
                    const u32x2 cv = *(const u32x2*)(prow + v0); u32x2 pv = (u32x2){0u, 0u}; if (hp) pv = *(const u32x2*)(prow - NP + v0);
                    const u32x2 gg = *(const u32x2*)(lrow + v0);
                    const f32x4 mu = *(const f32x4*)(mix + 2112 + ch), lw = *(const f32x4*)(F.in[I_LNW] + ch), lb = *(const f32x4*)(F.in[I_LNB] + ch);
                    const float c0 = bflo(cv.x), c1 = bfhi(cv.x), c2 = bflo(cv.y), c3 = bfhi(cv.y);
                    const float v_0 = c0 + (bflo(pv.x) - c0) * mu.x, v_1 = c1 + (bfhi(pv.x) - c1) * mu.y, v_2 = c2 + (bflo(pv.y) - c2) * mu.z, v_3 = c3 + (bfhi(pv.y) - c3) * mu.w;
                    const float o0 = ((acc[j][tt][4 * g] - mean) * rstd * lw.x + lb.x + bon * v_0) * bflo(gg.x);
                    const float o1 = ((acc[j][tt][4 * g + 1] - mean) * rstd * lw.y + lb.y + bon * v_1) * bfhi(gg.x);
                    const float o2 = ((acc[j][tt][4 * g + 2] - mean) * rstd * lw.z + lb.z + bon * v_2) * bflo(gg.y);
                    const float o3 = ((acc[j][tt][4 * g + 3] - mean) * rstd * lw.w + lb.w + bon * v_3) * bfhi(gg.y);
                    *(u32x2*)(yrow + v0) = (u32x2){pk2(o0, o1), pk2(o2, o3)}; }
        }
    }
}
}

__device__ __forceinline__ void phase_mix(Frame& F) {
    unsigned char* wl = F.ldsg + F.wave * 4096;
#ifdef RWKV_NAIVE
    const int nsp = F.G >= 64 ? 64 : 0;
    if (nsp && F.wave == 0 && F.vcu < 64) { rwkv_scan_naive(F, F.vcu, wl); return; }
#else
    const int nsp = F.G >= 128 ? 128 : 0;
    if (nsp && F.wave == 0 && F.vcu < 128) { rw::pass_b(F, F.vcu >> 1, F.vcu & 1); return; }
#endif
    int idx, nw;
    if (nsp) { nw = 8 * F.G - nsp; idx = (F.wave >= 1) ? F.vcu * 7 + (F.wave - 1) : 7 * F.G + (F.vcu - nsp); }
    else { nw = 8 * F.G; idx = F.vcu * 8 + F.wave;
#ifdef RWKV_NAIVE
        if (idx < 64) rwkv_scan_naive(F, idx, wl);
#else
        if (idx < 128) rw::pass_b(F, idx >> 1, idx & 1);
#endif
    }
    for (int task = idx; task < T * 8; task += nw) attn_task_naive(F, task, wl);
}

struct RouteRec { int cls, pos; float g_lo, g_hi, rstd; int pad0, pad1, pad2; };
__device__ __forceinline__ void phase7(Frame& F) {
    const int gw = F.vcu * 8 + F.wave, NGW = F.G * 8, lane = F.lane;
    { int* rowtok = (int*)(F.ws + WS_ROWTOK); for (int i = gw * 64 + lane; i < MPAD; i += NGW * 64) rowtok[i] = -1; }
    { LAS float* scr = (LAS float*)(F.lds + F.wave * 16384);
      bf16_t* WGU = (bf16_t*)(F.ws + WS_WGU); bf16_t* WDN = (bf16_t*)(F.ws + WS_WDN);
      constexpr int IG = (DM / 64) * (512 / 32), ID = (512 / 64) * (DM / 32);
      for (int it = gw; it < 16 * (2 * IG + ID); it += NGW) { const int e = it / (2 * IG + ID); int r = it % (2 * IG + ID);
          if (r < IG) transpose_item<2>(F.in[I_WEG] + (size_t)e * DM * 512, 512, WGU + (size_t)e * 1024 * DM, DM, scr, r / 16, r % 16, lane);
          else if (r < 2 * IG) { r -= IG; transpose_item<3>(F.in[I_WEU] + (size_t)e * DM * 512, 512, WGU + (size_t)e * 1024 * DM, DM, scr, r / 16, r % 16, lane); }
          else { r -= 2 * IG; transpose_item<0>(F.in[I_WED] + (size_t)e * 512 * DM, DM, WDN + (size_t)e * DM * 512, 512, scr, r / 64, r % 64, lane); } } }
    const float* x1 = F.out; const float* gf = F.in[I_GFFN]; const f32x4* wrg = (const f32x4*)F.in[I_WRG]; const f32x4* wre = (const f32x4*)F.in[I_WRE];
    RouteRec* rr = (RouteRec*)(F.ws + WS_ROUTE); unsigned* cnt = F.ctl + CW_CNT;
    for (int t = gw; t < T; t += NGW) {
        const f32x4* xr = (const f32x4*)(x1 + (size_t)t * DM) + lane; f32x4 v[8]; float s = 0.f;
#pragma unroll
        for (int j = 0; j < 8; ++j) { v[j] = xr[64 * j]; s += (v[j].x * v[j].x + v[j].y * v[j].y) + (v[j].z * v[j].z + v[j].w * v[j].w); }
        const float rstd = rsqrtf(wave_sum(s) * (1.f / DM) + NORM_EPS);
        float lg[20];
#pragma unroll
        for (int o = 0; o < 20; ++o) lg[o] = 0.f;
#pragma unroll
        for (int j = 0; j < 8; ++j) { const f32x4 g4 = ((const f32x4*)gf)[64 * j + lane];
            asm volatile("" ::: "memory");
#pragma unroll
            for (int e = 0; e < 4; ++e) { const int k = 4 * (64 * j + lane) + e; const float hv = v[j][e] * rstd * g4[e];
                const f32x4 wg = wrg[k]; lg[0] += hv * wg.x; lg[1] += hv * wg.y; lg[2] += hv * wg.z; lg[3] += hv * wg.w;
#pragma unroll
                for (int q = 0; q < 4; ++q) { const f32x4 we = wre[4 * k + q]; lg[4 + 4 * q] += hv * we.x; lg[5 + 4 * q] += hv * we.y; lg[6 + 4 * q] += hv * we.z; lg[7 + 4 * q] += hv * we.w; } } }
#pragma unroll
        for (int o = 0; o < 20; ++o) lg[o] = wave_sum(lg[o]);
        float gl[4]; float gm = -INFINITY;
#pragma unroll
        for (int o = 0; o < 4; ++o) { gl[o] = lg[o] + F.in[I_BRG][o]; gm = fmaxf(gm, gl[o]); }
        float gs = 0.f; int gsel = 0; float gbest = -INFINITY;
#pragma unroll
        for (int o = 0; o < 4; ++o) { gs += __expf(gl[o] - gm); if (gl[o] > gbest) { gbest = gl[o]; gsel = o; } }
        const float pgrp = __expf(gbest - gm) / gs;
        float el[4]; float em = -INFINITY;
#pragma unroll
        for (int q = 0; q < 4; ++q) { float vsel = 0.f;
#pragma unroll
            for (int g2 = 0; g2 < 4; ++g2) vsel = (gsel == g2) ? lg[4 + 4 * g2 + q] + F.in[I_BRE][4 * g2 + q] : vsel;
            el[q] = vsel; em = fmaxf(em, vsel); }
        int i1 = 0; float b1 = -INFINITY;
#pragma unroll
        for (int q = 0; q < 4; ++q) if (el[q] > b1) { b1 = el[q]; i1 = q; }
        int i2 = 0; float b2 = -INFINITY;
#pragma unroll
        for (int q = 0; q < 4; ++q) if (q != i1 && el[q] > b2) { b2 = el[q]; i2 = q; }
        const float p1 = __expf(b1 - em), p2 = __expf(b2 - em); const float inv = 1.0f / (p1 + p2);
        const float gw1 = pgrp * p1 * inv, gw2 = pgrp * p2 * inv;
        const int elo = i1 < i2 ? i1 : i2, ehi = i1 < i2 ? i2 : i1; const float glo = i1 < i2 ? gw1 : gw2, ghi = i1 < i2 ? gw2 : gw1;
        const int pair = (elo == 0) ? (ehi - 1) : (elo == 1 ? ehi + 1 : 5);
        const int cls = gsel * 6 + pair;
        if (lane == 0) { const unsigned pos = atomicAdd(&cnt[cls], 1u); RouteRec r; r.cls = cls; r.pos = (int)pos; r.g_lo = glo; r.g_hi = ghi; r.rstd = rstd; r.pad0 = r.pad1 = r.pad2 = 0; rr[t] = r; }
    }
}

__device__ __forceinline__ void class_bases(Frame& F, volatile LAS int* tb) {
    if (F.tid == 0) { int acc = 0; for (int c = 0; c < NCLS; ++c) { tb[c] = acc; const int n = (int)__hip_atomic_load(F.ctl + CW_CNT + c, __ATOMIC_RELAXED, __HIP_MEMORY_SCOPE_AGENT); acc += (n + 255) & ~255; } tb[NCLS] = acc; }
    __syncthreads();
}

__device__ __forceinline__ void phase8(Frame& F) {
    const int gw = F.vcu * 8 + F.wave, NGW = F.G * 8, lane = F.lane;
    volatile LAS int* tb = (volatile LAS int*)(F.lds + MISC_OFF + 128);
    class_bases(F, tb);
    const float* x1 = F.out; const float* gf = F.in[I_GFFN];
    const RouteRec* rr = (const RouteRec*)(F.ws + WS_ROUTE); int* rowtok = (int*)(F.ws + WS_ROWTOK); float* gates = (float*)(F.ws + WS_ROWTOK + 128 * 1024);
    bf16_t* H2S = (bf16_t*)(F.ws + WS_H2S);
    f32x4 gv[8];
#pragma unroll
    for (int j = 0; j < 8; ++j) gv[j] = ((const f32x4*)gf)[64 * j + lane];
    for (int t = gw; t < T; t += NGW) {
        const RouteRec r = rr[t]; const int row = tb[r.cls] + r.pos;
        const f32x4* xr = (const f32x4*)(x1 + (size_t)t * DM) + lane; u32x2* o = (u32x2*)(H2S + (size_t)row * DM) + lane;
#pragma unroll
        for (int j = 0; j < 8; ++j) { const f32x4 v = xr[64 * j]; u32x2 w; w.x = pk2(v.x * r.rstd * gv[j].x, v.y * r.rstd * gv[j].y); w.y = pk2(v.z * r.rstd * gv[j].z, v.w * r.rstd * gv[j].w); o[64 * j] = w; }
        if (lane == 0) { rowtok[row] = t; gates[2 * row] = r.g_lo; gates[2 * row + 1] = r.g_hi; }
    }
    for (int idx = gw; idx < NCLS * 256; idx += NGW) { const int c = idx >> 8, off = idx & 255; const int n = (int)__hip_atomic_load(F.ctl + CW_CNT + c, __ATOMIC_RELAXED, __HIP_MEMORY_SCOPE_AGENT);
        const int row = tb[c] + n + off;
        if (row < tb[c + 1]) { u32x2* o = (u32x2*)(H2S + (size_t)row * DM) + lane;
#pragma unroll
            for (int j = 0; j < 8; ++j) o[64 * j] = (u32x2){0u, 0u};
            if (lane == 0) { gates[2 * row] = 0.f; gates[2 * row + 1] = 0.f; } } }
}

__device__ __forceinline__ int class_of_tile(volatile LAS int* tb, int rt) { int c = 0; const int r0 = rt * 256; for (int k = 1; k < NCLS; ++k) c = (r0 >= tb[k]) ? k : c; return c; }
__device__ __forceinline__ int class_expert(int cls, int half) { const int g = cls / 6, p = cls % 6; const int elo = p < 3 ? 0 : (p < 5 ? 1 : 2); const int ehi = p < 3 ? p + 1 : (p < 5 ? p - 1 : 3); return 4 * g + (half ? ehi : elo); }
struct Moe1Sched {
    volatile LAS int* tb; const char* A; const char* B; int G, c, nu;
    __device__ bool seg(int i, pg8::Seg& s) const { const int L = i * G + c; if (L >= nu) return false; const int rt = L >> 3, pn = L & 7; const int cls = class_of_tile(tb, rt); const int e = class_expert(cls, pn >> 2);
        s.A = A + (size_t)rt * 256 * DM * 2; s.B = B + ((size_t)e * 1024 + (pn & 3) * 256) * DM * 2; s.u.pm = rt; s.u.pn = pn; s.u.aux = 0; s.last = 1; return true; }
};
struct Moe2Sched {
    volatile LAS int* tb; const char* A; const char* B; int G, c, nu;
    __device__ bool seg(int i, pg8::Seg& s) const { const int ui = i >> 1, half = i & 1; const int L = ui * G + c; if (L >= nu) return false; const int rt = L >> 3, pn = L & 7; const int cls = class_of_tile(tb, rt); const int e = class_expert(cls, half);
        s.A = A + ((size_t)rt * 256 * 1024 + half * 512) * 2; s.B = B + ((size_t)e * DM + pn * 256) * 512 * 2; s.u.pm = rt; s.u.pn = pn; s.u.aux = 0; s.last = half; return true; }
};

constexpr int NPHASE = 13;
__global__ void __launch_bounds__(512, 2) fwd_kernel(Args args) {
    extern __shared__ __attribute__((aligned(16))) unsigned char lds_raw[];
    Frame F;
    F.lds = (LAS unsigned char*)lds_raw; F.ldsg = lds_raw;
    F.tid = threadIdx.x; F.lane = F.tid & 63; F.wave = __builtin_amdgcn_readfirstlane(F.tid >> 6);
    F.G = gridDim.x; { const int bx = blockIdx.x; F.vcu = (F.G % 8 == 0) ? (bx % 8) * (F.G / 8) + bx / 8 : bx; }
    F.in = args.in; F.out = args.out; F.ws = args.ws; F.ctl = (unsigned*)(args.ws + WS_CTL);
    volatile LAS unsigned* MISC = (volatile LAS unsigned*)(F.lds + MISC_OFF);
    for (int u = F.tid; u < (LDS_BYTES - LDSCTL_OFF) / 4; u += 512) ((LAS unsigned*)(F.lds + LDSCTL_OFF))[u] = 0u;
    __syncthreads();
    const int lo = args.ph_lo, hi = args.ph_hi;
    const bool multi = (hi - lo) > 1;
    XcdBarrier bar; bar.bar = F.ctl + CW_BAR; bar.x = 0; bar.st = nullptr;
    if (multi) bar = xcd_barrier_post(F.ctl + CW_BAR, MISC + 8);
#ifndef PH_MASK
#define PH_MASK 0x1fff
#endif
#define IN(k) (((PH_MASK >> (k)) & 1) && lo <= (k) && (k) < hi)
#define SEAM(k) do { if (IN(k) && IN((k) + 1)) xcd_barrier(bar); } while (0)
    unsigned char* ws = args.ws;
    bf16_t* P = (bf16_t*)(ws + WS_P);

    if (IN(0)) { phase0(F); SEAM(0); }
    if (IN(1)) {
        pg8::PlainSched S; S.init((const bf16_t*)(ws + WS_HN), (const bf16_t*)(ws + WS_WIN), T, NP, DM, DM, F.G, (int)blockIdx.x);
        pg8::EpiBf16 E{P, NP};
        pg8::gemm_phase<pg8::EpiBf16, pg8::PlainSched, true>(F.lds, DM, DM, DM / 64, S, E);
        SEAM(1);
    }
    if (IN(2)) { phase2(F); SEAM(2); }
    if (IN(3)) {
        pg8::PlainSched S; S.init((const bf16_t*)(ws + WS_ALORA), (const bf16_t*)(ws + WS_WLORA), T, NL, KL, KL, F.G, (int)blockIdx.x);
        pg8::EpiLora E{(bf16_t*)(ws + WS_L3), F.in[I_W0], F.in[I_A0]};
        pg8::gemm_phase<pg8::EpiLora, pg8::PlainSched, true>(F.lds, KL, KL, KL / 64, S, E);
        SEAM(3);
    }
    if (IN(4)) { phase4(F); SEAM(4); }
#ifndef RWKV_NAIVE
    if (IN(5)) { rw::pass_a(F); SEAM(5); }
#else
    if (IN(5)) { SEAM(5); }
#endif
    if (IN(6)) { phase_mix(F); SEAM(6); }
#ifndef RWKV_NAIVE
    if (IN(7)) { rw::pass_c(F); SEAM(7); }
#else
    if (IN(7)) { SEAM(7); }
#endif
    if (IN(8)) {
        pg8::PlainSched S; S.init((const bf16_t*)(ws + WS_YCAT), (const bf16_t*)(ws + WS_WOUT), T, DM, DM, DM, F.G, (int)blockIdx.x);
        pg8::EpiResF32 E{F.in[I_X], F.out, DM};
        pg8::gemm_phase<pg8::EpiResF32, pg8::PlainSched, true>(F.lds, DM, DM, DM / 64, S, E);
        SEAM(8);
    }
    if (IN(9)) { phase7(F); SEAM(9); }
    if (IN(10)) { phase8(F); SEAM(10); }
    if (IN(11)) {
        volatile LAS int* tb = (volatile LAS int*)(F.lds + MISC_OFF + 128);
        class_bases(F, tb);
        Moe1Sched S; S.tb = tb; S.A = (const char*)(ws + WS_H2S); S.B = (const char*)(ws + WS_WGU); S.G = F.G; S.c = (int)blockIdx.x; S.nu = (tb[NCLS] >> 8) * 8;
        pg8::EpiMoe1 E{(bf16_t*)(ws + WS_HS), (const float*)(ws + WS_ROWTOK + 128 * 1024)};
        pg8::gemm_phase<pg8::EpiMoe1, Moe1Sched, true>(F.lds, DM, DM, DM / 64, S, E);
        SEAM(11);
    }
    if (IN(12)) {
        volatile LAS int* tb = (volatile LAS int*)(F.lds + MISC_OFF + 128);
        class_bases(F, tb);
        Moe2Sched S; S.tb = tb; S.A = (const char*)(ws + WS_HS); S.B = (const char*)(ws + WS_WDN); S.G = F.G; S.c = (int)blockIdx.x; S.nu = (tb[NCLS] >> 8) * 8;
        pg8::EpiMoe2 E{F.out, (const int*)(ws + WS_ROWTOK)};
        pg8::gemm_phase<pg8::EpiMoe2, Moe2Sched, true>(F.lds, 1024, 512, 512 / 64, S, E);
    }
#undef IN
#undef SEAM
}

extern "C" void kernel_launch(void* const* d_in, const int* in_sizes, int n_in, void* d_out, int out_size, void* d_ws, size_t ws_size, hipStream_t stream) {
    static int grid = 0;
    if (grid == 0) {
        if (n_in != 25 || in_sizes[0] != T * DM || out_size != T * DM || ws_size < WS_END) { fprintf(stderr, "kernel_launch: unexpected shapes (n_in %d, in0 %d, out %d, ws %zu)\n", n_in, n_in > 0 ? in_sizes[0] : -1, out_size, ws_size); grid = -1; return; }
        int dev = 0, cus = 0, per_cu = 0;
        if (hipGetDevice(&dev) != hipSuccess || hipDeviceGetAttribute(&cus, hipDeviceAttributeMultiprocessorCount, dev) != hipSuccess) { grid = -1; return; }
        if (hipFuncSetAttribute((const void*)fwd_kernel, hipFuncAttributeMaxDynamicSharedMemorySize, LDS_BYTES) != hipSuccess) { fprintf(stderr, "kernel_launch: hipFuncSetAttribute failed\n"); grid = -1; return; }
        if (hipOccupancyMaxActiveBlocksPerMultiprocessor(&per_cu, (const void*)fwd_kernel, 512, LDS_BYTES) != hipSuccess || per_cu < 1) { fprintf(stderr, "kernel_launch: occupancy query says %d blocks per CU\n", per_cu); (void)hipGetLastError(); grid = -1; return; }
        grid = cus;
    }
    if (grid < 0) return;
    (void)hipMemsetAsync((char*)d_ws + WS_CTL, 0, CTL_ZERO_BYTES, stream);
    Args a{};
    for (int i = 0; i < 25; ++i) a.in[i] = (const float*)d_in[i];
    a.out = (float*)d_out; a.ws = (unsigned char*)d_ws;
#if MK_SINGLE
    a.ph_lo = 0; a.ph_hi = NPHASE;
    void* kargs[] = {&a};
    hipError_t e = hipLaunchCooperativeKernel((const void*)fwd_kernel, dim3(grid), dim3(512), kargs, LDS_BYTES, stream);
    if (e != hipSuccess) fprintf(stderr, "kernel_launch: cooperative launch failed: %s (grid %d)\n", hipGetErrorString(e), grid);
#else
    for (int p = 0; p < NPHASE; ++p) { a.ph_lo = p; a.ph_hi = p + 1; hipLaunchKernelGGL(fwd_kernel, dim3(grid), dim3(512), LDS_BYTES, stream, a); }
#endif
}
```

```cpp
#include <hip/hip_runtime.h>
#include <hip/hip_cooperative_groups.h>
#include <cstdio>
#include <cstdint>
#include <cmath>

#ifndef MK_SINGLE
#define MK_SINGLE 1
#endif

#define GAS __attribute__((address_space(1)))
#define LAS __attribute__((address_space(3)))
typedef unsigned short bf16_t;
typedef short bf16x8 __attribute__((ext_vector_type(8)));
typedef float f32x4 __attribute__((ext_vector_type(4)));
typedef float f32x16 __attribute__((ext_vector_type(16)));
typedef float f32x2 __attribute__((ext_vector_type(2)));
typedef unsigned u32x4 __attribute__((ext_vector_type(4)));
typedef unsigned u32x2 __attribute__((ext_vector_type(2)));

constexpr int BATCH = 4, SEQ = 4096, DM = 2048, T = BATCH * SEQ;
constexpr int NP = 7680;
constexpr int PQ = 0, PK = 1024, PV = 2048, PQI = 3072, PKI = 4096, PWI = 4160, PDW = 4224, PDA = 4288, PR = 4352, PKR = 5376, PVR = 6400, PDG = 7424;
constexpr int IN_COLS = 7536, DSA_COLS = 4176;
constexpr int KL = 384, NL = 3072;
constexpr int MPAD = 22528;
constexpr int NCLS = 24;
constexpr float NORM_EPS = 1e-6f, GN_EPS = 64e-5f;
constexpr float QSCALE = 0.08838834764831845f * 1.4426950408889634f;

constexpr size_t MiB = 1u << 20;
constexpr size_t WS_CTL = 0, CTL_ZERO_BYTES = 1 * MiB;
constexpr size_t WS_WLORA = 1 * MiB;
constexpr size_t WS_WOUT = 4 * MiB;
constexpr size_t WS_MSK = 12 * MiB;
constexpr size_t WS_KI = 20 * MiB;
constexpr size_t WS_ROUTE = 22 * MiB;
constexpr size_t WS_ROWTOK = 23 * MiB;
constexpr size_t WS_ALORA = 24 * MiB;
constexpr size_t WS_WIN = 36 * MiB;
constexpr size_t WS_HN = 66 * MiB;
constexpr size_t WS_YCAT = WS_HN;
constexpr size_t WS_L3 = 130 * MiB;
constexpr size_t WS_P = 226 * MiB;
constexpr size_t WS_H2S = 226 * MiB;
constexpr size_t WS_HS = 314 * MiB;
constexpr size_t WS_WGU = 358 * MiB;
constexpr size_t WS_WDN = 422 * MiB;
constexpr size_t WS_MT = 24 * MiB;
constexpr size_t WS_BON = 56 * MiB;
constexpr size_t WS_SA = 466 * MiB;
constexpr size_t WS_END = 498 * MiB;
constexpr int CW_CNT = 64;
constexpr int CW_BAR = 4096;

constexpr int RING_BYTES = 131072;
constexpr int LDSCTL_OFF = RING_BYTES, MISC_OFF = LDSCTL_OFF + 320;
constexpr int LDS_BYTES = 147456;

#define LDS_WAIT() asm volatile("s_waitcnt lgkmcnt(0)" ::: "memory")
#define VM_WAIT() asm volatile("s_waitcnt vmcnt(0)" ::: "memory")
__device__ __forceinline__ unsigned f2bf(float f) { unsigned u = __builtin_bit_cast(unsigned, f); return (u + 0x7fffu + ((u >> 16) & 1u)) >> 16; }
__device__ __forceinline__ unsigned pk2(float lo, float hi) { return f2bf(lo) | (f2bf(hi) << 16); }
__device__ __forceinline__ float bf2f(unsigned short h) { return __builtin_bit_cast(float, (unsigned)h << 16); }
__device__ __forceinline__ float bflo(unsigned w) { return __builtin_bit_cast(float, w << 16); }
__device__ __forceinline__ float bfhi(unsigned w) { return __builtin_bit_cast(float, w & 0xffff0000u); }
__device__ __forceinline__ float wave_sum(float v) {
#pragma unroll
    for (int o = 1; o < 64; o <<= 1) v += __shfl_xor(v, o);
    return v;
}
__device__ __forceinline__ float half_sum(float v) {
#pragma unroll
    for (int o = 1; o < 32; o <<= 1) v += __shfl_xor(v, o);
    return v;
}
__device__ __forceinline__ float sigmoidf_(float x) { return 1.0f / (1.0f + __expf(-x)); }

namespace pg8 {
constexpr int BM = 256, BK = 64, HALF = 128, HTB = HALF * BK * 2, STAGE_BYTES = 8 * HTB, NXCD = 8, WGM = 8;
__host__ __device__ __forceinline__ int lds_byte(int r, int c) { const int st = (r >> 4) * 2 + (c >> 5), rr = r & 15, cc = c & 31, ob = rr * 64 + cc * 2; return st * 1024 + (ob ^ (((ob >> 9) & 1) << 5)); }
__host__ __device__ __forceinline__ void stage_rc(int b, int& R, int& C) { const int st = b / 1024, sb = b % 1024, swz = sb ^ (((sb >> 9) & 1) << 5); R = (st >> 1) * 16 + swz / 64; C = (st & 1) * 32 + (swz % 64) / 2; }
__host__ __device__ __forceinline__ int perm32(int rho) { const int n = rho >> 4, i = rho & 15; return 8 * (i >> 2) + 4 * n + (i & 3); }

struct Unit { int pm, pn, aux; };
struct Seg { const char* A; const char* B; Unit u; int last; };

struct TileOrder {
    int nM, nN, nwg, G, c;
    __device__ void init(int nM_, int nN_, int G_, int c_) { nM = nM_; nN = nN_; nwg = nM * nN; G = G_; c = c_; }
    __device__ bool next(int i, int& pm, int& pn) const {
        const long L = (long)i * G + c; if (L >= nwg) return false;
        int wgid = (int)L; { const int q = nwg / NXCD, r = nwg % NXCD, xcd = wgid % NXCD, off = wgid / NXCD; wgid = (xcd < r ? xcd * (q + 1) : r * (q + 1) + (xcd - r) * q) + off; }
        const int nig = WGM * nN, gid = wgid / nig, fm = gid * WGM, gsz = (nM - fm) < WGM ? (nM - fm) : WGM;
        pm = fm + ((wgid % nig) % gsz); pn = (wgid % nig) / gsz; return true;
    }
};
struct PlainSched {
    TileOrder o; const char* A; const char* B; size_t tA, tB;
    __device__ void init(const bf16_t* A_, const bf16_t* B_, int M, int N, int lda, int ldb, int G, int c) { o.init(M / BM, N / BM, G, c); A = (const char*)A_; B = (const char*)B_; tA = (size_t)BM * lda * 2; tB = (size_t)BM * ldb * 2; }
    __device__ bool seg(int i, Seg& s) const { int pm, pn; if (!o.next(i, pm, pn)) return false; s.A = A + pm * tA; s.B = B + pn * tB; s.u.pm = pm; s.u.pn = pn; s.u.aux = 0; s.last = 1; return true; }
};

__device__ __forceinline__ unsigned cvt_pk_bf16(float lo, float hi) { unsigned r; asm volatile("v_cvt_pk_bf16_f32 %0, %1, %2" : "=v"(r) : "v"(lo), "v"(hi)); return r; }

typedef f32x4 Acc[2][2][4][2];

template <class Epi, class Sched, bool ALIGN_EPI>
__device__ __forceinline__ void gemm_phase(LAS unsigned char* lds, const int lda, const int ldb, const int nt, const Sched& S, const Epi& E) {
    const int tid = threadIdx.x, wid = __builtin_amdgcn_readfirstlane(tid >> 6), lane = tid & 63, wr = wid >> 2, wc = wid & 3, fr = lane & 15, fq = lane >> 4;
    unsigned voffA[2], voffB[2];
#pragma unroll
    for (int i = 0; i < 2; ++i) { int R, C; stage_rc(tid * 16 + i * 8192, R, C); const int Rb = Epi::PERM ? ((R & ~31) + perm32(R & 31)) : R;
        voffA[i] = (unsigned)(R * lda + C) * 2u; voffB[i] = (unsigned)(Rb * ldb + C) * 2u; }
    const size_t kstep = (size_t)(BK * 2);
    const size_t hstepA = (size_t)HALF * lda * 2, hstepB = (size_t)HALF * ldb * 2;
    const unsigned ldsw = (unsigned)wid * 1024u;
    const int aoff = lds_byte(wr * 64 + fr, fq * 8), boff = lds_byte(wc * 32 + fr, fq * 8);
#define PG8_SA(b, h) (((b) * 2 + (h)) * HTB)
#define PG8_SB(b, h) ((4 + (b) * 2 + (h)) * HTB)
#define PG8_STAGE(bufoff, gbase, voff) do { _Pragma("unroll") for (int _i = 0; _i < 2; ++_i) \
        __builtin_amdgcn_global_load_lds((const unsigned*)((const char*)(gbase) + (voff)[_i]), (LAS unsigned*)(lds + (bufoff) + ldsw + _i * 8192), 16, 0, 0); } while (0)
#define PG8_LDA(dst, b, h) do { _Pragma("unroll") for (int m = 0; m < 4; ++m) _Pragma("unroll") for (int k = 0; k < 2; ++k) dst[m][k] = *(const LAS bf16x8*)(lds + PG8_SA(b, h) + aoff + m * 2048 + k * 1024); } while (0)
#define PG8_LDB(dst, b, h) do { _Pragma("unroll") for (int n = 0; n < 2; ++n) _Pragma("unroll") for (int k = 0; k < 2; ++k) dst[n][k] = *(const LAS bf16x8*)(lds + PG8_SB(b, h) + boff + n * 2048 + k * 1024); } while (0)
#define PG8_MMA(ai, bj, At, Bt) do { __builtin_amdgcn_s_setprio(1); _Pragma("unroll") for (int m = 0; m < 4; ++m) _Pragma("unroll") for (int n = 0; n < 2; ++n) _Pragma("unroll") for (int k = 0; k < 2; ++k) \
        acc[ai][bj][m][n] = __builtin_amdgcn_mfma_f32_16x16x32_bf16(Bt[n][k], At[m][k], acc[ai][bj][m][n], 0, 0, 0); __builtin_amdgcn_s_setprio(0); } while (0)
#define PG8_WAIT_V(n) asm volatile("s_waitcnt vmcnt(" #n ")" ::: "memory")
#define PG8_WAIT_L(n) asm volatile("s_waitcnt lgkmcnt(" #n ")" ::: "memory")
#define PG8_BAR __builtin_amdgcn_s_barrier()
#define PG8_SCHED __builtin_amdgcn_sched_barrier(0)
#define PG8_ZERO() do { _Pragma("unroll") for (int a = 0; a < 2; ++a) _Pragma("unroll") for (int b = 0; b < 2; ++b) _Pragma("unroll") for (int m = 0; m < 4; ++m) _Pragma("unroll") for (int n = 0; n < 2; ++n) acc[a][b][m][n] = (f32x4){0.f, 0.f, 0.f, 0.f}; } while (0)
    Seg cur, nxt; int qi = 0;
    if (!S.seg(0, cur)) return;
    Acc acc;
    PG8_ZERO();
    bf16x8 At[4][2], B0[2][2], B1[2][2];
    const char* cA = cur.A; const char* cB = cur.B;
    PG8_STAGE(PG8_SB(0, 0), cB, voffB); PG8_STAGE(PG8_SB(0, 1), cB + hstepB, voffB); PG8_STAGE(PG8_SA(0, 0), cA, voffA); PG8_STAGE(PG8_SA(0, 1), cA + hstepA, voffA);
    if (wr == 1) PG8_BAR;
    PG8_WAIT_V(2); PG8_BAR;
    PG8_STAGE(PG8_SB(1, 0), cB + kstep, voffB); PG8_STAGE(PG8_SA(1, 0), cA + kstep, voffA); PG8_STAGE(PG8_SB(1, 1), cB + hstepB + kstep, voffB);
    PG8_WAIT_V(6); PG8_BAR;
    for (;;) {
        bool has_next; const char* nA; const char* nB;
        for (;;) {
        has_next = S.seg(qi + 1, nxt);
        nA = has_next ? nxt.A : cA; nB = has_next ? nxt.B : cB;
#pragma unroll 1
        for (int t = 0; t < nt; t += 2) {
            const bool last = (t == nt - 2);
            const char* a1 = cA + (size_t)(t + 1) * kstep;
            const char* a2 = last ? nA : cA + (size_t)(t + 2) * kstep; const char* b2 = last ? nB : cB + (size_t)(t + 2) * kstep;
            const char* a3 = a2 + kstep; const char* b3 = b2 + kstep;
            PG8_LDB(B0, 0, 0); PG8_LDB(B1, 0, 1); PG8_SCHED; PG8_LDA(At, 0, 0); PG8_STAGE(PG8_SA(1, 1), a1 + hstepA, voffA);
            PG8_WAIT_V(8); PG8_WAIT_L(0); PG8_BAR; PG8_MMA(0, 0, At, B0); PG8_MMA(0, 1, At, B1); PG8_BAR; PG8_SCHED;
            PG8_LDA(At, 0, 1); PG8_STAGE(PG8_SB(0, 0), b2, voffB); PG8_STAGE(PG8_SB(0, 1), b2 + hstepB, voffB); PG8_STAGE(PG8_SA(0, 0), a2, voffA);
            PG8_WAIT_V(8); PG8_WAIT_L(0); PG8_BAR; PG8_MMA(1, 0, At, B0); PG8_MMA(1, 1, At, B1); PG8_BAR; PG8_SCHED;
            PG8_LDB(B0, 1, 0); PG8_LDB(B1, 1, 1); PG8_SCHED; PG8_LDA(At, 1, 0); PG8_STAGE(PG8_SA(0, 1), a2 + hstepA, voffA);
            PG8_WAIT_V(8); PG8_WAIT_L(0); PG8_BAR; PG8_MMA(0, 0, At, B0); PG8_MMA(0, 1, At, B1); PG8_BAR; PG8_SCHED;
            PG8_LDA(At, 1, 1); PG8_STAGE(PG8_SB(1, 0), b3, voffB); PG8_STAGE(PG8_SB(1, 1), b3 + hstepB, voffB); PG8_STAGE(PG8_SA(1, 0), a3, voffA);
            PG8_WAIT_V(8); PG8_WAIT_L(0); PG8_BAR; PG8_MMA(1, 0, At, B0); PG8_MMA(1, 1, At, B1); PG8_BAR; PG8_SCHED;
        }
        if (cur.last || !has_next) break;
        cur = nxt; cA = nA; cB = nB; ++qi;
        }
        if constexpr (ALIGN_EPI) { if (wr == 0) PG8_BAR; }
        E(acc, cur.u, wr, wc, fr, fq);
        if (!has_next) break;
        PG8_ZERO();
        cur = nxt; cA = nA; cB = nB; ++qi;
        if constexpr (ALIGN_EPI) { if (wr == 1) PG8_BAR; }
    }
    PG8_WAIT_V(0);
    if constexpr (!ALIGN_EPI) { if (wr == 0) PG8_BAR; }
    PG8_BAR;
#undef PG8_SA
#undef PG8_SB
#undef PG8_STAGE
#undef PG8_LDA
#undef PG8_LDB
#undef PG8_MMA
#undef PG8_WAIT_V
#undef PG8_WAIT_L
#undef PG8_BAR
#undef PG8_SCHED
#undef PG8_ZERO
}

struct EpiBf16 {
    static constexpr bool PERM = true;
    bf16_t* O; int ldc;
    __device__ __forceinline__ void operator()(const Acc& acc, const Unit& u, int wr, int wc, int fr, int fq) const {
        const int row0 = u.pm * BM + wr * 64 + fr; const int col0 = u.pn * BM + wc * 32 + 8 * fq;
#pragma unroll
        for (int ai = 0; ai < 2; ++ai)
#pragma unroll
            for (int m = 0; m < 4; ++m) { bf16_t* rowp = O + (size_t)(row0 + ai * HALF + m * 16) * ldc + col0;
#pragma unroll
                for (int bj = 0; bj < 2; ++bj) { const f32x4 v0 = acc[ai][bj][m][0], v1 = acc[ai][bj][m][1];
                    u32x4 w; w.x = cvt_pk_bf16(v0[0], v0[1]); w.y = cvt_pk_bf16(v0[2], v0[3]); w.z = cvt_pk_bf16(v1[0], v1[1]); w.w = cvt_pk_bf16(v1[2], v1[3]);
                    *(u32x4*)(rowp + bj * HALF) = w; } }
    }
};
struct EpiLora {
    static constexpr bool PERM = true;
    bf16_t* O; const float* w0; const float* a0;
    __device__ __forceinline__ void operator()(const Acc& acc, const Unit& u, int wr, int wc, int fr, int fq) const {
        const int row0 = u.pm * BM + wr * 64 + fr; const int col0 = u.pn * BM + wc * 32 + 8 * fq; const int typ = u.pn >> 2;
        const float* bsrc = (typ == 0) ? w0 : a0;
        const float mul = (typ == 0) ? -0.6065306597126334f : 1.0f; const bool lin = (typ == 2);
#pragma unroll
        for (int bj = 0; bj < 2; ++bj) {
            const int ch = (col0 + bj * HALF) & 1023;
            const f32x4 b0 = *(const f32x4*)(bsrc + ch), b1 = *(const f32x4*)(bsrc + ch + 4);
#pragma unroll
            for (int ai = 0; ai < 2; ++ai)
#pragma unroll
                for (int m = 0; m < 4; ++m) {
                    f32x4 v0 = acc[ai][bj][m][0], v1 = acc[ai][bj][m][1];
                    {
                        const f32x4 s0 = v0 + b0, s1 = v1 + b1;
                        v0.x = lin ? v0.x : mul * sigmoidf_(s0.x); v0.y = lin ? v0.y : mul * sigmoidf_(s0.y); v0.z = lin ? v0.z : mul * sigmoidf_(s0.z); v0.w = lin ? v0.w : mul * sigmoidf_(s0.w);
                        v1.x = lin ? v1.x : mul * sigmoidf_(s1.x); v1.y = lin ? v1.y : mul * sigmoidf_(s1.y); v1.z = lin ? v1.z : mul * sigmoidf_(s1.z); v1.w = lin ? v1.w : mul * sigmoidf_(s1.w);
                    }
                    u32x4 w; w.x = cvt_pk_bf16(v0.x, v0.y); w.y = cvt_pk_bf16(v0.z, v0.w); w.z = cvt_pk_bf16(v1.x, v1.y); w.w = cvt_pk_bf16(v1.z, v1.w);
                    *(u32x4*)(O + (size_t)(row0 + ai * HALF + m * 16) * NL + col0 + bj * HALF) = w;
                    asm volatile("" ::: "memory"); }
        }
    }
};
struct EpiResF32 {
    static constexpr bool PERM = false;
    const float* base; float* out; int ldc;
    __device__ __forceinline__ void operator()(const Acc& acc, const Unit& u, int wr, int wc, int fr, int fq) const {
        const int col0 = u.pn * BM + wc * 32 + 4 * fq;
#pragma unroll
        for (int ai = 0; ai < 2; ++ai)
#pragma unroll
            for (int m = 0; m < 4; ++m) { const size_t off = (size_t)(u.pm * BM + ai * HALF + wr * 64 + m * 16 + fr) * ldc + col0;
#pragma unroll
                for (int bj = 0; bj < 2; ++bj)
#pragma unroll
                    for (int n = 0; n < 2; ++n) { const f32x4 bs = *(const f32x4*)(base + off + bj * HALF + n * 16); *(f32x4*)(out + off + bj * HALF + n * 16) = bs + acc[ai][bj][m][n]; } }
    }
};
struct EpiMoe1 {
    static constexpr bool PERM = true;
    bf16_t* O; const float* gates;
    __device__ __forceinline__ void operator()(const Acc& acc, const Unit& u, int wr, int wc, int fr, int fq) const {
        const int row0 = u.pm * BM + wr * 64 + fr; const int half = u.pn >> 2; const int col0 = half * 512 + (u.pn & 3) * 128 + wc * 32 + 8 * fq;
#pragma unroll
        for (int ai = 0; ai < 2; ++ai)
#pragma unroll
            for (int m = 0; m < 4; ++m) { const int row = row0 + ai * HALF + m * 16; const float gw = gates[(size_t)row * 2 + half];
                float v[8];
#pragma unroll
                for (int e = 0; e < 8; ++e) { const float g = acc[ai][0][m][e >> 2][e & 3], up = acc[ai][1][m][e >> 2][e & 3]; v[e] = g * sigmoidf_(g) * up * gw; }
                u32x4 w; w.x = cvt_pk_bf16(v[0], v[1]); w.y = cvt_pk_bf16(v[2], v[3]); w.z = cvt_pk_bf16(v[4], v[5]); w.w = cvt_pk_bf16(v[6], v[7]);
                *(u32x4*)(O + (size_t)row * 1024 + col0) = w; }
    }
};
struct EpiMoe2 {
    static constexpr bool PERM = false;
    float* out; const int* rowtok;
    __device__ __forceinline__ void operator()(const Acc& acc, const Unit& u, int wr, int wc, int fr, int fq) const {
        const int col0 = u.pn * BM + wc * 32 + 4 * fq;
#pragma unroll
        for (int ai = 0; ai < 2; ++ai)
#pragma unroll
            for (int m = 0; m < 4; ++m) { const int row = u.pm * BM + ai * HALF + wr * 64 + m * 16 + fr; const int tok = rowtok[row];
                if (tok >= 0) { float* o = out + (size_t)tok * DM + col0;
#pragma unroll
                    for (int bj = 0; bj < 2; ++bj)
#pragma unroll
                        for (int n = 0; n < 2; ++n) { f32x4* p = (f32x4*)(o + bj * HALF + n * 16); *p = *p + acc[ai][bj][m][n]; } }
                asm volatile("" ::: "memory"); }
    }
};
}

#define XB_TMO      128
#define XB_XCNT(j)  (256  + 64 * (j))
#define XB_XSUB(j)  (1280 + 64 * (j))
#define XB_XGEN(j)  (2304 + 64 * (j))
#define XB_TOP      3328
#define XB_TOPGEN   3392
#define XCD_BAR_WORDS 3456
#define XB_SPIN_CAP (1u << 20)
__device__ __forceinline__ unsigned xb_ld(unsigned* p)              { return __hip_atomic_load(p, __ATOMIC_RELAXED, __HIP_MEMORY_SCOPE_AGENT); }
__device__ __forceinline__ unsigned xb_add(unsigned* p, unsigned v) { return __hip_atomic_fetch_add(p, v, __ATOMIC_RELAXED, __HIP_MEMORY_SCOPE_AGENT); }
__device__ __forceinline__ unsigned xb_xcc_id() { return (unsigned)__builtin_amdgcn_s_getreg((3 << 11) | 20) & 0xFu; }
#define XB_SPIN(cond, bar) do { unsigned _sp = 0; while (cond) { __builtin_amdgcn_s_sleep(1); \
    if ((++_sp & 255u) == 0u) { if (xb_ld(&(bar)[XB_TMO])) break; if (_sp > XB_SPIN_CAP) { atomicAdd(&(bar)[XB_TMO], 1u); break; } } } } while (0)
struct XcdBarrier { unsigned* bar; unsigned x; volatile LAS unsigned* st; };
__device__ __forceinline__ XcdBarrier xcd_barrier_post(unsigned* bar, volatile LAS unsigned* st) {
    XcdBarrier b; b.bar = bar; b.x = xb_xcc_id(); b.st = st;
    if (threadIdx.x == 0) (void)xb_add(&bar[XB_XCNT(b.x)], 1u);
    return b;
}
__device__ __forceinline__ void xcd_barrier_complete(unsigned* bar, unsigned x, unsigned& nloc, unsigned& nx) {
    const unsigned G = gridDim.x * gridDim.y * gridDim.z;
    unsigned sum, cnt, mine, sp = 0u;
    for (;;) {
        sum = 0u; cnt = 0u; mine = 0u;
#pragma unroll
        for (unsigned j = 0; j < 16; ++j) { const unsigned c = xb_ld(&bar[XB_XCNT(j)]); sum += c; cnt += (c > 0u) ? 1u : 0u; mine = (j == x) ? c : mine; }
        if (sum == G) break;
        __builtin_amdgcn_s_sleep(1);
        if ((++sp & 255u) == 0u) { if (xb_ld(&bar[XB_TMO])) break; if (sp > XB_SPIN_CAP) { atomicAdd(&bar[XB_TMO], 1u); break; } }
    }
    nloc = mine > 0u ? mine : 1u; nx = cnt > 0u ? cnt : 1u;
}
__device__ __forceinline__ void xcd_barrier(const XcdBarrier& b) {
    asm volatile("s_waitcnt vmcnt(0)" ::: "memory");
    __syncthreads();
    if (threadIdx.x == 0) {
        unsigned* bar = b.bar;
        __builtin_amdgcn_s_waitcnt(0);
        unsigned nloc = b.st[0], nx = b.st[1];
        if (nloc == 0u) { xcd_barrier_complete(bar, b.x, nloc, nx); b.st[0] = nloc; b.st[1] = nx; }
        const unsigned old = xb_add(&bar[XB_XSUB(b.x)], 1u);
        const unsigned gen = old / nloc;
        if (old + 1u == (gen + 1u) * nloc) {
            __builtin_amdgcn_fence(__ATOMIC_RELEASE, "agent");
            asm volatile("s_waitcnt vmcnt(0)" ::: "memory");
            const unsigned og = xb_add(&bar[XB_TOP], 1u);
            const unsigned tg = og / nx;
            if (og + 1u == (tg + 1u) * nx) xb_add(&bar[XB_TOPGEN], 1u);
            else XB_SPIN(xb_ld(&bar[XB_TOPGEN]) == tg, bar);
            __builtin_amdgcn_fence(__ATOMIC_ACQUIRE, "agent");
            xb_add(&bar[XB_XGEN(b.x)], 1u);
            asm volatile("s_waitcnt vmcnt(0)" ::: "memory");
        } else {
            XB_SPIN(xb_ld(&bar[XB_XGEN(b.x)]) == gen, bar);
            __builtin_amdgcn_fence(__ATOMIC_ACQUIRE, "agent");
            asm volatile("s_waitcnt vmcnt(0)" ::: "memory");
        }
    }
    __syncthreads();
}

struct Args { const float* in[25]; float* out; unsigned char* ws; int ph_lo, ph_hi; };
enum { I_X = 0, I_GMIX, I_WIN, I_MIX, I_QG, I_KG, I_W0, I_WDEC, I_A0, I_WAICL, I_WGATE, I_KK, I_KA, I_RK, I_LNW, I_LNB, I_WOUT, I_GFFN, I_WRG, I_BRG, I_WRE, I_BRE, I_WEG, I_WEU, I_WED };

struct Frame {
    LAS unsigned char* lds; unsigned char* ldsg;
    unsigned* ctl;
    int tid, lane, wave, vcu, G;
    const float* const* in; float* out; unsigned char* ws;
};

__device__ __forceinline__ int win_dmap(int n) {
    if (n < DSA_COLS) return n;
    const int m = n - DSA_COLS;
    if (m < 1024) return PR + m;
    if (m < 1088) return PDW + (m - 1024);
    if (m < 2112) return PKR + (m - 1088);
    if (m < 3136) return PVR + (m - 2112);
    if (m < 3200) return PDA + (m - 3136);
    return PDG + (m - 3200);
}
template <int MODE>
__device__ __forceinline__ void transpose_item(const float* W, int N, bf16_t* WT, int ldd, LAS float* scr, int kb, int nb, int lane) {
    const int k0 = 64 * kb, n0 = 32 * nb;
    const int nn = n0 + (lane & 31);
#pragma unroll 8
    for (int i = 0; i < 32; ++i) { const int kk = 2 * i + (lane >> 5); scr[kk * 33 + (lane & 31)] = (nn < N) ? W[(size_t)(k0 + kk) * N + nn] : 0.f; }
    LDS_WAIT(); asm volatile("" ::: "memory");
    const int c = lane & 7;
#pragma unroll
    for (int j = 0; j < 4; ++j) { const int nl = (lane >> 3) + 8 * j; const int n = n0 + nl; const LAS float* s = scr + (8 * c) * 33 + nl;
        u32x4 o; o.x = pk2(s[0 * 33], s[1 * 33]); o.y = pk2(s[2 * 33], s[3 * 33]); o.z = pk2(s[4 * 33], s[5 * 33]); o.w = pk2(s[6 * 33], s[7 * 33]);
        int dr = n;
        if (MODE == 1) dr = win_dmap(n);
        if (MODE == 2) dr = (n >> 7) * 256 + (n & 127);
        if (MODE == 3) dr = (n >> 7) * 256 + 128 + (n & 127);
        if (n < N) *(u32x4*)(WT + (size_t)dr * ldd + k0 + 8 * c) = o; }
    LDS_WAIT(); asm volatile("" ::: "memory");
}

__device__ __forceinline__ void phase0(Frame& F) {
    LAS float* scr = (LAS float*)(F.lds + F.wave * 16384);
    const int gw = F.vcu * 8 + F.wave, NGW = F.G * 8, lane = F.lane;
    constexpr int NB_IN = (IN_COLS + 31) / 32;
    constexpr int I_IN = (DM / 64) * NB_IN, I_OUT = (DM / 64) * (DM / 32);
    bf16_t* WIN = (bf16_t*)(F.ws + WS_WIN); bf16_t* WOUT = (bf16_t*)(F.ws + WS_WOUT);
    for (int it = gw; it < I_IN + I_OUT; it += NGW) {
        if (it < I_IN) transpose_item<1>(F.in[I_WIN], IN_COLS, WIN, DM, scr, it / NB_IN, it % NB_IN, lane);
        else { const int r = it - I_IN; transpose_item<0>(F.in[I_WOUT], DM, WOUT, DM, scr, r / (DM / 32), r % (DM / 32), lane); }
    }
    for (int i = gw; i < 144 * 4; i += NGW) { const int r = i >> 2, q = i & 3; const int row = r < 48 ? 4176 + r : 7584 + (r - 48);
        *(u32x4*)(WIN + (size_t)row * DM + q * 512 + lane * 8) = (u32x4){0u, 0u, 0u, 0u}; }
    { bf16_t* WL = (bf16_t*)(F.ws + WS_WLORA); const float* wd = F.in[I_WDEC]; const float* wa = F.in[I_WAICL]; const float* wg = F.in[I_WGATE];
      for (int i = gw * 64 + lane; i < NL * KL; i += NGW * 64) { const int n = i / KL, k = i % KL; const int typ = n >> 10, c = n & 1023; float v = 0.f;
          if (typ == 0 && k < 64) v = wd[k * 1024 + c];
          else if (typ == 1 && k >= 64 && k < 128) v = wa[(k - 64) * 1024 + c];
          else if (typ == 2 && k >= 128 && k < 288) v = wg[(k - 128) * 1024 + c];
          WL[i] = (bf16_t)f2bf(v); } }
    { const float* x = F.in[I_X]; const float* g = F.in[I_GMIX]; bf16_t* HN = (bf16_t*)(F.ws + WS_HN);
      f32x4 gv[8];
#pragma unroll
      for (int j = 0; j < 8; ++j) gv[j] = ((const f32x4*)g)[64 * j + lane];
      for (int m = gw; m < T; m += NGW) { const f32x4* xr = (const f32x4*)(x + (size_t)m * DM) + lane; f32x4 v[8]; float s = 0.f;
#pragma unroll
          for (int j = 0; j < 8; ++j) { v[j] = xr[64 * j]; s += (v[j].x * v[j].x + v[j].y * v[j].y) + (v[j].z * v[j].z + v[j].w * v[j].w); }
          const float rstd = rsqrtf(wave_sum(s) * (1.f / DM) + NORM_EPS);
          u32x2* o = (u32x2*)(HN + (size_t)m * DM) + lane;
#pragma unroll
          for (int j = 0; j < 8; ++j) { u32x2 w; w.x = pk2(v[j].x * rstd * gv[j].x, v[j].y * rstd * gv[j].y); w.y = pk2(v[j].z * rstd * gv[j].z, v[j].w * rstd * gv[j].w); o[64 * j] = w; } } }
}

__device__ __forceinline__ void rope4(float& y0, float& y1, float& y2, float& y3, float c0, float s0, float c1, float s1) {
    const float o0 = y0 * c0 - y2 * s0, o2 = y2 * c0 + y0 * s0, o1 = y1 * c1 - y3 * s1, o3 = y3 * c1 + y1 * s1; y0 = o0; y1 = o1; y2 = o2; y3 = o3;
}
__device__ __forceinline__ void phase2(Frame& F) {
    const int gw = F.vcu * 8 + F.wave, NGW = F.G * 8, lane = F.lane;
    bf16_t* P = (bf16_t*)(F.ws + WS_P); bf16_t* KI = (bf16_t*)(F.ws + WS_KI); bf16_t* AL = (bf16_t*)(F.ws + WS_ALORA);
    const float* mix = F.in[I_MIX];
    const int l5 = lane & 31, hsel = lane >> 5, l4 = lane & 15, hq = lane >> 4;
    float qg[4], kg[4];
    { const float* a = F.in[I_QG]; const float* b = F.in[I_KG];
      qg[0] = a[2 * l5]; qg[1] = a[2 * l5 + 1]; qg[2] = a[64 + 2 * l5]; qg[3] = a[65 + 2 * l5];
      kg[0] = b[2 * l5]; kg[1] = b[2 * l5 + 1]; kg[2] = b[64 + 2 * l5]; kg[3] = b[65 + 2 * l5]; }
    const float L2T = 13.287712379549449f;
    const float inv128_0 = exp2f(-(float)(2 * l5) * (1.0f / 64.0f) * L2T), inv128_1 = exp2f(-(float)(2 * l5 + 1) * (1.0f / 64.0f) * L2T);
    const float inv64_0 = exp2f(-(float)(2 * l4) * (1.0f / 32.0f) * L2T), inv64_1 = exp2f(-(float)(2 * l4 + 1) * (1.0f / 32.0f) * L2T);
    const float mu_dw = mix[1024 + lane], mu_da = mix[3136 + lane], mu_g0 = mix[3200 + lane], mu_g1 = mix[3264 + lane], mu_g2 = (lane < 32) ? mix[3328 + lane] : 0.f;
    for (int t = gw; t < T; t += NGW) {
        const int pos = t & (SEQ - 1); const float fp = (float)pos;
        bf16_t* row = P + (size_t)t * NP;
        float c0, s0, c1, s1, d0, e0, d1, e1;
        sincosf(fp * inv128_0, &s0, &c0); sincosf(fp * inv128_1, &s1, &c1);
        sincosf(fp * inv64_0, &e0, &d0); sincosf(fp * inv64_1, &e1, &d1);
#pragma unroll
        for (int which = 0; which < 2; ++which) {
#pragma unroll
            for (int hh = 0; hh < 4; ++hh) {
                unsigned* base = (unsigned*)(row + (which ? PK : PQ) + (2 * hh + hsel) * 128);
                const unsigned a = base[l5], b = base[32 + l5];
                float y0 = bflo(a), y1 = bfhi(a), y2 = bflo(b), y3 = bfhi(b);
                const float ss = half_sum((y0 * y0 + y1 * y1) + (y2 * y2 + y3 * y3));
                const float rstd = rsqrtf(ss * (1.0f / 128.0f) + NORM_EPS) * (which ? 1.0f : QSCALE);
                const float* gg = which ? kg : qg;
                y0 *= rstd * gg[0]; y1 *= rstd * gg[1]; y2 *= rstd * gg[2]; y3 *= rstd * gg[3];
                rope4(y0, y1, y2, y3, c0, s0, c1, s1);
                base[l5] = pk2(y0, y1); base[32 + l5] = pk2(y2, y3);
            }
        }
#pragma unroll
        for (int it = 0; it < 4; ++it) {
            unsigned* base = (unsigned*)(row + PQI + (4 * it + hq) * 64);
            const unsigned a = base[l4], b = base[16 + l4];
            float y0 = bflo(a), y1 = bfhi(a), y2 = bflo(b), y3 = bfhi(b);
            rope4(y0, y1, y2, y3, d0, e0, d1, e1);
            base[l4] = pk2(y0, y1); base[16 + l4] = pk2(y2, y3);
        }
        if (lane < 16) {
            const unsigned* base = (const unsigned*)(row + PKI);
            const unsigned a = base[l4], b = base[16 + l4];
            float y0 = bflo(a), y1 = bfhi(a), y2 = bflo(b), y3 = bfhi(b);
            rope4(y0, y1, y2, y3, d0, e0, d1, e1);
            unsigned* o = (unsigned*)(KI + (size_t)t * 64);
            o[l4] = pk2(y0, y1); o[16 + l4] = pk2(y2, y3);
        }
        {
            const bool hp = pos > 0; const bf16_t* prow = row - NP;
            bf16_t* al = AL + (size_t)t * KL;
            float p, pp, sh;
            p = bf2f(row[PDW + lane]); pp = hp ? bf2f(prow[PDW + lane]) : 0.f; sh = p + (pp - p) * mu_dw; al[lane] = (bf16_t)f2bf(tanhf(sh));
            p = bf2f(row[PDA + lane]); pp = hp ? bf2f(prow[PDA + lane]) : 0.f; sh = p + (pp - p) * mu_da; al[64 + lane] = (bf16_t)f2bf(sh);
            p = bf2f(row[PDG + lane]); pp = hp ? bf2f(prow[PDG + lane]) : 0.f; sh = p + (pp - p) * mu_g0; al[128 + lane] = (bf16_t)f2bf(sigmoidf_(sh));
            p = bf2f(row[PDG + 64 + lane]); pp = hp ? bf2f(prow[PDG + 64 + lane]) : 0.f; sh = p + (pp - p) * mu_g1; al[192 + lane] = (bf16_t)f2bf(sigmoidf_(sh));
            if (lane < 32) { p = bf2f(row[PDG + 128 + lane]); pp = hp ? bf2f(prow[PDG + 128 + lane]) : 0.f; sh = p + (pp - p) * mu_g2; al[256 + lane] = (bf16_t)f2bf(sigmoidf_(sh)); }
            al[288 + lane] = 0; if (lane < 32) al[352 + lane] = 0;
        }
    }
}

__device__ __forceinline__ unsigned fkey(float f) { const unsigned u = __builtin_bit_cast(unsigned, f); return (u & 0x80000000u) ? ~u : (u | 0x80000000u); }
__device__ __forceinline__ void phase4(Frame& F) {
    const int lane = F.lane, wave = F.wave;
    const bf16_t* P = (const bf16_t*)(F.ws + WS_P); const bf16_t* KI = (const bf16_t*)(F.ws + WS_KI); unsigned* MSK = (unsigned*)(F.ws + WS_MSK);
    const int r = lane & 31, h = lane >> 5;
    for (int u = F.vcu; u < 1024; u += F.G) {
        const int band = u >> 8, cc = u & 255, s4 = cc >> 4;
        const int i = (band == 0) ? 63 - s4 : (band == 1) ? 32 + s4 : (band == 2) ? 31 - s4 : s4;
        const int b = (cc & 15) >> 2, g = cc & 3;
        const int t0 = b * SEQ + i * 64 + g * 16 + 2 * wave;
        const int njt = 2 * (i + 1);
        bf16x8 a[4];
        { const bf16_t* ap = P + (size_t)(t0 + ((r >> 2) & 1)) * NP + PQI + ((r & 3) + 4 * (r >> 3)) * 64 + 8 * h;
#pragma unroll
          for (int s = 0; s < 4; ++s) a[s] = *(const bf16x8*)(ap + 16 * s); }
        float wq[16];
        { const bf16_t* wp = P + (size_t)(t0 + h) * NP + PWI;
#pragma unroll
          for (int e = 0; e < 16; ++e) wq[e] = bf2f(wp[e]) * (1.0f / 32.0f); }
        unsigned sc[128];
        const bf16_t* kp = KI + ((size_t)b * SEQ + r) * 64 + 8 * h;
#pragma unroll
        for (int j = 0; j < 128; ++j) {
            if (j < njt) {
                bf16x8 bb[4];
#pragma unroll
                for (int s = 0; s < 4; ++s) bb[s] = *(const bf16x8*)(kp + (size_t)j * 32 * 64 + 16 * s);
                f32x16 acc = {0.f, 0.f, 0.f, 0.f, 0.f, 0.f, 0.f, 0.f, 0.f, 0.f, 0.f, 0.f, 0.f, 0.f, 0.f, 0.f};
#pragma unroll
                for (int s = 0; s < 4; ++s) acc = __builtin_amdgcn_mfma_f32_32x32x16_bf16(a[s], bb[s], acc, 0, 0, 0);
                float sum = 0.f;
#pragma unroll
                for (int e = 0; e < 16; ++e) sum += wq[e] * fmaxf(acc[e], 0.f);
                sc[j] = fkey(sum);
            } else sc[j] = 0u;
        }
        unsigned thr = 0u;
        if (njt > 8) {
            for (int bit = 31; bit >= 0; --bit) {
                const unsigned cand = thr | (1u << bit);
                int cnt = 0;
#pragma unroll
                for (int j = 0; j < 128; ++j) if (j < njt) cnt += (sc[j] >= cand) ? 1 : 0;
#pragma unroll
                for (int o = 1; o < 32; o <<= 1) cnt += __shfl_xor(cnt, o);
                if (cnt >= 256) thr = cand;
            }
        }
        unsigned m0a = 0u, m0b = 0u, m1a = 0u, m1b = 0u;
#pragma unroll
        for (int j = 0; j < 128; ++j) {
            const bool pred = (j < njt) && (sc[j] >= thr);
            const unsigned long long bal = __ballot(pred);
            const unsigned lo = (unsigned)bal, hi = (unsigned)(bal >> 32);
            if (j < 64) { m0a = (lane == j) ? lo : m0a; m1a = (lane == j) ? hi : m1a; }
            else { m0b = (lane == j - 64) ? lo : m0b; m1b = (lane == j - 64) ? hi : m1b; }
        }
        MSK[(size_t)t0 * 128 + lane] = m0a; MSK[(size_t)t0 * 128 + 64 + lane] = m0b;
        MSK[(size_t)(t0 + 1) * 128 + lane] = m1a; MSK[(size_t)(t0 + 1) * 128 + 64 + lane] = m1b;
    }
}

__device__ __forceinline__ void attn_task_naive(Frame& F, int task, unsigned char* wl) {
    const int lane = F.lane;
    const bf16_t* P = (const bf16_t*)(F.ws + WS_P); const unsigned* MSK = (const unsigned*)(F.ws + WS_MSK); bf16_t* Y = (bf16_t*)(F.ws + WS_YCAT);
    int* list = (int*)wl; float* qs = (float*)(wl + 1024); float* ps = (float*)(wl + 1536);
    const int t = task >> 3, hd = task & 7, b = t >> 12, i = (t & (SEQ - 1)) >> 6;
    const int ntile = i + 1;
    int cnt = 0;
    for (int jj = 0; jj < ntile; ++jj) {
        const unsigned w0 = MSK[(size_t)t * 128 + 2 * jj], w1 = MSK[(size_t)t * 128 + 2 * jj + 1];
        const unsigned long long m = (unsigned long long)w0 | ((unsigned long long)w1 << 32);
        const int pre = __popcll(m & ((1ull << lane) - 1ull));
        if (((m >> lane) & 1ull) && (cnt + pre < 256)) list[cnt + pre] = 64 * jj + lane;
        cnt += __popcll(m);
    }
    const int nsel = cnt < 256 ? cnt : 256;
    { const bf16_t* qp = P + (size_t)t * NP + PQ + hd * 128; qs[lane] = bf2f(qp[lane]); qs[64 + lane] = bf2f(qp[64 + lane]); }
    LDS_WAIT(); asm volatile("" ::: "memory");
    float lg[4]; float mx = -INFINITY;
#pragma unroll
    for (int rr = 0; rr < 4; ++rr) {
        const int e = lane + 64 * rr; lg[rr] = -INFINITY;
        if (e < nsel) { const int key = list[e]; const u32x4* kp = (const u32x4*)(P + ((size_t)b * SEQ + key) * NP + PK + hd * 128); float d = 0.f;
#pragma unroll
            for (int c = 0; c < 16; ++c) { const u32x4 kv = kp[c]; const float* q = qs + 8 * c;
                d += q[0] * bflo(kv.x) + q[1] * bfhi(kv.x) + q[2] * bflo(kv.y) + q[3] * bfhi(kv.y) + q[4] * bflo(kv.z) + q[5] * bfhi(kv.z) + q[6] * bflo(kv.w) + q[7] * bfhi(kv.w); }
            lg[rr] = d; mx = fmaxf(mx, d); }
    }
#pragma unroll
    for (int o = 1; o < 64; o <<= 1) mx = fmaxf(mx, __shfl_xor(mx, o));
    float sum = 0.f;
#pragma unroll
    for (int rr = 0; rr < 4; ++rr) { const int e = lane + 64 * rr; const float p = (e < nsel) ? exp2f(lg[rr] - mx) : 0.f; ps[e] = p; sum += p; }
    sum = wave_sum(sum);
    LDS_WAIT(); asm volatile("" ::: "memory");
    float o0 = 0.f, o1 = 0.f;
    const bf16_t* vb = P + (size_t)b * SEQ * NP + PV + hd * 128 + 2 * lane;
    for (int e = 0; e < nsel; ++e) { const int key = list[e]; const float p = ps[e]; const unsigned v = *(const unsigned*)(vb + (size_t)key * NP); o0 += p * bflo(v); o1 += p * bfhi(v); }
    const float inv = 1.0f / sum;
    *(unsigned*)(Y + (size_t)t * DM + hd * 128 + 2 * lane) = pk2(o0 * inv, o1 * inv);
    LDS_WAIT(); asm volatile("" ::: "memory");
}

__device__ __forceinline__ void rwkv_scan_naive(Frame& F, int bh, unsigned char* wl) {
    const int lane = F.lane, b = bh >> 4, hd = bh & 15, ch = hd * 64 + lane;
    const bf16_t* P = (const bf16_t*)(F.ws + WS_P); const bf16_t* L3 = (const bf16_t*)(F.ws + WS_L3); bf16_t* Y = (bf16_t*)(F.ws + WS_YCAT);
    const float* mix = F.in[I_MIX];
    const float mu_r = mix[ch], mu_k = mix[1088 + ch], mu_v = mix[2112 + ch];
    const float kkc = F.in[I_KK][ch], kac = F.in[I_KA][ch], rkc = F.in[I_RK][ch], lnw = F.in[I_LNW][ch], lnb = F.in[I_LNB][ch];
    float* vec = (float*)wl;
    f32x4 S4[16];
#pragma unroll
    for (int k = 0; k < 16; ++k) S4[k] = (f32x4){0.f, 0.f, 0.f, 0.f};
    float prev_r = 0.f, prev_k = 0.f, prev_v = 0.f;
    constexpr int PF = 4;
    float in_r[PF], in_k[PF], in_v[PF], in_ld[PF], in_a[PF], in_g[PF];
    const bf16_t* prow = P + (size_t)b * SEQ * NP + ch; const bf16_t* lrow = L3 + (size_t)b * SEQ * NL + ch;
#pragma unroll
    for (int j = 0; j < PF; ++j) { const bf16_t* pr = prow + (size_t)j * NP; const bf16_t* lr = lrow + (size_t)j * NL;
        in_r[j] = bf2f(pr[PR]); in_k[j] = bf2f(pr[PKR]); in_v[j] = bf2f(pr[PVR]); in_ld[j] = bf2f(lr[0]); in_a[j] = bf2f(lr[1024]); in_g[j] = bf2f(lr[2048]); }
    const f32x4* vec4 = (const f32x4*)vec;
    for (int tb = 0; tb < SEQ; tb += PF) {
        float c_r[PF], c_k[PF], c_v[PF], c_ld[PF], c_a[PF], c_g[PF];
#pragma unroll
        for (int j = 0; j < PF; ++j) { c_r[j] = in_r[j]; c_k[j] = in_k[j]; c_v[j] = in_v[j]; c_ld[j] = in_ld[j]; c_a[j] = in_a[j]; c_g[j] = in_g[j]; }
        {
            const int tn = (tb + PF < SEQ) ? tb + PF : tb;
#pragma unroll
            for (int j = 0; j < PF; ++j) { const bf16_t* pr = prow + (size_t)(tn + j) * NP; const bf16_t* lr = lrow + (size_t)(tn + j) * NL;
                in_r[j] = bf2f(pr[PR]); in_k[j] = bf2f(pr[PKR]); in_v[j] = bf2f(pr[PVR]); in_ld[j] = bf2f(lr[0]); in_a[j] = bf2f(lr[1024]); in_g[j] = bf2f(lr[2048]); }
        }
#pragma unroll
        for (int j = 0; j < PF; ++j) {
            const float r_t = c_r[j] + (prev_r - c_r[j]) * mu_r, k_t = c_k[j] + (prev_k - c_k[j]) * mu_k, v_t = c_v[j] + (prev_v - c_v[j]) * mu_v;
            prev_r = c_r[j]; prev_k = c_k[j]; prev_v = c_v[j];
            const float a = c_a[j];
            const float kkr = k_t * kkc; const float n2 = wave_sum(kkr * kkr); const float kk = kkr * (1.0f / fmaxf(sqrtf(n2), 1e-12f));
            const float kp = k_t * (1.0f + (a - 1.0f) * kac); const float w = __expf(c_ld[j]); const float bb = kk * a;
            vec[lane] = -kk; vec[64 + lane] = w; vec[128 + lane] = bb; vec[192 + lane] = kp; vec[256 + lane] = r_t;
            LDS_WAIT(); asm volatile("" ::: "memory");
            f32x4 sa4 = (f32x4){0.f, 0.f, 0.f, 0.f};
#pragma unroll
            for (int k = 0; k < 16; ++k) { sa4 += S4[k] * vec4[k]; if ((k & 3) == 3) asm volatile("" ::: "memory"); }
            const float sa = (sa4.x + sa4.y) + (sa4.z + sa4.w);
            f32x4 y4 = (f32x4){0.f, 0.f, 0.f, 0.f};
#pragma unroll
            for (int k = 0; k < 16; ++k) {
                const f32x4 wv = vec4[16 + k], bv = vec4[32 + k], kv = vec4[48 + k], rv = vec4[64 + k];
                S4[k] = S4[k] * wv + bv * sa + kv * v_t; y4 += S4[k] * rv;
                if (k & 1) asm volatile("" ::: "memory"); }
            const float y = (y4.x + y4.y) + (y4.z + y4.w);
            const float mean = wave_sum(y) * (1.0f / 64.0f); const float dv = y - mean; const float var = wave_sum(dv * dv) * (1.0f / 64.0f);
            const float yn = dv * rsqrtf(var + GN_EPS) * lnw + lnb;
            const float bonus = wave_sum(r_t * kp * rkc) * v_t;
            const float o = (yn + bonus) * c_g[j];
            Y[((size_t)b * SEQ + tb + j) * DM + 1024 + ch] = (bf16_t)f2bf(o);
            asm volatile("" ::: "memory");
        }
    }
}


namespace rw {
constexpr int TP = 72, TILE_B = 64 * TP * 2;
enum { T_ATM = 0, T_RTM, T_BTM, T_KTM, T_ACM, T_VCM, T_BCM, T_KCM, T_MAB, T_MAK, T_MRB, T_MRK, T_TINV, NTILE };
constexpr int T_G1 = T_ATM, T_AP = T_BTM, T_U0 = T_KTM;
constexpr int OFF_X11T = NTILE * TILE_B, OFF_T1T = OFF_X11T + 2560, OFF_SEG = OFF_T1T + 2560, OFF_PC = OFF_SEG + 2048, LDS_END = OFF_PC + 256;
static_assert(LDS_END <= RING_BYTES, "rwkv pass A LDS");
__device__ __forceinline__ int crow(int e, int h) { return (e & 3) + 8 * (e >> 2) + 4 * h; }
__device__ __forceinline__ f32x16 zero16() { return (f32x16){0.f, 0.f, 0.f, 0.f, 0.f, 0.f, 0.f, 0.f, 0.f, 0.f, 0.f, 0.f, 0.f, 0.f, 0.f, 0.f}; }
template <int KS>
__device__ __forceinline__ f32x16 mmt(const LAS bf16_t* A, int ap, int ar0, int ac0, const LAS bf16_t* B, int bp, int br0, int bc0, f32x16 acc, int r, int h) {
    const LAS bf16_t* pa = A + (ar0 + r) * ap + ac0 + 8 * h; const LAS bf16_t* pb = B + (br0 + r) * bp + bc0 + 8 * h;
#pragma unroll
    for (int s = 0; s < KS; ++s) acc = __builtin_amdgcn_mfma_f32_32x32x16_bf16(*(const LAS bf16x8*)(pa + 16 * s), *(const LAS bf16x8*)(pb + 16 * s), acc, 0, 0, 0);
    return acc;
}
__device__ __forceinline__ void store_rm(LAS bf16_t* D, int r0, int c0, const f32x16& acc, int r, int h) {
#pragma unroll
    for (int e = 0; e < 16; ++e) D[(r0 + crow(e, h)) * TP + c0 + r] = (bf16_t)f2bf(acc[e]);
}
__device__ __forceinline__ u32x4 pack8(const f32x16& a, int s) { u32x4 w; w.x = pk2(a[8 * s], a[8 * s + 1]); w.y = pk2(a[8 * s + 2], a[8 * s + 3]); w.z = pk2(a[8 * s + 4], a[8 * s + 5]); w.w = pk2(a[8 * s + 6], a[8 * s + 7]); return w; }
__device__ __forceinline__ void unpack8(const u32x4 w, f32x16& a, int s) { a[8 * s] = bflo(w.x); a[8 * s + 1] = bfhi(w.x); a[8 * s + 2] = bflo(w.y); a[8 * s + 3] = bfhi(w.y); a[8 * s + 4] = bflo(w.z); a[8 * s + 5] = bfhi(w.z); a[8 * s + 6] = bflo(w.w); a[8 * s + 7] = bfhi(w.w); }
__device__ __forceinline__ unsigned char* l3_slot(unsigned char* l3, int tg0, int col0, int bo) { return l3 + ((size_t)(tg0 + (bo >> 7)) * NL + col0) * 2 + (bo & 127); }

__device__ __forceinline__ void pass_a(Frame& F) {
    const int lane = F.lane, wave = F.wave, r = lane & 31, h = lane >> 5;
    LAS bf16_t* tiles = (LAS bf16_t*)F.lds;
#define TL(i) (tiles + (i) * (TILE_B / 2))
    LAS bf16_t* X11T = (LAS bf16_t*)(F.lds + OFF_X11T); LAS bf16_t* T1T = (LAS bf16_t*)(F.lds + OFF_T1T);
    LAS float* seg = (LAS float*)(F.lds + OFF_SEG); LAS float* pc = (LAS float*)(F.lds + OFF_PC);
    const bf16_t* P = (const bf16_t*)(F.ws + WS_P); unsigned char* L3 = F.ws + WS_L3;
    bf16_t* MT = (bf16_t*)(F.ws + WS_MT); bf16_t* SA = (bf16_t*)(F.ws + WS_SA); float* BON = (float*)(F.ws + WS_BON);
    const float* mix = F.in[I_MIX];
    for (int unit = F.vcu; unit < 4096; unit += F.G) {
        const int b = unit >> 10, hd = (unit >> 6) & 15, ci = unit & 63, tg0 = b * SEQ + ci * 64;
        {
            const int c = lane, ch = hd * 64 + c, sg = wave;
            const float mu_r = mix[ch], mu_k = mix[1088 + ch], mu_v = mix[2112 + ch];
            const float kkc = F.in[I_KK][ch], kac = F.in[I_KA][ch], rkc = F.in[I_RK][ch];
            const bf16_t* p0 = P + (size_t)(tg0 + 8 * sg) * NP + ch; const bf16_t* l0 = (const bf16_t*)L3 + (size_t)(tg0 + 8 * sg) * NL + ch;
            float pr, pk, pv;
            if (ci == 0 && sg == 0) { pr = 0.f; pk = 0.f; pv = 0.f; } else { pr = bf2f(p0[PR - NP]); pk = bf2f(p0[PKR - NP]); pv = bf2f(p0[PVR - NP]); }
            float rr[8], kp[8], vv[8], kk[8], bb[8], ld[8], cl[8];
            float run = 0.f;
#pragma unroll
            for (int j = 0; j < 8; ++j) {
                const float cr = bf2f(p0[(size_t)j * NP + PR]), ck = bf2f(p0[(size_t)j * NP + PKR]), cv = bf2f(p0[(size_t)j * NP + PVR]);
                const float l = bf2f(l0[(size_t)j * NL]), a = bf2f(l0[(size_t)j * NL + 1024]);
                const float r_t = cr + (pr - cr) * mu_r, k_t = ck + (pk - ck) * mu_k, v_t = cv + (pv - cv) * mu_v; pr = cr; pk = ck; pv = cv;
                const float kkr = k_t * kkc; const float n2 = wave_sum(kkr * kkr); const float kkn = kkr * (1.0f / fmaxf(sqrtf(n2), 1e-12f));
                const float kpp = k_t * (1.0f + (a - 1.0f) * kac);
                const float bon = wave_sum(r_t * kpp * rkc);
                if (lane == 0) BON[(size_t)(tg0 + 8 * sg + j) * 16 + hd] = bon;
                run += l; rr[j] = r_t; kp[j] = kpp; vv[j] = v_t; kk[j] = kkn; bb[j] = kkn * a; ld[j] = l; cl[j] = run;
            }
            seg[sg * 64 + c] = run;
            __syncthreads();
            float off = 0.f, tot = 0.f;
#pragma unroll
            for (int q = 0; q < 8; ++q) { const float v = seg[q * 64 + c]; tot += v; off += (q < sg) ? v : 0.f; }
            if (sg == 0) pc[c] = __expf(tot);
            float ta[8], tr[8], tb[8], tk[8];
#pragma unroll
            for (int j = 0; j < 8; ++j) { const float lp = off + cl[j]; const float ep = __expf(lp), em = __expf(-lp), epm = __expf(lp - ld[j]);
                ta[j] = -kk[j] * epm; tr[j] = rr[j] * ep; tb[j] = bb[j] * em; tk[j] = kp[j] * em; }
#pragma unroll
            for (int j = 0; j < 8; ++j) { const int o = (8 * sg + j) * TP + c;
                TL(T_ATM)[o] = (bf16_t)f2bf(ta[j]); TL(T_RTM)[o] = (bf16_t)f2bf(tr[j]); TL(T_BTM)[o] = (bf16_t)f2bf(tb[j]); TL(T_KTM)[o] = (bf16_t)f2bf(tk[j]); }
            { const int o = c * TP + 8 * sg;
              *(LAS u32x4*)(TL(T_ACM) + o) = (u32x4){pk2(ta[0], ta[1]), pk2(ta[2], ta[3]), pk2(ta[4], ta[5]), pk2(ta[6], ta[7])};
              *(LAS u32x4*)(TL(T_VCM) + o) = (u32x4){pk2(vv[0], vv[1]), pk2(vv[2], vv[3]), pk2(vv[4], vv[5]), pk2(vv[6], vv[7])};
              *(LAS u32x4*)(TL(T_BCM) + o) = (u32x4){pk2(tb[0], tb[1]), pk2(tb[2], tb[3]), pk2(tb[4], tb[5]), pk2(tb[6], tb[7])};
              *(LAS u32x4*)(TL(T_KCM) + o) = (u32x4){pk2(tk[0], tk[1]), pk2(tk[2], tk[3]), pk2(tk[4], tk[5]), pk2(tk[6], tk[7])}; }
        }
        __syncthreads();
#pragma unroll
        for (int q = 0; q < 2; ++q) {
            const int id = 2 * wave + q, rt = id >> 2, ct = id & 3;
            const LAS bf16_t* Z = (rt < 2) ? TL(T_ATM) : TL(T_RTM); const LAS bf16_t* X = (ct < 2) ? TL(T_BTM) : TL(T_KTM);
            LAS bf16_t* D = (rt < 2) ? ((ct < 2) ? TL(T_MAB) : TL(T_MAK)) : ((ct < 2) ? TL(T_MRB) : TL(T_MRK));
            const int zr0 = (rt & 1) * 32, xr0 = (ct & 1) * 32; const bool strict = rt < 2;
            f32x16 acc = zero16();
            if (xr0 <= zr0) acc = mmt<4>(Z, TP, zr0, 0, X, TP, xr0, 0, acc, r, h);
#pragma unroll
            for (int e = 0; e < 16; ++e) { const int t = zr0 + crow(e, h), i = xr0 + r; const bool keep = strict ? (i < t) : (i <= t); D[t * TP + i] = keep ? (bf16_t)f2bf(acc[e]) : (bf16_t)0; }
        }
        __syncthreads();
        if (wave == 0) {
            const LAS bf16_t* Lm = TL(T_MAB); LAS bf16_t* TI = TL(T_TINV);
            const int n = r, o = 32 * h;
            float x[32];
#pragma unroll
            for (int t = 0; t < 32; ++t) {
                float acc = (t == n) ? 1.0f : 0.0f;
#pragma unroll
                for (int i8 = 0; i8 < (t + 7) / 8; ++i8) { const u32x4 w = *(const LAS u32x4*)(Lm + (o + t) * TP + o + 8 * i8);
                    const float l0 = bflo(w.x), l1 = bfhi(w.x), l2 = bflo(w.y), l3 = bfhi(w.y), l4 = bflo(w.z), l5 = bfhi(w.z), l6 = bflo(w.w), l7 = bfhi(w.w);
                    if (8 * i8 + 0 < t) acc += l0 * x[8 * i8 + 0]; if (8 * i8 + 1 < t) acc += l1 * x[8 * i8 + 1]; if (8 * i8 + 2 < t) acc += l2 * x[8 * i8 + 2]; if (8 * i8 + 3 < t) acc += l3 * x[8 * i8 + 3];
                    if (8 * i8 + 4 < t) acc += l4 * x[8 * i8 + 4]; if (8 * i8 + 5 < t) acc += l5 * x[8 * i8 + 5]; if (8 * i8 + 6 < t) acc += l6 * x[8 * i8 + 6]; if (8 * i8 + 7 < t) acc += l7 * x[8 * i8 + 7]; }
                x[t] = acc;
            }
#pragma unroll
            for (int t = 0; t < 32; ++t) { TI[(o + t) * TP + o + n] = (bf16_t)f2bf(x[t]); if (h == 0) TI[t * TP + 32 + n] = (bf16_t)0; }
            if (h == 0) {
#pragma unroll
                for (int q = 0; q < 4; ++q) *(LAS u32x4*)(X11T + n * 40 + 8 * q) = (u32x4){pk2(x[8 * q], x[8 * q + 1]), pk2(x[8 * q + 2], x[8 * q + 3]), pk2(x[8 * q + 4], x[8 * q + 5]), pk2(x[8 * q + 6], x[8 * q + 7])};
            }
            LDS_WAIT(); asm volatile("" ::: "memory");
            f32x16 t1 = mmt<2>(Lm, TP, 32, 0, X11T, 40, 0, 0, zero16(), r, h);
#pragma unroll
            for (int g = 0; g < 4; ++g) *(LAS u32x2*)(T1T + r * 40 + 8 * g + 4 * h) = (u32x2){pk2(t1[4 * g], t1[4 * g + 1]), pk2(t1[4 * g + 2], t1[4 * g + 3])};
            LDS_WAIT(); asm volatile("" ::: "memory");
            f32x16 x21 = mmt<2>(TI, TP, 32, 32, T1T, 40, 0, 0, zero16(), r, h);
            store_rm(TI, 32, 0, x21, r, h);
        } else if (wave >= 4) {
            const int mi = (wave - 4) >> 1, ni = (wave - 4) & 1;
            f32x16 acc = mmt<4>(TL(T_VCM), TP, 32 * mi, 0, TL(T_MAK), TP, 32 * ni, 0, zero16(), r, h);
            store_rm(TL(T_G1), 32 * mi, 32 * ni, acc, r, h);
        }
        __syncthreads();
        {
            const int w4 = wave & 3, mi = w4 >> 1, ni = w4 & 1;
            if (wave < 4) { f32x16 acc = mmt<4>(TL(T_ACM), TP, 32 * mi, 0, TL(T_TINV), TP, 32 * ni, 0, zero16(), r, h); store_rm(TL(T_AP), 32 * mi, 32 * ni, acc, r, h); }
            else { f32x16 acc = mmt<4>(TL(T_G1), TP, 32 * mi, 0, TL(T_TINV), TP, 32 * ni, 0, zero16(), r, h); store_rm(TL(T_U0), 32 * mi, 32 * ni, acc, r, h); }
        }
        __syncthreads();
#pragma unroll
        for (int q = 0; q < 2; ++q) {
            const int id = 2 * wave + q, typ = id >> 2, xx = (id >> 1) & 1, yy = id & 1;
            if (typ == 0) {
                f32x16 acc = mmt<4>(TL(T_AP), TP, 32 * xx, 0, TL(T_MRB), TP, 32 * yy, 0, zero16(), r, h);
#pragma unroll
                for (int g = 0; g < 4; ++g) { const u32x2 w = *(const LAS u32x2*)(TL(T_RTM) + (32 * yy + r) * TP + 32 * xx + 8 * g + 4 * h);
                    acc[4 * g] += bflo(w.x); acc[4 * g + 1] += bfhi(w.x); acc[4 * g + 2] += bflo(w.y); acc[4 * g + 3] += bfhi(w.y); }
#pragma unroll
                for (int s = 0; s < 2; ++s) *(u32x4*)l3_slot(L3, tg0, hd * 64, (((xx * 2 + s) * 2 + yy) * 64 + lane) * 16) = pack8(acc, s);
            } else if (typ == 1) {
                f32x16 acc = mmt<4>(TL(T_U0), TP, 32 * xx, 0, TL(T_MRB), TP, 32 * yy, 0, zero16(), r, h);
                acc = mmt<4>(TL(T_VCM), TP, 32 * xx, 0, TL(T_MRK), TP, 32 * yy, 0, acc, r, h);
#pragma unroll
                for (int s = 0; s < 2; ++s) *(u32x4*)l3_slot(L3, tg0, 1024 + hd * 64, ((xx * 2 + yy) * 64 + lane) * 32 + 16 * s) = pack8(acc, s);
            } else if (typ == 2) {
                f32x16 acc = mmt<4>(TL(T_AP), TP, 32 * xx, 0, TL(T_BCM), TP, 32 * yy, 0, zero16(), r, h);
                const float pcc = pc[32 * yy + r];
#pragma unroll
                for (int e = 0; e < 16; ++e) acc[e] = (acc[e] + ((32 * xx + crow(e, h) == 32 * yy + r) ? 1.0f : 0.0f)) * pcc;
#pragma unroll
                for (int s = 0; s < 2; ++s) *(u32x4*)(MT + (size_t)unit * 4096 + (((yy * 2 + xx) * 2 + s) * 64 + lane) * 8) = pack8(acc, s);
            } else {
                f32x16 acc = mmt<4>(TL(T_BCM), TP, 32 * xx, 0, TL(T_U0), TP, 32 * yy, 0, zero16(), r, h);
                acc = mmt<4>(TL(T_KCM), TP, 32 * xx, 0, TL(T_VCM), TP, 32 * yy, 0, acc, r, h);
#pragma unroll
                for (int e = 0; e < 16; ++e) acc[e] *= pc[32 * xx + crow(e, h)];
#pragma unroll
                for (int s = 0; s < 2; ++s) *(u32x4*)(SA + (size_t)unit * 4096 + ((yy * 2 + xx) * 64 + lane) * 16 + 8 * s) = pack8(acc, s);
            }
        }
        __syncthreads();
    }
#undef TL
}

__device__ __forceinline__ void pass_b(Frame& F, int bh, int j) {
    const int lane = F.lane;
    const bf16_t* MT = (const bf16_t*)(F.ws + WS_MT) + (size_t)bh * 64 * 4096; bf16_t* SA = (bf16_t*)(F.ws + WS_SA) + (size_t)bh * 64 * 4096 + j * 2048;
    f32x16 X[2] = {zero16(), zero16()};
    bf16x8 Af[8]; u32x4 Sd[4];
#pragma unroll
    for (int f = 0; f < 8; ++f) Af[f] = *(const bf16x8*)(MT + (f * 64 + lane) * 8);
#pragma unroll
    for (int q = 0; q < 4; ++q) Sd[q] = *(const u32x4*)(SA + (q >> 1) * 1024 + lane * 16 + 8 * (q & 1));
    for (int c = 0; c < 64; ++c) {
        bf16x8 An[8]; u32x4 Sn[4];
        const int cn = (c < 63) ? c + 1 : c;
#pragma unroll
        for (int f = 0; f < 8; ++f) An[f] = *(const bf16x8*)(MT + (size_t)cn * 4096 + (f * 64 + lane) * 8);
#pragma unroll
        for (int q = 0; q < 4; ++q) Sn[q] = *(const u32x4*)(SA + (size_t)cn * 4096 + (q >> 1) * 1024 + lane * 16 + 8 * (q & 1));
        bf16x8 Bf[4];
#pragma unroll
        for (int kt = 0; kt < 2; ++kt)
#pragma unroll
            for (int s = 0; s < 2; ++s) { const u32x4 w = pack8(X[kt], s); Bf[kt * 2 + s] = __builtin_bit_cast(bf16x8, w); *(u32x4*)(SA + (size_t)c * 4096 + ((kt * 2 + s) * 64 + lane) * 8) = w; }
        f32x16 D[2];
#pragma unroll
        for (int ip = 0; ip < 2; ++ip) { unpack8(Sd[2 * ip], D[ip], 0); unpack8(Sd[2 * ip + 1], D[ip], 1);
#pragma unroll
            for (int ks = 0; ks < 4; ++ks) D[ip] = __builtin_amdgcn_mfma_f32_32x32x16_bf16(Af[ip * 4 + ks], Bf[ks], D[ip], 0, 0, 0); }
        X[0] = D[0]; X[1] = D[1];
#pragma unroll
        for (int f = 0; f < 8; ++f) Af[f] = An[f];
#pragma unroll
        for (int q = 0; q < 4; ++q) Sd[q] = Sn[q];
    }
}

__device__ __forceinline__ void pass_c(Frame& F) {
    const int lane = F.lane, r = lane & 31, h = lane >> 5;
    const int gw = F.vcu * 8 + F.wave, NGW = F.G * 8;
    const bf16_t* P = (const bf16_t*)(F.ws + WS_P); unsigned char* L3 = F.ws + WS_L3; const bf16_t* SA = (const bf16_t*)(F.ws + WS_SA); const float* BON = (const float*)(F.ws + WS_BON);
    bf16_t* Y = (bf16_t*)(F.ws + WS_YCAT); const float* mix = F.in[I_MIX];
    for (int unit = gw; unit < 4096; unit += NGW) {
        const int b = unit >> 10, hd = (unit >> 6) & 15, ci = unit & 63, tg0 = b * SEQ + ci * 64;
        bf16x8 Af[8], Bf[8];
#pragma unroll
        for (int f = 0; f < 8; ++f) Af[f] = *(const bf16x8*)(SA + (size_t)unit * 4096 + (f * 64 + lane) * 8);
#pragma unroll
        for (int f = 0; f < 8; ++f) Bf[f] = *(const bf16x8*)l3_slot(L3, tg0, hd * 64, (f * 64 + lane) * 16);
        f32x16 acc[2][2];
#pragma unroll
        for (int j = 0; j < 2; ++j)
#pragma unroll
            for (int tt = 0; tt < 2; ++tt) {
#pragma unroll
                for (int s = 0; s < 2; ++s) unpack8(*(const u32x4*)l3_slot(L3, tg0, 1024 + hd * 64, ((j * 2 + tt) * 64 + lane) * 32 + 16 * s), acc[j][tt], s);
#pragma unroll
                for (int ks = 0; ks < 4; ++ks) acc[j][tt] = __builtin_amdgcn_mfma_f32_32x32x16_bf16(Af[j * 4 + ks], Bf[ks * 2 + tt], acc[j][tt], 0, 0, 0);
            }
#pragma unroll
        for (int tt = 0; tt < 2; ++tt) {
            const int tl = 32 * tt + r, tg = tg0 + tl;
            float sm = 0.f;
#pragma unroll
            for (int e = 0; e < 16; ++e) sm += acc[0][tt][e] + acc[1][tt][e];
            sm += __shfl_xor(sm, 32); const float mean = sm * (1.0f / 64.0f);
            float sq = 0.f;
#pragma unroll
            for (int e = 0; e < 16; ++e) { const float d0 = acc[0][tt][e] - mean, d1 = acc[1][tt][e] - mean; sq += d0 * d0 + d1 * d1; }
            sq += __shfl_xor(sq, 32); const float rstd = rsqrtf(sq * (1.0f / 64.0f) + GN_EPS);
            const float bon = BON[(size_t)tg * 16 + hd];
            const bool hp = (ci > 0) || (tl > 0);
            const bf16_t* prow = P + (size_t)tg * NP + PVR + hd * 64; const bf16_t* lrow = (const bf16_t*)L3 + (size_t)tg * NL + 2048 + hd * 64; bf16_t* yrow = Y + (size_t)tg * DM + 1024 + hd * 64;
#pragma unroll
            for (int j = 0; j < 2; ++j)
#pragma unroll
                for (int g = 0; g < 4; ++g) { const int v0 = 32 * j + 8 * g + 4 * h, ch = hd * 64 + v0;
                    const u32x2 cv = *(const u32x2*)(prow + v0); u32x2 pv = (u32x2){0u, 0u}; if (hp) pv = *(const u32x2*)(prow - NP + v0);
                    const u32x2 gg = *(const u32x2*)(lrow + v0);
                    const f32x4 mu = *(const f32x4*)(mix + 2112 + ch), lw = *(const f32x4*)(F.in[I_LNW] + ch), lb = *(const f32x4*)(F.in[I_LNB] + ch);
                    const float c0 = bflo(cv.x), c1 = bfhi(cv.x), c2 = bflo(cv.y), c3 = bfhi(cv.y);
                    const float v_0 = c0 + (bflo(pv.x) - c0) * mu.x, v_1 = c1 + (bfhi(pv.x) - c1) * mu.y, v_2 = c2 + (bflo(pv.y) - c2) * mu.z, v_3 = c3 + (bfhi(pv.y) - c3) * mu.w;
                    const float o0 = ((acc[j][tt][4 * g] - mean) * rstd * lw.x + lb.x + bon * v_0) * bflo(gg.x);
                    const float o1 = ((acc[j][tt][4 * g + 1] - mean) * rstd * lw.y + lb.y + bon * v_1) * bfhi(gg.x);
                    const float o2 = ((acc[j][tt][4 * g + 2] - mean) * rstd * lw.z + lb.z + bon * v_2) * bflo(gg.y);
                    const float o3 = ((acc[j][tt][4 * g + 3] - mean) * rstd * lw.w + lb.w + bon * v_3) * bfhi(gg.y);
                    *(u32x2*)(yrow + v0) = (u32x2){pk2(o0, o1), pk2(o2, o3)}; }
        }
    }
}
}


namespace att {
using s16x4 = __attribute__((ext_vector_type(4))) short;
constexpr int D = 128, NW = 8, QBLK = 32, KVBLK = 64;
constexpr float THRL = 8.0f * 1.4426950408889634f;
constexpr size_t SHM_V = KVBLK * D * 2, SHM_K = KVBLK * D * 2, SHM_ATTN = 2 * SHM_V + 2 * SHM_K + NW * 64 * 4;
static_assert(SHM_ATTN <= RING_BYTES, "attention LDS");
#define KSWZ(row, colB) ((row) * 256 + ((colB) ^ (((row) & 7) << 4)))
#define SBAR() __builtin_amdgcn_sched_barrier(0)
__device__ __forceinline__ int crow(int r, int hi) { return (r & 3) + 8 * (r >> 2) + 4 * hi; }
__device__ __forceinline__ unsigned cvtpk(float lo, float hi) { unsigned r; asm volatile("v_cvt_pk_bf16_f32 %0, %1, %2" : "=v"(r) : "v"(lo), "v"(hi)); return r; }
__device__ __forceinline__ void partialSM(f32x16& p0, f32x16& p1, const u32x2 mk, float& m_reg, float& mn, float& alpha) {
#pragma unroll
  for (int r = 0; r < 16; ++r) { const unsigned bit = 1u << ((r & 3) + 8 * (r >> 2)); p0[r] = (mk.x & bit) ? p0[r] : -INFINITY; p1[r] = (mk.y & bit) ? p1[r] : -INFINITY; }
  float pmax = p0[0];
#pragma unroll
  for (int r = 1; r < 16; ++r) pmax = fmaxf(pmax, p0[r]);
#pragma unroll
  for (int r = 0; r < 16; ++r) pmax = fmaxf(pmax, p1[r]);
  { auto rr = __builtin_amdgcn_permlane32_swap(__float_as_uint(pmax), __float_as_uint(pmax), false, false);
    pmax = fmaxf(__uint_as_float(rr[0]), __uint_as_float(rr[1])); }
  if (__builtin_expect(__all(pmax - m_reg <= THRL), 1)) { mn = m_reg; alpha = 1.f; }
  else { mn = fmaxf(m_reg, pmax); alpha = __builtin_amdgcn_exp2f(m_reg - mn); m_reg = mn; }
#pragma unroll
  for (int r = 0; r < 16; ++r) { p0[r] = __builtin_amdgcn_exp2f(p0[r] - mn); p1[r] = p1[r] - mn; }
}
__device__ __forceinline__ void finishSM(f32x16& p0, f32x16& p1, float alpha, float& l_reg, bf16x8& pa0, bf16x8& pa1, bf16x8& pa2, bf16x8& pa3) {
#pragma unroll
  for (int r = 0; r < 16; ++r) p1[r] = __builtin_amdgcn_exp2f(p1[r]);
  float ps = 0;
#pragma unroll
  for (int r = 0; r < 16; ++r) ps += p0[r];
#pragma unroll
  for (int r = 0; r < 16; ++r) ps += p1[r];
  { auto rr = __builtin_amdgcn_permlane32_swap(__float_as_uint(ps), __float_as_uint(ps), false, false);
    ps = __uint_as_float(rr[0]) + __uint_as_float(rr[1]); }
  l_reg = l_reg * alpha + ps;
#define PK4(P, BASE, OUT) do { unsigned a0 = cvtpk(P[BASE + 0], P[BASE + 1]), a1 = cvtpk(P[BASE + 2], P[BASE + 3]);   \
    unsigned b0 = cvtpk(P[BASE + 4], P[BASE + 5]), b1 = cvtpk(P[BASE + 6], P[BASE + 7]);                              \
    auto r0 = __builtin_amdgcn_permlane32_swap(a0, b0, false, false); auto r1 = __builtin_amdgcn_permlane32_swap(a1, b1, false, false); \
    u32x4 w = {r0[0], r1[0], r0[1], r1[1]}; OUT = __builtin_bit_cast(bf16x8, w); } while (0)
  PK4(p0, 0, pa0); PK4(p0, 8, pa1); PK4(p1, 0, pa2); PK4(p1, 8, pa3);
#undef PK4
}
__device__ __forceinline__ void qkt(f32x16& p0, f32x16& p1, const char* Ks, const bf16x8* qr, int r32, int hi) {
  p0 = f32x16{}; p1 = f32x16{};
#pragma unroll
  for (int d0 = 0; d0 < 8; ++d0) { int cb = (d0 * 16 + hi * 8) * 2;
    bf16x8 b0 = *reinterpret_cast<const bf16x8*>(Ks + KSWZ(r32, cb));
    bf16x8 b1 = *reinterpret_cast<const bf16x8*>(Ks + KSWZ(32 + r32, cb));
    p0 = __builtin_amdgcn_mfma_f32_32x32x16_bf16(b0, qr[d0], p0, 0, 0, 0);
    p1 = __builtin_amdgcn_mfma_f32_32x32x16_bf16(b1, qr[d0], p1, 0, 0, 0); }
}
__device__ __forceinline__ int v_st(int k, int c) { const int kk = (k & ~0xC) | ((k & 4) << 1) | ((k & 8) >> 1); return ((kk >> 3) * 4 + (c >> 5)) * 512 + ((kk & 7) * 32 + (c & 31)) * 2; }
__device__ __forceinline__ int v_rd_base(int lane) { return ((lane & 3) << 3) | (((lane >> 2) & 3) << 6) | (((lane >> 4) & 1) << 5) | (((lane >> 5) & 1) << 8); }
constexpr int v_rd_off(int d0, int ks, int half) { return d0 * 512 + ks * 4096 + half * 2048; }
template <int OFF> __device__ __forceinline__ s16x4 tr_read(int vb) { s16x4 r; asm volatile("ds_read_b64_tr_b16 %0, %1 offset:%2" : "=&v"(r) : "v"(vb), "i"(OFF) : "memory"); return r; }
template <int D0> __device__ __forceinline__ void pv_one(f32x16& od, int vb, bf16x8 pa0, bf16x8 pa1, bf16x8 pa2, bf16x8 pa3) {
  const s16x4 l0 = tr_read<v_rd_off(D0, 0, 0)>(vb), h0 = tr_read<v_rd_off(D0, 0, 1)>(vb), l1 = tr_read<v_rd_off(D0, 1, 0)>(vb), h1 = tr_read<v_rd_off(D0, 1, 1)>(vb);
  const s16x4 l2 = tr_read<v_rd_off(D0, 2, 0)>(vb), h2 = tr_read<v_rd_off(D0, 2, 1)>(vb), l3 = tr_read<v_rd_off(D0, 3, 0)>(vb), h3 = tr_read<v_rd_off(D0, 3, 1)>(vb);
  asm volatile("s_waitcnt lgkmcnt(0)" ::: "memory"); SBAR();
#define PK(L, H) (bf16x8){L[0], L[1], L[2], L[3], H[0], H[1], H[2], H[3]}
  od = __builtin_amdgcn_mfma_f32_32x32x16_bf16(pa0, PK(l0, h0), od, 0, 0, 0);
  od = __builtin_amdgcn_mfma_f32_32x32x16_bf16(pa1, PK(l1, h1), od, 0, 0, 0);
  od = __builtin_amdgcn_mfma_f32_32x32x16_bf16(pa2, PK(l2, h2), od, 0, 0, 0);
  od = __builtin_amdgcn_mfma_f32_32x32x16_bf16(pa3, PK(l3, h3), od, 0, 0, 0);
#undef PK
}
__device__ __forceinline__ void pv_d0(f32x16* o, int vb, bf16x8 pa0, bf16x8 pa1, bf16x8 pa2, bf16x8 pa3) {
  pv_one<0>(o[0], vb, pa0, pa1, pa2, pa3); pv_one<1>(o[1], vb, pa0, pa1, pa2, pa3); pv_one<2>(o[2], vb, pa0, pa1, pa2, pa3); pv_one<3>(o[3], vb, pa0, pa1, pa2, pa3);
}
__device__ __forceinline__ void attn_unit(const bf16_t* __restrict__ Qb, const bf16_t* __restrict__ Kh, const bf16_t* __restrict__ Vh, const unsigned* __restrict__ Mb,
                                          bf16_t* __restrict__ Ob, int seq, char* lds) {
  constexpr int LDQ = NP, LDK = NP, LDO = DM;
  int tid_ = threadIdx.x; asm volatile("" : "+v"(tid_));
  const int tid = tid_, wid = tid >> 6, lane = tid & 63, r32 = lane & 31, hi = lane >> 5;
  char* V_lds = lds; char* K_lds = lds + 2 * SHM_V;
  float* wsf = (float*)(lds + 2 * SHM_V + 2 * SHM_K) + wid * 64; float* li_l = wsf; float* al_l = wsf + 32;
  float m_reg = -1e30f, l_reg = 0; f32x16 o[4] = {}; bf16x8 qr[8];
  const bf16_t* Qw = Qb + (long)(wid * QBLK + r32) * LDQ + hi * 8;
#pragma unroll
  for (int d0 = 0; d0 < 8; ++d0) qr[d0] = *reinterpret_cast<const bf16x8*>(Qw + d0 * 16);
  const unsigned* Mw = Mb + (long)(wid * QBLK + r32) * 128;
  const int sh = 4 * hi;
  const int sr = tid >> 4, sc = (tid & 15) * 8, vst0 = v_st(sr, sc), vst1 = v_st(32 + sr, sc);
  const int vb0 = (int)(uintptr_t)V_lds + v_rd_base(lane);
  struct { bf16x8 vs0, vs1, ks0, ks1; } sr_[2];
#define SLOAD(i, k0) do { sr_[i].vs0 = *(const bf16x8*)(&Vh[(long)((k0) + sr) * LDK + sc]); sr_[i].vs1 = *(const bf16x8*)(&Vh[(long)((k0) + 32 + sr) * LDK + sc]); \
    sr_[i].ks0 = *(const bf16x8*)(&Kh[(long)((k0) + sr) * LDK + sc]); sr_[i].ks1 = *(const bf16x8*)(&Kh[(long)((k0) + 32 + sr) * LDK + sc]); } while (0)
#define SWRITE(b, i) do { *(bf16x8*)(V_lds + (b) * SHM_V + vst0) = sr_[i].vs0;          \
    *(bf16x8*)(V_lds + (b) * SHM_V + vst1) = sr_[i].vs1; int kc = sc * 2;               \
    *(bf16x8*)(K_lds + (b) * SHM_K + KSWZ(sr, kc)) = sr_[i].ks0;                       \
    *(bf16x8*)(K_lds + (b) * SHM_K + KSWZ(32 + sr, kc)) = sr_[i].ks1; } while (0)
#define SWAIT() asm volatile("s_waitcnt vmcnt(4)" ::: "memory")
#define RESC(a) do { if (__any((a) < 1.f)) { if (hi == 0) al_l[r32] = (a); asm volatile("s_waitcnt lgkmcnt(0)" ::: "memory"); \
    _Pragma("unroll") for (int d = 0; d < 4; ++d) _Pragma("unroll") for (int r = 0; r < 16; ++r) o[d][r] *= al_l[crow(r, hi)]; } } while (0)
#define MLOAD(j) ({ u32x2 _m = *(const u32x2*)(Mw + 2 * (j)); _m.x >>= sh; _m.y >>= sh; _m; })
  f32x16 pA0, pA1, pB0, pB1; float mnA, mnB, alA, alB; bf16x8 pa0, pa1, pa2, pa3; const int NT = seq / KVBLK;
  constexpr int SE = 0, SO = 1;
  u32x2 mkA = MLOAD(0), mkB = MLOAD(1);
  SLOAD(SE, 0); asm volatile("s_waitcnt vmcnt(0)" ::: "memory"); SWRITE(0, SE); __syncthreads();
  qkt(pA0, pA1, K_lds, qr, r32, hi); partialSM(pA0, pA1, mkA, m_reg, mnA, alA);
  SLOAD(SO, KVBLK); if (2 < NT) SLOAD(SE, 2 * KVBLK);
  SWAIT(); SWRITE(1, SO); __syncthreads();
  for (int j = 1; j + 1 < NT; j += 2) {
    mkA = MLOAD(j + 1);
    SBAR(); qkt(pB0, pB1, K_lds + SHM_K, qr, r32, hi);
    finishSM(pA0, pA1, alA, l_reg, pa0, pa1, pa2, pa3); SBAR();
    SLOAD(SO, (j + 2) * KVBLK); SBAR();
    pv_d0(o, vb0, pa0, pa1, pa2, pa3); partialSM(pB0, pB1, mkB, m_reg, mnB, alB);
    __syncthreads(); SWAIT(); SWRITE(0, SE);
    RESC(alB); __syncthreads();
    mkB = MLOAD(j + 2);
    SBAR(); qkt(pA0, pA1, K_lds, qr, r32, hi);
    finishSM(pB0, pB1, alB, l_reg, pa0, pa1, pa2, pa3); SBAR();
    if (j + 3 < NT) SLOAD(SE, (j + 3) * KVBLK); SBAR();
    pv_d0(o, vb0 + (int)SHM_V, pa0, pa1, pa2, pa3); partialSM(pA0, pA1, mkA, m_reg, mnA, alA);
    __syncthreads(); SWAIT(); SWRITE(1, SO);
    RESC(alA); __syncthreads();
  }
  SBAR(); qkt(pB0, pB1, K_lds + SHM_K, qr, r32, hi);
  finishSM(pA0, pA1, alA, l_reg, pa0, pa1, pa2, pa3); SBAR();
  pv_d0(o, vb0, pa0, pa1, pa2, pa3); partialSM(pB0, pB1, mkB, m_reg, mnB, alB);
  __syncthreads(); RESC(alB);
  finishSM(pB0, pB1, alB, l_reg, pa0, pa1, pa2, pa3); SBAR();
  pv_d0(o, vb0 + (int)SHM_V, pa0, pa1, pa2, pa3);
  if (hi == 0) li_l[r32] = l_reg; asm volatile("s_waitcnt lgkmcnt(0)" ::: "memory");
  float rli[16];
#pragma unroll
  for (int r = 0; r < 16; ++r) rli[r] = __builtin_amdgcn_rcpf(li_l[crow(r, hi)]);
  bf16_t* Ow = Ob + (long)(wid * QBLK) * LDO;
#pragma unroll
  for (int r = 0; r < 16; ++r) { int orow = crow(r, hi);
#pragma unroll
    for (int d0 = 0; d0 < 4; ++d0) Ow[(long)orow * LDO + d0 * 32 + r32] = (bf16_t)f2bf(o[d0][r] * rli[r]); }
  __syncthreads();
#undef SLOAD
#undef SWRITE
#undef SWAIT
#undef RESC
#undef MLOAD
}
__device__ __forceinline__ void attn_phase(Frame& F) {
  const bf16_t* P = (const bf16_t*)(F.ws + WS_P); const unsigned* MSK = (const unsigned*)(F.ws + WS_MSK); bf16_t* Y = (bf16_t*)(F.ws + WS_YCAT);
  for (int u = F.vcu; u < 512; u += F.G) {
    const int pairi = u & 255, second = u >> 8; const int bh = pairi >> 3, ql = pairi & 7; const int qb = second ? ql : 15 - ql;
    const int b = bh >> 3, hd = bh & 7; const long t0 = (long)b * SEQ + qb * 256;
    attn_unit(P + t0 * NP + PQ + hd * 128, P + (long)b * SEQ * NP + PK + hd * 128, P + (long)b * SEQ * NP + PV + hd * 128, MSK + t0 * 128, Y + t0 * DM + hd * 128, (qb + 1) * 256, (char*)F.ldsg);
  }
}
#undef KSWZ
#undef SBAR
}

__device__ __forceinline__ void phase_idx_passb(Frame& F) {
    if (F.G >= 128) { if (F.wave == 0 && F.vcu < 128) rw::pass_b(F, F.vcu >> 1, F.vcu & 1); }
    else { for (int i = F.vcu * 8 + F.wave; i < 128; i += F.G * 8) rw::pass_b(F, i >> 1, i & 1); }
    phase4(F);
}

struct RouteRec { int cls, pos; float g_lo, g_hi, rstd; int pad0, pad1, pad2; };
__device__ __forceinline__ void phase7(Frame& F) {
    const int gw = F.vcu * 8 + F.wave, NGW = F.G * 8, lane = F.lane;
    { int* rowtok = (int*)(F.ws + WS_ROWTOK); for (int i = gw * 64 + lane; i < MPAD; i += NGW * 64) rowtok[i] = -1; }
    { LAS float* scr = (LAS float*)(F.lds + F.wave * 16384);
      bf16_t* WGU = (bf16_t*)(F.ws + WS_WGU); bf16_t* WDN = (bf16_t*)(F.ws + WS_WDN);
      constexpr int IG = (DM / 64) * (512 / 32), ID = (512 / 64) * (DM / 32);
      for (int it = gw; it < 16 * (2 * IG + ID); it += NGW) { const int e = it / (2 * IG + ID); int r = it % (2 * IG + ID);
          if (r < IG) transpose_item<2>(F.in[I_WEG] + (size_t)e * DM * 512, 512, WGU + (size_t)e * 1024 * DM, DM, scr, r / 16, r % 16, lane);
          else if (r < 2 * IG) { r -= IG; transpose_item<3>(F.in[I_WEU] + (size_t)e * DM * 512, 512, WGU + (size_t)e * 1024 * DM, DM, scr, r / 16, r % 16, lane); }
          else { r -= 2 * IG; transpose_item<0>(F.in[I_WED] + (size_t)e * 512 * DM, DM, WDN + (size_t)e * DM * 512, 512, scr, r / 64, r % 64, lane); } } }
    const float* x1 = F.out; const float* gf = F.in[I_GFFN]; const f32x4* wrg = (const f32x4*)F.in[I_WRG]; const f32x4* wre = (const f32x4*)F.in[I_WRE];
    RouteRec* rr = (RouteRec*)(F.ws + WS_ROUTE); unsigned* cnt = F.ctl + CW_CNT;
    for (int t = gw; t < T; t += NGW) {
        const f32x4* xr = (const f32x4*)(x1 + (size_t)t * DM) + lane; f32x4 v[8]; float s = 0.f;
#pragma unroll
        for (int j = 0; j < 8; ++j) { v[j] = xr[64 * j]; s += (v[j].x * v[j].x + v[j].y * v[j].y) + (v[j].z * v[j].z + v[j].w * v[j].w); }
        const float rstd = rsqrtf(wave_sum(s) * (1.f / DM) + NORM_EPS);
        float lg[20];
#pragma unroll
        for (int o = 0; o < 20; ++o) lg[o] = 0.f;
#pragma unroll
        for (int j = 0; j < 8; ++j) { const f32x4 g4 = ((const f32x4*)gf)[64 * j + lane];
            asm volatile("" ::: "memory");
#pragma unroll
            for (int e = 0; e < 4; ++e) { const int k = 4 * (64 * j + lane) + e; const float hv = v[j][e] * rstd * g4[e];
                const f32x4 wg = wrg[k]; lg[0] += hv * wg.x; lg[1] += hv * wg.y; lg[2] += hv * wg.z; lg[3] += hv * wg.w;
#pragma unroll
                for (int q = 0; q < 4; ++q) { const f32x4 we = wre[4 * k + q]; lg[4 + 4 * q] += hv * we.x; lg[5 + 4 * q] += hv * we.y; lg[6 + 4 * q] += hv * we.z; lg[7 + 4 * q] += hv * we.w; } } }
#pragma unroll
        for (int o = 0; o < 20; ++o) lg[o] = wave_sum(lg[o]);
        float gl[4]; float gm = -INFINITY;
#pragma unroll
        for (int o = 0; o < 4; ++o) { gl[o] = lg[o] + F.in[I_BRG][o]; gm = fmaxf(gm, gl[o]); }
        float gs = 0.f; int gsel = 0; float gbest = -INFINITY;
#pragma unroll
        for (int o = 0; o < 4; ++o) { gs += __expf(gl[o] - gm); if (gl[o] > gbest) { gbest = gl[o]; gsel = o; } }
        const float pgrp = __expf(gbest - gm) / gs;
        float el[4]; float em = -INFINITY;
#pragma unroll
        for (int q = 0; q < 4; ++q) { float vsel = 0.f;
#pragma unroll
            for (int g2 = 0; g2 < 4; ++g2) vsel = (gsel == g2) ? lg[4 + 4 * g2 + q] + F.in[I_BRE][4 * g2 + q] : vsel;
            el[q] = vsel; em = fmaxf(em, vsel); }
        int i1 = 0; float b1 = -INFINITY;
#pragma unroll
        for (int q = 0; q < 4; ++q) if (el[q] > b1) { b1 = el[q]; i1 = q; }
        int i2 = 0; float b2 = -INFINITY;
#pragma unroll
        for (int q = 0; q < 4; ++q) if (q != i1 && el[q] > b2) { b2 = el[q]; i2 = q; }
        const float p1 = __expf(b1 - em), p2 = __expf(b2 - em); const float inv = 1.0f / (p1 + p2);
        const float gw1 = pgrp * p1 * inv, gw2 = pgrp * p2 * inv;
        const int elo = i1 < i2 ? i1 : i2, ehi = i1 < i2 ? i2 : i1; const float glo = i1 < i2 ? gw1 : gw2, ghi = i1 < i2 ? gw2 : gw1;
        const int pair = (elo == 0) ? (ehi - 1) : (elo == 1 ? ehi + 1 : 5);
        const int cls = gsel * 6 + pair;
        if (lane == 0) { const unsigned pos = atomicAdd(&cnt[cls], 1u); RouteRec r; r.cls = cls; r.pos = (int)pos; r.g_lo = glo; r.g_hi = ghi; r.rstd = rstd; r.pad0 = r.pad1 = r.pad2 = 0; rr[t] = r; }
    }
}

__device__ __forceinline__ void class_bases(Frame& F, volatile LAS int* tb) {
    if (F.tid == 0) { int acc = 0; for (int c = 0; c < NCLS; ++c) { tb[c] = acc; const int n = (int)__hip_atomic_load(F.ctl + CW_CNT + c, __ATOMIC_RELAXED, __HIP_MEMORY_SCOPE_AGENT); acc += (n + 255) & ~255; } tb[NCLS] = acc; }
    __syncthreads();
}

__device__ __forceinline__ void phase8(Frame& F) {
    const int gw = F.vcu * 8 + F.wave, NGW = F.G * 8, lane = F.lane;
    volatile LAS int* tb = (volatile LAS int*)(F.lds + MISC_OFF + 128);
    class_bases(F, tb);
    const float* x1 = F.out; const float* gf = F.in[I_GFFN];
    const RouteRec* rr = (const RouteRec*)(F.ws + WS_ROUTE); int* rowtok = (int*)(F.ws + WS_ROWTOK); float* gates = (float*)(F.ws + WS_ROWTOK + 128 * 1024);
    bf16_t* H2S = (bf16_t*)(F.ws + WS_H2S);
    f32x4 gv[8];
#pragma unroll
    for (int j = 0; j < 8; ++j) gv[j] = ((const f32x4*)gf)[64 * j + lane];
    for (int t = gw; t < T; t += NGW) {
        const RouteRec r = rr[t]; const int row = tb[r.cls] + r.pos;
        const f32x4* xr = (const f32x4*)(x1 + (size_t)t * DM) + lane; u32x2* o = (u32x2*)(H2S + (size_t)row * DM) + lane;
#pragma unroll
        for (int j = 0; j < 8; ++j) { const f32x4 v = xr[64 * j]; u32x2 w; w.x = pk2(v.x * r.rstd * gv[j].x, v.y * r.rstd * gv[j].y); w.y = pk2(v.z * r.rstd * gv[j].z, v.w * r.rstd * gv[j].w); o[64 * j] = w; }
        if (lane == 0) { rowtok[row] = t; gates[2 * row] = r.g_lo; gates[2 * row + 1] = r.g_hi; }
    }
    for (int idx = gw; idx < NCLS * 256; idx += NGW) { const int c = idx >> 8, off = idx & 255; const int n = (int)__hip_atomic_load(F.ctl + CW_CNT + c, __ATOMIC_RELAXED, __HIP_MEMORY_SCOPE_AGENT);
        const int row = tb[c] + n + off;
        if (row < tb[c + 1]) { u32x2* o = (u32x2*)(H2S + (size_t)row * DM) + lane;
#pragma unroll
            for (int j = 0; j < 8; ++j) o[64 * j] = (u32x2){0u, 0u};
            if (lane == 0) { gates[2 * row] = 0.f; gates[2 * row + 1] = 0.f; } } }
}

__device__ __forceinline__ int class_of_tile(volatile LAS int* tb, int rt) { int c = 0; const int r0 = rt * 256; for (int k = 1; k < NCLS; ++k) c = (r0 >= tb[k]) ? k : c; return c; }
__device__ __forceinline__ int class_expert(int cls, int half) { const int g = cls / 6, p = cls % 6; const int elo = p < 3 ? 0 : (p < 5 ? 1 : 2); const int ehi = p < 3 ? p + 1 : (p < 5 ? p - 1 : 3); return 4 * g + (half ? ehi : elo); }
struct Moe1Sched {
    volatile LAS int* tb; const char* A; const char* B; int G, c, nu;
    __device__ bool seg(int i, pg8::Seg& s) const { const int L = i * G + c; if (L >= nu) return false; const int rt = L >> 3, pn = L & 7; const int cls = class_of_tile(tb, rt); const int e = class_expert(cls, pn >> 2);
        s.A = A + (size_t)rt * 256 * DM * 2; s.B = B + ((size_t)e * 1024 + (pn & 3) * 256) * DM * 2; s.u.pm = rt; s.u.pn = pn; s.u.aux = 0; s.last = 1; return true; }
};
struct Moe2Sched {
    volatile LAS int* tb; const char* A; const char* B; int G, c, nu;
    __device__ bool seg(int i, pg8::Seg& s) const { const int ui = i >> 1, half = i & 1; const int L = ui * G + c; if (L >= nu) return false; const int rt = L >> 3, pn = L & 7; const int cls = class_of_tile(tb, rt); const int e = class_expert(cls, half);
        s.A = A + ((size_t)rt * 256 * 1024 + half * 512) * 2; s.B = B + ((size_t)e * DM + pn * 256) * 512 * 2; s.u.pm = rt; s.u.pn = pn; s.u.aux = 0; s.last = half; return true; }
};

constexpr int NPHASE = 12;
__global__ void __launch_bounds__(512, 2) fwd_kernel(Args args) {
    extern __shared__ __attribute__((aligned(16))) unsigned char lds_raw[];
    Frame F;
    F.lds = (LAS unsigned char*)lds_raw; F.ldsg = lds_raw;
    F.tid = threadIdx.x; F.lane = F.tid & 63; F.wave = __builtin_amdgcn_readfirstlane(F.tid >> 6);
    F.G = gridDim.x; { const int bx = blockIdx.x; F.vcu = (F.G % 8 == 0) ? (bx % 8) * (F.G / 8) + bx / 8 : bx; }
    F.in = args.in; F.out = args.out; F.ws = args.ws; F.ctl = (unsigned*)(args.ws + WS_CTL);
    volatile LAS unsigned* MISC = (volatile LAS unsigned*)(F.lds + MISC_OFF);
    for (int u = F.tid; u < (LDS_BYTES - LDSCTL_OFF) / 4; u += 512) ((LAS unsigned*)(F.lds + LDSCTL_OFF))[u] = 0u;
    __syncthreads();
    const int lo = args.ph_lo, hi = args.ph_hi;
    const bool multi = (hi - lo) > 1;
    XcdBarrier bar; bar.bar = F.ctl + CW_BAR; bar.x = 0; bar.st = nullptr;
    if (multi) bar = xcd_barrier_post(F.ctl + CW_BAR, MISC + 8);
#ifndef PH_MASK
#define PH_MASK 0xfff
#endif
#define IN(k) (((PH_MASK >> (k)) & 1) && lo <= (k) && (k) < hi)
#define SEAM(k) do { if (IN(k) && IN((k) + 1)) xcd_barrier(bar); } while (0)
    unsigned char* ws = args.ws;
    bf16_t* P = (bf16_t*)(ws + WS_P);

    if (IN(0)) { phase0(F); SEAM(0); }
    if (IN(1)) {
        pg8::PlainSched S; S.init((const bf16_t*)(ws + WS_HN), (const bf16_t*)(ws + WS_WIN), T, NP, DM, DM, F.G, (int)blockIdx.x);
        pg8::EpiBf16 E{P, NP};
        pg8::gemm_phase<pg8::EpiBf16, pg8::PlainSched, true>(F.lds, DM, DM, DM / 64, S, E);
        SEAM(1);
    }
    if (IN(2)) { phase2(F); SEAM(2); }
    if (IN(3)) {
        pg8::PlainSched S; S.init((const bf16_t*)(ws + WS_ALORA), (const bf16_t*)(ws + WS_WLORA), T, NL, KL, KL, F.G, (int)blockIdx.x);
        pg8::EpiLora E{(bf16_t*)(ws + WS_L3), F.in[I_W0], F.in[I_A0]};
        pg8::gemm_phase<pg8::EpiLora, pg8::PlainSched, true>(F.lds, KL, KL, KL / 64, S, E);
        SEAM(3);
    }
    if (IN(4)) { rw::pass_a(F); SEAM(4); }
    if (IN(5)) { phase_idx_passb(F); SEAM(5); }
    if (IN(6)) { att::attn_phase(F); rw::pass_c(F); SEAM(6); }
    if (IN(7)) {
        pg8::PlainSched S; S.init((const bf16_t*)(ws + WS_YCAT), (const bf16_t*)(ws + WS_WOUT), T, DM, DM, DM, F.G, (int)blockIdx.x);
        pg8::EpiResF32 E{F.in[I_X], F.out, DM};
        pg8::gemm_phase<pg8::EpiResF32, pg8::PlainSched, true>(F.lds, DM, DM, DM / 64, S, E);
        SEAM(7);
    }
    if (IN(8)) { phase7(F); SEAM(8); }
    if (IN(9)) { phase8(F); SEAM(9); }
    if (IN(10)) {
        volatile LAS int* tb = (volatile LAS int*)(F.lds + MISC_OFF + 128);
        class_bases(F, tb);
        Moe1Sched S; S.tb = tb; S.A = (const char*)(ws + WS_H2S); S.B = (const char*)(ws + WS_WGU); S.G = F.G; S.c = (int)blockIdx.x; S.nu = (tb[NCLS] >> 8) * 8;
        pg8::EpiMoe1 E{(bf16_t*)(ws + WS_HS), (const float*)(ws + WS_ROWTOK + 128 * 1024)};
        pg8::gemm_phase<pg8::EpiMoe1, Moe1Sched, true>(F.lds, DM, DM, DM / 64, S, E);
        SEAM(10);
    }
    if (IN(11)) {
        volatile LAS int* tb = (volatile LAS int*)(F.lds + MISC_OFF + 128);
        class_bases(F, tb);
        Moe2Sched S; S.tb = tb; S.A = (const char*)(ws + WS_HS); S.B = (const char*)(ws + WS_WDN); S.G = F.G; S.c = (int)blockIdx.x; S.nu = (tb[NCLS] >> 8) * 8;
        pg8::EpiMoe2 E{F.out, (const int*)(ws + WS_ROWTOK)};
        pg8::gemm_phase<pg8::EpiMoe2, Moe2Sched, true>(F.lds, 1024, 512, 512 / 64, S, E);
    }
#undef IN
#undef SEAM
}

extern "C" void kernel_launch(void* const* d_in, const int* in_sizes, int n_in, void* d_out, int out_size, void* d_ws, size_t ws_size, hipStream_t stream) {
    static int grid = 0;
    if (grid == 0) {
        if (n_in != 25 || in_sizes[0] != T * DM || out_size != T * DM || ws_size < WS_END) { fprintf(stderr, "kernel_launch: unexpected shapes (n_in %d, in0 %d, out %d, ws %zu)\n", n_in, n_in > 0 ? in_sizes[0] : -1, out_size, ws_size); grid = -1; return; }
        int dev = 0, cus = 0, per_cu = 0;
        if (hipGetDevice(&dev) != hipSuccess || hipDeviceGetAttribute(&cus, hipDeviceAttributeMultiprocessorCount, dev) != hipSuccess) { grid = -1; return; }
        if (hipFuncSetAttribute((const void*)fwd_kernel, hipFuncAttributeMaxDynamicSharedMemorySize, LDS_BYTES) != hipSuccess) { fprintf(stderr, "kernel_launch: hipFuncSetAttribute failed\n"); grid = -1; return; }
        if (hipOccupancyMaxActiveBlocksPerMultiprocessor(&per_cu, (const void*)fwd_kernel, 512, LDS_BYTES) != hipSuccess || per_cu < 1) { fprintf(stderr, "kernel_launch: occupancy query says %d blocks per CU\n", per_cu); (void)hipGetLastError(); grid = -1; return; }
        grid = cus;
    }
    if (grid < 0) return;
    (void)hipMemsetAsync((char*)d_ws + WS_CTL, 0, CTL_ZERO_BYTES, stream);
    Args a{};
    for (int i = 0; i < 25; ++i) a.in[i] = (const float*)d_in[i];
    a.out = (float*)d_out; a.ws = (unsigned char*)d_ws;
#if MK_SINGLE
    a.ph_lo = 0; a.ph_hi = NPHASE;
    void* kargs[] = {&a};
    hipError_t e = hipLaunchCooperativeKernel((const void*)fwd_kernel, dim3(grid), dim3(512), kargs, LDS_BYTES, stream);
    if (e != hipSuccess) fprintf(stderr, "kernel_launch: cooperative launch failed: %s (grid %d)\n", hipGetErrorString(e), grid);
#else
    for (int p = 0; p < NPHASE; ++p) { a.ph_lo = p; a.ph_hi = p + 1; hipLaunchKernelGGL(fwd_kernel, dim3(grid), dim3(512), LDS_BYTES, stream, a); }
#endif
}
```

```cpp
#include <hip/hip_runtime.h>
#include <hip/hip_cooperative_groups.h>
#include <cstdio>
#include <cstdint>
#include <cmath>

#ifndef MK_SINGLE
#define MK_SINGLE 1
#endif

#define GAS __attribute__((address_space(1)))
#define LAS __attribute__((address_space(3)))
typedef unsigned short bf16_t;
typedef short bf16x8 __attribute__((ext_vector_type(8)));
typedef float f32x4 __attribute__((ext_vector_type(4)));
typedef float f32x16 __attribute__((ext_vector_type(16)));
typedef float f32x2 __attribute__((ext_vector_type(2)));
typedef unsigned u32x4 __attribute__((ext_vector_type(4)));
typedef unsigned u32x2 __attribute__((ext_vector_type(2)));

constexpr int BATCH = 4, SEQ = 4096, DM = 2048, T = BATCH * SEQ;
constexpr int NP = 7680;
constexpr int PQ = 0, PK = 1024, PV = 2048, PQI = 3072, PKI = 4096, PWI = 4160, PDW = 4224, PDA = 4288, PR = 4352, PKR = 5376, PVR = 6400, PDG = 7424;
constexpr int IN_COLS = 7536, DSA_COLS = 4176;
constexpr int KL = 384, NL = 3072;
constexpr int MPAD = 22528;
constexpr int NCLS = 24;
constexpr float NORM_EPS = 1e-6f, GN_EPS = 64e-5f;
constexpr float QSCALE = 0.08838834764831845f * 1.4426950408889634f;

constexpr size_t MiB = 1u << 20;
constexpr size_t WS_CTL = 0, CTL_ZERO_BYTES = 1 * MiB;
constexpr size_t WS_WLORA = 1 * MiB;
constexpr size_t WS_WOUT = 4 * MiB;
constexpr size_t WS_MSK = 12 * MiB;
constexpr size_t WS_KI = 20 * MiB;
constexpr size_t WS_ROUTE = 22 * MiB;
constexpr size_t WS_ROWTOK = 23 * MiB;
constexpr size_t WS_WRT = 23 * MiB + 512 * 1024;
constexpr size_t WS_ALORA = 24 * MiB;
constexpr size_t WS_WIN = 36 * MiB;
constexpr size_t WS_HN = 66 * MiB;
constexpr size_t WS_YCAT = WS_HN;
constexpr size_t WS_L3 = 130 * MiB;
constexpr size_t WS_P = 226 * MiB;
constexpr size_t WS_H2S = 226 * MiB;
constexpr size_t WS_HS = 314 * MiB;
constexpr size_t WS_WGU = 358 * MiB;
constexpr size_t WS_WDN = 422 * MiB;
constexpr size_t WS_MT = 24 * MiB;
constexpr size_t WS_BON = 56 * MiB;
constexpr size_t WS_SA = 466 * MiB;
constexpr size_t WS_END = 498 * MiB;
constexpr int CW_CNT = 64;
constexpr int CW_BAR = 4096;

constexpr int RING_BYTES = 131072;
constexpr int LDSCTL_OFF = RING_BYTES, MISC_OFF = LDSCTL_OFF + 320;
constexpr int LDS_BYTES = 147456;

#define LDS_WAIT() asm volatile("s_waitcnt lgkmcnt(0)" ::: "memory")
#define VM_WAIT() asm volatile("s_waitcnt vmcnt(0)" ::: "memory")
__device__ __forceinline__ unsigned f2bf(float f) { unsigned u = __builtin_bit_cast(unsigned, f); return (u + 0x7fffu + ((u >> 16) & 1u)) >> 16; }
__device__ __forceinline__ unsigned pk2(float lo, float hi) { return f2bf(lo) | (f2bf(hi) << 16); }
__device__ __forceinline__ float bf2f(unsigned short h) { return __builtin_bit_cast(float, (unsigned)h << 16); }
__device__ __forceinline__ float bflo(unsigned w) { return __builtin_bit_cast(float, w << 16); }
__device__ __forceinline__ float bfhi(unsigned w) { return __builtin_bit_cast(float, w & 0xffff0000u); }
#define DPP_ADD(v, ctrl, rm) (v) += __builtin_bit_cast(float, __builtin_amdgcn_update_dpp(0, __builtin_bit_cast(int, (v)), (ctrl), (rm), 0xF, false))
__device__ __forceinline__ float row_sum16(float v) {
    DPP_ADD(v, 0xB1, 0xF); DPP_ADD(v, 0x4E, 0xF); DPP_ADD(v, 0x141, 0xF); DPP_ADD(v, 0x140, 0xF); return v;
}
__device__ __forceinline__ float wave_sum(float v) {
    v = row_sum16(v); DPP_ADD(v, 0x142, 0xA); DPP_ADD(v, 0x143, 0xC);
    return __builtin_bit_cast(float, __builtin_amdgcn_readlane(__builtin_bit_cast(int, v), 63));
}
__device__ __forceinline__ float half_sum(float v) {
    v = row_sum16(v); DPP_ADD(v, 0x142, 0xA);
    const float lo = __builtin_bit_cast(float, __builtin_amdgcn_readlane(__builtin_bit_cast(int, v), 31)), hi = __builtin_bit_cast(float, __builtin_amdgcn_readlane(__builtin_bit_cast(int, v), 63));
    return (threadIdx.x & 32) ? hi : lo;
}
__device__ __forceinline__ float sigmoidf_(float x) { return 1.0f / (1.0f + __expf(-x)); }

namespace pg8 {
constexpr int BM = 256, BK = 64, HALF = 128, HTB = HALF * BK * 2, STAGE_BYTES = 8 * HTB, NXCD = 8, WGM = 8;
__host__ __device__ __forceinline__ int lds_byte(int r, int c) { const int st = (r >> 4) * 2 + (c >> 5), rr = r & 15, cc = c & 31, ob = rr * 64 + cc * 2; return st * 1024 + (ob ^ (((ob >> 9) & 1) << 5)); }
__host__ __device__ __forceinline__ void stage_rc(int b, int& R, int& C) { const int st = b / 1024, sb = b % 1024, swz = sb ^ (((sb >> 9) & 1) << 5); R = (st >> 1) * 16 + swz / 64; C = (st & 1) * 32 + (swz % 64) / 2; }
__host__ __device__ __forceinline__ int perm32(int rho) { const int n = rho >> 4, i = rho & 15; return 8 * (i >> 2) + 4 * n + (i & 3); }

struct Unit { int pm, pn, aux; };
struct Seg { const char* A; const char* B; Unit u; int last; };

struct TileOrder {
    int nM, nN, nwg, G, c;
    __device__ void init(int nM_, int nN_, int G_, int c_) { nM = nM_; nN = nN_; nwg = nM * nN; G = G_; c = c_; }
    __device__ bool next(int i, int& pm, int& pn) const {
        const long L = (long)i * G + c; if (L >= nwg) return false;
        int wgid = (int)L; { const int q = nwg / NXCD, r = nwg % NXCD, xcd = wgid % NXCD, off = wgid / NXCD; wgid = (xcd < r ? xcd * (q + 1) : r * (q + 1) + (xcd - r) * q) + off; }
        const int nig = WGM * nN, gid = wgid / nig, fm = gid * WGM, gsz = (nM - fm) < WGM ? (nM - fm) : WGM;
        pm = fm + ((wgid % nig) % gsz); pn = (wgid % nig) / gsz; return true;
    }
};
struct PlainSched {
    TileOrder o; const char* A; const char* B; size_t tA, tB;
    __device__ void init(const bf16_t* A_, const bf16_t* B_, int M, int N, int lda, int ldb, int G, int c) { o.init(M / BM, N / BM, G, c); A = (const char*)A_; B = (const char*)B_; tA = (size_t)BM * lda * 2; tB = (size_t)BM * ldb * 2; }
    __device__ bool seg(int i, Seg& s) const { int pm, pn; if (!o.next(i, pm, pn)) return false; s.A = A + pm * tA; s.B = B + pn * tB; s.u.pm = pm; s.u.pn = pn; s.u.aux = 0; s.last = 1; return true; }
};

__device__ __forceinline__ unsigned cvt_pk_bf16(float lo, float hi) { unsigned r; asm volatile("v_cvt_pk_bf16_f32 %0, %1, %2" : "=v"(r) : "v"(lo), "v"(hi)); return r; }

typedef f32x4 Acc[2][2][4][2];

template <class Epi, class Sched, bool ALIGN_EPI>
__device__ __forceinline__ void gemm_phase(LAS unsigned char* lds, const int lda, const int ldb, const int nt, const Sched& S, const Epi& E) {
    const int tid = threadIdx.x, wid = __builtin_amdgcn_readfirstlane(tid >> 6), lane = tid & 63, wr = wid >> 2, wc = wid & 3, fr = lane & 15, fq = lane >> 4;
    unsigned voffA[2], voffB[2];
#pragma unroll
    for (int i = 0; i < 2; ++i) { int R, C; stage_rc(tid * 16 + i * 8192, R, C); const int Rb = Epi::PERM ? ((R & ~31) + perm32(R & 31)) : R;
        voffA[i] = (unsigned)(R * lda + C) * 2u; voffB[i] = (unsigned)(Rb * ldb + C) * 2u; }
    const size_t kstep = (size_t)(BK * 2);
    const size_t hstepA = (size_t)HALF * lda * 2, hstepB = (size_t)HALF * ldb * 2;
    const unsigned ldsw = (unsigned)wid * 1024u;
    const int aoff = lds_byte(wr * 64 + fr, fq * 8), boff = lds_byte(wc * 32 + fr, fq * 8);
#define PG8_SA(b, h) (((b) * 2 + (h)) * HTB)
#define PG8_SB(b, h) ((4 + (b) * 2 + (h)) * HTB)
#define PG8_STAGE(bufoff, gbase, voff) do { _Pragma("unroll") for (int _i = 0; _i < 2; ++_i) \
        __builtin_amdgcn_global_load_lds((const unsigned*)((const char*)(gbase) + (voff)[_i]), (LAS unsigned*)(lds + (bufoff) + ldsw + _i * 8192), 16, 0, 0); } while (0)
#define PG8_LDA(dst, b, h) do { _Pragma("unroll") for (int m = 0; m < 4; ++m) _Pragma("unroll") for (int k = 0; k < 2; ++k) dst[m][k] = *(const LAS bf16x8*)(lds + PG8_SA(b, h) + aoff + m * 2048 + k * 1024); } while (0)
#define PG8_LDB(dst, b, h) do { _Pragma("unroll") for (int n = 0; n < 2; ++n) _Pragma("unroll") for (int k = 0; k < 2; ++k) dst[n][k] = *(const LAS bf16x8*)(lds + PG8_SB(b, h) + boff + n * 2048 + k * 1024); } while (0)
#define PG8_MMA(ai, bj, At, Bt) do { __builtin_amdgcn_s_setprio(1); _Pragma("unroll") for (int m = 0; m < 4; ++m) _Pragma("unroll") for (int n = 0; n < 2; ++n) _Pragma("unroll") for (int k = 0; k < 2; ++k) \
        acc[ai][bj][m][n] = __builtin_amdgcn_mfma_f32_16x16x32_bf16(Bt[n][k], At[m][k], acc[ai][bj][m][n], 0, 0, 0); __builtin_amdgcn_s_setprio(0); } while (0)
#define PG8_WAIT_V(n) asm volatile("s_waitcnt vmcnt(" #n ")" ::: "memory")
#define PG8_WAIT_L(n) asm volatile("s_waitcnt lgkmcnt(" #n ")" ::: "memory")
#define PG8_BAR __builtin_amdgcn_s_barrier()
#define PG8_SCHED __builtin_amdgcn_sched_barrier(0)
#define PG8_ZERO() do { _Pragma("unroll") for (int a = 0; a < 2; ++a) _Pragma("unroll") for (int b = 0; b < 2; ++b) _Pragma("unroll") for (int m = 0; m < 4; ++m) _Pragma("unroll") for (int n = 0; n < 2; ++n) acc[a][b][m][n] = (f32x4){0.f, 0.f, 0.f, 0.f}; } while (0)
    Seg cur, nxt; int qi = 0;
    if (!S.seg(0, cur)) return;
    Acc acc;
    PG8_ZERO();
    bf16x8 At[4][2], B0[2][2], B1[2][2];
    const char* cA = cur.A; const char* cB = cur.B;
    PG8_STAGE(PG8_SB(0, 0), cB, voffB); PG8_STAGE(PG8_SB(0, 1), cB + hstepB, voffB); PG8_STAGE(PG8_SA(0, 0), cA, voffA); PG8_STAGE(PG8_SA(0, 1), cA + hstepA, voffA);
    if (wr == 1) PG8_BAR;
    PG8_WAIT_V(2); PG8_BAR;
    PG8_STAGE(PG8_SB(1, 0), cB + kstep, voffB); PG8_STAGE(PG8_SA(1, 0), cA + kstep, voffA); PG8_STAGE(PG8_SB(1, 1), cB + hstepB + kstep, voffB);
    PG8_WAIT_V(6); PG8_BAR;
    for (;;) {
        bool has_next; const char* nA; const char* nB;
        for (;;) {
        has_next = S.seg(qi + 1, nxt);
        nA = has_next ? nxt.A : cA; nB = has_next ? nxt.B : cB;
#pragma unroll 1
        for (int t = 0; t < nt; t += 2) {
            const bool last = (t == nt - 2);
            const char* a1 = cA + (size_t)(t + 1) * kstep;
            const char* a2 = last ? nA : cA + (size_t)(t + 2) * kstep; const char* b2 = last ? nB : cB + (size_t)(t + 2) * kstep;
            const char* a3 = a2 + kstep; const char* b3 = b2 + kstep;
            PG8_LDB(B0, 0, 0); PG8_LDB(B1, 0, 1); PG8_SCHED; PG8_LDA(At, 0, 0); PG8_STAGE(PG8_SA(1, 1), a1 + hstepA, voffA);
            PG8_WAIT_V(8); PG8_WAIT_L(0); PG8_BAR; PG8_MMA(0, 0, At, B0); PG8_MMA(0, 1, At, B1); PG8_BAR; PG8_SCHED;
            PG8_LDA(At, 0, 1); PG8_STAGE(PG8_SB(0, 0), b2, voffB); PG8_STAGE(PG8_SB(0, 1), b2 + hstepB, voffB); PG8_STAGE(PG8_SA(0, 0), a2, voffA);
            PG8_WAIT_V(8); PG8_WAIT_L(0); PG8_BAR; PG8_MMA(1, 0, At, B0); PG8_MMA(1, 1, At, B1); PG8_BAR; PG8_SCHED;
            PG8_LDB(B0, 1, 0); PG8_LDB(B1, 1, 1); PG8_SCHED; PG8_LDA(At, 1, 0); PG8_STAGE(PG8_SA(0, 1), a2 + hstepA, voffA);
            PG8_WAIT_V(8); PG8_WAIT_L(0); PG8_BAR; PG8_MMA(0, 0, At, B0); PG8_MMA(0, 1, At, B1); PG8_BAR; PG8_SCHED;
            PG8_LDA(At, 1, 1); PG8_STAGE(PG8_SB(1, 0), b3, voffB); PG8_STAGE(PG8_SB(1, 1), b3 + hstepB, voffB); PG8_STAGE(PG8_SA(1, 0), a3, voffA);
            PG8_WAIT_V(8); PG8_WAIT_L(0); PG8_BAR; PG8_MMA(1, 0, At, B0); PG8_MMA(1, 1, At, B1); PG8_BAR; PG8_SCHED;
        }
        if (cur.last || !has_next) break;
        cur = nxt; cA = nA; cB = nB; ++qi;
        }
        if constexpr (ALIGN_EPI) { if (wr == 0) PG8_BAR; }
        E(acc, cur.u, wr, wc, fr, fq);
        if (!has_next) break;
        PG8_ZERO();
        cur = nxt; cA = nA; cB = nB; ++qi;
        if constexpr (ALIGN_EPI) { if (wr == 1) PG8_BAR; }
    }
    PG8_WAIT_V(0);
    if constexpr (!ALIGN_EPI) { if (wr == 0) PG8_BAR; }
    PG8_BAR;
#undef PG8_SA
#undef PG8_SB
#undef PG8_STAGE
#undef PG8_LDA
#undef PG8_LDB
#undef PG8_MMA
#undef PG8_WAIT_V
#undef PG8_WAIT_L
#undef PG8_BAR
#undef PG8_SCHED
#undef PG8_ZERO
}

struct EpiBf16 {
    static constexpr bool PERM = true;
    bf16_t* O; int ldc;
    __device__ __forceinline__ void operator()(const Acc& acc, const Unit& u, int wr, int wc, int fr, int fq) const {
        const int row0 = u.pm * BM + wr * 64 + fr; const int col0 = u.pn * BM + wc * 32 + 8 * fq;
#pragma unroll
        for (int ai = 0; ai < 2; ++ai)
#pragma unroll
            for (int m = 0; m < 4; ++m) { bf16_t* rowp = O + (size_t)(row0 + ai * HALF + m * 16) * ldc + col0;
#pragma unroll
                for (int bj = 0; bj < 2; ++bj) { const f32x4 v0 = acc[ai][bj][m][0], v1 = acc[ai][bj][m][1];
                    u32x4 w; w.x = cvt_pk_bf16(v0[0], v0[1]); w.y = cvt_pk_bf16(v0[2], v0[3]); w.z = cvt_pk_bf16(v1[0], v1[1]); w.w = cvt_pk_bf16(v1[2], v1[3]);
                    *(u32x4*)(rowp + bj * HALF) = w; } }
    }
};
struct EpiLora {
    static constexpr bool PERM = true;
    bf16_t* O; const float* w0; const float* a0;
    __device__ __forceinline__ void operator()(const Acc& acc, const Unit& u, int wr, int wc, int fr, int fq) const {
        const int row0 = u.pm * BM + wr * 64 + fr; const int col0 = u.pn * BM + wc * 32 + 8 * fq; const int typ = u.pn >> 2;
        const float* bsrc = (typ == 0) ? w0 : a0;
        const float mul = (typ == 0) ? -0.6065306597126334f : 1.0f; const bool lin = (typ == 2);
#pragma unroll
        for (int bj = 0; bj < 2; ++bj) {
            const int ch = (col0 + bj * HALF) & 1023;
            const f32x4 b0 = *(const f32x4*)(bsrc + ch), b1 = *(const f32x4*)(bsrc + ch + 4);
#pragma unroll
            for (int ai = 0; ai < 2; ++ai)
#pragma unroll
                for (int m = 0; m < 4; ++m) {
                    f32x4 v0 = acc[ai][bj][m][0], v1 = acc[ai][bj][m][1];
                    {
                        const f32x4 s0 = v0 + b0, s1 = v1 + b1;
                        v0.x = lin ? v0.x : mul * sigmoidf_(s0.x); v0.y = lin ? v0.y : mul * sigmoidf_(s0.y); v0.z = lin ? v0.z : mul * sigmoidf_(s0.z); v0.w = lin ? v0.w : mul * sigmoidf_(s0.w);
                        v1.x = lin ? v1.x : mul * sigmoidf_(s1.x); v1.y = lin ? v1.y : mul * sigmoidf_(s1.y); v1.z = lin ? v1.z : mul * sigmoidf_(s1.z); v1.w = lin ? v1.w : mul * sigmoidf_(s1.w);
                    }
                    u32x4 w; w.x = cvt_pk_bf16(v0.x, v0.y); w.y = cvt_pk_bf16(v0.z, v0.w); w.z = cvt_pk_bf16(v1.x, v1.y); w.w = cvt_pk_bf16(v1.z, v1.w);
                    *(u32x4*)(O + (size_t)(row0 + ai * HALF + m * 16) * NL + col0 + bj * HALF) = w;
                    asm volatile("" ::: "memory"); }
        }
    }
};
struct EpiResF32 {
    static constexpr bool PERM = false;
    const float* base; float* out; int ldc;
    __device__ __forceinline__ void operator()(const Acc& acc, const Unit& u, int wr, int wc, int fr, int fq) const {
        const int col0 = u.pn * BM + wc * 32 + 4 * fq;
#pragma unroll
        for (int ai = 0; ai < 2; ++ai)
#pragma unroll
            for (int m = 0; m < 4; ++m) { const size_t off = (size_t)(u.pm * BM + ai * HALF + wr * 64 + m * 16 + fr) * ldc + col0;
#pragma unroll
                for (int bj = 0; bj < 2; ++bj)
#pragma unroll
                    for (int n = 0; n < 2; ++n) { const f32x4 bs = *(const f32x4*)(base + off + bj * HALF + n * 16); *(f32x4*)(out + off + bj * HALF + n * 16) = bs + acc[ai][bj][m][n]; } }
    }
};
struct EpiMoe1 {
    static constexpr bool PERM = true;
    bf16_t* O; const float* gates;
    __device__ __forceinline__ void operator()(const Acc& acc, const Unit& u, int wr, int wc, int fr, int fq) const {
        const int row0 = u.pm * BM + wr * 64 + fr; const int half = u.pn >> 2; const int col0 = half * 512 + (u.pn & 3) * 128 + wc * 32 + 8 * fq;
#pragma unroll
        for (int ai = 0; ai < 2; ++ai)
#pragma unroll
            for (int m = 0; m < 4; ++m) { const int row = row0 + ai * HALF + m * 16; const float gw = gates[(size_t)row * 2 + half];
                float v[8];
#pragma unroll
                for (int e = 0; e < 8; ++e) { const float g = acc[ai][0][m][e >> 2][e & 3], up = acc[ai][1][m][e >> 2][e & 3]; v[e] = g * sigmoidf_(g) * up * gw; }
                u32x4 w; w.x = cvt_pk_bf16(v[0], v[1]); w.y = cvt_pk_bf16(v[2], v[3]); w.z = cvt_pk_bf16(v[4], v[5]); w.w = cvt_pk_bf16(v[6], v[7]);
                *(u32x4*)(O + (size_t)row * 1024 + col0) = w; }
    }
};
struct EpiMoe2 {
    static constexpr bool PERM = false;
    float* out; const int* rowtok; int dry;
    __device__ __forceinline__ void operator()(const Acc& acc, const Unit& u, int wr, int wc, int fr, int fq) const {
        const int col0 = u.pn * BM + wc * 32 + 4 * fq;
#pragma unroll
        for (int ai = 0; ai < 2; ++ai)
#pragma unroll
            for (int m = 0; m < 4; ++m) { const int row = u.pm * BM + ai * HALF + wr * 64 + m * 16 + fr; const int tok = rowtok[row];
                if (tok >= 0 && !dry) { float* o = out + (size_t)tok * DM + col0;
#pragma unroll
                    for (int bj = 0; bj < 2; ++bj)
#pragma unroll
                        for (int n = 0; n < 2; ++n) { f32x4* p = (f32x4*)(o + bj * HALF + n * 16); *p = *p + acc[ai][bj][m][n]; } }
                asm volatile("" ::: "memory"); }
    }
};
}

#define XB_TMO      128
#define XB_XCNT(j)  (256  + 64 * (j))
#define XB_XSUB(j)  (1280 + 64 * (j))
#define XB_XGEN(j)  (2304 + 64 * (j))
#define XB_TOP      3328
#define XB_TOPGEN   3392
#define XCD_BAR_WORDS 3456
#define XB_SPIN_CAP (1u << 20)
__device__ __forceinline__ unsigned xb_ld(unsigned* p)              { return __hip_atomic_load(p, __ATOMIC_RELAXED, __HIP_MEMORY_SCOPE_AGENT); }
__device__ __forceinline__ unsigned xb_add(unsigned* p, unsigned v) { return __hip_atomic_fetch_add(p, v, __ATOMIC_RELAXED, __HIP_MEMORY_SCOPE_AGENT); }
__device__ __forceinline__ unsigned xb_xcc_id() { return (unsigned)__builtin_amdgcn_s_getreg((3 << 11) | 20) & 0xFu; }
#define XB_SPIN(cond, bar) do { unsigned _sp = 0; while (cond) { __builtin_amdgcn_s_sleep(1); \
    if ((++_sp & 255u) == 0u) { if (xb_ld(&(bar)[XB_TMO])) break; if (_sp > XB_SPIN_CAP) { atomicAdd(&(bar)[XB_TMO], 1u); break; } } } } while (0)
struct XcdBarrier { unsigned* bar; unsigned x; volatile LAS unsigned* st; };
__device__ __forceinline__ XcdBarrier xcd_barrier_post(unsigned* bar, volatile LAS unsigned* st) {
    XcdBarrier b; b.bar = bar; b.x = xb_xcc_id(); b.st = st;
    if (threadIdx.x == 0) (void)xb_add(&bar[XB_XCNT(b.x)], 1u);
    return b;
}
__device__ __forceinline__ void xcd_barrier_complete(unsigned* bar, unsigned x, unsigned& nloc, unsigned& nx) {
    const unsigned G = gridDim.x * gridDim.y * gridDim.z;
    unsigned sum, cnt, mine, sp = 0u;
    for (;;) {
        sum = 0u; cnt = 0u; mine = 0u;
#pragma unroll
        for (unsigned j = 0; j < 16; ++j) { const unsigned c = xb_ld(&bar[XB_XCNT(j)]); sum += c; cnt += (c > 0u) ? 1u : 0u; mine = (j == x) ? c : mine; }
        if (sum == G) break;
        __builtin_amdgcn_s_sleep(1);
        if ((++sp & 255u) == 0u) { if (xb_ld(&bar[XB_TMO])) break; if (sp > XB_SPIN_CAP) { atomicAdd(&bar[XB_TMO], 1u); break; } }
    }
    nloc = mine > 0u ? mine : 1u; nx = cnt > 0u ? cnt : 1u;
}
__device__ __forceinline__ void xcd_barrier(const XcdBarrier& b) {
    asm volatile("s_waitcnt vmcnt(0)" ::: "memory");
    __syncthreads();
    if (threadIdx.x == 0) {
        unsigned* bar = b.bar;
        __builtin_amdgcn_s_waitcnt(0);
        unsigned nloc = b.st[0], nx = b.st[1];
        if (nloc == 0u) { xcd_barrier_complete(bar, b.x, nloc, nx); b.st[0] = nloc; b.st[1] = nx; }
        const unsigned old = xb_add(&bar[XB_XSUB(b.x)], 1u);
        const unsigned gen = old / nloc;
        if (old + 1u == (gen + 1u) * nloc) {
            __builtin_amdgcn_fence(__ATOMIC_RELEASE, "agent");
            asm volatile("s_waitcnt vmcnt(0)" ::: "memory");
            const unsigned og = xb_add(&bar[XB_TOP], 1u);
            const unsigned tg = og / nx;
            if (og + 1u == (tg + 1u) * nx) xb_add(&bar[XB_TOPGEN], 1u);
            else XB_SPIN(xb_ld(&bar[XB_TOPGEN]) == tg, bar);
            __builtin_amdgcn_fence(__ATOMIC_ACQUIRE, "agent");
            xb_add(&bar[XB_XGEN(b.x)], 1u);
            asm volatile("s_waitcnt vmcnt(0)" ::: "memory");
        } else {
            XB_SPIN(xb_ld(&bar[XB_XGEN(b.x)]) == gen, bar);
            __builtin_amdgcn_fence(__ATOMIC_ACQUIRE, "agent");
            asm volatile("s_waitcnt vmcnt(0)" ::: "memory");
        }
    }
    __syncthreads();
}

struct Args { const float* in[25]; float* out; unsigned char* ws; int ph_lo, ph_hi; };
enum { I_X = 0, I_GMIX, I_WIN, I_MIX, I_QG, I_KG, I_W0, I_WDEC, I_A0, I_WAICL, I_WGATE, I_KK, I_KA, I_RK, I_LNW, I_LNB, I_WOUT, I_GFFN, I_WRG, I_BRG, I_WRE, I_BRE, I_WEG, I_WEU, I_WED };

struct Frame {
    LAS unsigned char* lds; unsigned char* ldsg;
    unsigned* ctl;
    int tid, lane, wave, vcu, G;
    const float* const* in; float* out; unsigned char* ws;
};

__device__ __forceinline__ int win_dmap(int n) {
    if (n < DSA_COLS) return n;
    const int m = n - DSA_COLS;
    if (m < 1024) return PR + m;
    if (m < 1088) return PDW + (m - 1024);
    if (m < 2112) return PKR + (m - 1088);
    if (m < 3136) return PVR + (m - 2112);
    if (m < 3200) return PDA + (m - 3136);
    return PDG + (m - 3200);
}
template <int MODE>
__device__ __forceinline__ void transpose_item(const float* W, int N, bf16_t* WT, int ldd, LAS float* scr, int kb, int nb, int lane) {
    const int k0 = 64 * kb, n0 = 32 * nb;
    const int nn = n0 + (lane & 31);
    float tv[32];
#pragma unroll
    for (int i = 0; i < 32; ++i) { const int kk = 2 * i + (lane >> 5); tv[i] = (nn < N) ? W[(size_t)(k0 + kk) * N + nn] : 0.f; }
#pragma unroll
    for (int i = 0; i < 32; ++i) { const int kk = 2 * i + (lane >> 5); scr[kk * 33 + (lane & 31)] = tv[i]; }
    LDS_WAIT(); asm volatile("" ::: "memory");
    const int c = lane & 7;
#pragma unroll
    for (int j = 0; j < 4; ++j) { const int nl = (lane >> 3) + 8 * j; const int n = n0 + nl; const LAS float* s = scr + (8 * c) * 33 + nl;
        u32x4 o; o.x = pk2(s[0 * 33], s[1 * 33]); o.y = pk2(s[2 * 33], s[3 * 33]); o.z = pk2(s[4 * 33], s[5 * 33]); o.w = pk2(s[6 * 33], s[7 * 33]);
        int dr = n;
        if (MODE == 1) dr = win_dmap(n);
        if (MODE == 2) dr = (n >> 7) * 256 + (n & 127);
        if (MODE == 3) dr = (n >> 7) * 256 + 128 + (n & 127);
        if (n < N) *(u32x4*)(WT + (size_t)dr * ldd + k0 + 8 * c) = o; }
    LDS_WAIT(); asm volatile("" ::: "memory");
}

__device__ __forceinline__ void phase0(Frame& F) {
    LAS float* scr = (LAS float*)(F.lds + F.wave * 16384);
    const int gw = F.vcu * 8 + F.wave, NGW = F.G * 8, lane = F.lane;
    constexpr int NB_IN = (IN_COLS + 31) / 32;
    constexpr int I_IN = (DM / 64) * NB_IN, I_OUT = (DM / 64) * (DM / 32);
    bf16_t* WIN = (bf16_t*)(F.ws + WS_WIN); bf16_t* WOUT = (bf16_t*)(F.ws + WS_WOUT);
    for (int it = gw; it < I_IN + I_OUT; it += NGW) {
        if (it < I_IN) transpose_item<1>(F.in[I_WIN], IN_COLS, WIN, DM, scr, it / NB_IN, it % NB_IN, lane);
        else { const int r = it - I_IN; transpose_item<0>(F.in[I_WOUT], DM, WOUT, DM, scr, r / (DM / 32), r % (DM / 32), lane); }
    }
    for (int i = gw; i < 144 * 4; i += NGW) { const int r = i >> 2, q = i & 3; const int row = r < 48 ? 4176 + r : 7584 + (r - 48);
        *(u32x4*)(WIN + (size_t)row * DM + q * 512 + lane * 8) = (u32x4){0u, 0u, 0u, 0u}; }
    { bf16_t* WL = (bf16_t*)(F.ws + WS_WLORA); const float* wd = F.in[I_WDEC]; const float* wa = F.in[I_WAICL]; const float* wg = F.in[I_WGATE];
      for (int i = gw * 64 + lane; i < NL * KL; i += NGW * 64) { const int n = i / KL, k = i % KL; const int typ = n >> 10, c = n & 1023; float v = 0.f;
          if (typ == 0 && k < 64) v = wd[k * 1024 + c];
          else if (typ == 1 && k >= 64 && k < 128) v = wa[(k - 64) * 1024 + c];
          else if (typ == 2 && k >= 128 && k < 288) v = wg[(k - 128) * 1024 + c];
          WL[i] = (bf16_t)f2bf(v); } }
    { float* WRT = (float*)(F.ws + WS_WRT); const float* wrg = F.in[I_WRG]; const float* wre = F.in[I_WRE]; const float* gf = F.in[I_GFFN];
      for (int i = gw * 64 + lane; i < 20 * DM; i += NGW * 64) { const int o = i / DM, k = i % DM; WRT[i] = gf[k] * (o < 4 ? wrg[k * 4 + o] : wre[k * 16 + (o - 4)]); } }
    { const float* x = F.in[I_X]; const float* g = F.in[I_GMIX]; bf16_t* HN = (bf16_t*)(F.ws + WS_HN);
      f32x4 gv[8];
#pragma unroll
      for (int j = 0; j < 8; ++j) gv[j] = ((const f32x4*)g)[64 * j + lane];
      for (int m = gw; m < T; m += NGW) { const f32x4* xr = (const f32x4*)(x + (size_t)m * DM) + lane; f32x4 v[8]; float s = 0.f;
#pragma unroll
          for (int j = 0; j < 8; ++j) { v[j] = xr[64 * j]; s += (v[j].x * v[j].x + v[j].y * v[j].y) + (v[j].z * v[j].z + v[j].w * v[j].w); }
          const float rstd = rsqrtf(wave_sum(s) * (1.f / DM) + NORM_EPS);
          u32x2* o = (u32x2*)(HN + (size_t)m * DM) + lane;
#pragma unroll
          for (int j = 0; j < 8; ++j) { u32x2 w; w.x = pk2(v[j].x * rstd * gv[j].x, v[j].y * rstd * gv[j].y); w.y = pk2(v[j].z * rstd * gv[j].z, v[j].w * rstd * gv[j].w); o[64 * j] = w; } } }
}

__device__ __forceinline__ void rope4(float& y0, float& y1, float& y2, float& y3, float c0, float s0, float c1, float s1) {
    const float o0 = y0 * c0 - y2 * s0, o2 = y2 * c0 + y0 * s0, o1 = y1 * c1 - y3 * s1, o3 = y3 * c1 + y1 * s1; y0 = o0; y1 = o1; y2 = o2; y3 = o3;
}
__device__ __forceinline__ void phase2(Frame& F, const bool dry) {
    const int gw = F.vcu * 8 + F.wave, NGW = F.G * 8, lane = F.lane;
    bf16_t* P = (bf16_t*)(F.ws + WS_P); bf16_t* KI = (bf16_t*)(F.ws + WS_KI); bf16_t* AL = (bf16_t*)(F.ws + WS_ALORA);
    const float* mix = F.in[I_MIX];
    const int l5 = lane & 31, hsel = lane >> 5, l4 = lane & 15, hq = lane >> 4;
    float qg[4], kg[4];
    { const float* a = F.in[I_QG]; const float* b = F.in[I_KG];
      qg[0] = a[2 * l5]; qg[1] = a[2 * l5 + 1]; qg[2] = a[64 + 2 * l5]; qg[3] = a[65 + 2 * l5];
      kg[0] = b[2 * l5]; kg[1] = b[2 * l5 + 1]; kg[2] = b[64 + 2 * l5]; kg[3] = b[65 + 2 * l5]; }
    const float L2T = 13.287712379549449f;
    const float inv128_0 = exp2f(-(float)(2 * l5) * (1.0f / 64.0f) * L2T), inv128_1 = exp2f(-(float)(2 * l5 + 1) * (1.0f / 64.0f) * L2T);
    const float inv64_0 = exp2f(-(float)(2 * l4) * (1.0f / 32.0f) * L2T), inv64_1 = exp2f(-(float)(2 * l4 + 1) * (1.0f / 32.0f) * L2T);
    const float mu_dw = mix[1024 + lane], mu_da = mix[3136 + lane], mu_g0 = mix[3200 + lane], mu_g1 = mix[3264 + lane], mu_g2 = (lane < 32) ? mix[3328 + lane] : 0.f;
    for (int tp = gw; tp < T / 2; tp += NGW) {
        unsigned qa[2][4], qb[2][4], ka[2][4], kb[2][4], ia[2][4], ib[2][4], xa[2], xb[2];
        float ap[2][5], apv[2][5];
#pragma unroll
        for (int u = 0; u < 2; ++u) {
            const int t = 2 * tp + u; const int pos = t & (SEQ - 1);
            const bf16_t* row = P + (size_t)t * NP;
#pragma unroll
            for (int hh = 0; hh < 4; ++hh) {
                const unsigned* bq = (const unsigned*)(row + PQ + (2 * hh + hsel) * 128); const unsigned* bk = (const unsigned*)(row + PK + (2 * hh + hsel) * 128);
                qa[u][hh] = bq[l5]; qb[u][hh] = bq[32 + l5]; ka[u][hh] = bk[l5]; kb[u][hh] = bk[32 + l5];
                const unsigned* bi = (const unsigned*)(row + PQI + (4 * hh + hq) * 64);
                ia[u][hh] = bi[l4]; ib[u][hh] = bi[16 + l4];
            }
            { const unsigned* bx = (const unsigned*)(row + PKI); xa[u] = bx[l4]; xb[u] = bx[16 + l4]; }
            const bool hp = pos > 0; const bf16_t* prow = row - NP;
            ap[u][0] = bf2f(row[PDW + lane]); ap[u][1] = bf2f(row[PDA + lane]); ap[u][2] = bf2f(row[PDG + lane]); ap[u][3] = bf2f(row[PDG + 64 + lane]); ap[u][4] = (lane < 32) ? bf2f(row[PDG + 128 + lane]) : 0.f;
            apv[u][0] = hp ? bf2f(prow[PDW + lane]) : 0.f; apv[u][1] = hp ? bf2f(prow[PDA + lane]) : 0.f; apv[u][2] = hp ? bf2f(prow[PDG + lane]) : 0.f;
            apv[u][3] = hp ? bf2f(prow[PDG + 64 + lane]) : 0.f; apv[u][4] = (hp && lane < 32) ? bf2f(prow[PDG + 128 + lane]) : 0.f;
        }
        asm volatile("" ::: "memory");
#pragma unroll
        for (int u = 0; u < 2; ++u) {
            const int t = 2 * tp + u; const int pos = t & (SEQ - 1); const float fp = (float)pos;
            bf16_t* row = P + (size_t)t * NP;
            float c0, s0, c1, s1, d0, e0, d1, e1;
            sincosf(fp * inv128_0, &s0, &c0); sincosf(fp * inv128_1, &s1, &c1);
            sincosf(fp * inv64_0, &e0, &d0); sincosf(fp * inv64_1, &e1, &d1);
#pragma unroll
            for (int which = 0; which < 2; ++which) {
#pragma unroll
                for (int hh = 0; hh < 4; ++hh) {
                    unsigned* base = (unsigned*)(row + (which ? PK : PQ) + (2 * hh + hsel) * 128);
                    const unsigned a = which ? ka[u][hh] : qa[u][hh], b = which ? kb[u][hh] : qb[u][hh];
                    float y0 = bflo(a), y1 = bfhi(a), y2 = bflo(b), y3 = bfhi(b);
                    const float ss = half_sum((y0 * y0 + y1 * y1) + (y2 * y2 + y3 * y3));
                    const float rstd = rsqrtf(ss * (1.0f / 128.0f) + NORM_EPS) * (which ? 1.0f : QSCALE);
                    const float* gg = which ? kg : qg;
                    y0 *= rstd * gg[0]; y1 *= rstd * gg[1]; y2 *= rstd * gg[2]; y3 *= rstd * gg[3];
                    rope4(y0, y1, y2, y3, c0, s0, c1, s1);
                    if (!dry) { base[l5] = pk2(y0, y1); base[32 + l5] = pk2(y2, y3); }
                }
            }
#pragma unroll
            for (int it = 0; it < 4; ++it) {
                unsigned* base = (unsigned*)(row + PQI + (4 * it + hq) * 64);
                float y0 = bflo(ia[u][it]), y1 = bfhi(ia[u][it]), y2 = bflo(ib[u][it]), y3 = bfhi(ib[u][it]);
                rope4(y0, y1, y2, y3, d0, e0, d1, e1);
                if (!dry) { base[l4] = pk2(y0, y1); base[16 + l4] = pk2(y2, y3); }
            }
            if (lane < 16 && !dry) {
                float y0 = bflo(xa[u]), y1 = bfhi(xa[u]), y2 = bflo(xb[u]), y3 = bfhi(xb[u]);
                rope4(y0, y1, y2, y3, d0, e0, d1, e1);
                unsigned* o = (unsigned*)(KI + (size_t)t * 64);
                o[l4] = pk2(y0, y1); o[16 + l4] = pk2(y2, y3);
            }
            if (!dry) {
                bf16_t* al = AL + (size_t)t * KL;
                float sh;
                sh = ap[u][0] + (apv[u][0] - ap[u][0]) * mu_dw; al[lane] = (bf16_t)f2bf(tanhf(sh));
                sh = ap[u][1] + (apv[u][1] - ap[u][1]) * mu_da; al[64 + lane] = (bf16_t)f2bf(sh);
                sh = ap[u][2] + (apv[u][2] - ap[u][2]) * mu_g0; al[128 + lane] = (bf16_t)f2bf(sigmoidf_(sh));
                sh = ap[u][3] + (apv[u][3] - ap[u][3]) * mu_g1; al[192 + lane] = (bf16_t)f2bf(sigmoidf_(sh));
                if (lane < 32) { sh = ap[u][4] + (apv[u][4] - ap[u][4]) * mu_g2; al[256 + lane] = (bf16_t)f2bf(sigmoidf_(sh)); }
                al[288 + lane] = 0; if (lane < 32) al[352 + lane] = 0;
            }
        }
    }
}

__device__ __forceinline__ unsigned fkey(float f) { const unsigned u = __builtin_bit_cast(unsigned, f); return (u & 0x80000000u) ? ~u : (u | 0x80000000u); }
constexpr int CW_QIDX = 192;
constexpr int IDX_BUF = 256 * 128;
__device__ __forceinline__ void half_sum_i(int v, int& lo, int& hi) {
#define DPP_ADDI(v, ctrl, rm) (v) += __builtin_amdgcn_update_dpp(0, (v), (ctrl), (rm), 0xF, false)
    DPP_ADDI(v, 0xB1, 0xF); DPP_ADDI(v, 0x4E, 0xF); DPP_ADDI(v, 0x141, 0xF); DPP_ADDI(v, 0x140, 0xF); DPP_ADDI(v, 0x142, 0xA);
#undef DPP_ADDI
    lo = __builtin_amdgcn_readlane(v, 31); hi = __builtin_amdgcn_readlane(v, 63);
}
__device__ __forceinline__ void idx_unit(Frame& F, int u) {
    int tid_ = F.tid; asm volatile("" : "+v"(tid_));
    const int lane = tid_ & 63, wave = F.wave;
    const bf16_t* P = (const bf16_t*)(F.ws + WS_P); const unsigned char* KI = F.ws + WS_KI; unsigned* MSK = (unsigned*)(F.ws + WS_MSK);
    const int r = lane & 31, h = lane >> 5;
    const int i = 63 - (u >> 4), b = (u & 15) >> 2, g = u & 3;
    const int t0 = b * SEQ + i * 64 + g * 16 + 2 * wave;
    const int njt = 2 * (i + 1), nst = (njt + 7) >> 3;
    bf16x8 a[4];
    { const bf16_t* ap = P + (size_t)(t0 + ((r >> 2) & 1)) * NP + PQI + ((r & 3) + 4 * (r >> 3)) * 64 + 8 * h;
#pragma unroll
      for (int s = 0; s < 4; ++s) a[s] = *(const bf16x8*)(ap + 16 * s); }
    typedef _Float16 h16x2 __attribute__((ext_vector_type(2)));
    h16x2 wq[8];
    { const bf16_t* wp = P + (size_t)(t0 + h) * NP + PWI;
#pragma unroll
      for (int e = 0; e < 8; ++e) { wq[e].x = (_Float16)(bf2f(wp[2 * e]) * (1.0f / 32.0f)); wq[e].y = (_Float16)(bf2f(wp[2 * e + 1]) * (1.0f / 32.0f)); } }
    const unsigned char* kg = KI + ((size_t)b * SEQ) * 128 + (size_t)(wave * 8 + (lane >> 3)) * 128 + (size_t)(((lane & 7) ^ (lane >> 3)) * 16);
#define IDX_STAGE(st_, buf_) do { _Pragma("unroll") for (int q = 0; q < 4; ++q) \
        __builtin_amdgcn_global_load_lds((const unsigned*)(kg + (size_t)(st_) * 32768 + q * 8192), (LAS unsigned*)(F.lds + (buf_) * IDX_BUF + (q * 8 + wave) * 1024), 16, 0, 0); } while (0)
    IDX_STAGE(0, 0);
    __syncthreads();
    unsigned sc[128];
    const int lr = r * 128, sw = r & 7;
#pragma unroll
    for (int st = 0; st < 16; ++st) {
        if (st < nst) {
            if (st + 1 < nst) IDX_STAGE(st + 1, (st + 1) & 1);
            const LAS unsigned char* kb = F.lds + (st & 1) * IDX_BUF + lr;
#pragma unroll
            for (int jb = 0; jb < 8; ++jb) {
                const int j = 8 * st + jb;
                const unsigned adm = (j < njt) ? 0xFFFFFFFFu : 0u;
                f32x16 acc = {0.f, 0.f, 0.f, 0.f, 0.f, 0.f, 0.f, 0.f, 0.f, 0.f, 0.f, 0.f, 0.f, 0.f, 0.f, 0.f};
#pragma unroll
                for (int s = 0; s < 4; ++s) acc = __builtin_amdgcn_mfma_f32_32x32x16_bf16(a[s], *(const LAS bf16x8*)(kb + jb * 4096 + (((2 * s + h) ^ sw) * 16)), acc, 0, 0, 0);
                float sum = 0.f, sum1 = 0.f;
#pragma unroll
                for (int e = 0; e < 16; ++e) { const float rl = __builtin_amdgcn_fmed3f(acc[e], 0.f, 3.0e38f);
                    const unsigned wpk = __builtin_bit_cast(unsigned, wq[e >> 1]);
                    if (e & 1) asm("v_fma_mix_f32 %0, %1, %2, %0 op_sel:[1,0,0] op_sel_hi:[1,0,0]" : "+v"(sum1) : "v"(wpk), "v"(rl));
                    else asm("v_fma_mix_f32 %0, %1, %2, %0 op_sel:[0,0,0] op_sel_hi:[1,0,0]" : "+v"(sum) : "v"(wpk), "v"(rl)); }
                sum += sum1;
                sc[j] = fkey(sum) & adm;
            }
            __syncthreads();
        } else {
#pragma unroll
            for (int jb = 0; jb < 8; ++jb) sc[8 * st + jb] = 0u;
        }
    }
#undef IDX_STAGE
    unsigned thr = 1u;
    if (njt > 8) {
        thr = 0u; bool dlo = false, dhi = false;
        for (int bit = 31; bit >= 0; --bit) {
            const unsigned cand = thr | (1u << bit);
            int cnt = 0;
#pragma unroll
            for (int jg = 0; jg < 16; ++jg) {
                if (8 * jg < njt) {
#pragma unroll
                    for (int jj = 0; jj < 8; ++jj) cnt += (sc[8 * jg + jj] >= cand) ? 1 : 0;
                }
            }
            int clo, chi; half_sum_i(cnt, clo, chi);
            const int mine = h ? chi : clo;
            if (mine >= 256) thr = cand;
            dlo |= (clo == 256); dhi |= (chi == 256);
            if (dlo && dhi) break;
        }
    }
    unsigned m0a = 0u, m0b = 0u, m1a = 0u, m1b = 0u;
#pragma unroll
    for (int j = 0; j < 128; ++j) {
        const unsigned long long bal = __ballot(sc[j] >= thr);
        const unsigned lo = (unsigned)bal, hi = (unsigned)(bal >> 32);
        if (j < 64) { asm volatile("s_nop 3\n\tv_writelane_b32 %0, %1, %2" : "+v"(m0a) : "s"(lo), "n"(j)); asm volatile("v_writelane_b32 %0, %1, %2" : "+v"(m1a) : "s"(hi), "n"(j)); }
        else { asm volatile("s_nop 3\n\tv_writelane_b32 %0, %1, %2" : "+v"(m0b) : "s"(lo), "n"(j - 64)); asm volatile("v_writelane_b32 %0, %1, %2" : "+v"(m1b) : "s"(hi), "n"(j - 64)); }
        if ((j & 7) == 7) __builtin_amdgcn_sched_barrier(0);
    }
    MSK[(size_t)t0 * 128 + lane] = m0a; MSK[(size_t)t0 * 128 + 64 + lane] = m0b;
    MSK[(size_t)(t0 + 1) * 128 + lane] = m1a; MSK[(size_t)(t0 + 1) * 128 + 64 + lane] = m1b;
}

__device__ __forceinline__ void attn_task_naive(Frame& F, int task, unsigned char* wl) {
    const int lane = F.lane;
    const bf16_t* P = (const bf16_t*)(F.ws + WS_P); const unsigned* MSK = (const unsigned*)(F.ws + WS_MSK); bf16_t* Y = (bf16_t*)(F.ws + WS_YCAT);
    int* list = (int*)wl; float* qs = (float*)(wl + 1024); float* ps = (float*)(wl + 1536);
    const int t = task >> 3, hd = task & 7, b = t >> 12, i = (t & (SEQ - 1)) >> 6;
    const int ntile = i + 1;
    int cnt = 0;
    for (int jj = 0; jj < ntile; ++jj) {
        const unsigned w0 = MSK[(size_t)t * 128 + 2 * jj], w1 = MSK[(size_t)t * 128 + 2 * jj + 1];
        const unsigned long long m = (unsigned long long)w0 | ((unsigned long long)w1 << 32);
        const int pre = __popcll(m & ((1ull << lane) - 1ull));
        if (((m >> lane) & 1ull) && (cnt + pre < 256)) list[cnt + pre] = 64 * jj + lane;
        cnt += __popcll(m);
    }
    const int nsel = cnt < 256 ? cnt : 256;
    { const bf16_t* qp = P + (size_t)t * NP + PQ + hd * 128; qs[lane] = bf2f(qp[lane]); qs[64 + lane] = bf2f(qp[64 + lane]); }
    LDS_WAIT(); asm volatile("" ::: "memory");
    float lg[4]; float mx = -INFINITY;
#pragma unroll
    for (int rr = 0; rr < 4; ++rr) {
        const int e = lane + 64 * rr; lg[rr] = -INFINITY;
        if (e < nsel) { const int key = list[e]; const u32x4* kp = (const u32x4*)(P + ((size_t)b * SEQ + key) * NP + PK + hd * 128); float d = 0.f;
#pragma unroll
            for (int c = 0; c < 16; ++c) { const u32x4 kv = kp[c]; const float* q = qs + 8 * c;
                d += q[0] * bflo(kv.x) + q[1] * bfhi(kv.x) + q[2] * bflo(kv.y) + q[3] * bfhi(kv.y) + q[4] * bflo(kv.z) + q[5] * bfhi(kv.z) + q[6] * bflo(kv.w) + q[7] * bfhi(kv.w); }
            lg[rr] = d; mx = fmaxf(mx, d); }
    }
#pragma unroll
    for (int o = 1; o < 64; o <<= 1) mx = fmaxf(mx, __shfl_xor(mx, o));
    float sum = 0.f;
#pragma unroll
    for (int rr = 0; rr < 4; ++rr) { const int e = lane + 64 * rr; const float p = (e < nsel) ? exp2f(lg[rr] - mx) : 0.f; ps[e] = p; sum += p; }
    sum = wave_sum(sum);
    LDS_WAIT(); asm volatile("" ::: "memory");
    float o0 = 0.f, o1 = 0.f;
    const bf16_t* vb = P + (size_t)b * SEQ * NP + PV + hd * 128 + 2 * lane;
    for (int e = 0; e < nsel; ++e) { const int key = list[e]; const float p = ps[e]; const unsigned v = *(const unsigned*)(vb + (size_t)key * NP); o0 += p * bflo(v); o1 += p * bfhi(v); }
    const float inv = 1.0f / sum;
    *(unsigned*)(Y + (size_t)t * DM + hd * 128 + 2 * lane) = pk2(o0 * inv, o1 * inv);
    LDS_WAIT(); asm volatile("" ::: "memory");
}

__device__ __forceinline__ void rwkv_scan_naive(Frame& F, int bh, unsigned char* wl) {
    const int lane = F.lane, b = bh >> 4, hd = bh & 15, ch = hd * 64 + lane;
    const bf16_t* P = (const bf16_t*)(F.ws + WS_P); const bf16_t* L3 = (const bf16_t*)(F.ws + WS_L3); bf16_t* Y = (bf16_t*)(F.ws + WS_YCAT);
    const float* mix = F.in[I_MIX];
    const float mu_r = mix[ch], mu_k = mix[1088 + ch], mu_v = mix[2112 + ch];
    const float kkc = F.in[I_KK][ch], kac = F.in[I_KA][ch], rkc = F.in[I_RK][ch], lnw = F.in[I_LNW][ch], lnb = F.in[I_LNB][ch];
    float* vec = (float*)wl;
    f32x4 S4[16];
#pragma unroll
    for (int k = 0; k < 16; ++k) S4[k] = (f32x4){0.f, 0.f, 0.f, 0.f};
    float prev_r = 0.f, prev_k = 0.f, prev_v = 0.f;
    constexpr int PF = 4;
    float in_r[PF], in_k[PF], in_v[PF], in_ld[PF], in_a[PF], in_g[PF];
    const bf16_t* prow = P + (size_t)b * SEQ * NP + ch; const bf16_t* lrow = L3 + (size_t)b * SEQ * NL + ch;
#pragma unroll
    for (int j = 0; j < PF; ++j) { const bf16_t* pr = prow + (size_t)j * NP; const bf16_t* lr = lrow + (size_t)j * NL;
        in_r[j] = bf2f(pr[PR]); in_k[j] = bf2f(pr[PKR]); in_v[j] = bf2f(pr[PVR]); in_ld[j] = bf2f(lr[0]); in_a[j] = bf2f(lr[1024]); in_g[j] = bf2f(lr[2048]); }
    const f32x4* vec4 = (const f32x4*)vec;
    for (int tb = 0; tb < SEQ; tb += PF) {
        float c_r[PF], c_k[PF], c_v[PF], c_ld[PF], c_a[PF], c_g[PF];
#pragma unroll
        for (int j = 0; j < PF; ++j) { c_r[j] = in_r[j]; c_k[j] = in_k[j]; c_v[j] = in_v[j]; c_ld[j] = in_ld[j]; c_a[j] = in_a[j]; c_g[j] = in_g[j]; }
        {
            const int tn = (tb + PF < SEQ) ? tb + PF : tb;
#pragma unroll
            for (int j = 0; j < PF; ++j) { const bf16_t* pr = prow + (size_t)(tn + j) * NP; const bf16_t* lr = lrow + (size_t)(tn + j) * NL;
                in_r[j] = bf2f(pr[PR]); in_k[j] = bf2f(pr[PKR]); in_v[j] = bf2f(pr[PVR]); in_ld[j] = bf2f(lr[0]); in_a[j] = bf2f(lr[1024]); in_g[j] = bf2f(lr[2048]); }
        }
#pragma unroll
        for (int j = 0; j < PF; ++j) {
            const float r_t = c_r[j] + (prev_r - c_r[j]) * mu_r, k_t = c_k[j] + (prev_k - c_k[j]) * mu_k, v_t = c_v[j] + (prev_v - c_v[j]) * mu_v;
            prev_r = c_r[j]; prev_k = c_k[j]; prev_v = c_v[j];
            const float a = c_a[j];
            const float kkr = k_t * kkc; const float n2 = wave_sum(kkr * kkr); const float kk = kkr * (1.0f / fmaxf(sqrtf(n2), 1e-12f));
            const float kp = k_t * (1.0f + (a - 1.0f) * kac); const float w = __expf(c_ld[j]); const float bb = kk * a;
            vec[lane] = -kk; vec[64 + lane] = w; vec[128 + lane] = bb; vec[192 + lane] = kp; vec[256 + lane] = r_t;
            LDS_WAIT(); asm volatile("" ::: "memory");
            f32x4 sa4 = (f32x4){0.f, 0.f, 0.f, 0.f};
#pragma unroll
            for (int k = 0; k < 16; ++k) { sa4 += S4[k] * vec4[k]; if ((k & 3) == 3) asm volatile("" ::: "memory"); }
            const float sa = (sa4.x + sa4.y) + (sa4.z + sa4.w);
            f32x4 y4 = (f32x4){0.f, 0.f, 0.f, 0.f};
#pragma unroll
            for (int k = 0; k < 16; ++k) {
                const f32x4 wv = vec4[16 + k], bv = vec4[32 + k], kv = vec4[48 + k], rv = vec4[64 + k];
                S4[k] = S4[k] * wv + bv * sa + kv * v_t; y4 += S4[k] * rv;
                if (k & 1) asm volatile("" ::: "memory"); }
            const float y = (y4.x + y4.y) + (y4.z + y4.w);
            const float mean = wave_sum(y) * (1.0f / 64.0f); const float dv = y - mean; const float var = wave_sum(dv * dv) * (1.0f / 64.0f);
            const float yn = dv * rsqrtf(var + GN_EPS) * lnw + lnb;
            const float bonus = wave_sum(r_t * kp * rkc) * v_t;
            const float o = (yn + bonus) * c_g[j];
            Y[((size_t)b * SEQ + tb + j) * DM + 1024 + ch] = (bf16_t)f2bf(o);
            asm volatile("" ::: "memory");
        }
    }
}


namespace rw {
constexpr int TP = 72, TILE_B = 64 * TP * 2;
enum { T_ATM = 0, T_RTM, T_BTM, T_KTM, T_ACM, T_VCM, T_BCM, T_KCM, T_MAB, T_MAK, T_MRB, T_MRK, T_TINV, NTILE };
constexpr int T_G1 = T_ATM, T_AP = T_BTM, T_U0 = T_KTM;
constexpr int OFF_X11T = NTILE * TILE_B, OFF_T1T = OFF_X11T + 2560, OFF_SEG = OFF_T1T + 2560, OFF_PC = OFF_SEG + 2048, LDS_END = OFF_PC + 256;
static_assert(LDS_END <= RING_BYTES, "rwkv pass A LDS");
__device__ __forceinline__ int crow(int e, int h) { return (e & 3) + 8 * (e >> 2) + 4 * h; }
__device__ __forceinline__ f32x16 zero16() { return (f32x16){0.f, 0.f, 0.f, 0.f, 0.f, 0.f, 0.f, 0.f, 0.f, 0.f, 0.f, 0.f, 0.f, 0.f, 0.f, 0.f}; }
template <int KS>
__device__ __forceinline__ f32x16 mmt(const LAS bf16_t* A, int ap, int ar0, int ac0, const LAS bf16_t* B, int bp, int br0, int bc0, f32x16 acc, int r, int h) {
    const LAS bf16_t* pa = A + (ar0 + r) * ap + ac0 + 8 * h; const LAS bf16_t* pb = B + (br0 + r) * bp + bc0 + 8 * h;
#pragma unroll
    for (int s = 0; s < KS; ++s) acc = __builtin_amdgcn_mfma_f32_32x32x16_bf16(*(const LAS bf16x8*)(pa + 16 * s), *(const LAS bf16x8*)(pb + 16 * s), acc, 0, 0, 0);
    return acc;
}
__device__ __forceinline__ void store_rm(LAS bf16_t* D, int r0, int c0, const f32x16& acc, int r, int h) {
#pragma unroll
    for (int e = 0; e < 16; ++e) D[(r0 + crow(e, h)) * TP + c0 + r] = (bf16_t)f2bf(acc[e]);
}
__device__ __forceinline__ u32x4 pack8(const f32x16& a, int s) { u32x4 w; w.x = pk2(a[8 * s], a[8 * s + 1]); w.y = pk2(a[8 * s + 2], a[8 * s + 3]); w.z = pk2(a[8 * s + 4], a[8 * s + 5]); w.w = pk2(a[8 * s + 6], a[8 * s + 7]); return w; }
__device__ __forceinline__ void unpack8(const u32x4 w, f32x16& a, int s) { a[8 * s] = bflo(w.x); a[8 * s + 1] = bfhi(w.x); a[8 * s + 2] = bflo(w.y); a[8 * s + 3] = bfhi(w.y); a[8 * s + 4] = bflo(w.z); a[8 * s + 5] = bfhi(w.z); a[8 * s + 6] = bflo(w.w); a[8 * s + 7] = bfhi(w.w); }
__device__ __forceinline__ unsigned char* l3_slot(unsigned char* l3, int tg0, int col0, int bo) { return l3 + ((size_t)(tg0 + (bo >> 7)) * NL + col0) * 2 + (bo & 127); }

__device__ __forceinline__ void pass_a(Frame& F) {
    const int lane = F.lane, wave = F.wave, r = lane & 31, h = lane >> 5;
    LAS bf16_t* tiles = (LAS bf16_t*)F.lds;
#define TL(i) (tiles + (i) * (TILE_B / 2))
    LAS bf16_t* X11T = (LAS bf16_t*)(F.lds + OFF_X11T); LAS bf16_t* T1T = (LAS bf16_t*)(F.lds + OFF_T1T);
    LAS float* seg = (LAS float*)(F.lds + OFF_SEG); LAS float* pc = (LAS float*)(F.lds + OFF_PC);
    const bf16_t* P = (const bf16_t*)(F.ws + WS_P); unsigned char* L3 = F.ws + WS_L3;
    bf16_t* MT = (bf16_t*)(F.ws + WS_MT); bf16_t* SA = (bf16_t*)(F.ws + WS_SA); float* BON = (float*)(F.ws + WS_BON);
    const float* mix = F.in[I_MIX];
    for (int unit = F.vcu; unit < 4096; unit += F.G) {
        const int b = unit >> 10, hd = (unit >> 6) & 15, ci = unit & 63, tg0 = b * SEQ + ci * 64;
        {
            const int c = lane, ch = hd * 64 + c, sg = wave;
            const float mu_r = mix[ch], mu_k = mix[1088 + ch], mu_v = mix[2112 + ch];
            const float kkc = F.in[I_KK][ch], kac = F.in[I_KA][ch], rkc = F.in[I_RK][ch];
            const bf16_t* p0 = P + (size_t)(tg0 + 8 * sg) * NP + ch; const bf16_t* l0 = (const bf16_t*)L3 + (size_t)(tg0 + 8 * sg) * NL + ch;
            float pr, pk, pv;
            if (ci == 0 && sg == 0) { pr = 0.f; pk = 0.f; pv = 0.f; } else { pr = bf2f(p0[PR - NP]); pk = bf2f(p0[PKR - NP]); pv = bf2f(p0[PVR - NP]); }
            float rr[8], kp[8], vv[8], kk[8], bb[8], ld[8], cl[8];
            float run = 0.f;
#pragma unroll
            for (int j = 0; j < 8; ++j) {
                const float cr = bf2f(p0[(size_t)j * NP + PR]), ck = bf2f(p0[(size_t)j * NP + PKR]), cv = bf2f(p0[(size_t)j * NP + PVR]);
                const float l = bf2f(l0[(size_t)j * NL]), a = bf2f(l0[(size_t)j * NL + 1024]);
                const float r_t = cr + (pr - cr) * mu_r, k_t = ck + (pk - ck) * mu_k, v_t = cv + (pv - cv) * mu_v; pr = cr; pk = ck; pv = cv;
                const float kkr = k_t * kkc; const float n2 = wave_sum(kkr * kkr); const float kkn = kkr * (1.0f / fmaxf(sqrtf(n2), 1e-12f));
                const float kpp = k_t * (1.0f + (a - 1.0f) * kac);
                const float bon = wave_sum(r_t * kpp * rkc);
                if (lane == 0) BON[(size_t)(tg0 + 8 * sg + j) * 16 + hd] = bon;
                run += l; rr[j] = r_t; kp[j] = kpp; vv[j] = v_t; kk[j] = kkn; bb[j] = kkn * a; ld[j] = l; cl[j] = run;
            }
            seg[sg * 64 + c] = run;
            __syncthreads();
            float off = 0.f, tot = 0.f;
#pragma unroll
            for (int q = 0; q < 8; ++q) { const float v = seg[q * 64 + c]; tot += v; off += (q < sg) ? v : 0.f; }
            if (sg == 0) pc[c] = __expf(tot);
            float ta[8], tr[8], tb[8], tk[8];
#pragma unroll
            for (int j = 0; j < 8; ++j) { const float lp = off + cl[j]; const float ep = __expf(lp), em = __expf(-lp), epm = __expf(lp - ld[j]);
                ta[j] = -kk[j] * epm; tr[j] = rr[j] * ep; tb[j] = bb[j] * em; tk[j] = kp[j] * em; }
#pragma unroll
            for (int j = 0; j < 8; ++j) { const int o = (8 * sg + j) * TP + c;
                TL(T_ATM)[o] = (bf16_t)f2bf(ta[j]); TL(T_RTM)[o] = (bf16_t)f2bf(tr[j]); TL(T_BTM)[o] = (bf16_t)f2bf(tb[j]); TL(T_KTM)[o] = (bf16_t)f2bf(tk[j]); }
            { const int o = c * TP + 8 * sg;
              *(LAS u32x4*)(TL(T_ACM) + o) = (u32x4){pk2(ta[0], ta[1]), pk2(ta[2], ta[3]), pk2(ta[4], ta[5]), pk2(ta[6], ta[7])};
              *(LAS u32x4*)(TL(T_VCM) + o) = (u32x4){pk2(vv[0], vv[1]), pk2(vv[2], vv[3]), pk2(vv[4], vv[5]), pk2(vv[6], vv[7])};
              *(LAS u32x4*)(TL(T_BCM) + o) = (u32x4){pk2(tb[0], tb[1]), pk2(tb[2], tb[3]), pk2(tb[4], tb[5]), pk2(tb[6], tb[7])};
              *(LAS u32x4*)(TL(T_KCM) + o) = (u32x4){pk2(tk[0], tk[1]), pk2(tk[2], tk[3]), pk2(tk[4], tk[5]), pk2(tk[6], tk[7])}; }
        }
        __syncthreads();
#pragma unroll
        for (int q = 0; q < 2; ++q) {
            const int id = 2 * wave + q, rt = id >> 2, ct = id & 3;
            const LAS bf16_t* Z = (rt < 2) ? TL(T_ATM) : TL(T_RTM); const LAS bf16_t* X = (ct < 2) ? TL(T_BTM) : TL(T_KTM);
            LAS bf16_t* D = (rt < 2) ? ((ct < 2) ? TL(T_MAB) : TL(T_MAK)) : ((ct < 2) ? TL(T_MRB) : TL(T_MRK));
            const int zr0 = (rt & 1) * 32, xr0 = (ct & 1) * 32; const bool strict = rt < 2;
            f32x16 acc = zero16();
            if (xr0 <= zr0) acc = mmt<4>(Z, TP, zr0, 0, X, TP, xr0, 0, acc, r, h);
#pragma unroll
            for (int e = 0; e < 16; ++e) { const int t = zr0 + crow(e, h), i = xr0 + r; const bool keep = strict ? (i < t) : (i <= t); D[t * TP + i] = keep ? (bf16_t)f2bf(acc[e]) : (bf16_t)0; }
        }
        __syncthreads();
        if (wave == 0) {
            const LAS bf16_t* Lm = TL(T_MAB); LAS bf16_t* TI = TL(T_TINV);
            const int n = r, o = 32 * h;
            float x[32];
#pragma unroll
            for (int t = 0; t < 32; ++t) {
                float acc = (t == n) ? 1.0f : 0.0f;
#pragma unroll
                for (int i8 = 0; i8 < (t + 7) / 8; ++i8) { const u32x4 w = *(const LAS u32x4*)(Lm + (o + t) * TP + o + 8 * i8);
                    const float l0 = bflo(w.x), l1 = bfhi(w.x), l2 = bflo(w.y), l3 = bfhi(w.y), l4 = bflo(w.z), l5 = bfhi(w.z), l6 = bflo(w.w), l7 = bfhi(w.w);
                    if (8 * i8 + 0 < t) acc += l0 * x[8 * i8 + 0]; if (8 * i8 + 1 < t) acc += l1 * x[8 * i8 + 1]; if (8 * i8 + 2 < t) acc += l2 * x[8 * i8 + 2]; if (8 * i8 + 3 < t) acc += l3 * x[8 * i8 + 3];
                    if (8 * i8 + 4 < t) acc += l4 * x[8 * i8 + 4]; if (8 * i8 + 5 < t) acc += l5 * x[8 * i8 + 5]; if (8 * i8 + 6 < t) acc += l6 * x[8 * i8 + 6]; if (8 * i8 + 7 < t) acc += l7 * x[8 * i8 + 7]; }
                x[t] = acc;
            }
#pragma unroll
            for (int t = 0; t < 32; ++t) { TI[(o + t) * TP + o + n] = (bf16_t)f2bf(x[t]); if (h == 0) TI[t * TP + 32 + n] = (bf16_t)0; }
            if (h == 0) {
#pragma unroll
                for (int q = 0; q < 4; ++q) *(LAS u32x4*)(X11T + n * 40 + 8 * q) = (u32x4){pk2(x[8 * q], x[8 * q + 1]), pk2(x[8 * q + 2], x[8 * q + 3]), pk2(x[8 * q + 4], x[8 * q + 5]), pk2(x[8 * q + 6], x[8 * q + 7])};
            }
            LDS_WAIT(); asm volatile("" ::: "memory");
            f32x16 t1 = mmt<2>(Lm, TP, 32, 0, X11T, 40, 0, 0, zero16(), r, h);
#pragma unroll
            for (int g = 0; g < 4; ++g) *(LAS u32x2*)(T1T + r * 40 + 8 * g + 4 * h) = (u32x2){pk2(t1[4 * g], t1[4 * g + 1]), pk2(t1[4 * g + 2], t1[4 * g + 3])};
            LDS_WAIT(); asm volatile("" ::: "memory");
            f32x16 x21 = mmt<2>(TI, TP, 32, 32, T1T, 40, 0, 0, zero16(), r, h);
            store_rm(TI, 32, 0, x21, r, h);
        } else if (wave >= 4) {
            const int mi = (wave - 4) >> 1, ni = (wave - 4) & 1;
            f32x16 acc = mmt<4>(TL(T_VCM), TP, 32 * mi, 0, TL(T_MAK), TP, 32 * ni, 0, zero16(), r, h);
            store_rm(TL(T_G1), 32 * mi, 32 * ni, acc, r, h);
        }
        __syncthreads();
        {
            const int w4 = wave & 3, mi = w4 >> 1, ni = w4 & 1;
            if (wave < 4) { f32x16 acc = mmt<4>(TL(T_ACM), TP, 32 * mi, 0, TL(T_TINV), TP, 32 * ni, 0, zero16(), r, h); store_rm(TL(T_AP), 32 * mi, 32 * ni, acc, r, h); }
            else { f32x16 acc = mmt<4>(TL(T_G1), TP, 32 * mi, 0, TL(T_TINV), TP, 32 * ni, 0, zero16(), r, h); store_rm(TL(T_U0), 32 * mi, 32 * ni, acc, r, h); }
        }
        __syncthreads();
#pragma unroll
        for (int q = 0; q < 2; ++q) {
            const int id = 2 * wave + q, typ = id >> 2, xx = (id >> 1) & 1, yy = id & 1;
            if (typ == 0) {
                f32x16 acc = mmt<4>(TL(T_AP), TP, 32 * xx, 0, TL(T_MRB), TP, 32 * yy, 0, zero16(), r, h);
#pragma unroll
                for (int g = 0; g < 4; ++g) { const u32x2 w = *(const LAS u32x2*)(TL(T_RTM) + (32 * yy + r) * TP + 32 * xx + 8 * g + 4 * h);
                    acc[4 * g] += bflo(w.x); acc[4 * g + 1] += bfhi(w.x); acc[4 * g + 2] += bflo(w.y); acc[4 * g + 3] += bfhi(w.y); }
#pragma unroll
                for (int s = 0; s < 2; ++s) *(u32x4*)l3_slot(L3, tg0, hd * 64, (((xx * 2 + s) * 2 + yy) * 64 + lane) * 16) = pack8(acc, s);
            } else if (typ == 1) {
                f32x16 acc = mmt<4>(TL(T_U0), TP, 32 * xx, 0, TL(T_MRB), TP, 32 * yy, 0, zero16(), r, h);
                acc = mmt<4>(TL(T_VCM), TP, 32 * xx, 0, TL(T_MRK), TP, 32 * yy, 0, acc, r, h);
#pragma unroll
                for (int s = 0; s < 2; ++s) *(u32x4*)l3_slot(L3, tg0, 1024 + hd * 64, ((xx * 2 + yy) * 64 + lane) * 32 + 16 * s) = pack8(acc, s);
            } else if (typ == 2) {
                f32x16 acc = mmt<4>(TL(T_AP), TP, 32 * xx, 0, TL(T_BCM), TP, 32 * yy, 0, zero16(), r, h);
                const float pcc = pc[32 * yy + r];
#pragma unroll
                for (int e = 0; e < 16; ++e) acc[e] = (acc[e] + ((32 * xx + crow(e, h) == 32 * yy + r) ? 1.0f : 0.0f)) * pcc;
#pragma unroll
                for (int s = 0; s < 2; ++s) *(u32x4*)(MT + (size_t)unit * 4096 + (((yy * 2 + xx) * 2 + s) * 64 + lane) * 8) = pack8(acc, s);
            } else {
                f32x16 acc = mmt<4>(TL(T_BCM), TP, 32 * xx, 0, TL(T_U0), TP, 32 * yy, 0, zero16(), r, h);
                acc = mmt<4>(TL(T_KCM), TP, 32 * xx, 0, TL(T_VCM), TP, 32 * yy, 0, acc, r, h);
#pragma unroll
                for (int e = 0; e < 16; ++e) acc[e] *= pc[32 * xx + crow(e, h)];
#pragma unroll
                for (int s = 0; s < 2; ++s) *(u32x4*)(SA + (size_t)unit * 4096 + ((yy * 2 + xx) * 64 + lane) * 16 + 8 * s) = pack8(acc, s);
            }
        }
        __syncthreads();
    }
#undef TL
}

struct PbSet { bf16x8 A[8]; u32x4 S[4]; };
__device__ __forceinline__ void pb_load(PbSet& d, const bf16_t* MT, const bf16_t* SA, int c, int lane) {
    const int cc = c < 64 ? c : 63;
    const char* mb = (const char*)MT + (size_t)cc * 8192; const char* sb = (const char*)SA + (size_t)cc * 8192;
    const unsigned lo16 = (unsigned)lane * 16u, lo32 = (unsigned)lane * 32u;
#pragma unroll
    for (int f = 0; f < 8; ++f) d.A[f] = *(const bf16x8*)(mb + lo16 + f * 1024);
#pragma unroll
    for (int q = 0; q < 4; ++q) d.S[q] = *(const u32x4*)(sb + lo32 + (q >> 1) * 2048 + 16 * (q & 1));
}
__device__ __forceinline__ void pb_step(const PbSet& d, f32x16 (&X)[2], bf16_t* SA, int c, int lane, const bool dry) {
    bf16x8 Bf[4];
#pragma unroll
    for (int kt = 0; kt < 2; ++kt)
#pragma unroll
        for (int s = 0; s < 2; ++s) { const u32x4 w = pack8(X[kt], s); Bf[kt * 2 + s] = __builtin_bit_cast(bf16x8, w); if (!dry) *(u32x4*)((char*)SA + (size_t)c * 8192 + (unsigned)lane * 16u + (kt * 2 + s) * 1024) = w; }
    f32x16 D[2];
#pragma unroll
    for (int ip = 0; ip < 2; ++ip) { unpack8(d.S[2 * ip], D[ip], 0); unpack8(d.S[2 * ip + 1], D[ip], 1);
#pragma unroll
        for (int ks = 0; ks < 4; ++ks) D[ip] = __builtin_amdgcn_mfma_f32_32x32x16_bf16(d.A[ip * 4 + ks], Bf[ks], D[ip], 0, 0, 0); }
    X[0] = D[0]; X[1] = D[1];
}
__device__ __forceinline__ void pass_b(Frame& F, int bh, int j, const bool dry) {
    const int lane = F.lane;
    const bf16_t* MT = (const bf16_t*)(F.ws + WS_MT) + (size_t)bh * 64 * 4096; bf16_t* SA = (bf16_t*)(F.ws + WS_SA) + (size_t)bh * 64 * 4096 + j * 2048;
    f32x16 X[2] = {zero16(), zero16()};
    PbSet s0, s1, s2;
    pb_load(s0, MT, SA, 0, lane); pb_load(s1, MT, SA, 1, lane);
    for (int c = 0; c < 63; c += 3) {
        pb_load(s2, MT, SA, c + 2, lane); pb_step(s0, X, SA, c, lane, dry);
        pb_load(s0, MT, SA, c + 3, lane); pb_step(s1, X, SA, c + 1, lane, dry);
        pb_load(s1, MT, SA, c + 4, lane); pb_step(s2, X, SA, c + 2, lane, dry);
    }
    pb_step(s0, X, SA, 63, lane, dry);
}

__device__ __forceinline__ void pass_c(Frame& F) {
    const int lane = F.lane, r = lane & 31, h = lane >> 5;
    const int gw = F.vcu * 8 + F.wave, NGW = F.G * 8;
    const bf16_t* P = (const bf16_t*)(F.ws + WS_P); unsigned char* L3 = F.ws + WS_L3; const bf16_t* SA = (const bf16_t*)(F.ws + WS_SA); const float* BON = (const float*)(F.ws + WS_BON);
    bf16_t* Y = (bf16_t*)(F.ws + WS_YCAT); const float* mix = F.in[I_MIX];
    for (int unit = gw; unit < 4096; unit += NGW) {
        const int b = unit >> 10, hd = (unit >> 6) & 15, ci = unit & 63, tg0 = b * SEQ + ci * 64;
        bf16x8 Af[8], Bf[8];
#pragma unroll
        for (int f = 0; f < 8; ++f) Af[f] = *(const bf16x8*)(SA + (size_t)unit * 4096 + (f * 64 + lane) * 8);
#pragma unroll
        for (int f = 0; f < 8; ++f) Bf[f] = *(const bf16x8*)l3_slot(L3, tg0, hd * 64, (f * 64 + lane) * 16);
        f32x16 acc[2][2];
#pragma unroll
        for (int j = 0; j < 2; ++j)
#pragma unroll
            for (int tt = 0; tt < 2; ++tt) {
#pragma unroll
                for (int s = 0; s < 2; ++s) unpack8(*(const u32x4*)l3_slot(L3, tg0, 1024 + hd * 64, ((j * 2 + tt) * 64 + lane) * 32 + 16 * s), acc[j][tt], s);
#pragma unroll
                for (int ks = 0; ks < 4; ++ks) acc[j][tt] = __builtin_amdgcn_mfma_f32_32x32x16_bf16(Af[j * 4 + ks], Bf[ks * 2 + tt], acc[j][tt], 0, 0, 0);
            }
#pragma unroll
        for (int tt = 0; tt < 2; ++tt) {
            const int tl = 32 * tt + r, tg = tg0 + tl;
            float sm = 0.f;
#pragma unroll
            for (int e = 0; e < 16; ++e) sm += acc[0][tt][e] + acc[1][tt][e];
            sm += __shfl_xor(sm, 32); const float mean = sm * (1.0f / 64.0f);
            float sq = 0.f;
#pragma unroll
            for (int e = 0; e < 16; ++e) { const float d0 = acc[0][tt][e] - mean, d1 = acc[1][tt][e] - mean; sq += d0 * d0 + d1 * d1; }
            sq += __shfl_xor(sq, 32); const float rstd = rsqrtf(sq * (1.0f / 64.0f) + GN_EPS);
            const float bon = BON[(size_t)tg * 16 + hd];
            const bool hp = (ci > 0) || (tl > 0);
            const bf16_t* prow = P + (size_t)tg * NP + PVR + hd * 64; const bf16_t* lrow = (const bf16_t*)L3 + (size_t)tg * NL + 2048 + hd * 64; bf16_t* yrow = Y + (size_t)tg * DM + 1024 + hd * 64;
#pragma unroll
            for (int j = 0; j < 2; ++j)
#pragma unroll
                for (int g = 0; g < 4; ++g) { const int v0 = 32 * j + 8 * g + 4 * h, ch = hd * 64 + v0;
                    const u32x2 cv = *(const u32x2*)(prow + v0); u32x2 pv = (u32x2){0u, 0u}; if (hp) pv = *(const u32x2*)(prow - NP + v0);
                    const u32x2 gg = *(const u32x2*)(lrow + v0);
                    const f32x4 mu = *(const f32x4*)(mix + 2112 + ch), lw = *(const f32x4*)(F.in[I_LNW] + ch), lb = *(const f32x4*)(F.in[I_LNB] + ch);
                    const float c0 = bflo(cv.x), c1 = bfhi(cv.x), c2 = bflo(cv.y), c3 = bfhi(cv.y);
                    const float v_0 = c0 + (bflo(pv.x) - c0) * mu.x, v_1 = c1 + (bfhi(pv.x) - c1) * mu.y, v_2 = c2 + (bflo(pv.y) - c2) * mu.z, v_3 = c3 + (bfhi(pv.y) - c3) * mu.w;
                    const float o0 = ((acc[j][tt][4 * g] - mean) * rstd * lw.x + lb.x + bon * v_0) * bflo(gg.x);
                    const float o1 = ((acc[j][tt][4 * g + 1] - mean) * rstd * lw.y + lb.y + bon * v_1) * bfhi(gg.x);
                    const float o2 = ((acc[j][tt][4 * g + 2] - mean) * rstd * lw.z + lb.z + bon * v_2) * bflo(gg.y);
                    const float o3 = ((acc[j][tt][4 * g + 3] - mean) * rstd * lw.w + lb.w + bon * v_3) * bfhi(gg.y);
                    *(u32x2*)(yrow + v0) = (u32x2){pk2(o0, o1), pk2(o2, o3)}; }
        }
    }
}
}


namespace att {
using s16x4 = __attribute__((ext_vector_type(4))) short;
constexpr int D = 128, NW = 8, QBLK = 32, KVBLK = 64;
constexpr float THRL = 8.0f * 1.4426950408889634f;
constexpr size_t SHM_V = KVBLK * D * 2, SHM_K = KVBLK * D * 2, SHM_ATTN = 2 * SHM_V + 2 * SHM_K + NW * 64 * 4;
static_assert(SHM_ATTN <= RING_BYTES, "attention LDS");
#define KSWZ(row, colB) ((row) * 256 + ((colB) ^ (((row) & 7) << 4)))
#define SBAR() __builtin_amdgcn_sched_barrier(0)
__device__ __forceinline__ int crow(int r, int hi) { return (r & 3) + 8 * (r >> 2) + 4 * hi; }
__device__ __forceinline__ unsigned cvtpk(float lo, float hi) { unsigned r; asm volatile("v_cvt_pk_bf16_f32 %0, %1, %2" : "=v"(r) : "v"(lo), "v"(hi)); return r; }
__device__ __forceinline__ void partialSM(f32x16& p0, f32x16& p1, const u32x2 mk, float& m_reg, float& mn, float& alpha) {
#pragma unroll
  for (int r = 0; r < 16; ++r) { const unsigned bit = 1u << ((r & 3) + 8 * (r >> 2)); p0[r] = (mk.x & bit) ? p0[r] : -INFINITY; p1[r] = (mk.y & bit) ? p1[r] : -INFINITY; }
  float pmax = p0[0];
#pragma unroll
  for (int r = 1; r < 16; ++r) pmax = fmaxf(pmax, p0[r]);
#pragma unroll
  for (int r = 0; r < 16; ++r) pmax = fmaxf(pmax, p1[r]);
  { auto rr = __builtin_amdgcn_permlane32_swap(__float_as_uint(pmax), __float_as_uint(pmax), false, false);
    pmax = fmaxf(__uint_as_float(rr[0]), __uint_as_float(rr[1])); }
  if (__builtin_expect(__all(pmax - m_reg <= THRL), 1)) { mn = m_reg; alpha = 1.f; }
  else { mn = fmaxf(m_reg, pmax); alpha = __builtin_amdgcn_exp2f(m_reg - mn); m_reg = mn; }
#pragma unroll
  for (int r = 0; r < 16; ++r) { p0[r] = __builtin_amdgcn_exp2f(p0[r] - mn); p1[r] = p1[r] - mn; }
}
__device__ __forceinline__ void finishSM(f32x16& p0, f32x16& p1, float alpha, float& l_reg, bf16x8& pa0, bf16x8& pa1, bf16x8& pa2, bf16x8& pa3) {
#pragma unroll
  for (int r = 0; r < 16; ++r) p1[r] = __builtin_amdgcn_exp2f(p1[r]);
  float ps = 0;
#pragma unroll
  for (int r = 0; r < 16; ++r) ps += p0[r];
#pragma unroll
  for (int r = 0; r < 16; ++r) ps += p1[r];
  { auto rr = __builtin_amdgcn_permlane32_swap(__float_as_uint(ps), __float_as_uint(ps), false, false);
    ps = __uint_as_float(rr[0]) + __uint_as_float(rr[1]); }
  l_reg = l_reg * alpha + ps;
#define PK4(P, BASE, OUT) do { unsigned a0 = cvtpk(P[BASE + 0], P[BASE + 1]), a1 = cvtpk(P[BASE + 2], P[BASE + 3]);   \
    unsigned b0 = cvtpk(P[BASE + 4], P[BASE + 5]), b1 = cvtpk(P[BASE + 6], P[BASE + 7]);                              \
    auto r0 = __builtin_amdgcn_permlane32_swap(a0, b0, false, false); auto r1 = __builtin_amdgcn_permlane32_swap(a1, b1, false, false); \
    u32x4 w = {r0[0], r1[0], r0[1], r1[1]}; OUT = __builtin_bit_cast(bf16x8, w); } while (0)
  PK4(p0, 0, pa0); PK4(p0, 8, pa1); PK4(p1, 0, pa2); PK4(p1, 8, pa3);
#undef PK4
}
__device__ __forceinline__ void qkt(f32x16& p0, f32x16& p1, const char* Ks, const bf16x8* qr, int r32, int hi) {
  p0 = f32x16{}; p1 = f32x16{};
#pragma unroll
  for (int d0 = 0; d0 < 8; ++d0) { int cb = (d0 * 16 + hi * 8) * 2;
    bf16x8 b0 = *reinterpret_cast<const bf16x8*>(Ks + KSWZ(r32, cb));
    bf16x8 b1 = *reinterpret_cast<const bf16x8*>(Ks + KSWZ(32 + r32, cb));
    p0 = __builtin_amdgcn_mfma_f32_32x32x16_bf16(b0, qr[d0], p0, 0, 0, 0);
    p1 = __builtin_amdgcn_mfma_f32_32x32x16_bf16(b1, qr[d0], p1, 0, 0, 0); }
}
__device__ __forceinline__ int v_st(int k, int c) { const int kk = (k & ~0xC) | ((k & 4) << 1) | ((k & 8) >> 1); return ((kk >> 3) * 4 + (c >> 5)) * 512 + ((kk & 7) * 32 + (c & 31)) * 2; }
__device__ __forceinline__ int v_rd_base(int lane) { return ((lane & 3) << 3) | (((lane >> 2) & 3) << 6) | (((lane >> 4) & 1) << 5) | (((lane >> 5) & 1) << 8); }
constexpr int v_rd_off(int d0, int ks, int half) { return d0 * 512 + ks * 4096 + half * 2048; }
template <int OFF> __device__ __forceinline__ s16x4 tr_read(int vb) { s16x4 r; asm volatile("ds_read_b64_tr_b16 %0, %1 offset:%2" : "=&v"(r) : "v"(vb), "i"(OFF) : "memory"); return r; }
template <int D0> __device__ __forceinline__ void pv_one(f32x16& od, int vb, bf16x8 pa0, bf16x8 pa1, bf16x8 pa2, bf16x8 pa3) {
  const s16x4 l0 = tr_read<v_rd_off(D0, 0, 0)>(vb), h0 = tr_read<v_rd_off(D0, 0, 1)>(vb), l1 = tr_read<v_rd_off(D0, 1, 0)>(vb), h1 = tr_read<v_rd_off(D0, 1, 1)>(vb);
  const s16x4 l2 = tr_read<v_rd_off(D0, 2, 0)>(vb), h2 = tr_read<v_rd_off(D0, 2, 1)>(vb), l3 = tr_read<v_rd_off(D0, 3, 0)>(vb), h3 = tr_read<v_rd_off(D0, 3, 1)>(vb);
  asm volatile("s_waitcnt lgkmcnt(0)" ::: "memory"); SBAR();
#define PK(L, H) (bf16x8){L[0], L[1], L[2], L[3], H[0], H[1], H[2], H[3]}
  od = __builtin_amdgcn_mfma_f32_32x32x16_bf16(pa0, PK(l0, h0), od, 0, 0, 0);
  od = __builtin_amdgcn_mfma_f32_32x32x16_bf16(pa1, PK(l1, h1), od, 0, 0, 0);
  od = __builtin_amdgcn_mfma_f32_32x32x16_bf16(pa2, PK(l2, h2), od, 0, 0, 0);
  od = __builtin_amdgcn_mfma_f32_32x32x16_bf16(pa3, PK(l3, h3), od, 0, 0, 0);
#undef PK
}
__device__ __forceinline__ void pv_d0(f32x16* o, int vb, bf16x8 pa0, bf16x8 pa1, bf16x8 pa2, bf16x8 pa3) {
  pv_one<0>(o[0], vb, pa0, pa1, pa2, pa3); pv_one<1>(o[1], vb, pa0, pa1, pa2, pa3); pv_one<2>(o[2], vb, pa0, pa1, pa2, pa3); pv_one<3>(o[3], vb, pa0, pa1, pa2, pa3);
}
__device__ __forceinline__ void attn_unit(const bf16_t* __restrict__ Qb, const bf16_t* __restrict__ Kh, const bf16_t* __restrict__ Vh, const unsigned* __restrict__ Mb,
                                          bf16_t* __restrict__ Ob, int seq, char* lds) {
  constexpr int LDQ = NP, LDK = NP, LDO = DM;
  int tid_ = threadIdx.x; asm volatile("" : "+v"(tid_));
  const int tid = tid_, wid = tid >> 6, lane = tid & 63, r32 = lane & 31, hi = lane >> 5;
  char* V_lds = lds; char* K_lds = lds + 2 * SHM_V;
  float* wsf = (float*)(lds + 2 * SHM_V + 2 * SHM_K) + wid * 64; float* li_l = wsf; float* al_l = wsf + 32;
  float m_reg = -1e30f, l_reg = 0; f32x16 o[4] = {}; bf16x8 qr[8];
  const bf16_t* Qw = Qb + (long)(wid * QBLK + r32) * LDQ + hi * 8;
#pragma unroll
  for (int d0 = 0; d0 < 8; ++d0) qr[d0] = *reinterpret_cast<const bf16x8*>(Qw + d0 * 16);
  const unsigned* Mw = Mb + (long)(wid * QBLK + r32) * 128;
  const int sh = 4 * hi;
  const int sr = tid >> 4, sc = (tid & 15) * 8, vst0 = v_st(sr, sc), vst1 = v_st(32 + sr, sc);
  const int vb0 = (int)(uintptr_t)V_lds + v_rd_base(lane);
  struct { bf16x8 vs0, vs1, ks0, ks1; } sr_[2];
#define SLOAD(i, k0) do { sr_[i].vs0 = *(const bf16x8*)(&Vh[(long)((k0) + sr) * LDK + sc]); sr_[i].vs1 = *(const bf16x8*)(&Vh[(long)((k0) + 32 + sr) * LDK + sc]); \
    sr_[i].ks0 = *(const bf16x8*)(&Kh[(long)((k0) + sr) * LDK + sc]); sr_[i].ks1 = *(const bf16x8*)(&Kh[(long)((k0) + 32 + sr) * LDK + sc]); } while (0)
#define SWRITE(b, i) do { *(bf16x8*)(V_lds + (b) * SHM_V + vst0) = sr_[i].vs0;          \
    *(bf16x8*)(V_lds + (b) * SHM_V + vst1) = sr_[i].vs1; int kc = sc * 2;               \
    *(bf16x8*)(K_lds + (b) * SHM_K + KSWZ(sr, kc)) = sr_[i].ks0;                       \
    *(bf16x8*)(K_lds + (b) * SHM_K + KSWZ(32 + sr, kc)) = sr_[i].ks1; } while (0)
#define SWAIT() asm volatile("s_waitcnt vmcnt(4)" ::: "memory")
#define RESC(a) do { if (__any((a) < 1.f)) { if (hi == 0) al_l[r32] = (a); asm volatile("s_waitcnt lgkmcnt(0)" ::: "memory"); \
    _Pragma("unroll") for (int d = 0; d < 4; ++d) _Pragma("unroll") for (int r = 0; r < 16; ++r) o[d][r] *= al_l[crow(r, hi)]; } } while (0)
#define MLOAD(j) ({ u32x2 _m = *(const u32x2*)(Mw + 2 * (j)); _m.x >>= sh; _m.y >>= sh; _m; })
  f32x16 pA0, pA1, pB0, pB1; float mnA, mnB, alA, alB; bf16x8 pa0, pa1, pa2, pa3; const int NT = seq / KVBLK;
  constexpr int SE = 0, SO = 1;
  u32x2 mkA = MLOAD(0), mkB = MLOAD(1);
  SLOAD(SE, 0); asm volatile("s_waitcnt vmcnt(0)" ::: "memory"); SWRITE(0, SE); __syncthreads();
  qkt(pA0, pA1, K_lds, qr, r32, hi); partialSM(pA0, pA1, mkA, m_reg, mnA, alA);
  SLOAD(SO, KVBLK); if (2 < NT) SLOAD(SE, 2 * KVBLK);
  SWAIT(); SWRITE(1, SO); __syncthreads();
  for (int j = 1; j + 1 < NT; j += 2) {
    mkA = MLOAD(j + 1);
    SBAR(); qkt(pB0, pB1, K_lds + SHM_K, qr, r32, hi);
    finishSM(pA0, pA1, alA, l_reg, pa0, pa1, pa2, pa3); SBAR();
    SLOAD(SO, (j + 2) * KVBLK); SBAR();
    pv_d0(o, vb0, pa0, pa1, pa2, pa3); partialSM(pB0, pB1, mkB, m_reg, mnB, alB);
    __syncthreads(); SWAIT(); SWRITE(0, SE);
    RESC(alB); __syncthreads();
    mkB = MLOAD(j + 2);
    SBAR(); qkt(pA0, pA1, K_lds, qr, r32, hi);
    finishSM(pB0, pB1, alB, l_reg, pa0, pa1, pa2, pa3); SBAR();
    if (j + 3 < NT) SLOAD(SE, (j + 3) * KVBLK); SBAR();
    pv_d0(o, vb0 + (int)SHM_V, pa0, pa1, pa2, pa3); partialSM(pA0, pA1, mkA, m_reg, mnA, alA);
    __syncthreads(); SWAIT(); SWRITE(1, SO);
    RESC(alA); __syncthreads();
  }
  SBAR(); qkt(pB0, pB1, K_lds + SHM_K, qr, r32, hi);
  finishSM(pA0, pA1, alA, l_reg, pa0, pa1, pa2, pa3); SBAR();
  pv_d0(o, vb0, pa0, pa1, pa2, pa3); partialSM(pB0, pB1, mkB, m_reg, mnB, alB);
  __syncthreads(); RESC(alB);
  finishSM(pB0, pB1, alB, l_reg, pa0, pa1, pa2, pa3); SBAR();
  pv_d0(o, vb0 + (int)SHM_V, pa0, pa1, pa2, pa3);
  if (hi == 0) li_l[r32] = l_reg; asm volatile("s_waitcnt lgkmcnt(0)" ::: "memory");
  float rli[16];
#pragma unroll
  for (int r = 0; r < 16; ++r) rli[r] = __builtin_amdgcn_rcpf(li_l[crow(r, hi)]);
  bf16_t* Ow = Ob + (long)(wid * QBLK) * LDO;
#pragma unroll
  for (int r = 0; r < 16; ++r) { int orow = crow(r, hi);
#pragma unroll
    for (int d0 = 0; d0 < 4; ++d0) Ow[(long)orow * LDO + d0 * 32 + r32] = (bf16_t)f2bf(o[d0][r] * rli[r]); }
  __syncthreads();
#undef SLOAD
#undef SWRITE
#undef SWAIT
#undef RESC
#undef MLOAD
}
__device__ __forceinline__ void attn_phase(Frame& F) {
  const bf16_t* P = (const bf16_t*)(F.ws + WS_P); const unsigned* MSK = (const unsigned*)(F.ws + WS_MSK); bf16_t* Y = (bf16_t*)(F.ws + WS_YCAT);
  for (int u = F.vcu; u < 512; u += F.G) {
    const int pairi = u & 255, second = u >> 8; const int bh = pairi >> 3, ql = pairi & 7; const int qb = second ? ql : 15 - ql;
    const int b = bh >> 3, hd = bh & 7; const long t0 = (long)b * SEQ + qb * 256;
    attn_unit(P + t0 * NP + PQ + hd * 128, P + (long)b * SEQ * NP + PK + hd * 128, P + (long)b * SEQ * NP + PV + hd * 128, MSK + t0 * 128, Y + t0 * DM + hd * 128, (qb + 1) * 256, (char*)F.ldsg);
  }
}
#undef KSWZ
#undef SBAR
}

__device__ __forceinline__ void phase_idx_passb(Frame& F, const bool dry, const int qw) {
    const int npb = (F.G >= 64) ? 16 : 0;
    if (npb) { if (F.vcu < npb) { const int ch = F.vcu * 8 + F.wave; rw::pass_b(F, ch >> 1, ch & 1, dry); return; } }
    else { for (int ch = F.vcu * 8 + F.wave; ch < 128; ch += F.G * 8) rw::pass_b(F, ch >> 1, ch & 1, dry); __syncthreads(); }
    volatile LAS int* qs = (volatile LAS int*)(F.lds + MISC_OFF + 64);
    for (;;) {
        if (F.tid == 0) qs[0] = (int)atomicAdd(F.ctl + CW_QIDX + 64 * qw, 1u);
        __syncthreads();
        const int u = qs[0];
        __syncthreads();
        if (u >= 1024) break;
        idx_unit(F, u);
    }
}

struct RouteRec { int cls, pos; float g_lo, g_hi, rstd; int pad0, pad1, pad2; };
__device__ __forceinline__ void phase7(Frame& F, const bool dry) {
    const int gw = F.vcu * 8 + F.wave, NGW = F.G * 8, lane = F.lane;
    { int* rowtok = (int*)(F.ws + WS_ROWTOK); for (int i = gw * 64 + lane; i < MPAD; i += NGW * 64) rowtok[i] = -1; }
    { LAS float* scr = (LAS float*)(F.lds + F.wave * 16384);
      bf16_t* WGU = (bf16_t*)(F.ws + WS_WGU); bf16_t* WDN = (bf16_t*)(F.ws + WS_WDN);
      constexpr int IG = (DM / 64) * (512 / 32), ID = (512 / 64) * (DM / 32);
      for (int it = gw; it < 16 * (2 * IG + ID); it += NGW) { const int e = it / (2 * IG + ID); int r = it % (2 * IG + ID);
          if (r < IG) transpose_item<2>(F.in[I_WEG] + (size_t)e * DM * 512, 512, WGU + (size_t)e * 1024 * DM, DM, scr, r / 16, r % 16, lane);
          else if (r < 2 * IG) { r -= IG; transpose_item<3>(F.in[I_WEU] + (size_t)e * DM * 512, 512, WGU + (size_t)e * 1024 * DM, DM, scr, r / 16, r % 16, lane); }
          else { r -= 2 * IG; transpose_item<0>(F.in[I_WED] + (size_t)e * 512 * DM, DM, WDN + (size_t)e * DM * 512, 512, scr, r / 64, r % 64, lane); } } }
    const float* x1 = F.out; const f32x4* wrt = (const f32x4*)(F.ws + WS_WRT);
    RouteRec* rr = (RouteRec*)(F.ws + WS_ROUTE); unsigned* cnt = F.ctl + CW_CNT;
    float brg[4], bre[16];
#pragma unroll
    for (int o = 0; o < 4; ++o) brg[o] = F.in[I_BRG][o];
#pragma unroll
    for (int o = 0; o < 16; ++o) bre[o] = F.in[I_BRE][o];
    for (int tp = gw; tp < T / 2; tp += NGW) {
        float ssq[2] = {0.f, 0.f};
        float lg[2][20];
#pragma unroll
        for (int o = 0; o < 20; ++o) { lg[0][o] = 0.f; lg[1][o] = 0.f; }
        const f32x4* xr0 = (const f32x4*)(x1 + (size_t)(2 * tp) * DM) + lane; const f32x4* xr1 = xr0 + DM / 4;
#pragma unroll 2
        for (int j = 0; j < 8; ++j) {
            const f32x4 v0 = xr0[64 * j], v1 = xr1[64 * j];
            ssq[0] += (v0.x * v0.x + v0.y * v0.y) + (v0.z * v0.z + v0.w * v0.w); ssq[1] += (v1.x * v1.x + v1.y * v1.y) + (v1.z * v1.z + v1.w * v1.w);
#pragma unroll
            for (int o = 0; o < 20; ++o) { const f32x4 w = wrt[o * (DM / 4) + 64 * j + lane];
                lg[0][o] += (v0.x * w.x + v0.y * w.y) + (v0.z * w.z + v0.w * w.w);
                lg[1][o] += (v1.x * w.x + v1.y * w.y) + (v1.z * w.z + v1.w * w.w); }
        }
#pragma unroll
        for (int u = 0; u < 2; ++u) {
            const int t = 2 * tp + u;
            const float rstd = rsqrtf(wave_sum(ssq[u]) * (1.f / DM) + NORM_EPS);
#pragma unroll
            for (int o = 0; o < 20; ++o) lg[u][o] = wave_sum(lg[u][o]) * rstd;
            float gl[4]; float gm = -INFINITY;
#pragma unroll
            for (int o = 0; o < 4; ++o) { gl[o] = lg[u][o] + brg[o]; gm = fmaxf(gm, gl[o]); }
            float gs = 0.f; int gsel = 0; float gbest = -INFINITY;
#pragma unroll
            for (int o = 0; o < 4; ++o) { gs += __expf(gl[o] - gm); if (gl[o] > gbest) { gbest = gl[o]; gsel = o; } }
            const float pgrp = __expf(gbest - gm) / gs;
            float el[4]; float em = -INFINITY;
#pragma unroll
            for (int q = 0; q < 4; ++q) { float vsel = 0.f;
#pragma unroll
                for (int g2 = 0; g2 < 4; ++g2) vsel = (gsel == g2) ? lg[u][4 + 4 * g2 + q] + bre[4 * g2 + q] : vsel;
                el[q] = vsel; em = fmaxf(em, vsel); }
            int i1 = 0; float b1 = -INFINITY;
#pragma unroll
            for (int q = 0; q < 4; ++q) if (el[q] > b1) { b1 = el[q]; i1 = q; }
            int i2 = 0; float b2 = -INFINITY;
#pragma unroll
            for (int q = 0; q < 4; ++q) if (q != i1 && el[q] > b2) { b2 = el[q]; i2 = q; }
            const float p1 = __expf(b1 - em), p2 = __expf(b2 - em); const float inv = 1.0f / (p1 + p2);
            const float gw1 = pgrp * p1 * inv, gw2 = pgrp * p2 * inv;
            const int elo = i1 < i2 ? i1 : i2, ehi = i1 < i2 ? i2 : i1; const float glo = i1 < i2 ? gw1 : gw2, ghi = i1 < i2 ? gw2 : gw1;
            const int pair = (elo == 0) ? (ehi - 1) : (elo == 1 ? ehi + 1 : 5);
            const int cls = gsel * 6 + pair;
            if (lane == 0 && !dry) { const unsigned pos = atomicAdd(&cnt[cls], 1u); RouteRec r; r.cls = cls; r.pos = (int)pos; r.g_lo = glo; r.g_hi = ghi; r.rstd = rstd; r.pad0 = r.pad1 = r.pad2 = 0; rr[t] = r; }
        }
    }
}

__device__ __forceinline__ void class_bases(Frame& F, volatile LAS int* tb) {
    if (F.tid == 0) { int acc = 0; for (int c = 0; c < NCLS; ++c) { tb[c] = acc; const int n = (int)__hip_atomic_load(F.ctl + CW_CNT + c, __ATOMIC_RELAXED, __HIP_MEMORY_SCOPE_AGENT); acc += (n + 255) & ~255; } tb[NCLS] = acc; }
    __syncthreads();
}

__device__ __forceinline__ void phase8(Frame& F) {
    const int gw = F.vcu * 8 + F.wave, NGW = F.G * 8, lane = F.lane;
    volatile LAS int* tb = (volatile LAS int*)(F.lds + MISC_OFF + 128);
    class_bases(F, tb);
    const float* x1 = F.out; const float* gf = F.in[I_GFFN];
    const RouteRec* rr = (const RouteRec*)(F.ws + WS_ROUTE); int* rowtok = (int*)(F.ws + WS_ROWTOK); float* gates = (float*)(F.ws + WS_ROWTOK + 128 * 1024);
    bf16_t* H2S = (bf16_t*)(F.ws + WS_H2S);
    f32x4 gv[8];
#pragma unroll
    for (int j = 0; j < 8; ++j) gv[j] = ((const f32x4*)gf)[64 * j + lane];
    for (int t = gw; t < T; t += NGW) {
        const RouteRec r = rr[t]; const int row = tb[r.cls] + r.pos;
        const f32x4* xr = (const f32x4*)(x1 + (size_t)t * DM) + lane; u32x2* o = (u32x2*)(H2S + (size_t)row * DM) + lane;
#pragma unroll
        for (int j = 0; j < 8; ++j) { const f32x4 v = xr[64 * j]; u32x2 w; w.x = pk2(v.x * r.rstd * gv[j].x, v.y * r.rstd * gv[j].y); w.y = pk2(v.z * r.rstd * gv[j].z, v.w * r.rstd * gv[j].w); o[64 * j] = w; }
        if (lane == 0) { rowtok[row] = t; gates[2 * row] = r.g_lo; gates[2 * row + 1] = r.g_hi; }
    }
    for (int idx = gw; idx < NCLS * 256; idx += NGW) { const int c = idx >> 8, off = idx & 255; const int n = (int)__hip_atomic_load(F.ctl + CW_CNT + c, __ATOMIC_RELAXED, __HIP_MEMORY_SCOPE_AGENT);
        const int row = tb[c] + n + off;
        if (row < tb[c + 1]) { u32x2* o = (u32x2*)(H2S + (size_t)row * DM) + lane;
#pragma unroll
            for (int j = 0; j < 8; ++j) o[64 * j] = (u32x2){0u, 0u};
            if (lane == 0) { gates[2 * row] = 0.f; gates[2 * row + 1] = 0.f; } } }
}

__device__ __forceinline__ int class_of_tile(volatile LAS int* tb, int rt) { int c = 0; const int r0 = rt * 256; for (int k = 1; k < NCLS; ++k) c = (r0 >= tb[k]) ? k : c; return c; }
__device__ __forceinline__ int class_expert(int cls, int half) { const int g = cls / 6, p = cls % 6; const int elo = p < 3 ? 0 : (p < 5 ? 1 : 2); const int ehi = p < 3 ? p + 1 : (p < 5 ? p - 1 : 3); return 4 * g + (half ? ehi : elo); }
struct Moe1Sched {
    volatile LAS int* tb; const char* A; const char* B; int G, c, nu;
    __device__ bool seg(int i, pg8::Seg& s) const { const int L = i * G + c; if (L >= nu) return false; const int rt = L >> 3, pn = L & 7; const int cls = class_of_tile(tb, rt); const int e = class_expert(cls, pn >> 2);
        s.A = A + (size_t)rt * 256 * DM * 2; s.B = B + ((size_t)e * 1024 + (pn & 3) * 256) * DM * 2; s.u.pm = rt; s.u.pn = pn; s.u.aux = 0; s.last = 1; return true; }
};
struct Moe2Sched {
    volatile LAS int* tb; const char* A; const char* B; int G, c, nu;
    __device__ bool seg(int i, pg8::Seg& s) const { const int ui = i >> 1, half = i & 1; const int L = ui * G + c; if (L >= nu) return false; const int rt = L >> 3, pn = L & 7; const int cls = class_of_tile(tb, rt); const int e = class_expert(cls, half);
        s.A = A + ((size_t)rt * 256 * 1024 + half * 512) * 2; s.B = B + ((size_t)e * DM + pn * 256) * 512 * 2; s.u.pm = rt; s.u.pn = pn; s.u.aux = 0; s.last = half; return true; }
};

constexpr int NPHASE = 12;
__global__ void __launch_bounds__(512, 2) fwd_kernel(Args args) {
    extern __shared__ __attribute__((aligned(16))) unsigned char lds_raw[];
    Frame F;
    F.lds = (LAS unsigned char*)lds_raw; F.ldsg = lds_raw;
    F.tid = threadIdx.x; F.lane = F.tid & 63; F.wave = __builtin_amdgcn_readfirstlane(F.tid >> 6);
    F.G = gridDim.x; { const int bx = blockIdx.x; F.vcu = (F.G % 8 == 0) ? (bx % 8) * (F.G / 8) + bx / 8 : bx; }
    F.in = args.in; F.out = args.out; F.ws = args.ws; F.ctl = (unsigned*)(args.ws + WS_CTL);
    volatile LAS unsigned* MISC = (volatile LAS unsigned*)(F.lds + MISC_OFF);
    for (int u = F.tid; u < (LDS_BYTES - LDSCTL_OFF) / 4; u += 512) ((LAS unsigned*)(F.lds + LDSCTL_OFF))[u] = 0u;
    __syncthreads();
    const int lo = args.ph_lo, hi = args.ph_hi;
    const bool DRY_T = (args.ph_hi != 999), DRY_F = (args.ph_hi == 999);
    const bool multi = (hi - lo) > 1;
    XcdBarrier bar; bar.bar = F.ctl + CW_BAR; bar.x = 0; bar.st = nullptr;
    if (multi) bar = xcd_barrier_post(F.ctl + CW_BAR, MISC + 8);
#ifndef PH_MASK
#define PH_MASK 0xfff
#endif
#define IN(k) (((PH_MASK >> (k)) & 1) && lo <= (k) && (k) < hi)
#define SEAM(k) do { if (IN(k) && IN((k) + 1)) xcd_barrier(bar); } while (0)
#ifndef DUP_MASK
#define DUP_MASK 0
#endif
    unsigned char* ws = args.ws;
    bf16_t* P = (bf16_t*)(ws + WS_P);

    if (IN(0)) { phase0(F); SEAM(0); }
    if (IN(1)) {
        pg8::PlainSched S; S.init((const bf16_t*)(ws + WS_HN), (const bf16_t*)(ws + WS_WIN), T, NP, DM, DM, F.G, (int)blockIdx.x);
        pg8::EpiBf16 E{P, NP};
        pg8::gemm_phase<pg8::EpiBf16, pg8::PlainSched, true>(F.lds, DM, DM, DM / 64, S, E);
        SEAM(1);
    }
    if (IN(2)) { if ((DUP_MASK >> 2) & 1) { phase2(F, DRY_T); if (multi) xcd_barrier(bar); } phase2(F, DRY_F); SEAM(2); }
    if (IN(3)) {
        pg8::PlainSched S; S.init((const bf16_t*)(ws + WS_ALORA), (const bf16_t*)(ws + WS_WLORA), T, NL, KL, KL, F.G, (int)blockIdx.x);
        pg8::EpiLora E{(bf16_t*)(ws + WS_L3), F.in[I_W0], F.in[I_A0]};
        if ((DUP_MASK >> 3) & 1) { pg8::gemm_phase<pg8::EpiLora, pg8::PlainSched, true>(F.lds, KL, KL, KL / 64, S, E); if (multi) xcd_barrier(bar); }
        pg8::gemm_phase<pg8::EpiLora, pg8::PlainSched, true>(F.lds, KL, KL, KL / 64, S, E);
        SEAM(3);
    }
    if (IN(4)) { rw::pass_a(F); SEAM(4); }
    if (IN(5)) { if ((DUP_MASK >> 5) & 1) { phase_idx_passb(F, DRY_T, 1); if (multi) xcd_barrier(bar); } phase_idx_passb(F, DRY_F, 0); SEAM(5); }
    if (IN(6)) { att::attn_phase(F); rw::pass_c(F); SEAM(6); }
    if (IN(7)) {
        pg8::PlainSched S; S.init((const bf16_t*)(ws + WS_YCAT), (const bf16_t*)(ws + WS_WOUT), T, DM, DM, DM, F.G, (int)blockIdx.x);
        pg8::EpiResF32 E{F.in[I_X], F.out, DM};
        pg8::gemm_phase<pg8::EpiResF32, pg8::PlainSched, true>(F.lds, DM, DM, DM / 64, S, E);
        SEAM(7);
    }
    if (IN(8)) { if ((DUP_MASK >> 8) & 1) { phase7(F, DRY_T); if (multi) xcd_barrier(bar); } phase7(F, DRY_F); SEAM(8); }
    if (IN(9)) { if ((DUP_MASK >> 9) & 1) { phase8(F); if (multi) xcd_barrier(bar); } phase8(F); SEAM(9); }
    if (IN(10)) {
        volatile LAS int* tb = (volatile LAS int*)(F.lds + MISC_OFF + 128);
        class_bases(F, tb);
        Moe1Sched S; S.tb = tb; S.A = (const char*)(ws + WS_H2S); S.B = (const char*)(ws + WS_WGU); S.G = F.G; S.c = (int)blockIdx.x; S.nu = (tb[NCLS] >> 8) * 8;
        pg8::EpiMoe1 E{(bf16_t*)(ws + WS_HS), (const float*)(ws + WS_ROWTOK + 128 * 1024)};
        pg8::gemm_phase<pg8::EpiMoe1, Moe1Sched, true>(F.lds, DM, DM, DM / 64, S, E);
        SEAM(10);
    }
    if (IN(11)) {
        volatile LAS int* tb = (volatile LAS int*)(F.lds + MISC_OFF + 128);
        class_bases(F, tb);
        Moe2Sched S; S.tb = tb; S.A = (const char*)(ws + WS_HS); S.B = (const char*)(ws + WS_WDN); S.G = F.G; S.c = (int)blockIdx.x; S.nu = (tb[NCLS] >> 8) * 8;
        if ((DUP_MASK >> 11) & 1) { pg8::EpiMoe2 E0{F.out, (const int*)(ws + WS_ROWTOK), DRY_T ? 1 : 0}; pg8::gemm_phase<pg8::EpiMoe2, Moe2Sched, true>(F.lds, 1024, 512, 512 / 64, S, E0); if (multi) xcd_barrier(bar); }
        pg8::EpiMoe2 E{F.out, (const int*)(ws + WS_ROWTOK), DRY_F ? 1 : 0};
        pg8::gemm_phase<pg8::EpiMoe2, Moe2Sched, true>(F.lds, 1024, 512, 512 / 64, S, E);
    }
#undef IN
#undef SEAM
}

extern "C" void kernel_launch(void* const* d_in, const int* in_sizes, int n_in, void* d_out, int out_size, void* d_ws, size_t ws_size, hipStream_t stream) {
    static int grid = 0;
    if (grid == 0) {
        if (n_in != 25 || in_sizes[0] != T * DM || out_size != T * DM || ws_size < WS_END) { fprintf(stderr, "kernel_launch: unexpected shapes (n_in %d, in0 %d, out %d, ws %zu)\n", n_in, n_in > 0 ? in_sizes[0] : -1, out_size, ws_size); grid = -1; return; }
        int dev = 0, cus = 0, per_cu = 0;
        if (hipGetDevice(&dev) != hipSuccess || hipDeviceGetAttribute(&cus, hipDeviceAttributeMultiprocessorCount, dev) != hipSuccess) { grid = -1; return; }
        if (hipFuncSetAttribute((const void*)fwd_kernel, hipFuncAttributeMaxDynamicSharedMemorySize, LDS_BYTES) != hipSuccess) { fprintf(stderr, "kernel_launch: hipFuncSetAttribute failed\n"); grid = -1; return; }
        if (hipOccupancyMaxActiveBlocksPerMultiprocessor(&per_cu, (const void*)fwd_kernel, 512, LDS_BYTES) != hipSuccess || per_cu < 1) { fprintf(stderr, "kernel_launch: occupancy query says %d blocks per CU\n", per_cu); (void)hipGetLastError(); grid = -1; return; }
        grid = cus;
    }
    if (grid < 0) return;
    (void)hipMemsetAsync((char*)d_ws + WS_CTL, 0, CTL_ZERO_BYTES, stream);
    Args a{};
    for (int i = 0; i < 25; ++i) a.in[i] = (const float*)d_in[i];
    a.out = (float*)d_out; a.ws = (unsigned char*)d_ws;
#if MK_SINGLE
    a.ph_lo = 0; a.ph_hi = NPHASE;
    void* kargs[] = {&a};
    hipError_t e = hipLaunchCooperativeKernel((const void*)fwd_kernel, dim3(grid), dim3(512), kargs, LDS_BYTES, stream);
    if (e != hipSuccess) fprintf(stderr, "kernel_launch: cooperative launch failed: %s (grid %d)\n", hipGetErrorString(e), grid);
#else
    for (int p = 0; p < NPHASE; ++p) { a.ph_lo = p; a.ph_hi = p + 1; hipLaunchKernelGGL(fwd_kernel, dim3(grid), dim3(512), LDS_BYTES, stream, a); }
#endif
}
```

```cpp
#include <hip/hip_runtime.h>
#include <hip/hip_cooperative_groups.h>
#include <cstdio>
#include <cstdint>
#include <cmath>

#ifndef MK_SINGLE
#define MK_SINGLE 1
#endif

#define GAS __attribute__((address_space(1)))
#define LAS __attribute__((address_space(3)))
typedef unsigned short bf16_t;
typedef short bf16x8 __attribute__((ext_vector_type(8)));
typedef float f32x4 __attribute__((ext_vector_type(4)));
typedef float f32x16 __attribute__((ext_vector_type(16)));
typedef float f32x2 __attribute__((ext_vector_type(2)));
typedef unsigned u32x4 __attribute__((ext_vector_type(4)));
typedef unsigned u32x2 __attribute__((ext_vector_type(2)));

constexpr int BATCH = 4, SEQ = 4096, DM = 2048, T = BATCH * SEQ;
constexpr int NP = 7680;
constexpr int PQ = 0, PK = 1024, PV = 2048, PQI = 3072, PKI = 4096, PWI = 4160, PDW = 4224, PDA = 4288, PR = 4352, PKR = 5376, PVR = 6400, PDG = 7424;
constexpr int IN_COLS = 7536, DSA_COLS = 4176;
constexpr int KL = 384, NL = 3072;
constexpr int MPAD = 22528;
constexpr int NCLS = 24;
constexpr float NORM_EPS = 1e-6f, GN_EPS = 64e-5f;
constexpr float QSCALE = 0.08838834764831845f * 1.4426950408889634f;

constexpr size_t MiB = 1u << 20;
constexpr size_t WS_CTL = 0, CTL_ZERO_BYTES = 1 * MiB;
constexpr size_t WS_WLORA = 1 * MiB;
constexpr size_t WS_WOUT = 4 * MiB;
constexpr size_t WS_MSK = 12 * MiB;
constexpr size_t WS_KI = 20 * MiB;
constexpr size_t WS_ROUTE = 22 * MiB;
constexpr size_t WS_ROWTOK = 23 * MiB;
constexpr size_t WS_WRT = 23 * MiB + 512 * 1024;
constexpr size_t WS_ALORA = 24 * MiB;
constexpr size_t WS_WIN = 36 * MiB;
constexpr size_t WS_HN = 66 * MiB;
constexpr size_t WS_YCAT = WS_HN;
constexpr size_t WS_L3 = 130 * MiB;
constexpr size_t WS_P = 226 * MiB;
constexpr size_t WS_H2S = 226 * MiB;
constexpr size_t WS_HS = 314 * MiB;
constexpr size_t WS_WGU = 358 * MiB;
constexpr size_t WS_WDN = 422 * MiB;
constexpr size_t WS_MT = 24 * MiB;
constexpr size_t WS_BON = 56 * MiB;
constexpr size_t WS_SA = 466 * MiB;
constexpr size_t WS_END = 498 * MiB;
constexpr int CW_CNT = 64;
constexpr int CW_BAR = 4096;

constexpr int RING_BYTES = 131072;
constexpr int LDSCTL_OFF = RING_BYTES, MISC_OFF = LDSCTL_OFF + 320;
constexpr int LDS_BYTES = 147456;

#define LDS_WAIT() asm volatile("s_waitcnt lgkmcnt(0)" ::: "memory")
#define VM_WAIT() asm volatile("s_waitcnt vmcnt(0)" ::: "memory")
__device__ __forceinline__ unsigned f2bf(float f) { unsigned u = __builtin_bit_cast(unsigned, f); return (u + 0x7fffu + ((u >> 16) & 1u)) >> 16; }
__device__ __forceinline__ unsigned pk2(float lo, float hi) { return f2bf(lo) | (f2bf(hi) << 16); }
__device__ __forceinline__ float bf2f(unsigned short h) { return __builtin_bit_cast(float, (unsigned)h << 16); }
__device__ __forceinline__ float bflo(unsigned w) { return __builtin_bit_cast(float, w << 16); }
__device__ __forceinline__ float bfhi(unsigned w) { return __builtin_bit_cast(float, w & 0xffff0000u); }
#define DPP_ADD(v, ctrl, rm) (v) += __builtin_bit_cast(float, __builtin_amdgcn_update_dpp(0, __builtin_bit_cast(int, (v)), (ctrl), (rm), 0xF, false))
__device__ __forceinline__ float row_sum16(float v) {
    DPP_ADD(v, 0xB1, 0xF); DPP_ADD(v, 0x4E, 0xF); DPP_ADD(v, 0x141, 0xF); DPP_ADD(v, 0x140, 0xF); return v;
}
__device__ __forceinline__ float wave_sum(float v) {
    v = row_sum16(v); DPP_ADD(v, 0x142, 0xA); DPP_ADD(v, 0x143, 0xC);
    return __builtin_bit_cast(float, __builtin_amdgcn_readlane(__builtin_bit_cast(int, v), 63));
}
__device__ __forceinline__ float half_sum(float v) {
    v = row_sum16(v); DPP_ADD(v, 0x142, 0xA);
    const float lo = __builtin_bit_cast(float, __builtin_amdgcn_readlane(__builtin_bit_cast(int, v), 31)), hi = __builtin_bit_cast(float, __builtin_amdgcn_readlane(__builtin_bit_cast(int, v), 63));
    return (threadIdx.x & 32) ? hi : lo;
}
__device__ __forceinline__ float sigmoidf_(float x) { return 1.0f / (1.0f + __expf(-x)); }

namespace pg8 {
constexpr int BM = 256, BK = 64, HALF = 128, HTB = HALF * BK * 2, STAGE_BYTES = 8 * HTB, NXCD = 8, WGM = 8;
__host__ __device__ __forceinline__ int lds_byte(int r, int c) { const int st = (r >> 4) * 2 + (c >> 5), rr = r & 15, cc = c & 31, ob = rr * 64 + cc * 2; return st * 1024 + (ob ^ (((ob >> 9) & 1) << 5)); }
__host__ __device__ __forceinline__ void stage_rc(int b, int& R, int& C) { const int st = b / 1024, sb = b % 1024, swz = sb ^ (((sb >> 9) & 1) << 5); R = (st >> 1) * 16 + swz / 64; C = (st & 1) * 32 + (swz % 64) / 2; }
__host__ __device__ __forceinline__ int perm32(int rho) { const int n = rho >> 4, i = rho & 15; return 8 * (i >> 2) + 4 * n + (i & 3); }

struct Unit { int pm, pn, aux; };
struct Seg { const char* A; const char* B; Unit u; int last; };

struct TileOrder {
    int nM, nN, nwg, G, c;
    __device__ void init(int nM_, int nN_, int G_, int c_) { nM = nM_; nN = nN_; nwg = nM * nN; G = G_; c = c_; }
    __device__ bool next(int i, int& pm, int& pn) const {
        const long L = (long)i * G + c; if (L >= nwg) return false;
        int wgid = (int)L; { const int q = nwg / NXCD, r = nwg % NXCD, xcd = wgid % NXCD, off = wgid / NXCD; wgid = (xcd < r ? xcd * (q + 1) : r * (q + 1) + (xcd - r) * q) + off; }
        const int nig = WGM * nN, gid = wgid / nig, fm = gid * WGM, gsz = (nM - fm) < WGM ? (nM - fm) : WGM;
        pm = fm + ((wgid % nig) % gsz); pn = (wgid % nig) / gsz; return true;
    }
};
struct PlainSched {
    TileOrder o; const char* A; const char* B; size_t tA, tB;
    __device__ void init(const bf16_t* A_, const bf16_t* B_, int M, int N, int lda, int ldb, int G, int c) { o.init(M / BM, N / BM, G, c); A = (const char*)A_; B = (const char*)B_; tA = (size_t)BM * lda * 2; tB = (size_t)BM * ldb * 2; }
    __device__ bool seg(int i, Seg& s) const { int pm, pn; if (!o.next(i, pm, pn)) return false; s.A = A + pm * tA; s.B = B + pn * tB; s.u.pm = pm; s.u.pn = pn; s.u.aux = 0; s.last = 1; return true; }
};

__device__ __forceinline__ unsigned cvt_pk_bf16(float lo, float hi) { unsigned r; asm volatile("v_cvt_pk_bf16_f32 %0, %1, %2" : "=v"(r) : "v"(lo), "v"(hi)); return r; }

typedef f32x4 Acc[2][2][4][2];

template <class Epi, class Sched, bool ALIGN_EPI>
__device__ __forceinline__ void gemm_phase(LAS unsigned char* lds, const int lda, const int ldb, const int nt, const Sched& S, const Epi& E) {
    const int tid = threadIdx.x, wid = __builtin_amdgcn_readfirstlane(tid >> 6), lane = tid & 63, wr = wid >> 2, wc = wid & 3, fr = lane & 15, fq = lane >> 4;
    unsigned voffA[2], voffB[2];
#pragma unroll
    for (int i = 0; i < 2; ++i) { int R, C; stage_rc(tid * 16 + i * 8192, R, C); const int Rb = Epi::PERM ? ((R & ~31) + perm32(R & 31)) : R;
        voffA[i] = (unsigned)(R * lda + C) * 2u; voffB[i] = (unsigned)(Rb * ldb + C) * 2u; }
    const size_t kstep = (size_t)(BK * 2);
    const size_t hstepA = (size_t)HALF * lda * 2, hstepB = (size_t)HALF * ldb * 2;
    const unsigned ldsw = (unsigned)wid * 1024u;
    const int aoff = lds_byte(wr * 64 + fr, fq * 8), boff = lds_byte(wc * 32 + fr, fq * 8);
#define PG8_SA(b, h) (((b) * 2 + (h)) * HTB)
#define PG8_SB(b, h) ((4 + (b) * 2 + (h)) * HTB)
#define PG8_STAGE(bufoff, gbase, voff) do { _Pragma("unroll") for (int _i = 0; _i < 2; ++_i) \
        __builtin_amdgcn_global_load_lds((const unsigned*)((const char*)(gbase) + (voff)[_i]), (LAS unsigned*)(lds + (bufoff) + ldsw + _i * 8192), 16, 0, 0); } while (0)
#define PG8_LDA(dst, b, h) do { _Pragma("unroll") for (int m = 0; m < 4; ++m) _Pragma("unroll") for (int k = 0; k < 2; ++k) dst[m][k] = *(const LAS bf16x8*)(lds + PG8_SA(b, h) + aoff + m * 2048 + k * 1024); } while (0)
#define PG8_LDB(dst, b, h) do { _Pragma("unroll") for (int n = 0; n < 2; ++n) _Pragma("unroll") for (int k = 0; k < 2; ++k) dst[n][k] = *(const LAS bf16x8*)(lds + PG8_SB(b, h) + boff + n * 2048 + k * 1024); } while (0)
#define PG8_MMA(ai, bj, At, Bt) do { __builtin_amdgcn_s_setprio(1); _Pragma("unroll") for (int m = 0; m < 4; ++m) _Pragma("unroll") for (int n = 0; n < 2; ++n) _Pragma("unroll") for (int k = 0; k < 2; ++k) \
        acc[ai][bj][m][n] = __builtin_amdgcn_mfma_f32_16x16x32_bf16(Bt[n][k], At[m][k], acc[ai][bj][m][n], 0, 0, 0); __builtin_amdgcn_s_setprio(0); } while (0)
#define PG8_WAIT_V(n) asm volatile("s_waitcnt vmcnt(" #n ")" ::: "memory")
#define PG8_WAIT_L(n) asm volatile("s_waitcnt lgkmcnt(" #n ")" ::: "memory")
#define PG8_BAR __builtin_amdgcn_s_barrier()
#define PG8_SCHED __builtin_amdgcn_sched_barrier(0)
#define PG8_ZERO() do { _Pragma("unroll") for (int a = 0; a < 2; ++a) _Pragma("unroll") for (int b = 0; b < 2; ++b) _Pragma("unroll") for (int m = 0; m < 4; ++m) _Pragma("unroll") for (int n = 0; n < 2; ++n) acc[a][b][m][n] = (f32x4){0.f, 0.f, 0.f, 0.f}; } while (0)
    Seg cur, nxt; int qi = 0;
    if (!S.seg(0, cur)) return;
    Acc acc;
    PG8_ZERO();
    bf16x8 At[4][2], B0[2][2], B1[2][2];
    const char* cA = cur.A; const char* cB = cur.B;
    PG8_STAGE(PG8_SB(0, 0), cB, voffB); PG8_STAGE(PG8_SB(0, 1), cB + hstepB, voffB); PG8_STAGE(PG8_SA(0, 0), cA, voffA); PG8_STAGE(PG8_SA(0, 1), cA + hstepA, voffA);
    if (wr == 1) PG8_BAR;
    PG8_WAIT_V(2); PG8_BAR;
    PG8_STAGE(PG8_SB(1, 0), cB + kstep, voffB); PG8_STAGE(PG8_SA(1, 0), cA + kstep, voffA); PG8_STAGE(PG8_SB(1, 1), cB + hstepB + kstep, voffB);
    PG8_WAIT_V(6); PG8_BAR;
    for (;;) {
        bool has_next; const char* nA; const char* nB;
        for (;;) {
        has_next = S.seg(qi + 1, nxt);
        nA = has_next ? nxt.A : cA; nB = has_next ? nxt.B : cB;
#pragma unroll 1
        for (int t = 0; t < nt; t += 2) {
            const bool last = (t == nt - 2);
            const char* a1 = cA + (size_t)(t + 1) * kstep;
            const char* a2 = last ? nA : cA + (size_t)(t + 2) * kstep; const char* b2 = last ? nB : cB + (size_t)(t + 2) * kstep;
            const char* a3 = a2 + kstep; const char* b3 = b2 + kstep;
            PG8_LDB(B0, 0, 0); PG8_LDB(B1, 0, 1); PG8_SCHED; PG8_LDA(At, 0, 0); PG8_STAGE(PG8_SA(1, 1), a1 + hstepA, voffA);
            PG8_WAIT_V(8); PG8_WAIT_L(0); PG8_BAR; PG8_MMA(0, 0, At, B0); PG8_MMA(0, 1, At, B1); PG8_BAR; PG8_SCHED;
            PG8_LDA(At, 0, 1); PG8_STAGE(PG8_SB(0, 0), b2, voffB); PG8_STAGE(PG8_SB(0, 1), b2 + hstepB, voffB); PG8_STAGE(PG8_SA(0, 0), a2, voffA);
            PG8_WAIT_V(8); PG8_WAIT_L(0); PG8_BAR; PG8_MMA(1, 0, At, B0); PG8_MMA(1, 1, At, B1); PG8_BAR; PG8_SCHED;
            PG8_LDB(B0, 1, 0); PG8_LDB(B1, 1, 1); PG8_SCHED; PG8_LDA(At, 1, 0); PG8_STAGE(PG8_SA(0, 1), a2 + hstepA, voffA);
            PG8_WAIT_V(8); PG8_WAIT_L(0); PG8_BAR; PG8_MMA(0, 0, At, B0); PG8_MMA(0, 1, At, B1); PG8_BAR; PG8_SCHED;
            PG8_LDA(At, 1, 1); PG8_STAGE(PG8_SB(1, 0), b3, voffB); PG8_STAGE(PG8_SB(1, 1), b3 + hstepB, voffB); PG8_STAGE(PG8_SA(1, 0), a3, voffA);
            PG8_WAIT_V(8); PG8_WAIT_L(0); PG8_BAR; PG8_MMA(1, 0, At, B0); PG8_MMA(1, 1, At, B1); PG8_BAR; PG8_SCHED;
        }
        if (cur.last || !has_next) break;
        cur = nxt; cA = nA; cB = nB; ++qi;
        }
        if constexpr (ALIGN_EPI) { if (wr == 0) PG8_BAR; }
        E(acc, cur.u, wr, wc, fr, fq);
        if (!has_next) break;
        PG8_ZERO();
        cur = nxt; cA = nA; cB = nB; ++qi;
        if constexpr (ALIGN_EPI) { if (wr == 1) PG8_BAR; }
    }
    PG8_WAIT_V(0);
    if constexpr (!ALIGN_EPI) { if (wr == 0) PG8_BAR; }
    PG8_BAR;
#undef PG8_SA
#undef PG8_SB
#undef PG8_STAGE
#undef PG8_LDA
#undef PG8_LDB
#undef PG8_MMA
#undef PG8_WAIT_V
#undef PG8_WAIT_L
#undef PG8_BAR
#undef PG8_SCHED
#undef PG8_ZERO
}

struct EpiBf16 {
    static constexpr bool PERM = true;
    bf16_t* O; int ldc;
    __device__ __forceinline__ void operator()(const Acc& acc, const Unit& u, int wr, int wc, int fr, int fq) const {
        const int row0 = u.pm * BM + wr * 64 + fr; const int col0 = u.pn * BM + wc * 32 + 8 * fq;
#pragma unroll
        for (int ai = 0; ai < 2; ++ai)
#pragma unroll
            for (int m = 0; m < 4; ++m) { bf16_t* rowp = O + (size_t)(row0 + ai * HALF + m * 16) * ldc + col0;
#pragma unroll
                for (int bj = 0; bj < 2; ++bj) { const f32x4 v0 = acc[ai][bj][m][0], v1 = acc[ai][bj][m][1];
                    u32x4 w; w.x = cvt_pk_bf16(v0[0], v0[1]); w.y = cvt_pk_bf16(v0[2], v0[3]); w.z = cvt_pk_bf16(v1[0], v1[1]); w.w = cvt_pk_bf16(v1[2], v1[3]);
                    *(u32x4*)(rowp + bj * HALF) = w; } }
    }
};
struct EpiLora {
    static constexpr bool PERM = true;
    bf16_t* O; const float* w0; const float* a0;
    __device__ __forceinline__ void operator()(const Acc& acc, const Unit& u, int wr, int wc, int fr, int fq) const {
        const int row0 = u.pm * BM + wr * 64 + fr; const int col0 = u.pn * BM + wc * 32 + 8 * fq; const int typ = u.pn >> 2;
        const float* bsrc = (typ == 0) ? w0 : a0;
        const float mul = (typ == 0) ? -0.6065306597126334f : 1.0f; const bool lin = (typ == 2);
#pragma unroll
        for (int bj = 0; bj < 2; ++bj) {
            const int ch = (col0 + bj * HALF) & 1023;
            const f32x4 b0 = *(const f32x4*)(bsrc + ch), b1 = *(const f32x4*)(bsrc + ch + 4);
#pragma unroll
            for (int ai = 0; ai < 2; ++ai)
#pragma unroll
                for (int m = 0; m < 4; ++m) {
                    f32x4 v0 = acc[ai][bj][m][0], v1 = acc[ai][bj][m][1];
                    {
                        const f32x4 s0 = v0 + b0, s1 = v1 + b1;
                        v0.x = lin ? v0.x : mul * sigmoidf_(s0.x); v0.y = lin ? v0.y : mul * sigmoidf_(s0.y); v0.z = lin ? v0.z : mul * sigmoidf_(s0.z); v0.w = lin ? v0.w : mul * sigmoidf_(s0.w);
                        v1.x = lin ? v1.x : mul * sigmoidf_(s1.x); v1.y = lin ? v1.y : mul * sigmoidf_(s1.y); v1.z = lin ? v1.z : mul * sigmoidf_(s1.z); v1.w = lin ? v1.w : mul * sigmoidf_(s1.w);
                    }
                    u32x4 w; w.x = cvt_pk_bf16(v0.x, v0.y); w.y = cvt_pk_bf16(v0.z, v0.w); w.z = cvt_pk_bf16(v1.x, v1.y); w.w = cvt_pk_bf16(v1.z, v1.w);
                    *(u32x4*)(O + (size_t)(row0 + ai * HALF + m * 16) * NL + col0 + bj * HALF) = w;
                    asm volatile("" ::: "memory"); }
        }
    }
};
struct EpiResF32 {
    static constexpr bool PERM = false;
    const float* base; float* out; int ldc;
    __device__ __forceinline__ void operator()(const Acc& acc, const Unit& u, int wr, int wc, int fr, int fq) const {
        const int col0 = u.pn * BM + wc * 32 + 4 * fq;
#pragma unroll
        for (int ai = 0; ai < 2; ++ai)
#pragma unroll
            for (int m = 0; m < 4; ++m) { const size_t off = (size_t)(u.pm * BM + ai * HALF + wr * 64 + m * 16 + fr) * ldc + col0;
#pragma unroll
                for (int bj = 0; bj < 2; ++bj)
#pragma unroll
                    for (int n = 0; n < 2; ++n) { const f32x4 bs = *(const f32x4*)(base + off + bj * HALF + n * 16); *(f32x4*)(out + off + bj * HALF + n * 16) = bs + acc[ai][bj][m][n]; } }
    }
};
struct EpiMoe1 {
    static constexpr bool PERM = true;
    bf16_t* O; const float* gates;
    __device__ __forceinline__ void operator()(const Acc& acc, const Unit& u, int wr, int wc, int fr, int fq) const {
        const int row0 = u.pm * BM + wr * 64 + fr; const int half = u.pn >> 2; const int col0 = half * 512 + (u.pn & 3) * 128 + wc * 32 + 8 * fq;
#pragma unroll
        for (int ai = 0; ai < 2; ++ai)
#pragma unroll
            for (int m = 0; m < 4; ++m) { const int row = row0 + ai * HALF + m * 16; const float gw = gates[(size_t)row * 2 + half];
                float v[8];
#pragma unroll
                for (int e = 0; e < 8; ++e) { const float g = acc[ai][0][m][e >> 2][e & 3], up = acc[ai][1][m][e >> 2][e & 3]; v[e] = g * sigmoidf_(g) * up * gw; }
                u32x4 w; w.x = cvt_pk_bf16(v[0], v[1]); w.y = cvt_pk_bf16(v[2], v[3]); w.z = cvt_pk_bf16(v[4], v[5]); w.w = cvt_pk_bf16(v[6], v[7]);
                *(u32x4*)(O + (size_t)row * 1024 + col0) = w; }
    }
};
struct EpiMoe2 {
    static constexpr bool PERM = false;
    float* out; const int* rowtok; int dry;
    __device__ __forceinline__ void operator()(const Acc& acc, const Unit& u, int wr, int wc, int fr, int fq) const {
        const int col0 = u.pn * BM + wc * 32 + 4 * fq;
#pragma unroll
        for (int ai = 0; ai < 2; ++ai)
#pragma unroll
            for (int m = 0; m < 4; ++m) { const int row = u.pm * BM + ai * HALF + wr * 64 + m * 16 + fr; const int tok = rowtok[row];
                if (tok >= 0 && !dry) { float* o = out + (size_t)tok * DM + col0;
#pragma unroll
                    for (int bj = 0; bj < 2; ++bj)
#pragma unroll
                        for (int n = 0; n < 2; ++n) { f32x4* p = (f32x4*)(o + bj * HALF + n * 16); *p = *p + acc[ai][bj][m][n]; } }
                asm volatile("" ::: "memory"); }
    }
};
}

#define XB_TMO      128
#define XB_XCNT(j)  (256  + 64 * (j))
#define XB_XSUB(j)  (1280 + 64 * (j))
#define XB_XGEN(j)  (2304 + 64 * (j))
#define XB_TOP      3328
#define XB_TOPGEN   3392
#define XCD_BAR_WORDS 3456
#define XB_SPIN_CAP (1u << 20)
__device__ __forceinline__ unsigned xb_ld(unsigned* p)              { return __hip_atomic_load(p, __ATOMIC_RELAXED, __HIP_MEMORY_SCOPE_AGENT); }
__device__ __forceinline__ unsigned xb_add(unsigned* p, unsigned v) { return __hip_atomic_fetch_add(p, v, __ATOMIC_RELAXED, __HIP_MEMORY_SCOPE_AGENT); }
__device__ __forceinline__ unsigned xb_xcc_id() { return (unsigned)__builtin_amdgcn_s_getreg((3 << 11) | 20) & 0xFu; }
#define XB_SPIN(cond, bar) do { unsigned _sp = 0; while (cond) { __builtin_amdgcn_s_sleep(1); \
    if ((++_sp & 255u) == 0u) { if (xb_ld(&(bar)[XB_TMO])) break; if (_sp > XB_SPIN_CAP) { atomicAdd(&(bar)[XB_TMO], 1u); break; } } } } while (0)
struct XcdBarrier { unsigned* bar; unsigned x; volatile LAS unsigned* st; };
__device__ __forceinline__ XcdBarrier xcd_barrier_post(unsigned* bar, volatile LAS unsigned* st) {
    XcdBarrier b; b.bar = bar; b.x = xb_xcc_id(); b.st = st;
    if (threadIdx.x == 0) (void)xb_add(&bar[XB_XCNT(b.x)], 1u);
    return b;
}
__device__ __forceinline__ void xcd_barrier_complete(unsigned* bar, unsigned x, unsigned& nloc, unsigned& nx) {
    const unsigned G = gridDim.x * gridDim.y * gridDim.z;
    unsigned sum, cnt, mine, sp = 0u;
    for (;;) {
        sum = 0u; cnt = 0u; mine = 0u;
#pragma unroll
        for (unsigned j = 0; j < 16; ++j) { const unsigned c = xb_ld(&bar[XB_XCNT(j)]); sum += c; cnt += (c > 0u) ? 1u : 0u; mine = (j == x) ? c : mine; }
        if (sum == G) break;
        __builtin_amdgcn_s_sleep(1);
        if ((++sp & 255u) == 0u) { if (xb_ld(&bar[XB_TMO])) break; if (sp > XB_SPIN_CAP) { atomicAdd(&bar[XB_TMO], 1u); break; } }
    }
    nloc = mine > 0u ? mine : 1u; nx = cnt > 0u ? cnt : 1u;
}
__device__ __forceinline__ void xcd_barrier(const XcdBarrier& b) {
    asm volatile("s_waitcnt vmcnt(0)" ::: "memory");
    __syncthreads();
    if (threadIdx.x == 0) {
        unsigned* bar = b.bar;
        __builtin_amdgcn_s_waitcnt(0);
        unsigned nloc = b.st[0], nx = b.st[1];
        if (nloc == 0u) { xcd_barrier_complete(bar, b.x, nloc, nx); b.st[0] = nloc; b.st[1] = nx; }
        const unsigned old = xb_add(&bar[XB_XSUB(b.x)], 1u);
        const unsigned gen = old / nloc;
        if (old + 1u == (gen + 1u) * nloc) {
            __builtin_amdgcn_fence(__ATOMIC_RELEASE, "agent");
            asm volatile("s_waitcnt vmcnt(0)" ::: "memory");
            const unsigned og = xb_add(&bar[XB_TOP], 1u);
            const unsigned tg = og / nx;
            if (og + 1u == (tg + 1u) * nx) xb_add(&bar[XB_TOPGEN], 1u);
            else XB_SPIN(xb_ld(&bar[XB_TOPGEN]) == tg, bar);
            __builtin_amdgcn_fence(__ATOMIC_ACQUIRE, "agent");
            xb_add(&bar[XB_XGEN(b.x)], 1u);
            asm volatile("s_waitcnt vmcnt(0)" ::: "memory");
        } else {
            XB_SPIN(xb_ld(&bar[XB_XGEN(b.x)]) == gen, bar);
            __builtin_amdgcn_fence(__ATOMIC_ACQUIRE, "agent");
            asm volatile("s_waitcnt vmcnt(0)" ::: "memory");
        }
    }
    __syncthreads();
}

struct Args { const float* in[25]; float* out; unsigned char* ws; int ph_lo, ph_hi; };
enum { I_X = 0, I_GMIX, I_WIN, I_MIX, I_QG, I_KG, I_W0, I_WDEC, I_A0, I_WAICL, I_WGATE, I_KK, I_KA, I_RK, I_LNW, I_LNB, I_WOUT, I_GFFN, I_WRG, I_BRG, I_WRE, I_BRE, I_WEG, I_WEU, I_WED };

struct Frame {
    LAS unsigned char* lds; unsigned char* ldsg;
    unsigned* ctl;
    int tid, lane, wave, vcu, G;
    const float* const* in; float* out; unsigned char* ws;
};

__device__ __forceinline__ int win_dmap(int n) {
    if (n < DSA_COLS) return n;
    const int m = n - DSA_COLS;
    if (m < 1024) return PR + m;
    if (m < 1088) return PDW + (m - 1024);
    if (m < 2112) return PKR + (m - 1088);
    if (m < 3136) return PVR + (m - 2112);
    if (m < 3200) return PDA + (m - 3136);
    return PDG + (m - 3200);
}
template <int MODE>
__device__ __forceinline__ void transpose_item(const float* W, int N, bf16_t* WT, int ldd, LAS float* scr, int kb, int nb, int lane) {
    const int k0 = 64 * kb, n0 = 32 * nb;
    const int nn = n0 + (lane & 31);
    float tv[32];
#pragma unroll
    for (int i = 0; i < 32; ++i) { const int kk = 2 * i + (lane >> 5); tv[i] = (nn < N) ? W[(size_t)(k0 + kk) * N + nn] : 0.f; }
#pragma unroll
    for (int i = 0; i < 32; ++i) { const int kk = 2 * i + (lane >> 5); scr[kk * 33 + (lane & 31)] = tv[i]; }
    LDS_WAIT(); asm volatile("" ::: "memory");
    const int c = lane & 7;
#pragma unroll
    for (int j = 0; j < 4; ++j) { const int nl = (lane >> 3) + 8 * j; const int n = n0 + nl; const LAS float* s = scr + (8 * c) * 33 + nl;
        u32x4 o; o.x = pk2(s[0 * 33], s[1 * 33]); o.y = pk2(s[2 * 33], s[3 * 33]); o.z = pk2(s[4 * 33], s[5 * 33]); o.w = pk2(s[6 * 33], s[7 * 33]);
        int dr = n;
        if (MODE == 1) dr = win_dmap(n);
        if (MODE == 2) dr = (n >> 7) * 256 + (n & 127);
        if (MODE == 3) dr = (n >> 7) * 256 + 128 + (n & 127);
        if (n < N) *(u32x4*)(WT + (size_t)dr * ldd + k0 + 8 * c) = o; }
    LDS_WAIT(); asm volatile("" ::: "memory");
}

__device__ __forceinline__ void phase0(Frame& F) {
    LAS float* scr = (LAS float*)(F.lds + F.wave * 16384);
    const int gw = F.vcu * 8 + F.wave, NGW = F.G * 8, lane = F.lane;
    constexpr int NB_IN = (IN_COLS + 31) / 32;
    constexpr int I_IN = (DM / 64) * NB_IN, I_OUT = (DM / 64) * (DM / 32);
    bf16_t* WIN = (bf16_t*)(F.ws + WS_WIN); bf16_t* WOUT = (bf16_t*)(F.ws + WS_WOUT);
    for (int it = gw; it < I_IN + I_OUT; it += NGW) {
        if (it < I_IN) transpose_item<1>(F.in[I_WIN], IN_COLS, WIN, DM, scr, it / NB_IN, it % NB_IN, lane);
        else { const int r = it - I_IN; transpose_item<0>(F.in[I_WOUT], DM, WOUT, DM, scr, r / (DM / 32), r % (DM / 32), lane); }
    }
    for (int i = gw; i < 144 * 4; i += NGW) { const int r = i >> 2, q = i & 3; const int row = r < 48 ? 4176 + r : 7584 + (r - 48);
        *(u32x4*)(WIN + (size_t)row * DM + q * 512 + lane * 8) = (u32x4){0u, 0u, 0u, 0u}; }
    { bf16_t* WL = (bf16_t*)(F.ws + WS_WLORA); const float* wd = F.in[I_WDEC]; const float* wa = F.in[I_WAICL]; const float* wg = F.in[I_WGATE];
      for (int i = gw * 64 + lane; i < NL * KL; i += NGW * 64) { const int n = i / KL, k = i % KL; const int typ = n >> 10, c = n & 1023; float v = 0.f;
          if (typ == 0 && k < 64) v = wd[k * 1024 + c];
          else if (typ == 1 && k >= 64 && k < 128) v = wa[(k - 64) * 1024 + c];
          else if (typ == 2 && k >= 128 && k < 288) v = wg[(k - 128) * 1024 + c];
          WL[i] = (bf16_t)f2bf(v); } }
    { float* WRT = (float*)(F.ws + WS_WRT); const float* wrg = F.in[I_WRG]; const float* wre = F.in[I_WRE]; const float* gf = F.in[I_GFFN];
      for (int i = gw * 64 + lane; i < 20 * DM; i += NGW * 64) { const int o = i / DM, k = i % DM; WRT[i] = gf[k] * (o < 4 ? wrg[k * 4 + o] : wre[k * 16 + (o - 4)]); } }
    { const float* x = F.in[I_X]; const float* g = F.in[I_GMIX]; bf16_t* HN = (bf16_t*)(F.ws + WS_HN);
      f32x4 gv[8];
#pragma unroll
      for (int j = 0; j < 8; ++j) gv[j] = ((const f32x4*)g)[64 * j + lane];
      for (int m = gw; m < T; m += NGW) { const f32x4* xr = (const f32x4*)(x + (size_t)m * DM) + lane; f32x4 v[8]; float s = 0.f;
#pragma unroll
          for (int j = 0; j < 8; ++j) { v[j] = xr[64 * j]; s += (v[j].x * v[j].x + v[j].y * v[j].y) + (v[j].z * v[j].z + v[j].w * v[j].w); }
          const float rstd = rsqrtf(wave_sum(s) * (1.f / DM) + NORM_EPS);
          u32x2* o = (u32x2*)(HN + (size_t)m * DM) + lane;
#pragma unroll
          for (int j = 0; j < 8; ++j) { u32x2 w; w.x = pk2(v[j].x * rstd * gv[j].x, v[j].y * rstd * gv[j].y); w.y = pk2(v[j].z * rstd * gv[j].z, v[j].w * rstd * gv[j].w); o[64 * j] = w; } } }
}

__device__ __forceinline__ void rope4(float& y0, float& y1, float& y2, float& y3, float c0, float s0, float c1, float s1) {
    const float o0 = y0 * c0 - y2 * s0, o2 = y2 * c0 + y0 * s0, o1 = y1 * c1 - y3 * s1, o3 = y3 * c1 + y1 * s1; y0 = o0; y1 = o1; y2 = o2; y3 = o3;
}
__device__ __forceinline__ void phase2(Frame& F, const bool dry) {
    const int gw = F.vcu * 8 + F.wave, NGW = F.G * 8, lane = F.lane;
    bf16_t* P = (bf16_t*)(F.ws + WS_P); bf16_t* KI = (bf16_t*)(F.ws + WS_KI); bf16_t* AL = (bf16_t*)(F.ws + WS_ALORA);
    const float* mix = F.in[I_MIX];
    const int l5 = lane & 31, hsel = lane >> 5, l4 = lane & 15, hq = lane >> 4;
    float qg[4], kg[4];
    { const float* a = F.in[I_QG]; const float* b = F.in[I_KG];
      qg[0] = a[2 * l5]; qg[1] = a[2 * l5 + 1]; qg[2] = a[64 + 2 * l5]; qg[3] = a[65 + 2 * l5];
      kg[0] = b[2 * l5]; kg[1] = b[2 * l5 + 1]; kg[2] = b[64 + 2 * l5]; kg[3] = b[65 + 2 * l5]; }
    const float L2T = 13.287712379549449f;
    const float inv128_0 = exp2f(-(float)(2 * l5) * (1.0f / 64.0f) * L2T), inv128_1 = exp2f(-(float)(2 * l5 + 1) * (1.0f / 64.0f) * L2T);
    const float inv64_0 = exp2f(-(float)(2 * l4) * (1.0f / 32.0f) * L2T), inv64_1 = exp2f(-(float)(2 * l4 + 1) * (1.0f / 32.0f) * L2T);
    const float mu_dw = mix[1024 + lane], mu_da = mix[3136 + lane], mu_g0 = mix[3200 + lane], mu_g1 = mix[3264 + lane], mu_g2 = (lane < 32) ? mix[3328 + lane] : 0.f;
    for (int tp = gw; tp < T / 2; tp += NGW) {
        unsigned qa[2][4], qb[2][4], ka[2][4], kb[2][4], ia[2][4], ib[2][4], xa[2], xb[2];
        float ap[2][5], apv[2][5];
#pragma unroll
        for (int u = 0; u < 2; ++u) {
            const int t = 2 * tp + u; const int pos = t & (SEQ - 1);
            const bf16_t* row = P + (size_t)t * NP;
#pragma unroll
            for (int hh = 0; hh < 4; ++hh) {
                const unsigned* bq = (const unsigned*)(row + PQ + (2 * hh + hsel) * 128); const unsigned* bk = (const unsigned*)(row + PK + (2 * hh + hsel) * 128);
                qa[u][hh] = bq[l5]; qb[u][hh] = bq[32 + l5]; ka[u][hh] = bk[l5]; kb[u][hh] = bk[32 + l5];
                const unsigned* bi = (const unsigned*)(row + PQI + (4 * hh + hq) * 64);
                ia[u][hh] = bi[l4]; ib[u][hh] = bi[16 + l4];
            }
            { const unsigned* bx = (const unsigned*)(row + PKI); xa[u] = bx[l4]; xb[u] = bx[16 + l4]; }
            const bool hp = pos > 0; const bf16_t* prow = row - NP;
            ap[u][0] = bf2f(row[PDW + lane]); ap[u][1] = bf2f(row[PDA + lane]); ap[u][2] = bf2f(row[PDG + lane]); ap[u][3] = bf2f(row[PDG + 64 + lane]); ap[u][4] = (lane < 32) ? bf2f(row[PDG + 128 + lane]) : 0.f;
            apv[u][0] = hp ? bf2f(prow[PDW + lane]) : 0.f; apv[u][1] = hp ? bf2f(prow[PDA + lane]) : 0.f; apv[u][2] = hp ? bf2f(prow[PDG + lane]) : 0.f;
            apv[u][3] = hp ? bf2f(prow[PDG + 64 + lane]) : 0.f; apv[u][4] = (hp && lane < 32) ? bf2f(prow[PDG + 128 + lane]) : 0.f;
        }
        asm volatile("" ::: "memory");
#pragma unroll
        for (int u = 0; u < 2; ++u) {
            const int t = 2 * tp + u; const int pos = t & (SEQ - 1); const float fp = (float)pos;
            bf16_t* row = P + (size_t)t * NP;
            float c0, s0, c1, s1, d0, e0, d1, e1;
            sincosf(fp * inv128_0, &s0, &c0); sincosf(fp * inv128_1, &s1, &c1);
            sincosf(fp * inv64_0, &e0, &d0); sincosf(fp * inv64_1, &e1, &d1);
#pragma unroll
            for (int which = 0; which < 2; ++which) {
#pragma unroll
                for (int hh = 0; hh < 4; ++hh) {
                    unsigned* base = (unsigned*)(row + (which ? PK : PQ) + (2 * hh + hsel) * 128);
                    const unsigned a = which ? ka[u][hh] : qa[u][hh], b = which ? kb[u][hh] : qb[u][hh];
                    float y0 = bflo(a), y1 = bfhi(a), y2 = bflo(b), y3 = bfhi(b);
                    const float ss = half_sum((y0 * y0 + y1 * y1) + (y2 * y2 + y3 * y3));
                    const float rstd = rsqrtf(ss * (1.0f / 128.0f) + NORM_EPS) * (which ? 1.0f : QSCALE);
                    const float* gg = which ? kg : qg;
                    y0 *= rstd * gg[0]; y1 *= rstd * gg[1]; y2 *= rstd * gg[2]; y3 *= rstd * gg[3];
                    rope4(y0, y1, y2, y3, c0, s0, c1, s1);
                    if (!dry) { base[l5] = pk2(y0, y1); base[32 + l5] = pk2(y2, y3); }
                }
            }
#pragma unroll
            for (int it = 0; it < 4; ++it) {
                unsigned* base = (unsigned*)(row + PQI + (4 * it + hq) * 64);
                float y0 = bflo(ia[u][it]), y1 = bfhi(ia[u][it]), y2 = bflo(ib[u][it]), y3 = bfhi(ib[u][it]);
                rope4(y0, y1, y2, y3, d0, e0, d1, e1);
                if (!dry) { base[l4] = pk2(y0, y1); base[16 + l4] = pk2(y2, y3); }
            }
            if (lane < 16 && !dry) {
                float y0 = bflo(xa[u]), y1 = bfhi(xa[u]), y2 = bflo(xb[u]), y3 = bfhi(xb[u]);
                rope4(y0, y1, y2, y3, d0, e0, d1, e1);
                unsigned* o = (unsigned*)(KI + (size_t)t * 64);
                o[l4] = pk2(y0, y1); o[16 + l4] = pk2(y2, y3);
            }
            if (!dry) {
                bf16_t* al = AL + (size_t)t * KL;
                float sh;
                sh = ap[u][0] + (apv[u][0] - ap[u][0]) * mu_dw; al[lane] = (bf16_t)f2bf(tanhf(sh));
                sh = ap[u][1] + (apv[u][1] - ap[u][1]) * mu_da; al[64 + lane] = (bf16_t)f2bf(sh);
                sh = ap[u][2] + (apv[u][2] - ap[u][2]) * mu_g0; al[128 + lane] = (bf16_t)f2bf(sigmoidf_(sh));
                sh = ap[u][3] + (apv[u][3] - ap[u][3]) * mu_g1; al[192 + lane] = (bf16_t)f2bf(sigmoidf_(sh));
                if (lane < 32) { sh = ap[u][4] + (apv[u][4] - ap[u][4]) * mu_g2; al[256 + lane] = (bf16_t)f2bf(sigmoidf_(sh)); }
                al[288 + lane] = 0; if (lane < 32) al[352 + lane] = 0;
            }
        }
    }
}

__device__ __forceinline__ unsigned fkey(float f) { const unsigned u = __builtin_bit_cast(unsigned, f); return (u & 0x80000000u) ? ~u : (u | 0x80000000u); }
constexpr int CW_QIDX = 192;
constexpr int IDX_BUF = 256 * 128;
__device__ __forceinline__ void half_sum_i(int v, int& lo, int& hi) {
#define DPP_ADDI(v, ctrl, rm) (v) += __builtin_amdgcn_update_dpp(0, (v), (ctrl), (rm), 0xF, false)
    DPP_ADDI(v, 0xB1, 0xF); DPP_ADDI(v, 0x4E, 0xF); DPP_ADDI(v, 0x141, 0xF); DPP_ADDI(v, 0x140, 0xF); DPP_ADDI(v, 0x142, 0xA);
#undef DPP_ADDI
    lo = __builtin_amdgcn_readlane(v, 31); hi = __builtin_amdgcn_readlane(v, 63);
}
__device__ __forceinline__ void idx_unit(Frame& F, int u) {
    int tid_ = F.tid; asm volatile("" : "+v"(tid_));
    const int lane = tid_ & 63, wave = F.wave;
    const bf16_t* P = (const bf16_t*)(F.ws + WS_P); const unsigned char* KI = F.ws + WS_KI; unsigned* MSK = (unsigned*)(F.ws + WS_MSK);
    const int r = lane & 31, h = lane >> 5;
    const int i = 63 - (u >> 4), b = (u & 15) >> 2, g = u & 3;
    const int t0 = b * SEQ + i * 64 + g * 16 + 2 * wave;
    const int njt = 2 * (i + 1), nst = (njt + 7) >> 3;
    bf16x8 a[4];
    { const bf16_t* ap = P + (size_t)(t0 + ((r >> 2) & 1)) * NP + PQI + ((r & 3) + 4 * (r >> 3)) * 64 + 8 * h;
#pragma unroll
      for (int s = 0; s < 4; ++s) a[s] = *(const bf16x8*)(ap + 16 * s); }
    typedef _Float16 h16x2 __attribute__((ext_vector_type(2)));
    h16x2 wq[8];
    { const bf16_t* wp = P + (size_t)(t0 + h) * NP + PWI;
#pragma unroll
      for (int e = 0; e < 8; ++e) { wq[e].x = (_Float16)(bf2f(wp[2 * e]) * (1.0f / 32.0f)); wq[e].y = (_Float16)(bf2f(wp[2 * e + 1]) * (1.0f / 32.0f)); } }
    const unsigned char* kg = KI + ((size_t)b * SEQ) * 128 + (size_t)(wave * 8 + (lane >> 3)) * 128 + (size_t)(((lane & 7) ^ (lane >> 3)) * 16);
#define IDX_STAGE(st_, buf_) do { _Pragma("unroll") for (int q = 0; q < 4; ++q) \
        __builtin_amdgcn_global_load_lds((const unsigned*)(kg + (size_t)(st_) * 32768 + q * 8192), (LAS unsigned*)(F.lds + (buf_) * IDX_BUF + (q * 8 + wave) * 1024), 16, 0, 0); } while (0)
    IDX_STAGE(0, 0);
    __syncthreads();
    unsigned sc[128];
    const int lr = r * 128, sw = r & 7;
#pragma unroll
    for (int st = 0; st < 16; ++st) {
        if (st < nst) {
            if (st + 1 < nst) IDX_STAGE(st + 1, (st + 1) & 1);
            const LAS unsigned char* kb = F.lds + (st & 1) * IDX_BUF + lr;
#pragma unroll
            for (int jb = 0; jb < 8; ++jb) {
                const int j = 8 * st + jb;
                const unsigned adm = (j < njt) ? 0xFFFFFFFFu : 0u;
                f32x16 acc = {0.f, 0.f, 0.f, 0.f, 0.f, 0.f, 0.f, 0.f, 0.f, 0.f, 0.f, 0.f, 0.f, 0.f, 0.f, 0.f};
#pragma unroll
                for (int s = 0; s < 4; ++s) acc = __builtin_amdgcn_mfma_f32_32x32x16_bf16(a[s], *(const LAS bf16x8*)(kb + jb * 4096 + (((2 * s + h) ^ sw) * 16)), acc, 0, 0, 0);
                float sum = 0.f, sum1 = 0.f;
#pragma unroll
                for (int e = 0; e < 16; ++e) { const float rl = __builtin_amdgcn_fmed3f(acc[e], 0.f, 3.0e38f);
                    const unsigned wpk = __builtin_bit_cast(unsigned, wq[e >> 1]);
                    if (e & 1) asm("v_fma_mix_f32 %0, %1, %2, %0 op_sel:[1,0,0] op_sel_hi:[1,0,0]" : "+v"(sum1) : "v"(wpk), "v"(rl));
                    else asm("v_fma_mix_f32 %0, %1, %2, %0 op_sel:[0,0,0] op_sel_hi:[1,0,0]" : "+v"(sum) : "v"(wpk), "v"(rl)); }
                sum += sum1;
                sc[j] = fkey(sum) & adm;
            }
            __syncthreads();
        } else {
#pragma unroll
            for (int jb = 0; jb < 8; ++jb) sc[8 * st + jb] = 0u;
        }
    }
#undef IDX_STAGE
    unsigned thr = 1u;
    if (njt > 8) {
        thr = 0u; bool dlo = false, dhi = false;
        for (int bit = 31; bit >= 0; --bit) {
            const unsigned cand = thr | (1u << bit);
            int cnt = 0;
#pragma unroll
            for (int jg = 0; jg < 16; ++jg) {
                if (8 * jg < njt) {
#pragma unroll
                    for (int jj = 0; jj < 8; ++jj) cnt += (sc[8 * jg + jj] >= cand) ? 1 : 0;
                }
            }
            int clo, chi; half_sum_i(cnt, clo, chi);
            const int mine = h ? chi : clo;
            if (mine >= 256) thr = cand;
            dlo |= (clo == 256); dhi |= (chi == 256);
            if (dlo && dhi) break;
        }
    }
    unsigned m0a = 0u, m0b = 0u, m1a = 0u, m1b = 0u;
#pragma unroll
    for (int j = 0; j < 128; ++j) {
        const unsigned long long bal = __ballot(sc[j] >= thr);
        const unsigned lo = (unsigned)bal, hi = (unsigned)(bal >> 32);
        if (j < 64) { asm volatile("s_nop 3\n\tv_writelane_b32 %0, %1, %2" : "+v"(m0a) : "s"(lo), "n"(j)); asm volatile("v_writelane_b32 %0, %1, %2" : "+v"(m1a) : "s"(hi), "n"(j)); }
        else { asm volatile("s_nop 3\n\tv_writelane_b32 %0, %1, %2" : "+v"(m0b) : "s"(lo), "n"(j - 64)); asm volatile("v_writelane_b32 %0, %1, %2" : "+v"(m1b) : "s"(hi), "n"(j - 64)); }
        if ((j & 7) == 7) __builtin_amdgcn_sched_barrier(0);
    }
    MSK[(size_t)t0 * 128 + lane] = m0a; MSK[(size_t)t0 * 128 + 64 + lane] = m0b;
    MSK[(size_t)(t0 + 1) * 128 + lane] = m1a; MSK[(size_t)(t0 + 1) * 128 + 64 + lane] = m1b;
}

__device__ __forceinline__ void attn_task_naive(Frame& F, int task, unsigned char* wl) {
    const int lane = F.lane;
    const bf16_t* P = (const bf16_t*)(F.ws + WS_P); const unsigned* MSK = (const unsigned*)(F.ws + WS_MSK); bf16_t* Y = (bf16_t*)(F.ws + WS_YCAT);
    int* list = (int*)wl; float* qs = (float*)(wl + 1024); float* ps = (float*)(wl + 1536);
    const int t = task >> 3, hd = task & 7, b = t >> 12, i = (t & (SEQ - 1)) >> 6;
    const int ntile = i + 1;
    int cnt = 0;
    for (int jj = 0; jj < ntile; ++jj) {
        const unsigned w0 = MSK[(size_t)t * 128 + 2 * jj], w1 = MSK[(size_t)t * 128 + 2 * jj + 1];
        const unsigned long long m = (unsigned long long)w0 | ((unsigned long long)w1 << 32);
        const int pre = __popcll(m & ((1ull << lane) - 1ull));
        if (((m >> lane) & 1ull) && (cnt + pre < 256)) list[cnt + pre] = 64 * jj + lane;
        cnt += __popcll(m);
    }
    const int nsel = cnt < 256 ? cnt : 256;
    { const bf16_t* qp = P + (size_t)t * NP + PQ + hd * 128; qs[lane] = bf2f(qp[lane]); qs[64 + lane] = bf2f(qp[64 + lane]); }
    LDS_WAIT(); asm volatile("" ::: "memory");
    float lg[4]; float mx = -INFINITY;
#pragma unroll
    for (int rr = 0; rr < 4; ++rr) {
        const int e = lane + 64 * rr; lg[rr] = -INFINITY;
        if (e < nsel) { const int key = list[e]; const u32x4* kp = (const u32x4*)(P + ((size_t)b * SEQ + key) * NP + PK + hd * 128); float d = 0.f;
#pragma unroll
            for (int c = 0; c < 16; ++c) { const u32x4 kv = kp[c]; const float* q = qs + 8 * c;
                d += q[0] * bflo(kv.x) + q[1] * bfhi(kv.x) + q[2] * bflo(kv.y) + q[3] * bfhi(kv.y) + q[4] * bflo(kv.z) + q[5] * bfhi(kv.z) + q[6] * bflo(kv.w) + q[7] * bfhi(kv.w); }
            lg[rr] = d; mx = fmaxf(mx, d); }
    }
#pragma unroll
    for (int o = 1; o < 64; o <<= 1) mx = fmaxf(mx, __shfl_xor(mx, o));
    float sum = 0.f;
#pragma unroll
    for (int rr = 0; rr < 4; ++rr) { const int e = lane + 64 * rr; const float p = (e < nsel) ? exp2f(lg[rr] - mx) : 0.f; ps[e] = p; sum += p; }
    sum = wave_sum(sum);
    LDS_WAIT(); asm volatile("" ::: "memory");
    float o0 = 0.f, o1 = 0.f;
    const bf16_t* vb = P + (size_t)b * SEQ * NP + PV + hd * 128 + 2 * lane;
    for (int e = 0; e < nsel; ++e) { const int key = list[e]; const float p = ps[e]; const unsigned v = *(const unsigned*)(vb + (size_t)key * NP); o0 += p * bflo(v); o1 += p * bfhi(v); }
    const float inv = 1.0f / sum;
    *(unsigned*)(Y + (size_t)t * DM + hd * 128 + 2 * lane) = pk2(o0 * inv, o1 * inv);
    LDS_WAIT(); asm volatile("" ::: "memory");
}

__device__ __forceinline__ void rwkv_scan_naive(Frame& F, int bh, unsigned char* wl) {
    const int lane = F.lane, b = bh >> 4, hd = bh & 15, ch = hd * 64 + lane;
    const bf16_t* P = (const bf16_t*)(F.ws + WS_P); const bf16_t* L3 = (const bf16_t*)(F.ws + WS_L3); bf16_t* Y = (bf16_t*)(F.ws + WS_YCAT);
    const float* mix = F.in[I_MIX];
    const float mu_r = mix[ch], mu_k = mix[1088 + ch], mu_v = mix[2112 + ch];
    const float kkc = F.in[I_KK][ch], kac = F.in[I_KA][ch], rkc = F.in[I_RK][ch], lnw = F.in[I_LNW][ch], lnb = F.in[I_LNB][ch];
    float* vec = (float*)wl;
    f32x4 S4[16];
#pragma unroll
    for (int k = 0; k < 16; ++k) S4[k] = (f32x4){0.f, 0.f, 0.f, 0.f};
    float prev_r = 0.f, prev_k = 0.f, prev_v = 0.f;
    constexpr int PF = 4;
    float in_r[PF], in_k[PF], in_v[PF], in_ld[PF], in_a[PF], in_g[PF];
    const bf16_t* prow = P + (size_t)b * SEQ * NP + ch; const bf16_t* lrow = L3 + (size_t)b * SEQ * NL + ch;
#pragma unroll
    for (int j = 0; j < PF; ++j) { const bf16_t* pr = prow + (size_t)j * NP; const bf16_t* lr = lrow + (size_t)j * NL;
        in_r[j] = bf2f(pr[PR]); in_k[j] = bf2f(pr[PKR]); in_v[j] = bf2f(pr[PVR]); in_ld[j] = bf2f(lr[0]); in_a[j] = bf2f(lr[1024]); in_g[j] = bf2f(lr[2048]); }
    const f32x4* vec4 = (const f32x4*)vec;
    for (int tb = 0; tb < SEQ; tb += PF) {
        float c_r[PF], c_k[PF], c_v[PF], c_ld[PF], c_a[PF], c_g[PF];
#pragma unroll
        for (int j = 0; j < PF; ++j) { c_r[j] = in_r[j]; c_k[j] = in_k[j]; c_v[j] = in_v[j]; c_ld[j] = in_ld[j]; c_a[j] = in_a[j]; c_g[j] = in_g[j]; }
        {
            const int tn = (tb + PF < SEQ) ? tb + PF : tb;
#pragma unroll
            for (int j = 0; j < PF; ++j) { const bf16_t* pr = prow + (size_t)(tn + j) * NP; const bf16_t* lr = lrow + (size_t)(tn + j) * NL;
                in_r[j] = bf2f(pr[PR]); in_k[j] = bf2f(pr[PKR]); in_v[j] = bf2f(pr[PVR]); in_ld[j] = bf2f(lr[0]); in_a[j] = bf2f(lr[1024]); in_g[j] = bf2f(lr[2048]); }
        }
#pragma unroll
        for (int j = 0; j < PF; ++j) {
            const float r_t = c_r[j] + (prev_r - c_r[j]) * mu_r, k_t = c_k[j] + (prev_k - c_k[j]) * mu_k, v_t = c_v[j] + (prev_v - c_v[j]) * mu_v;
            prev_r = c_r[j]; prev_k = c_k[j]; prev_v = c_v[j];
            const float a = c_a[j];
            const float kkr = k_t * kkc; const float n2 = wave_sum(kkr * kkr); const float kk = kkr * (1.0f / fmaxf(sqrtf(n2), 1e-12f));
            const float kp = k_t * (1.0f + (a - 1.0f) * kac); const float w = __expf(c_ld[j]); const float bb = kk * a;
            vec[lane] = -kk; vec[64 + lane] = w; vec[128 + lane] = bb; vec[192 + lane] = kp; vec[256 + lane] = r_t;
            LDS_WAIT(); asm volatile("" ::: "memory");
            f32x4 sa4 = (f32x4){0.f, 0.f, 0.f, 0.f};
#pragma unroll
            for (int k = 0; k < 16; ++k) { sa4 += S4[k] * vec4[k]; if ((k & 3) == 3) asm volatile("" ::: "memory"); }
            const float sa = (sa4.x + sa4.y) + (sa4.z + sa4.w);
            f32x4 y4 = (f32x4){0.f, 0.f, 0.f, 0.f};
#pragma unroll
            for (int k = 0; k < 16; ++k) {
                const f32x4 wv = vec4[16 + k], bv = vec4[32 + k], kv = vec4[48 + k], rv = vec4[64 + k];
                S4[k] = S4[k] * wv + bv * sa + kv * v_t; y4 += S4[k] * rv;
                if (k & 1) asm volatile("" ::: "memory"); }
            const float y = (y4.x + y4.y) + (y4.z + y4.w);
            const float mean = wave_sum(y) * (1.0f / 64.0f); const float dv = y - mean; const float var = wave_sum(dv * dv) * (1.0f / 64.0f);
            const float yn = dv * rsqrtf(var + GN_EPS) * lnw + lnb;
            const float bonus = wave_sum(r_t * kp * rkc) * v_t;
            const float o = (yn + bonus) * c_g[j];
            Y[((size_t)b * SEQ + tb + j) * DM + 1024 + ch] = (bf16_t)f2bf(o);
            asm volatile("" ::: "memory");
        }
    }
}


namespace rw {
constexpr int TP = 72, TILE_B = 64 * TP * 2;
enum { T_ATM = 0, T_RTM, T_BTM, T_KTM, T_ACM, T_VCM, T_BCM, T_KCM, T_MAB, T_MAK, T_MRB, T_MRK, T_TINV, NTILE };
constexpr int T_G1 = T_ATM, T_AP = T_BTM, T_U0 = T_KTM;
constexpr int OFF_X11T = NTILE * TILE_B, OFF_T1T = OFF_X11T + 2560, OFF_SEG = OFF_T1T + 2560, OFF_PC = OFF_SEG + 2048, LDS_END = OFF_PC + 256;
static_assert(LDS_END <= RING_BYTES, "rwkv pass A LDS");
__device__ __forceinline__ int crow(int e, int h) { return (e & 3) + 8 * (e >> 2) + 4 * h; }
__device__ __forceinline__ f32x16 zero16() { return (f32x16){0.f, 0.f, 0.f, 0.f, 0.f, 0.f, 0.f, 0.f, 0.f, 0.f, 0.f, 0.f, 0.f, 0.f, 0.f, 0.f}; }
template <int KS>
__device__ __forceinline__ f32x16 mmt(const LAS bf16_t* A, int ap, int ar0, int ac0, const LAS bf16_t* B, int bp, int br0, int bc0, f32x16 acc, int r, int h) {
    const LAS bf16_t* pa = A + (ar0 + r) * ap + ac0 + 8 * h; const LAS bf16_t* pb = B + (br0 + r) * bp + bc0 + 8 * h;
#pragma unroll
    for (int s = 0; s < KS; ++s) acc = __builtin_amdgcn_mfma_f32_32x32x16_bf16(*(const LAS bf16x8*)(pa + 16 * s), *(const LAS bf16x8*)(pb + 16 * s), acc, 0, 0, 0);
    return acc;
}
__device__ __forceinline__ void store_rm(LAS bf16_t* D, int r0, int c0, const f32x16& acc, int r, int h) {
#pragma unroll
    for (int e = 0; e < 16; ++e) D[(r0 + crow(e, h)) * TP + c0 + r] = (bf16_t)f2bf(acc[e]);
}
__device__ __forceinline__ u32x4 pack8(const f32x16& a, int s) { u32x4 w; w.x = pk2(a[8 * s], a[8 * s + 1]); w.y = pk2(a[8 * s + 2], a[8 * s + 3]); w.z = pk2(a[8 * s + 4], a[8 * s + 5]); w.w = pk2(a[8 * s + 6], a[8 * s + 7]); return w; }
__device__ __forceinline__ void unpack8(const u32x4 w, f32x16& a, int s) { a[8 * s] = bflo(w.x); a[8 * s + 1] = bfhi(w.x); a[8 * s + 2] = bflo(w.y); a[8 * s + 3] = bfhi(w.y); a[8 * s + 4] = bflo(w.z); a[8 * s + 5] = bfhi(w.z); a[8 * s + 6] = bflo(w.w); a[8 * s + 7] = bfhi(w.w); }
__device__ __forceinline__ unsigned char* l3_slot(unsigned char* l3, int tg0, int col0, int bo) { return l3 + ((size_t)(tg0 + (bo >> 7)) * NL + col0) * 2 + (bo & 127); }

__device__ __forceinline__ void pass_a(Frame& F) {
    const int lane = F.lane, wave = F.wave, r = lane & 31, h = lane >> 5;
    LAS bf16_t* tiles = (LAS bf16_t*)F.lds;
#define TL(i) (tiles + (i) * (TILE_B / 2))
    LAS bf16_t* X11T = (LAS bf16_t*)(F.lds + OFF_X11T); LAS bf16_t* T1T = (LAS bf16_t*)(F.lds + OFF_T1T);
    LAS float* seg = (LAS float*)(F.lds + OFF_SEG); LAS float* pc = (LAS float*)(F.lds + OFF_PC);
    const bf16_t* P = (const bf16_t*)(F.ws + WS_P); unsigned char* L3 = F.ws + WS_L3;
    bf16_t* MT = (bf16_t*)(F.ws + WS_MT); bf16_t* SA = (bf16_t*)(F.ws + WS_SA); float* BON = (float*)(F.ws + WS_BON);
    const float* mix = F.in[I_MIX];
    struct Raw { float pr, pk, pv, cr[8], ck[8], cv[8], l[8], a[8]; };
    auto load_raw = [&](int unit, Raw& w) {
        const int b = unit >> 10, hd = (unit >> 6) & 15, ci = unit & 63, tg0 = b * SEQ + ci * 64, ch = hd * 64 + lane;
        const bf16_t* p0 = P + (size_t)(tg0 + 8 * wave) * NP + ch; const bf16_t* l0 = (const bf16_t*)L3 + (size_t)(tg0 + 8 * wave) * NL + ch;
        if (ci == 0 && wave == 0) { w.pr = 0.f; w.pk = 0.f; w.pv = 0.f; } else { w.pr = bf2f(p0[PR - NP]); w.pk = bf2f(p0[PKR - NP]); w.pv = bf2f(p0[PVR - NP]); }
#pragma unroll
        for (int j = 0; j < 8; ++j) { w.cr[j] = bf2f(p0[(size_t)j * NP + PR]); w.ck[j] = bf2f(p0[(size_t)j * NP + PKR]); w.cv[j] = bf2f(p0[(size_t)j * NP + PVR]);
            w.l[j] = bf2f(l0[(size_t)j * NL]); w.a[j] = bf2f(l0[(size_t)j * NL + 1024]); }
    };
    Raw cur;
    if (F.vcu < 4096) load_raw(F.vcu, cur);
    for (int unit = F.vcu; unit < 4096; unit += F.G) {
        const int b = unit >> 10, hd = (unit >> 6) & 15, ci = unit & 63, tg0 = b * SEQ + ci * 64;
        Raw nxt;
        {
            const int c = lane, ch = hd * 64 + c, sg = wave;
            const float mu_r = mix[ch], mu_k = mix[1088 + ch], mu_v = mix[2112 + ch];
            const float kkc = F.in[I_KK][ch], kac = F.in[I_KA][ch], rkc = F.in[I_RK][ch];
            float pr = cur.pr, pk = cur.pk, pv = cur.pv;
            float rr[8], kp[8], vv[8], kk[8], bb[8], ld[8], cl[8];
            float run = 0.f;
#pragma unroll
            for (int j = 0; j < 8; ++j) {
                const float cr = cur.cr[j], ck = cur.ck[j], cv = cur.cv[j];
                const float l = cur.l[j], a = cur.a[j];
                const float r_t = cr + (pr - cr) * mu_r, k_t = ck + (pk - ck) * mu_k, v_t = cv + (pv - cv) * mu_v; pr = cr; pk = ck; pv = cv;
                const float kkr = k_t * kkc; const float n2 = wave_sum(kkr * kkr); const float kkn = kkr * (1.0f / fmaxf(sqrtf(n2), 1e-12f));
                const float kpp = k_t * (1.0f + (a - 1.0f) * kac);
                const float bon = wave_sum(r_t * kpp * rkc);
                if (lane == 0) BON[(size_t)(tg0 + 8 * sg + j) * 16 + hd] = bon;
                run += l; rr[j] = r_t; kp[j] = kpp; vv[j] = v_t; kk[j] = kkn; bb[j] = kkn * a; ld[j] = l; cl[j] = run;
            }
            seg[sg * 64 + c] = run;
            __syncthreads();
            float off = 0.f, tot = 0.f;
#pragma unroll
            for (int q = 0; q < 8; ++q) { const float v = seg[q * 64 + c]; tot += v; off += (q < sg) ? v : 0.f; }
            if (sg == 0) pc[c] = __expf(tot);
            float ta[8], tr[8], tb[8], tk[8];
#pragma unroll
            for (int j = 0; j < 8; ++j) { const float lp = off + cl[j]; const float ep = __expf(lp), em = __expf(-lp), epm = __expf(lp - ld[j]);
                ta[j] = -kk[j] * epm; tr[j] = rr[j] * ep; tb[j] = bb[j] * em; tk[j] = kp[j] * em; }
#pragma unroll
            for (int j = 0; j < 8; ++j) { const int o = (8 * sg + j) * TP + c;
                TL(T_ATM)[o] = (bf16_t)f2bf(ta[j]); TL(T_RTM)[o] = (bf16_t)f2bf(tr[j]); TL(T_BTM)[o] = (bf16_t)f2bf(tb[j]); TL(T_KTM)[o] = (bf16_t)f2bf(tk[j]); }
            { const int o = c * TP + 8 * sg;
              *(LAS u32x4*)(TL(T_ACM) + o) = (u32x4){pk2(ta[0], ta[1]), pk2(ta[2], ta[3]), pk2(ta[4], ta[5]), pk2(ta[6], ta[7])};
              *(LAS u32x4*)(TL(T_VCM) + o) = (u32x4){pk2(vv[0], vv[1]), pk2(vv[2], vv[3]), pk2(vv[4], vv[5]), pk2(vv[6], vv[7])};
              *(LAS u32x4*)(TL(T_BCM) + o) = (u32x4){pk2(tb[0], tb[1]), pk2(tb[2], tb[3]), pk2(tb[4], tb[5]), pk2(tb[6], tb[7])};
              *(LAS u32x4*)(TL(T_KCM) + o) = (u32x4){pk2(tk[0], tk[1]), pk2(tk[2], tk[3]), pk2(tk[4], tk[5]), pk2(tk[6], tk[7])}; }
        }
        __syncthreads();
#pragma unroll
        for (int q = 0; q < 2; ++q) {
            const int id = 2 * wave + q, rt = id >> 2, ct = id & 3;
            const LAS bf16_t* Z = (rt < 2) ? TL(T_ATM) : TL(T_RTM); const LAS bf16_t* X = (ct < 2) ? TL(T_BTM) : TL(T_KTM);
            LAS bf16_t* D = (rt < 2) ? ((ct < 2) ? TL(T_MAB) : TL(T_MAK)) : ((ct < 2) ? TL(T_MRB) : TL(T_MRK));
            const int zr0 = (rt & 1) * 32, xr0 = (ct & 1) * 32; const bool strict = rt < 2;
            f32x16 acc = zero16();
            if (xr0 <= zr0) acc = mmt<4>(Z, TP, zr0, 0, X, TP, xr0, 0, acc, r, h);
#pragma unroll
            for (int e = 0; e < 16; ++e) { const int t = zr0 + crow(e, h), i = xr0 + r; const bool keep = strict ? (i < t) : (i <= t); D[t * TP + i] = keep ? (bf16_t)f2bf(acc[e]) : (bf16_t)0; }
        }
        __syncthreads();
        if (unit + F.G < 4096) load_raw(unit + F.G, nxt); else nxt = cur;
        if (wave == 0) {
            const LAS bf16_t* Lm = TL(T_MAB); LAS bf16_t* TI = TL(T_TINV);
            const int n = r, o = 32 * h;
            float x[32];
#pragma unroll
            for (int t = 0; t < 32; ++t) {
                float acc = (t == n) ? 1.0f : 0.0f;
#pragma unroll
                for (int i8 = 0; i8 < (t + 7) / 8; ++i8) { const u32x4 w = *(const LAS u32x4*)(Lm + (o + t) * TP + o + 8 * i8);
                    const float l0 = bflo(w.x), l1 = bfhi(w.x), l2 = bflo(w.y), l3 = bfhi(w.y), l4 = bflo(w.z), l5 = bfhi(w.z), l6 = bflo(w.w), l7 = bfhi(w.w);
                    if (8 * i8 + 0 < t) acc += l0 * x[8 * i8 + 0]; if (8 * i8 + 1 < t) acc += l1 * x[8 * i8 + 1]; if (8 * i8 + 2 < t) acc += l2 * x[8 * i8 + 2]; if (8 * i8 + 3 < t) acc += l3 * x[8 * i8 + 3];
                    if (8 * i8 + 4 < t) acc += l4 * x[8 * i8 + 4]; if (8 * i8 + 5 < t) acc += l5 * x[8 * i8 + 5]; if (8 * i8 + 6 < t) acc += l6 * x[8 * i8 + 6]; if (8 * i8 + 7 < t) acc += l7 * x[8 * i8 + 7]; }
                x[t] = acc;
            }
#pragma unroll
            for (int t = 0; t < 32; ++t) { TI[(o + t) * TP + o + n] = (bf16_t)f2bf(x[t]); if (h == 0) TI[t * TP + 32 + n] = (bf16_t)0; }
            if (h == 0) {
#pragma unroll
                for (int q = 0; q < 4; ++q) *(LAS u32x4*)(X11T + n * 40 + 8 * q) = (u32x4){pk2(x[8 * q], x[8 * q + 1]), pk2(x[8 * q + 2], x[8 * q + 3]), pk2(x[8 * q + 4], x[8 * q + 5]), pk2(x[8 * q + 6], x[8 * q + 7])};
            }
            LDS_WAIT(); asm volatile("" ::: "memory");
            f32x16 t1 = mmt<2>(Lm, TP, 32, 0, X11T, 40, 0, 0, zero16(), r, h);
#pragma unroll
            for (int g = 0; g < 4; ++g) *(LAS u32x2*)(T1T + r * 40 + 8 * g + 4 * h) = (u32x2){pk2(t1[4 * g], t1[4 * g + 1]), pk2(t1[4 * g + 2], t1[4 * g + 3])};
            LDS_WAIT(); asm volatile("" ::: "memory");
            f32x16 x21 = mmt<2>(TI, TP, 32, 32, T1T, 40, 0, 0, zero16(), r, h);
            store_rm(TI, 32, 0, x21, r, h);
        } else if (wave >= 4) {
            const int mi = (wave - 4) >> 1, ni = (wave - 4) & 1;
            f32x16 acc = mmt<4>(TL(T_VCM), TP, 32 * mi, 0, TL(T_MAK), TP, 32 * ni, 0, zero16(), r, h);
            store_rm(TL(T_G1), 32 * mi, 32 * ni, acc, r, h);
        }
        __syncthreads();
        {
            const int w4 = wave & 3, mi = w4 >> 1, ni = w4 & 1;
            if (wave < 4) { f32x16 acc = mmt<4>(TL(T_ACM), TP, 32 * mi, 0, TL(T_TINV), TP, 32 * ni, 0, zero16(), r, h); store_rm(TL(T_AP), 32 * mi, 32 * ni, acc, r, h); }
            else { f32x16 acc = mmt<4>(TL(T_G1), TP, 32 * mi, 0, TL(T_TINV), TP, 32 * ni, 0, zero16(), r, h); store_rm(TL(T_U0), 32 * mi, 32 * ni, acc, r, h); }
        }
        __syncthreads();
#pragma unroll
        for (int q = 0; q < 2; ++q) {
            const int id = 2 * wave + q, typ = id >> 2, xx = (id >> 1) & 1, yy = id & 1;
            if (typ == 0) {
                f32x16 acc = mmt<4>(TL(T_AP), TP, 32 * xx, 0, TL(T_MRB), TP, 32 * yy, 0, zero16(), r, h);
#pragma unroll
                for (int g = 0; g < 4; ++g) { const u32x2 w = *(const LAS u32x2*)(TL(T_RTM) + (32 * yy + r) * TP + 32 * xx + 8 * g + 4 * h);
                    acc[4 * g] += bflo(w.x); acc[4 * g + 1] += bfhi(w.x); acc[4 * g + 2] += bflo(w.y); acc[4 * g + 3] += bfhi(w.y); }
#pragma unroll
                for (int s = 0; s < 2; ++s) *(u32x4*)l3_slot(L3, tg0, hd * 64, (((xx * 2 + s) * 2 + yy) * 64 + lane) * 16) = pack8(acc, s);
            } else if (typ == 1) {
                f32x16 acc = mmt<4>(TL(T_U0), TP, 32 * xx, 0, TL(T_MRB), TP, 32 * yy, 0, zero16(), r, h);
                acc = mmt<4>(TL(T_VCM), TP, 32 * xx, 0, TL(T_MRK), TP, 32 * yy, 0, acc, r, h);
#pragma unroll
                for (int s = 0; s < 2; ++s) *(u32x4*)l3_slot(L3, tg0, 1024 + hd * 64, ((xx * 2 + yy) * 64 + lane) * 32 + 16 * s) = pack8(acc, s);
            } else if (typ == 2) {
                f32x16 acc = mmt<4>(TL(T_AP), TP, 32 * xx, 0, TL(T_BCM), TP, 32 * yy, 0, zero16(), r, h);
                const float pcc = pc[32 * yy + r];
#pragma unroll
                for (int e = 0; e < 16; ++e) acc[e] = (acc[e] + ((32 * xx + crow(e, h) == 32 * yy + r) ? 1.0f : 0.0f)) * pcc;
#pragma unroll
                for (int s = 0; s < 2; ++s) *(u32x4*)(MT + (size_t)unit * 4096 + (((yy * 2 + xx) * 2 + s) * 64 + lane) * 8) = pack8(acc, s);
            } else {
                f32x16 acc = mmt<4>(TL(T_BCM), TP, 32 * xx, 0, TL(T_U0), TP, 32 * yy, 0, zero16(), r, h);
                acc = mmt<4>(TL(T_KCM), TP, 32 * xx, 0, TL(T_VCM), TP, 32 * yy, 0, acc, r, h);
#pragma unroll
                for (int e = 0; e < 16; ++e) acc[e] *= pc[32 * xx + crow(e, h)];
#pragma unroll
                for (int s = 0; s < 2; ++s) *(u32x4*)(SA + (size_t)unit * 4096 + ((yy * 2 + xx) * 64 + lane) * 16 + 8 * s) = pack8(acc, s);
            }
        }
        __syncthreads();
        cur = nxt;
    }
#undef TL
}

struct PbSet { bf16x8 A[8]; u32x4 S[4]; };
__device__ __forceinline__ void pb_load(PbSet& d, const bf16_t* MT, const bf16_t* SA, int c, int lane) {
    const int cc = c < 64 ? c : 63;
    const char* mb = (const char*)MT + (size_t)cc * 8192; const char* sb = (const char*)SA + (size_t)cc * 8192;
    const unsigned lo16 = (unsigned)lane * 16u, lo32 = (unsigned)lane * 32u;
#pragma unroll
    for (int f = 0; f < 8; ++f) d.A[f] = *(const bf16x8*)(mb + lo16 + f * 1024);
#pragma unroll
    for (int q = 0; q < 4; ++q) d.S[q] = *(const u32x4*)(sb + lo32 + (q >> 1) * 2048 + 16 * (q & 1));
}
__device__ __forceinline__ void pb_step(const PbSet& d, f32x16 (&X)[2], bf16_t* SA, int c, int lane, const bool dry) {
    bf16x8 Bf[4];
#pragma unroll
    for (int kt = 0; kt < 2; ++kt)
#pragma unroll
        for (int s = 0; s < 2; ++s) { const u32x4 w = pack8(X[kt], s); Bf[kt * 2 + s] = __builtin_bit_cast(bf16x8, w); if (!dry) *(u32x4*)((char*)SA + (size_t)c * 8192 + (unsigned)lane * 16u + (kt * 2 + s) * 1024) = w; }
    f32x16 D[2];
#pragma unroll
    for (int ip = 0; ip < 2; ++ip) { unpack8(d.S[2 * ip], D[ip], 0); unpack8(d.S[2 * ip + 1], D[ip], 1);
#pragma unroll
        for (int ks = 0; ks < 4; ++ks) D[ip] = __builtin_amdgcn_mfma_f32_32x32x16_bf16(d.A[ip * 4 + ks], Bf[ks], D[ip], 0, 0, 0); }
    X[0] = D[0]; X[1] = D[1];
}
__device__ __forceinline__ void pass_b(Frame& F, int bh, int j, const bool dry) {
    const int lane = F.lane;
    const bf16_t* MT = (const bf16_t*)(F.ws + WS_MT) + (size_t)bh * 64 * 4096; bf16_t* SA = (bf16_t*)(F.ws + WS_SA) + (size_t)bh * 64 * 4096 + j * 2048;
    f32x16 X[2] = {zero16(), zero16()};
    PbSet s0, s1, s2;
    pb_load(s0, MT, SA, 0, lane); pb_load(s1, MT, SA, 1, lane);
    for (int c = 0; c < 63; c += 3) {
        pb_load(s2, MT, SA, c + 2, lane); pb_step(s0, X, SA, c, lane, dry);
        pb_load(s0, MT, SA, c + 3, lane); pb_step(s1, X, SA, c + 1, lane, dry);
        pb_load(s1, MT, SA, c + 4, lane); pb_step(s2, X, SA, c + 2, lane, dry);
    }
    pb_step(s0, X, SA, 63, lane, dry);
}

__device__ __forceinline__ void pass_c(Frame& F) {
    const int lane = F.lane, r = lane & 31, h = lane >> 5;
    const int gw = F.vcu * 8 + F.wave, NGW = F.G * 8;
    const bf16_t* P = (const bf16_t*)(F.ws + WS_P); unsigned char* L3 = F.ws + WS_L3; const bf16_t* SA = (const bf16_t*)(F.ws + WS_SA); const float* BON = (const float*)(F.ws + WS_BON);
    bf16_t* Y = (bf16_t*)(F.ws + WS_YCAT); const float* mix = F.in[I_MIX];
    for (int unit = gw; unit < 4096; unit += NGW) {
        const int b = unit >> 10, hd = (unit >> 6) & 15, ci = unit & 63, tg0 = b * SEQ + ci * 64;
        bf16x8 Af[8], Bf[8];
#pragma unroll
        for (int f = 0; f < 8; ++f) Af[f] = *(const bf16x8*)(SA + (size_t)unit * 4096 + (f * 64 + lane) * 8);
#pragma unroll
        for (int f = 0; f < 8; ++f) Bf[f] = *(const bf16x8*)l3_slot(L3, tg0, hd * 64, (f * 64 + lane) * 16);
        f32x16 acc[2][2];
#pragma unroll
        for (int j = 0; j < 2; ++j)
#pragma unroll
            for (int tt = 0; tt < 2; ++tt) {
#pragma unroll
                for (int s = 0; s < 2; ++s) unpack8(*(const u32x4*)l3_slot(L3, tg0, 1024 + hd * 64, ((j * 2 + tt) * 64 + lane) * 32 + 16 * s), acc[j][tt], s);
#pragma unroll
                for (int ks = 0; ks < 4; ++ks) acc[j][tt] = __builtin_amdgcn_mfma_f32_32x32x16_bf16(Af[j * 4 + ks], Bf[ks * 2 + tt], acc[j][tt], 0, 0, 0);
            }
#pragma unroll
        for (int tt = 0; tt < 2; ++tt) {
            const int tl = 32 * tt + r, tg = tg0 + tl;
            float sm = 0.f;
#pragma unroll
            for (int e = 0; e < 16; ++e) sm += acc[0][tt][e] + acc[1][tt][e];
            sm += __shfl_xor(sm, 32); const float mean = sm * (1.0f / 64.0f);
            float sq = 0.f;
#pragma unroll
            for (int e = 0; e < 16; ++e) { const float d0 = acc[0][tt][e] - mean, d1 = acc[1][tt][e] - mean; sq += d0 * d0 + d1 * d1; }
            sq += __shfl_xor(sq, 32); const float rstd = rsqrtf(sq * (1.0f / 64.0f) + GN_EPS);
            const float bon = BON[(size_t)tg * 16 + hd];
            const bool hp = (ci > 0) || (tl > 0);
            const bf16_t* prow = P + (size_t)tg * NP + PVR + hd * 64; const bf16_t* lrow = (const bf16_t*)L3 + (size_t)tg * NL + 2048 + hd * 64; bf16_t* yrow = Y + (size_t)tg * DM + 1024 + hd * 64;
#pragma unroll
            for (int j = 0; j < 2; ++j)
#pragma unroll
                for (int g = 0; g < 4; ++g) { const int v0 = 32 * j + 8 * g + 4 * h, ch = hd * 64 + v0;
                    const u32x2 cv = *(const u32x2*)(prow + v0); u32x2 pv = (u32x2){0u, 0u}; if (hp) pv = *(const u32x2*)(prow - NP + v0);
                    const u32x2 gg = *(const u32x2*)(lrow + v0);
                    const f32x4 mu = *(const f32x4*)(mix + 2112 + ch), lw = *(const f32x4*)(F.in[I_LNW] + ch), lb = *(const f32x4*)(F.in[I_LNB] + ch);
                    const float c0 = bflo(cv.x), c1 = bfhi(cv.x), c2 = bflo(cv.y), c3 = bfhi(cv.y);
                    const float v_0 = c0 + (bflo(pv.x) - c0) * mu.x, v_1 = c1 + (bfhi(pv.x) - c1) * mu.y, v_2 = c2 + (bflo(pv.y) - c2) * mu.z, v_3 = c3 + (bfhi(pv.y) - c3) * mu.w;
                    const float o0 = ((acc[j][tt][4 * g] - mean) * rstd * lw.x + lb.x + bon * v_0) * bflo(gg.x);
                    const float o1 = ((acc[j][tt][4 * g + 1] - mean) * rstd * lw.y + lb.y + bon * v_1) * bfhi(gg.x);
                    const float o2 = ((acc[j][tt][4 * g + 2] - mean) * rstd * lw.z + lb.z + bon * v_2) * bflo(gg.y);
                    const float o3 = ((acc[j][tt][4 * g + 3] - mean) * rstd * lw.w + lb.w + bon * v_3) * bfhi(gg.y);
                    *(u32x2*)(yrow + v0) = (u32x2){pk2(o0, o1), pk2(o2, o3)}; }
        }
    }
}
}


namespace att {
using s16x4 = __attribute__((ext_vector_type(4))) short;
constexpr int D = 128, NW = 8, QBLK = 32, KVBLK = 64;
constexpr float THRL = 8.0f * 1.4426950408889634f;
constexpr size_t SHM_V = KVBLK * D * 2, SHM_K = KVBLK * D * 2, SHM_ATTN = 2 * SHM_V + 2 * SHM_K + NW * 64 * 4;
static_assert(SHM_ATTN <= RING_BYTES, "attention LDS");
#define KSWZ(row, colB) ((row) * 256 + ((colB) ^ (((row) & 7) << 4)))
#define SBAR() __builtin_amdgcn_sched_barrier(0)
__device__ __forceinline__ int crow(int r, int hi) { return (r & 3) + 8 * (r >> 2) + 4 * hi; }
__device__ __forceinline__ unsigned cvtpk(float lo, float hi) { unsigned r; asm volatile("v_cvt_pk_bf16_f32 %0, %1, %2" : "=v"(r) : "v"(lo), "v"(hi)); return r; }
__device__ __forceinline__ void partialSM(f32x16& p0, f32x16& p1, const u32x2 mk, float& m_reg, float& mn, float& alpha) {
#pragma unroll
  for (int r = 0; r < 16; ++r) { const unsigned bit = 1u << ((r & 3) + 8 * (r >> 2)); p0[r] = (mk.x & bit) ? p0[r] : -INFINITY; p1[r] = (mk.y & bit) ? p1[r] : -INFINITY; }
  float pmax = p0[0];
#pragma unroll
  for (int r = 1; r < 16; ++r) pmax = fmaxf(pmax, p0[r]);
#pragma unroll
  for (int r = 0; r < 16; ++r) pmax = fmaxf(pmax, p1[r]);
  { auto rr = __builtin_amdgcn_permlane32_swap(__float_as_uint(pmax), __float_as_uint(pmax), false, false);
    pmax = fmaxf(__uint_as_float(rr[0]), __uint_as_float(rr[1])); }
  if (__builtin_expect(__all(pmax - m_reg <= THRL), 1)) { mn = m_reg; alpha = 1.f; }
  else { mn = fmaxf(m_reg, pmax); alpha = __builtin_amdgcn_exp2f(m_reg - mn); m_reg = mn; }
#pragma unroll
  for (int r = 0; r < 16; ++r) { p0[r] = __builtin_amdgcn_exp2f(p0[r] - mn); p1[r] = p1[r] - mn; }
}
__device__ __forceinline__ void finishSM(f32x16& p0, f32x16& p1, float alpha, float& l_reg, bf16x8& pa0, bf16x8& pa1, bf16x8& pa2, bf16x8& pa3) {
#pragma unroll
  for (int r = 0; r < 16; ++r) p1[r] = __builtin_amdgcn_exp2f(p1[r]);
  float ps = 0;
#pragma unroll
  for (int r = 0; r < 16; ++r) ps += p0[r];
#pragma unroll
  for (int r = 0; r < 16; ++r) ps += p1[r];
  { auto rr = __builtin_amdgcn_permlane32_swap(__float_as_uint(ps), __float_as_uint(ps), false, false);
    ps = __uint_as_float(rr[0]) + __uint_as_float(rr[1]); }
  l_reg = l_reg * alpha + ps;
#define PK4(P, BASE, OUT) do { unsigned a0 = cvtpk(P[BASE + 0], P[BASE + 1]), a1 = cvtpk(P[BASE + 2], P[BASE + 3]);   \
    unsigned b0 = cvtpk(P[BASE + 4], P[BASE + 5]), b1 = cvtpk(P[BASE + 6], P[BASE + 7]);                              \
    auto r0 = __builtin_amdgcn_permlane32_swap(a0, b0, false, false); auto r1 = __builtin_amdgcn_permlane32_swap(a1, b1, false, false); \
    u32x4 w = {r0[0], r1[0], r0[1], r1[1]}; OUT = __builtin_bit_cast(bf16x8, w); } while (0)
  PK4(p0, 0, pa0); PK4(p0, 8, pa1); PK4(p1, 0, pa2); PK4(p1, 8, pa3);
#undef PK4
}
__device__ __forceinline__ void qkt(f32x16& p0, f32x16& p1, const char* Ks, const bf16x8* qr, int r32, int hi) {
  p0 = f32x16{}; p1 = f32x16{};
#pragma unroll
  for (int d0 = 0; d0 < 8; ++d0) { int cb = (d0 * 16 + hi * 8) * 2;
    bf16x8 b0 = *reinterpret_cast<const bf16x8*>(Ks + KSWZ(r32, cb));
    bf16x8 b1 = *reinterpret_cast<const bf16x8*>(Ks + KSWZ(32 + r32, cb));
    p0 = __builtin_amdgcn_mfma_f32_32x32x16_bf16(b0, qr[d0], p0, 0, 0, 0);
    p1 = __builtin_amdgcn_mfma_f32_32x32x16_bf16(b1, qr[d0], p1, 0, 0, 0); }
}
__device__ __forceinline__ int v_st(int k, int c) { const int kk = (k & ~0xC) | ((k & 4) << 1) | ((k & 8) >> 1); return ((kk >> 3) * 4 + (c >> 5)) * 512 + ((kk & 7) * 32 + (c & 31)) * 2; }
__device__ __forceinline__ int v_rd_base(int lane) { return ((lane & 3) << 3) | (((lane >> 2) & 3) << 6) | (((lane >> 4) & 1) << 5) | (((lane >> 5) & 1) << 8); }
constexpr int v_rd_off(int d0, int ks, int half) { return d0 * 512 + ks * 4096 + half * 2048; }
template <int OFF> __device__ __forceinline__ s16x4 tr_read(int vb) { s16x4 r; asm volatile("ds_read_b64_tr_b16 %0, %1 offset:%2" : "=&v"(r) : "v"(vb), "i"(OFF) : "memory"); return r; }
template <int D0> __device__ __forceinline__ void pv_one(f32x16& od, int vb, bf16x8 pa0, bf16x8 pa1, bf16x8 pa2, bf16x8 pa3) {
  const s16x4 l0 = tr_read<v_rd_off(D0, 0, 0)>(vb), h0 = tr_read<v_rd_off(D0, 0, 1)>(vb), l1 = tr_read<v_rd_off(D0, 1, 0)>(vb), h1 = tr_read<v_rd_off(D0, 1, 1)>(vb);
  const s16x4 l2 = tr_read<v_rd_off(D0, 2, 0)>(vb), h2 = tr_read<v_rd_off(D0, 2, 1)>(vb), l3 = tr_read<v_rd_off(D0, 3, 0)>(vb), h3 = tr_read<v_rd_off(D0, 3, 1)>(vb);
  asm volatile("s_waitcnt lgkmcnt(0)" ::: "memory"); SBAR();
#define PK(L, H) (bf16x8){L[0], L[1], L[2], L[3], H[0], H[1], H[2], H[3]}
  od = __builtin_amdgcn_mfma_f32_32x32x16_bf16(pa0, PK(l0, h0), od, 0, 0, 0);
  od = __builtin_amdgcn_mfma_f32_32x32x16_bf16(pa1, PK(l1, h1), od, 0, 0, 0);
  od = __builtin_amdgcn_mfma_f32_32x32x16_bf16(pa2, PK(l2, h2), od, 0, 0, 0);
  od = __builtin_amdgcn_mfma_f32_32x32x16_bf16(pa3, PK(l3, h3), od, 0, 0, 0);
#undef PK
}
__device__ __forceinline__ void pv_d0(f32x16* o, int vb, bf16x8 pa0, bf16x8 pa1, bf16x8 pa2, bf16x8 pa3) {
  pv_one<0>(o[0], vb, pa0, pa1, pa2, pa3); pv_one<1>(o[1], vb, pa0, pa1, pa2, pa3); pv_one<2>(o[2], vb, pa0, pa1, pa2, pa3); pv_one<3>(o[3], vb, pa0, pa1, pa2, pa3);
}
__device__ __forceinline__ void attn_unit(const bf16_t* __restrict__ Qb, const bf16_t* __restrict__ Kh, const bf16_t* __restrict__ Vh, const unsigned* __restrict__ Mb,
                                          bf16_t* __restrict__ Ob, int seq, char* lds) {
  constexpr int LDQ = NP, LDK = NP, LDO = DM;
  int tid_ = threadIdx.x; asm volatile("" : "+v"(tid_));
  const int tid = tid_, wid = tid >> 6, lane = tid & 63, r32 = lane & 31, hi = lane >> 5;
  char* V_lds = lds; char* K_lds = lds + 2 * SHM_V;
  float* wsf = (float*)(lds + 2 * SHM_V + 2 * SHM_K) + wid * 64; float* li_l = wsf; float* al_l = wsf + 32;
  float m_reg = -1e30f, l_reg = 0; f32x16 o[4] = {}; bf16x8 qr[8];
  const bf16_t* Qw = Qb + (long)(wid * QBLK + r32) * LDQ + hi * 8;
#pragma unroll
  for (int d0 = 0; d0 < 8; ++d0) qr[d0] = *reinterpret_cast<const bf16x8*>(Qw + d0 * 16);
  const unsigned* Mw = Mb + (long)(wid * QBLK + r32) * 128;
  const int sh = 4 * hi;
  const int sr = tid >> 4, sc = (tid & 15) * 8, vst0 = v_st(sr, sc), vst1 = v_st(32 + sr, sc);
  const int vb0 = (int)(uintptr_t)V_lds + v_rd_base(lane);
  struct { bf16x8 vs0, vs1, ks0, ks1; } sr_[2];
#define SLOAD(i, k0) do { sr_[i].vs0 = *(const bf16x8*)(&Vh[(long)((k0) + sr) * LDK + sc]); sr_[i].vs1 = *(const bf16x8*)(&Vh[(long)((k0) + 32 + sr) * LDK + sc]); \
    sr_[i].ks0 = *(const bf16x8*)(&Kh[(long)((k0) + sr) * LDK + sc]); sr_[i].ks1 = *(const bf16x8*)(&Kh[(long)((k0) + 32 + sr) * LDK + sc]); } while (0)
#define SWRITE(b, i) do { *(bf16x8*)(V_lds + (b) * SHM_V + vst0) = sr_[i].vs0;          \
    *(bf16x8*)(V_lds + (b) * SHM_V + vst1) = sr_[i].vs1; int kc = sc * 2;               \
    *(bf16x8*)(K_lds + (b) * SHM_K + KSWZ(sr, kc)) = sr_[i].ks0;                       \
    *(bf16x8*)(K_lds + (b) * SHM_K + KSWZ(32 + sr, kc)) = sr_[i].ks1; } while (0)
#define SWAIT() asm volatile("s_waitcnt vmcnt(4)" ::: "memory")
#define RESC(a) do { if (__any((a) < 1.f)) { if (hi == 0) al_l[r32] = (a); asm volatile("s_waitcnt lgkmcnt(0)" ::: "memory"); \
    _Pragma("unroll") for (int d = 0; d < 4; ++d) _Pragma("unroll") for (int r = 0; r < 16; ++r) o[d][r] *= al_l[crow(r, hi)]; } } while (0)
#define MLOAD(j) ({ u32x2 _m = *(const u32x2*)(Mw + 2 * (j)); _m.x >>= sh; _m.y >>= sh; _m; })
  f32x16 pA0, pA1, pB0, pB1; float mnA, mnB, alA, alB; bf16x8 pa0, pa1, pa2, pa3; const int NT = seq / KVBLK;
  constexpr int SE = 0, SO = 1;
  u32x2 mkA = MLOAD(0), mkB = MLOAD(1);
  SLOAD(SE, 0); asm volatile("s_waitcnt vmcnt(0)" ::: "memory"); SWRITE(0, SE); __syncthreads();
  qkt(pA0, pA1, K_lds, qr, r32, hi); partialSM(pA0, pA1, mkA, m_reg, mnA, alA);
  SLOAD(SO, KVBLK); if (2 < NT) SLOAD(SE, 2 * KVBLK);
  SWAIT(); SWRITE(1, SO); __syncthreads();
  for (int j = 1; j + 1 < NT; j += 2) {
    mkA = MLOAD(j + 1);
    SBAR(); qkt(pB0, pB1, K_lds + SHM_K, qr, r32, hi);
    finishSM(pA0, pA1, alA, l_reg, pa0, pa1, pa2, pa3); SBAR();
    SLOAD(SO, (j + 2) * KVBLK); SBAR();
    pv_d0(o, vb0, pa0, pa1, pa2, pa3); partialSM(pB0, pB1, mkB, m_reg, mnB, alB);
    __syncthreads(); SWAIT(); SWRITE(0, SE);
    RESC(alB); __syncthreads();
    mkB = MLOAD(j + 2);
    SBAR(); qkt(pA0, pA1, K_lds, qr, r32, hi);
    finishSM(pB0, pB1, alB, l_reg, pa0, pa1, pa2, pa3); SBAR();
    if (j + 3 < NT) SLOAD(SE, (j + 3) * KVBLK); SBAR();
    pv_d0(o, vb0 + (int)SHM_V, pa0, pa1, pa2, pa3); partialSM(pA0, pA1, mkA, m_reg, mnA, alA);
    __syncthreads(); SWAIT(); SWRITE(1, SO);
    RESC(alA); __syncthreads();
  }
  SBAR(); qkt(pB0, pB1, K_lds + SHM_K, qr, r32, hi);
  finishSM(pA0, pA1, alA, l_reg, pa0, pa1, pa2, pa3); SBAR();
  pv_d0(o, vb0, pa0, pa1, pa2, pa3); partialSM(pB0, pB1, mkB, m_reg, mnB, alB);
  __syncthreads(); RESC(alB);
  finishSM(pB0, pB1, alB, l_reg, pa0, pa1, pa2, pa3); SBAR();
  pv_d0(o, vb0 + (int)SHM_V, pa0, pa1, pa2, pa3);
  if (hi == 0) li_l[r32] = l_reg; asm volatile("s_waitcnt lgkmcnt(0)" ::: "memory");
  float rli[16];
#pragma unroll
  for (int r = 0; r < 16; ++r) rli[r] = __builtin_amdgcn_rcpf(li_l[crow(r, hi)]);
  bf16_t* Ow = Ob + (long)(wid * QBLK) * LDO;
#pragma unroll
  for (int r = 0; r < 16; ++r) { int orow = crow(r, hi);
#pragma unroll
    for (int d0 = 0; d0 < 4; ++d0) Ow[(long)orow * LDO + d0 * 32 + r32] = (bf16_t)f2bf(o[d0][r] * rli[r]); }
  __syncthreads();
#undef SLOAD
#undef SWRITE
#undef SWAIT
#undef RESC
#undef MLOAD
}
__device__ __forceinline__ void attn_phase(Frame& F) {
  const bf16_t* P = (const bf16_t*)(F.ws + WS_P); const unsigned* MSK = (const unsigned*)(F.ws + WS_MSK); bf16_t* Y = (bf16_t*)(F.ws + WS_YCAT);
  for (int u = F.vcu; u < 512; u += F.G) {
    const int pairi = u & 255, second = u >> 8; const int bh = pairi >> 3, ql = pairi & 7; const int qb = second ? ql : 15 - ql;
    const int b = bh >> 3, hd = bh & 7; const long t0 = (long)b * SEQ + qb * 256;
    attn_unit(P + t0 * NP + PQ + hd * 128, P + (long)b * SEQ * NP + PK + hd * 128, P + (long)b * SEQ * NP + PV + hd * 128, MSK + t0 * 128, Y + t0 * DM + hd * 128, (qb + 1) * 256, (char*)F.ldsg);
  }
}
#undef KSWZ
#undef SBAR
}

__device__ __forceinline__ void phase_idx_passb(Frame& F, const bool dry, const int qw) {
    const int npb = (F.G >= 64) ? 16 : 0;
    if (npb) { if (F.vcu < npb) { const int ch = F.vcu * 8 + F.wave; rw::pass_b(F, ch >> 1, ch & 1, dry); return; } }
    else { for (int ch = F.vcu * 8 + F.wave; ch < 128; ch += F.G * 8) rw::pass_b(F, ch >> 1, ch & 1, dry); __syncthreads(); }
    volatile LAS int* qs = (volatile LAS int*)(F.lds + MISC_OFF + 64);
    for (;;) {
        if (F.tid == 0) qs[0] = (int)atomicAdd(F.ctl + CW_QIDX + 64 * qw, 1u);
        __syncthreads();
        const int u = qs[0];
        __syncthreads();
        if (u >= 1024) break;
        idx_unit(F, u);
    }
}

struct RouteRec { int cls, pos; float g_lo, g_hi, rstd; int pad0, pad1, pad2; };
__device__ __forceinline__ void phase7(Frame& F, const bool dry) {
    const int gw = F.vcu * 8 + F.wave, NGW = F.G * 8, lane = F.lane;
    { int* rowtok = (int*)(F.ws + WS_ROWTOK); for (int i = gw * 64 + lane; i < MPAD; i += NGW * 64) rowtok[i] = -1; }
    { LAS float* scr = (LAS float*)(F.lds + F.wave * 16384);
      bf16_t* WGU = (bf16_t*)(F.ws + WS_WGU); bf16_t* WDN = (bf16_t*)(F.ws + WS_WDN);
      constexpr int IG = (DM / 64) * (512 / 32), ID = (512 / 64) * (DM / 32);
      for (int it = gw; it < 16 * (2 * IG + ID); it += NGW) { const int e = it / (2 * IG + ID); int r = it % (2 * IG + ID);
          if (r < IG) transpose_item<2>(F.in[I_WEG] + (size_t)e * DM * 512, 512, WGU + (size_t)e * 1024 * DM, DM, scr, r / 16, r % 16, lane);
          else if (r < 2 * IG) { r -= IG; transpose_item<3>(F.in[I_WEU] + (size_t)e * DM * 512, 512, WGU + (size_t)e * 1024 * DM, DM, scr, r / 16, r % 16, lane); }
          else { r -= 2 * IG; transpose_item<0>(F.in[I_WED] + (size_t)e * 512 * DM, DM, WDN + (size_t)e * DM * 512, 512, scr, r / 64, r % 64, lane); } } }
    const float* x1 = F.out; const f32x4* wrt = (const f32x4*)(F.ws + WS_WRT);
    RouteRec* rr = (RouteRec*)(F.ws + WS_ROUTE); unsigned* cnt = F.ctl + CW_CNT;
    float brg[4], bre[16];
#pragma unroll
    for (int o = 0; o < 4; ++o) brg[o] = F.in[I_BRG][o];
#pragma unroll
    for (int o = 0; o < 16; ++o) bre[o] = F.in[I_BRE][o];
    for (int tp = gw; tp < T / 2; tp += NGW) {
        float ssq[2] = {0.f, 0.f};
        float lg[2][20];
#pragma unroll
        for (int o = 0; o < 20; ++o) { lg[0][o] = 0.f; lg[1][o] = 0.f; }
        const f32x4* xr0 = (const f32x4*)(x1 + (size_t)(2 * tp) * DM) + lane; const f32x4* xr1 = xr0 + DM / 4;
#pragma unroll 2
        for (int j = 0; j < 8; ++j) {
            const f32x4 v0 = xr0[64 * j], v1 = xr1[64 * j];
            ssq[0] += (v0.x * v0.x + v0.y * v0.y) + (v0.z * v0.z + v0.w * v0.w); ssq[1] += (v1.x * v1.x + v1.y * v1.y) + (v1.z * v1.z + v1.w * v1.w);
#pragma unroll
            for (int o = 0; o < 20; ++o) { const f32x4 w = wrt[o * (DM / 4) + 64 * j + lane];
                lg[0][o] += (v0.x * w.x + v0.y * w.y) + (v0.z * w.z + v0.w * w.w);
                lg[1][o] += (v1.x * w.x + v1.y * w.y) + (v1.z * w.z + v1.w * w.w); }
        }
#pragma unroll
        for (int u = 0; u < 2; ++u) {
            const int t = 2 * tp + u;
            const float rstd = rsqrtf(wave_sum(ssq[u]) * (1.f / DM) + NORM_EPS);
#pragma unroll
            for (int o = 0; o < 20; ++o) lg[u][o] = wave_sum(lg[u][o]) * rstd;
            float gl[4]; float gm = -INFINITY;
#pragma unroll
            for (int o = 0; o < 4; ++o) { gl[o] = lg[u][o] + brg[o]; gm = fmaxf(gm, gl[o]); }
            float gs = 0.f; int gsel = 0; float gbest = -INFINITY;
#pragma unroll
            for (int o = 0; o < 4; ++o) { gs += __expf(gl[o] - gm); if (gl[o] > gbest) { gbest = gl[o]; gsel = o; } }
            const float pgrp = __expf(gbest - gm) / gs;
            float el[4]; float em = -INFINITY;
#pragma unroll
            for (int q = 0; q < 4; ++q) { float vsel = 0.f;
#pragma unroll
                for (int g2 = 0; g2 < 4; ++g2) vsel = (gsel == g2) ? lg[u][4 + 4 * g2 + q] + bre[4 * g2 + q] : vsel;
                el[q] = vsel; em = fmaxf(em, vsel); }
            int i1 = 0; float b1 = -INFINITY;
#pragma unroll
            for (int q = 0; q < 4; ++q) if (el[q] > b1) { b1 = el[q]; i1 = q; }
            int i2 = 0; float b2 = -INFINITY;
#pragma unroll
            for (int q = 0; q < 4; ++q) if (q != i1 && el[q] > b2) { b2 = el[q]; i2 = q; }
            const float p1 = __expf(b1 - em), p2 = __expf(b2 - em); const float inv = 1.0f / (p1 + p2);
            const float gw1 = pgrp * p1 * inv, gw2 = pgrp * p2 * inv;
            const int elo = i1 < i2 ? i1 : i2, ehi = i1 < i2 ? i2 : i1; const float glo = i1 < i2 ? gw1 : gw2, ghi = i1 < i2 ? gw2 : gw1;
            const int pair = (elo == 0) ? (ehi - 1) : (elo == 1 ? ehi + 1 : 5);
            const int cls = gsel * 6 + pair;
            if (lane == 0 && !dry) { const unsigned pos = atomicAdd(&cnt[cls], 1u); RouteRec r; r.cls = cls; r.pos = (int)pos; r.g_lo = glo; r.g_hi = ghi; r.rstd = rstd; r.pad0 = r.pad1 = r.pad2 = 0; rr[t] = r; }
        }
    }
}

__device__ __forceinline__ void class_bases(Frame& F, volatile LAS int* tb) {
    if (F.tid == 0) { int acc = 0; for (int c = 0; c < NCLS; ++c) { tb[c] = acc; const int n = (int)__hip_atomic_load(F.ctl + CW_CNT + c, __ATOMIC_RELAXED, __HIP_MEMORY_SCOPE_AGENT); acc += (n + 255) & ~255; } tb[NCLS] = acc; }
    __syncthreads();
}

__device__ __forceinline__ void phase8(Frame& F) {
    const int gw = F.vcu * 8 + F.wave, NGW = F.G * 8, lane = F.lane;
    volatile LAS int* tb = (volatile LAS int*)(F.lds + MISC_OFF + 128);
    class_bases(F, tb);
    const float* x1 = F.out; const float* gf = F.in[I_GFFN];
    const RouteRec* rr = (const RouteRec*)(F.ws + WS_ROUTE); int* rowtok = (int*)(F.ws + WS_ROWTOK); float* gates = (float*)(F.ws + WS_ROWTOK + 128 * 1024);
    bf16_t* H2S = (bf16_t*)(F.ws + WS_H2S);
    f32x4 gv[8];
#pragma unroll
    for (int j = 0; j < 8; ++j) gv[j] = ((const f32x4*)gf)[64 * j + lane];
    for (int t = gw; t < T; t += NGW) {
        const RouteRec r = rr[t]; const int row = tb[r.cls] + r.pos;
        const f32x4* xr = (const f32x4*)(x1 + (size_t)t * DM) + lane; u32x2* o = (u32x2*)(H2S + (size_t)row * DM) + lane;
#pragma unroll
        for (int j = 0; j < 8; ++j) { const f32x4 v = xr[64 * j]; u32x2 w; w.x = pk2(v.x * r.rstd * gv[j].x, v.y * r.rstd * gv[j].y); w.y = pk2(v.z * r.rstd * gv[j].z, v.w * r.rstd * gv[j].w); o[64 * j] = w; }
        if (lane == 0) { rowtok[row] = t; gates[2 * row] = r.g_lo; gates[2 * row + 1] = r.g_hi; }
    }
    for (int idx = gw; idx < NCLS * 256; idx += NGW) { const int c = idx >> 8, off = idx & 255; const int n = (int)__hip_atomic_load(F.ctl + CW_CNT + c, __ATOMIC_RELAXED, __HIP_MEMORY_SCOPE_AGENT);
        const int row = tb[c] + n + off;
        if (row < tb[c + 1]) { u32x2* o = (u32x2*)(H2S + (size_t)row * DM) + lane;
#pragma unroll
            for (int j = 0; j < 8; ++j) o[64 * j] = (u32x2){0u, 0u};
            if (lane == 0) { gates[2 * row] = 0.f; gates[2 * row + 1] = 0.f; } } }
}

__device__ __forceinline__ int class_of_tile(volatile LAS int* tb, int rt) { int c = 0; const int r0 = rt * 256; for (int k = 1; k < NCLS; ++k) c = (r0 >= tb[k]) ? k : c; return c; }
__device__ __forceinline__ int class_expert(int cls, int half) { const int g = cls / 6, p = cls % 6; const int elo = p < 3 ? 0 : (p < 5 ? 1 : 2); const int ehi = p < 3 ? p + 1 : (p < 5 ? p - 1 : 3); return 4 * g + (half ? ehi : elo); }
struct Moe1Sched {
    volatile LAS int* tb; const char* A; const char* B; int G, c, nu;
    __device__ bool seg(int i, pg8::Seg& s) const { const int L = i * G + c; if (L >= nu) return false; const int rt = L >> 3, pn = L & 7; const int cls = class_of_tile(tb, rt); const int e = class_expert(cls, pn >> 2);
        s.A = A + (size_t)rt * 256 * DM * 2; s.B = B + ((size_t)e * 1024 + (pn & 3) * 256) * DM * 2; s.u.pm = rt; s.u.pn = pn; s.u.aux = 0; s.last = 1; return true; }
};
struct Moe2Sched {
    volatile LAS int* tb; const char* A; const char* B; int G, c, nu;
    __device__ bool seg(int i, pg8::Seg& s) const { const int ui = i >> 1, half = i & 1; const int L = ui * G + c; if (L >= nu) return false; const int rt = L >> 3, pn = L & 7; const int cls = class_of_tile(tb, rt); const int e = class_expert(cls, half);
        s.A = A + ((size_t)rt * 256 * 1024 + half * 512) * 2; s.B = B + ((size_t)e * DM + pn * 256) * 512 * 2; s.u.pm = rt; s.u.pn = pn; s.u.aux = 0; s.last = half; return true; }
};

constexpr int NPHASE = 12;
__global__ void __launch_bounds__(512, 2) fwd_kernel(Args args) {
    extern __shared__ __attribute__((aligned(16))) unsigned char lds_raw[];
    Frame F;
    F.lds = (LAS unsigned char*)lds_raw; F.ldsg = lds_raw;
    F.tid = threadIdx.x; F.lane = F.tid & 63; F.wave = __builtin_amdgcn_readfirstlane(F.tid >> 6);
    F.G = gridDim.x; { const int bx = blockIdx.x; F.vcu = (F.G % 8 == 0) ? (bx % 8) * (F.G / 8) + bx / 8 : bx; }
    F.in = args.in; F.out = args.out; F.ws = args.ws; F.ctl = (unsigned*)(args.ws + WS_CTL);
    volatile LAS unsigned* MISC = (volatile LAS unsigned*)(F.lds + MISC_OFF);
    for (int u = F.tid; u < (LDS_BYTES - LDSCTL_OFF) / 4; u += 512) ((LAS unsigned*)(F.lds + LDSCTL_OFF))[u] = 0u;
    __syncthreads();
    const int lo = args.ph_lo, hi = args.ph_hi;
    const bool DRY_T = (args.ph_hi != 999), DRY_F = (args.ph_hi == 999);
    const bool multi = (hi - lo) > 1;
    XcdBarrier bar; bar.bar = F.ctl + CW_BAR; bar.x = 0; bar.st = nullptr;
    if (multi) bar = xcd_barrier_post(F.ctl + CW_BAR, MISC + 8);
#ifndef PH_MASK
#define PH_MASK 0xfff
#endif
#define IN(k) (((PH_MASK >> (k)) & 1) && lo <= (k) && (k) < hi)
#define SEAM(k) do { if (IN(k) && IN((k) + 1)) xcd_barrier(bar); } while (0)
#ifndef DUP_MASK
#define DUP_MASK 0
#endif
    unsigned char* ws = args.ws;
    bf16_t* P = (bf16_t*)(ws + WS_P);

    if (IN(0)) { phase0(F); SEAM(0); }
    if (IN(1)) {
        pg8::PlainSched S; S.init((const bf16_t*)(ws + WS_HN), (const bf16_t*)(ws + WS_WIN), T, NP, DM, DM, F.G, (int)blockIdx.x);
        pg8::EpiBf16 E{P, NP};
        pg8::gemm_phase<pg8::EpiBf16, pg8::PlainSched, true>(F.lds, DM, DM, DM / 64, S, E);
        SEAM(1);
    }
    if (IN(2)) { if ((DUP_MASK >> 2) & 1) { phase2(F, DRY_T); if (multi) xcd_barrier(bar); } phase2(F, DRY_F); SEAM(2); }
    if (IN(3)) {
        pg8::PlainSched S; S.init((const bf16_t*)(ws + WS_ALORA), (const bf16_t*)(ws + WS_WLORA), T, NL, KL, KL, F.G, (int)blockIdx.x);
        pg8::EpiLora E{(bf16_t*)(ws + WS_L3), F.in[I_W0], F.in[I_A0]};
        if ((DUP_MASK >> 3) & 1) { pg8::gemm_phase<pg8::EpiLora, pg8::PlainSched, true>(F.lds, KL, KL, KL / 64, S, E); if (multi) xcd_barrier(bar); }
        pg8::gemm_phase<pg8::EpiLora, pg8::PlainSched, true>(F.lds, KL, KL, KL / 64, S, E);
        SEAM(3);
    }
    if (IN(4)) { rw::pass_a(F); SEAM(4); }
    if (IN(5)) { if ((DUP_MASK >> 5) & 1) { phase_idx_passb(F, DRY_T, 1); if (multi) xcd_barrier(bar); } phase_idx_passb(F, DRY_F, 0); SEAM(5); }
    if (IN(6)) { att::attn_phase(F); rw::pass_c(F); SEAM(6); }
    if (IN(7)) {
        pg8::PlainSched S; S.init((const bf16_t*)(ws + WS_YCAT), (const bf16_t*)(ws + WS_WOUT), T, DM, DM, DM, F.G, (int)blockIdx.x);
        pg8::EpiResF32 E{F.in[I_X], F.out, DM};
        pg8::gemm_phase<pg8::EpiResF32, pg8::PlainSched, true>(F.lds, DM, DM, DM / 64, S, E);
        SEAM(7);
    }
    if (IN(8)) { if ((DUP_MASK >> 8) & 1) { phase7(F, DRY_T); if (multi) xcd_barrier(bar); } phase7(F, DRY_F); SEAM(8); }
    if (IN(9)) { if ((DUP_MASK >> 9) & 1) { phase8(F); if (multi) xcd_barrier(bar); } phase8(F); SEAM(9); }
    if (IN(10)) {
        volatile LAS int* tb = (volatile LAS int*)(F.lds + MISC_OFF + 128);
        class_bases(F, tb);
        Moe1Sched S; S.tb = tb; S.A = (const char*)(ws + WS_H2S); S.B = (const char*)(ws + WS_WGU); S.G = F.G; S.c = (int)blockIdx.x; S.nu = (tb[NCLS] >> 8) * 8;
        pg8::EpiMoe1 E{(bf16_t*)(ws + WS_HS), (const float*)(ws + WS_ROWTOK + 128 * 1024)};
        pg8::gemm_phase<pg8::EpiMoe1, Moe1Sched, true>(F.lds, DM, DM, DM / 64, S, E);
        SEAM(10);
    }
    if (IN(11)) {
        volatile LAS int* tb = (volatile LAS int*)(F.lds + MISC_OFF + 128);
        class_bases(F, tb);
        Moe2Sched S; S.tb = tb; S.A = (const char*)(ws + WS_HS); S.B = (const char*)(ws + WS_WDN); S.G = F.G; S.c = (int)blockIdx.x; S.nu = (tb[NCLS] >> 8) * 8;
        if ((DUP_MASK >> 11) & 1) { pg8::EpiMoe2 E0{F.out, (const int*)(ws + WS_ROWTOK), DRY_T ? 1 : 0}; pg8::gemm_phase<pg8::EpiMoe2, Moe2Sched, true>(F.lds, 1024, 512, 512 / 64, S, E0); if (multi) xcd_barrier(bar); }
        pg8::EpiMoe2 E{F.out, (const int*)(ws + WS_ROWTOK), DRY_F ? 1 : 0};
        pg8::gemm_phase<pg8::EpiMoe2, Moe2Sched, true>(F.lds, 1024, 512, 512 / 64, S, E);
    }
#undef IN
#undef SEAM
}

extern "C" void kernel_launch(void* const* d_in, const int* in_sizes, int n_in, void* d_out, int out_size, void* d_ws, size_t ws_size, hipStream_t stream) {
    static int grid = 0;
    if (grid == 0) {
        if (n_in != 25 || in_sizes[0] != T * DM || out_size != T * DM || ws_size < WS_END) { fprintf(stderr, "kernel_launch: unexpected shapes (n_in %d, in0 %d, out %d, ws %zu)\n", n_in, n_in > 0 ? in_sizes[0] : -1, out_size, ws_size); grid = -1; return; }
        int dev = 0, cus = 0, per_cu = 0;
        if (hipGetDevice(&dev) != hipSuccess || hipDeviceGetAttribute(&cus, hipDeviceAttributeMultiprocessorCount, dev) != hipSuccess) { grid = -1; return; }
        if (hipFuncSetAttribute((const void*)fwd_kernel, hipFuncAttributeMaxDynamicSharedMemorySize, LDS_BYTES) != hipSuccess) { fprintf(stderr, "kernel_launch: hipFuncSetAttribute failed\n"); grid = -1; return; }
        if (hipOccupancyMaxActiveBlocksPerMultiprocessor(&per_cu, (const void*)fwd_kernel, 512, LDS_BYTES) != hipSuccess || per_cu < 1) { fprintf(stderr, "kernel_launch: occupancy query says %d blocks per CU\n", per_cu); (void)hipGetLastError(); grid = -1; return; }
        grid = cus;
    }
    if (grid < 0) return;
    (void)hipMemsetAsync((char*)d_ws + WS_CTL, 0, CTL_ZERO_BYTES, stream);
    Args a{};
    for (int i = 0; i < 25; ++i) a.in[i] = (const float*)d_in[i];
    a.out = (float*)d_out; a.ws = (unsigned char*)d_ws;
#if MK_SINGLE
    a.ph_lo = 0; a.ph_hi = NPHASE;
    void* kargs[] = {&a};
    hipError_t e = hipLaunchCooperativeKernel((const void*)fwd_kernel, dim3(grid), dim3(512), kargs, LDS_BYTES, stream);
    if (e != hipSuccess) fprintf(stderr, "kernel_launch: cooperative launch failed: %s (grid %d)\n", hipGetErrorString(e), grid);
#else
    for (int p = 0; p < NPHASE; ++p) { a.ph_lo = p; a.ph_hi = p + 1; hipLaunchKernelGGL(fwd_kernel, dim3(grid), dim3(512), LDS_BYTES, stream, a); }
#endif
}
```

```cpp
#include <hip/hip_runtime.h>
#include <hip/hip_cooperative_groups.h>
#include <cstdio>
#include <cstdint>
#include <cmath>

#ifndef MK_SINGLE
#define MK_SINGLE 1
#endif

#define GAS __attribute__((address_space(1)))
#define LAS __attribute__((address_space(3)))
typedef unsigned short bf16_t;
typedef short bf16x8 __attribute__((ext_vector_type(8)));
typedef float f32x4 __attribute__((ext_vector_type(4)));
typedef float f32x16 __attribute__((ext_vector_type(16)));
typedef float f32x2 __attribute__((ext_vector_type(2)));
typedef unsigned u32x4 __attribute__((ext_vector_type(4)));
typedef unsigned u32x2 __attribute__((ext_vector_type(2)));

constexpr int BATCH = 4, SEQ = 4096, DM = 2048, T = BATCH * SEQ;
constexpr int NP = 7680;
constexpr int PQ = 0, PK = 1024, PV = 2048, PQI = 3072, PKI = 4096, PWI = 4160, PDW = 4224, PDA = 4288, PR = 4352, PKR = 5376, PVR = 6400, PDG = 7424;
constexpr int IN_COLS = 7536, DSA_COLS = 4176;
constexpr int KL = 384, NL = 3072;
constexpr int MPAD = 22528;
constexpr int NCLS = 24;
constexpr float NORM_EPS = 1e-6f, GN_EPS = 64e-5f;
constexpr float QSCALE = 0.08838834764831845f * 1.4426950408889634f;

constexpr size_t MiB = 1u << 20;
constexpr size_t WS_CTL = 0, CTL_ZERO_BYTES = 32 * 1024;
constexpr size_t WS_WLORA = 1 * MiB;
constexpr size_t WS_WOUT = 4 * MiB;
constexpr size_t WS_MSK = 12 * MiB;
constexpr size_t WS_KI = 20 * MiB;
constexpr size_t WS_ROUTE = 22 * MiB;
constexpr size_t WS_ROWTOK = 23 * MiB;
constexpr size_t WS_WRT = 23 * MiB + 512 * 1024;
constexpr size_t WS_ALORA = 24 * MiB;
constexpr size_t WS_WIN = 36 * MiB;
constexpr size_t WS_HN = 66 * MiB;
constexpr size_t WS_YCAT = WS_HN;
constexpr size_t WS_L3 = 130 * MiB;
constexpr size_t WS_P = 226 * MiB;
constexpr size_t WS_H2S = 226 * MiB;
constexpr size_t WS_HS = 314 * MiB;
constexpr size_t WS_WGU = 358 * MiB;
constexpr size_t WS_WDN = 422 * MiB;
constexpr size_t WS_MT = 24 * MiB;
constexpr size_t WS_BON = 56 * MiB;
constexpr size_t WS_SA = 466 * MiB;
constexpr size_t WS_END = 498 * MiB;
constexpr int CW_CNT = 64;
constexpr int CW_BAR = 4096;

constexpr int RING_BYTES = 131072;
constexpr int LDSCTL_OFF = RING_BYTES, MISC_OFF = LDSCTL_OFF + 320;
constexpr int LDS_BYTES = 147456;

#define LDS_WAIT() asm volatile("s_waitcnt lgkmcnt(0)" ::: "memory")
#define VM_WAIT() asm volatile("s_waitcnt vmcnt(0)" ::: "memory")
__device__ __forceinline__ unsigned f2bf(float f) { unsigned u = __builtin_bit_cast(unsigned, f); return (u + 0x7fffu + ((u >> 16) & 1u)) >> 16; }
__device__ __forceinline__ unsigned pk2(float lo, float hi) { return f2bf(lo) | (f2bf(hi) << 16); }
__device__ __forceinline__ float bf2f(unsigned short h) { return __builtin_bit_cast(float, (unsigned)h << 16); }
__device__ __forceinline__ float bflo(unsigned w) { return __builtin_bit_cast(float, w << 16); }
__device__ __forceinline__ float bfhi(unsigned w) { return __builtin_bit_cast(float, w & 0xffff0000u); }
#define DPP_ADD(v, ctrl, rm) (v) += __builtin_bit_cast(float, __builtin_amdgcn_update_dpp(0, __builtin_bit_cast(int, (v)), (ctrl), (rm), 0xF, false))
__device__ __forceinline__ float row_sum16(float v) {
    DPP_ADD(v, 0xB1, 0xF); DPP_ADD(v, 0x4E, 0xF); DPP_ADD(v, 0x141, 0xF); DPP_ADD(v, 0x140, 0xF); return v;
}
__device__ __forceinline__ float wave_sum(float v) {
    v = row_sum16(v); DPP_ADD(v, 0x142, 0xA); DPP_ADD(v, 0x143, 0xC);
    return __builtin_bit_cast(float, __builtin_amdgcn_readlane(__builtin_bit_cast(int, v), 63));
}
__device__ __forceinline__ float half_sum(float v) {
    v = row_sum16(v); DPP_ADD(v, 0x142, 0xA);
    const float lo = __builtin_bit_cast(float, __builtin_amdgcn_readlane(__builtin_bit_cast(int, v), 31)), hi = __builtin_bit_cast(float, __builtin_amdgcn_readlane(__builtin_bit_cast(int, v), 63));
    return (threadIdx.x & 32) ? hi : lo;
}
__device__ __forceinline__ float sigmoidf_(float x) { return 1.0f / (1.0f + __expf(-x)); }

namespace pg8 {
constexpr int BM = 256, BK = 64, HALF = 128, HTB = HALF * BK * 2, STAGE_BYTES = 8 * HTB, NXCD = 8, WGM = 8;
__host__ __device__ __forceinline__ int lds_byte(int r, int c) { const int st = (r >> 4) * 2 + (c >> 5), rr = r & 15, cc = c & 31, ob = rr * 64 + cc * 2; return st * 1024 + (ob ^ (((ob >> 9) & 1) << 5)); }
__host__ __device__ __forceinline__ void stage_rc(int b, int& R, int& C) { const int st = b / 1024, sb = b % 1024, swz = sb ^ (((sb >> 9) & 1) << 5); R = (st >> 1) * 16 + swz / 64; C = (st & 1) * 32 + (swz % 64) / 2; }
__host__ __device__ __forceinline__ int perm32(int rho) { const int n = rho >> 4, i = rho & 15; return 8 * (i >> 2) + 4 * n + (i & 3); }

struct Unit { int pm, pn, aux; };
struct Seg { const char* A; const char* B; Unit u; int last; };

struct TileOrder {
    int nM, nN, nwg, G, c;
    __device__ void init(int nM_, int nN_, int G_, int c_) { nM = nM_; nN = nN_; nwg = nM * nN; G = G_; c = c_; }
    __device__ bool next(int i, int& pm, int& pn) const {
        const long L = (long)i * G + c; if (L >= nwg) return false;
        int wgid = (int)L; { const int q = nwg / NXCD, r = nwg % NXCD, xcd = wgid % NXCD, off = wgid / NXCD; wgid = (xcd < r ? xcd * (q + 1) : r * (q + 1) + (xcd - r) * q) + off; }
        const int nig = WGM * nN, gid = wgid / nig, fm = gid * WGM, gsz = (nM - fm) < WGM ? (nM - fm) : WGM;
        pm = fm + ((wgid % nig) % gsz); pn = (wgid % nig) / gsz; return true;
    }
};
struct PlainSched {
    TileOrder o; const char* A; const char* B; size_t tA, tB;
    __device__ void init(const bf16_t* A_, const bf16_t* B_, int M, int N, int lda, int ldb, int G, int c) { o.init(M / BM, N / BM, G, c); A = (const char*)A_; B = (const char*)B_; tA = (size_t)BM * lda * 2; tB = (size_t)BM * ldb * 2; }
    __device__ bool seg(int i, Seg& s) const { int pm, pn; if (!o.next(i, pm, pn)) return false; s.A = A + pm * tA; s.B = B + pn * tB; s.u.pm = pm; s.u.pn = pn; s.u.aux = 0; s.last = 1; return true; }
};

__device__ __forceinline__ unsigned cvt_pk_bf16(float lo, float hi) { unsigned r; asm volatile("v_cvt_pk_bf16_f32 %0, %1, %2" : "=v"(r) : "v"(lo), "v"(hi)); return r; }

typedef f32x4 Acc[2][2][4][2];

template <class Epi, class Sched, bool ALIGN_EPI>
__device__ __forceinline__ void gemm_phase(LAS unsigned char* lds, const int lda, const int ldb, const int nt, const Sched& S, const Epi& E) {
    const int tid = threadIdx.x, wid = __builtin_amdgcn_readfirstlane(tid >> 6), lane = tid & 63, wr = wid >> 2, wc = wid & 3, fr = lane & 15, fq = lane >> 4;
    unsigned voffA[2], voffB[2];
#pragma unroll
    for (int i = 0; i < 2; ++i) { int R, C; stage_rc(tid * 16 + i * 8192, R, C); const int Rb = Epi::PERM ? ((R & ~31) + perm32(R & 31)) : R;
        voffA[i] = (unsigned)(R * lda + C) * 2u; voffB[i] = (unsigned)(Rb * ldb + C) * 2u; }
    const size_t kstep = (size_t)(BK * 2);
    const size_t hstepA = (size_t)HALF * lda * 2, hstepB = (size_t)HALF * ldb * 2;
    const unsigned ldsw = (unsigned)wid * 1024u;
    const int aoff = lds_byte(wr * 64 + fr, fq * 8), boff = lds_byte(wc * 32 + fr, fq * 8);
#define PG8_SA(b, h) (((b) * 2 + (h)) * HTB)
#define PG8_SB(b, h) ((4 + (b) * 2 + (h)) * HTB)
#define PG8_STAGE(bufoff, gbase, voff) do { _Pragma("unroll") for (int _i = 0; _i < 2; ++_i) \
        __builtin_amdgcn_global_load_lds((const unsigned*)((const char*)(gbase) + (voff)[_i]), (LAS unsigned*)(lds + (bufoff) + ldsw + _i * 8192), 16, 0, 0); } while (0)
#define PG8_LDA(dst, b, h) do { _Pragma("unroll") for (int m = 0; m < 4; ++m) _Pragma("unroll") for (int k = 0; k < 2; ++k) dst[m][k] = *(const LAS bf16x8*)(lds + PG8_SA(b, h) + aoff + m * 2048 + k * 1024); } while (0)
#define PG8_LDB(dst, b, h) do { _Pragma("unroll") for (int n = 0; n < 2; ++n) _Pragma("unroll") for (int k = 0; k < 2; ++k) dst[n][k] = *(const LAS bf16x8*)(lds + PG8_SB(b, h) + boff + n * 2048 + k * 1024); } while (0)
#define PG8_MMA(ai, bj, At, Bt) do { __builtin_amdgcn_s_setprio(1); _Pragma("unroll") for (int m = 0; m < 4; ++m) _Pragma("unroll") for (int n = 0; n < 2; ++n) _Pragma("unroll") for (int k = 0; k < 2; ++k) \
        acc[ai][bj][m][n] = __builtin_amdgcn_mfma_f32_16x16x32_bf16(Bt[n][k], At[m][k], acc[ai][bj][m][n], 0, 0, 0); __builtin_amdgcn_s_setprio(0); } while (0)
#define PG8_WAIT_V(n) asm volatile("s_waitcnt vmcnt(" #n ")" ::: "memory")
#define PG8_WAIT_L(n) asm volatile("s_waitcnt lgkmcnt(" #n ")" ::: "memory")
#define PG8_BAR __builtin_amdgcn_s_barrier()
#define PG8_SCHED __builtin_amdgcn_sched_barrier(0)
#define PG8_ZERO() do { _Pragma("unroll") for (int a = 0; a < 2; ++a) _Pragma("unroll") for (int b = 0; b < 2; ++b) _Pragma("unroll") for (int m = 0; m < 4; ++m) _Pragma("unroll") for (int n = 0; n < 2; ++n) acc[a][b][m][n] = (f32x4){0.f, 0.f, 0.f, 0.f}; } while (0)
    Seg cur, nxt; int qi = 0;
    if (!S.seg(0, cur)) return;
    Acc acc;
    PG8_ZERO();
    bf16x8 At[4][2], B0[2][2], B1[2][2];
    const char* cA = cur.A; const char* cB = cur.B;
    PG8_STAGE(PG8_SB(0, 0), cB, voffB); PG8_STAGE(PG8_SB(0, 1), cB + hstepB, voffB); PG8_STAGE(PG8_SA(0, 0), cA, voffA); PG8_STAGE(PG8_SA(0, 1), cA + hstepA, voffA);
    if (wr == 1) PG8_BAR;
    PG8_WAIT_V(2); PG8_BAR;
    PG8_STAGE(PG8_SB(1, 0), cB + kstep, voffB); PG8_STAGE(PG8_SA(1, 0), cA + kstep, voffA); PG8_STAGE(PG8_SB(1, 1), cB + hstepB + kstep, voffB);
    PG8_WAIT_V(6); PG8_BAR;
    for (;;) {
        bool has_next; const char* nA; const char* nB;
        for (;;) {
        has_next = S.seg(qi + 1, nxt);
        nA = has_next ? nxt.A : cA; nB = has_next ? nxt.B : cB;
#pragma unroll 1
        for (int t = 0; t < nt; t += 2) {
            const bool last = (t == nt - 2);
            const char* a1 = cA + (size_t)(t + 1) * kstep;
            const char* a2 = last ? nA : cA + (size_t)(t + 2) * kstep; const char* b2 = last ? nB : cB + (size_t)(t + 2) * kstep;
            const char* a3 = a2 + kstep; const char* b3 = b2 + kstep;
            PG8_LDB(B0, 0, 0); PG8_LDB(B1, 0, 1); PG8_SCHED; PG8_LDA(At, 0, 0); PG8_STAGE(PG8_SA(1, 1), a1 + hstepA, voffA);
            PG8_WAIT_V(8); PG8_WAIT_L(0); PG8_BAR; PG8_MMA(0, 0, At, B0); PG8_MMA(0, 1, At, B1); PG8_BAR; PG8_SCHED;
            PG8_LDA(At, 0, 1); PG8_STAGE(PG8_SB(0, 0), b2, voffB); PG8_STAGE(PG8_SB(0, 1), b2 + hstepB, voffB); PG8_STAGE(PG8_SA(0, 0), a2, voffA);
            PG8_WAIT_V(8); PG8_WAIT_L(0); PG8_BAR; PG8_MMA(1, 0, At, B0); PG8_MMA(1, 1, At, B1); PG8_BAR; PG8_SCHED;
            PG8_LDB(B0, 1, 0); PG8_LDB(B1, 1, 1); PG8_SCHED; PG8_LDA(At, 1, 0); PG8_STAGE(PG8_SA(0, 1), a2 + hstepA, voffA);
            PG8_WAIT_V(8); PG8_WAIT_L(0); PG8_BAR; PG8_MMA(0, 0, At, B0); PG8_MMA(0, 1, At, B1); PG8_BAR; PG8_SCHED;
            PG8_LDA(At, 1, 1); PG8_STAGE(PG8_SB(1, 0), b3, voffB); PG8_STAGE(PG8_SB(1, 1), b3 + hstepB, voffB); PG8_STAGE(PG8_SA(1, 0), a3, voffA);
            PG8_WAIT_V(8); PG8_WAIT_L(0); PG8_BAR; PG8_MMA(1, 0, At, B0); PG8_MMA(1, 1, At, B1); PG8_BAR; PG8_SCHED;
        }
        if (cur.last || !has_next) break;
        cur = nxt; cA = nA; cB = nB; ++qi;
        }
        if constexpr (ALIGN_EPI) { if (wr == 0) PG8_BAR; }
        E(acc, cur.u, wr, wc, fr, fq);
        if (!has_next) break;
        PG8_ZERO();
        cur = nxt; cA = nA; cB = nB; ++qi;
        if constexpr (ALIGN_EPI) { if (wr == 1) PG8_BAR; }
    }
    PG8_WAIT_V(0);
    if constexpr (!ALIGN_EPI) { if (wr == 0) PG8_BAR; }
    PG8_BAR;
#undef PG8_SA
#undef PG8_SB
#undef PG8_STAGE
#undef PG8_LDA
#undef PG8_LDB
#undef PG8_MMA
#undef PG8_WAIT_V
#undef PG8_WAIT_L
#undef PG8_BAR
#undef PG8_SCHED
#undef PG8_ZERO
}

struct EpiBf16 {
    static constexpr bool PERM = true;
    bf16_t* O; int ldc;
    __device__ __forceinline__ void operator()(const Acc& acc, const Unit& u, int wr, int wc, int fr, int fq) const {
        const int row0 = u.pm * BM + wr * 64 + fr; const int col0 = u.pn * BM + wc * 32 + 8 * fq;
#pragma unroll
        for (int ai = 0; ai < 2; ++ai)
#pragma unroll
            for (int m = 0; m < 4; ++m) { bf16_t* rowp = O + (size_t)(row0 + ai * HALF + m * 16) * ldc + col0;
#pragma unroll
                for (int bj = 0; bj < 2; ++bj) { const f32x4 v0 = acc[ai][bj][m][0], v1 = acc[ai][bj][m][1];
                    u32x4 w; w.x = cvt_pk_bf16(v0[0], v0[1]); w.y = cvt_pk_bf16(v0[2], v0[3]); w.z = cvt_pk_bf16(v1[0], v1[1]); w.w = cvt_pk_bf16(v1[2], v1[3]);
                    *(u32x4*)(rowp + bj * HALF) = w; } }
    }
};
struct EpiLora {
    static constexpr bool PERM = true;
    bf16_t* O; const float* w0; const float* a0;
    __device__ __forceinline__ void operator()(const Acc& acc, const Unit& u, int wr, int wc, int fr, int fq) const {
        const int row0 = u.pm * BM + wr * 64 + fr; const int col0 = u.pn * BM + wc * 32 + 8 * fq; const int typ = u.pn >> 2;
        const float* bsrc = (typ == 0) ? w0 : a0;
        const float mul = (typ == 0) ? -0.6065306597126334f : 1.0f; const bool lin = (typ == 2);
#pragma unroll
        for (int bj = 0; bj < 2; ++bj) {
            const int ch = (col0 + bj * HALF) & 1023;
            const f32x4 b0 = *(const f32x4*)(bsrc + ch), b1 = *(const f32x4*)(bsrc + ch + 4);
#pragma unroll
            for (int ai = 0; ai < 2; ++ai)
#pragma unroll
                for (int m = 0; m < 4; ++m) {
                    f32x4 v0 = acc[ai][bj][m][0], v1 = acc[ai][bj][m][1];
                    {
                        const f32x4 s0 = v0 + b0, s1 = v1 + b1;
                        v0.x = lin ? v0.x : mul * sigmoidf_(s0.x); v0.y = lin ? v0.y : mul * sigmoidf_(s0.y); v0.z = lin ? v0.z : mul * sigmoidf_(s0.z); v0.w = lin ? v0.w : mul * sigmoidf_(s0.w);
                        v1.x = lin ? v1.x : mul * sigmoidf_(s1.x); v1.y = lin ? v1.y : mul * sigmoidf_(s1.y); v1.z = lin ? v1.z : mul * sigmoidf_(s1.z); v1.w = lin ? v1.w : mul * sigmoidf_(s1.w);
                    }
                    u32x4 w; w.x = cvt_pk_bf16(v0.x, v0.y); w.y = cvt_pk_bf16(v0.z, v0.w); w.z = cvt_pk_bf16(v1.x, v1.y); w.w = cvt_pk_bf16(v1.z, v1.w);
                    *(u32x4*)(O + (size_t)(row0 + ai * HALF + m * 16) * NL + col0 + bj * HALF) = w;
                    asm volatile("" ::: "memory"); }
        }
    }
};
struct EpiResF32 {
    static constexpr bool PERM = false;
    const float* base; float* out; int ldc;
    __device__ __forceinline__ void operator()(const Acc& acc, const Unit& u, int wr, int wc, int fr, int fq) const {
        const int col0 = u.pn * BM + wc * 32 + 4 * fq;
#pragma unroll
        for (int ai = 0; ai < 2; ++ai)
#pragma unroll
            for (int m = 0; m < 4; ++m) { const size_t off = (size_t)(u.pm * BM + ai * HALF + wr * 64 + m * 16 + fr) * ldc + col0;
#pragma unroll
                for (int bj = 0; bj < 2; ++bj)
#pragma unroll
                    for (int n = 0; n < 2; ++n) { const f32x4 bs = *(const f32x4*)(base + off + bj * HALF + n * 16); *(f32x4*)(out + off + bj * HALF + n * 16) = bs + acc[ai][bj][m][n]; } }
    }
};
struct EpiMoe1 {
    static constexpr bool PERM = true;
    bf16_t* O; const float* gates;
    __device__ __forceinline__ void operator()(const Acc& acc, const Unit& u, int wr, int wc, int fr, int fq) const {
        const int row0 = u.pm * BM + wr * 64 + fr; const int half = u.pn >> 2; const int col0 = half * 512 + (u.pn & 3) * 128 + wc * 32 + 8 * fq;
#pragma unroll
        for (int ai = 0; ai < 2; ++ai)
#pragma unroll
            for (int m = 0; m < 4; ++m) { const int row = row0 + ai * HALF + m * 16; const float gw = gates[(size_t)row * 2 + half];
                float v[8];
#pragma unroll
                for (int e = 0; e < 8; ++e) { const float g = acc[ai][0][m][e >> 2][e & 3], up = acc[ai][1][m][e >> 2][e & 3]; v[e] = g * sigmoidf_(g) * up * gw; }
                u32x4 w; w.x = cvt_pk_bf16(v[0], v[1]); w.y = cvt_pk_bf16(v[2], v[3]); w.z = cvt_pk_bf16(v[4], v[5]); w.w = cvt_pk_bf16(v[6], v[7]);
                *(u32x4*)(O + (size_t)row * 1024 + col0) = w; }
    }
};
struct EpiMoe2 {
    static constexpr bool PERM = false;
    float* out; const int* rowtok; int dry;
    __device__ __forceinline__ void operator()(const Acc& acc, const Unit& u, int wr, int wc, int fr, int fq) const {
        const int col0 = u.pn * BM + wc * 32 + 4 * fq;
#pragma unroll
        for (int ai = 0; ai < 2; ++ai)
#pragma unroll
            for (int m = 0; m < 4; ++m) { const int row = u.pm * BM + ai * HALF + wr * 64 + m * 16 + fr; const int tok = rowtok[row];
                if (tok >= 0 && !dry) { float* o = out + (size_t)tok * DM + col0;
#pragma unroll
                    for (int bj = 0; bj < 2; ++bj)
#pragma unroll
                        for (int n = 0; n < 2; ++n) { f32x4* p = (f32x4*)(o + bj * HALF + n * 16); *p = *p + acc[ai][bj][m][n]; } }
                asm volatile("" ::: "memory"); }
    }
};
}

#define XB_TMO      128
#define XB_XCNT(j)  (256  + 64 * (j))
#define XB_XSUB(j)  (1280 + 64 * (j))
#define XB_XGEN(j)  (2304 + 64 * (j))
#define XB_TOP      3328
#define XB_TOPGEN   3392
#define XCD_BAR_WORDS 3456
#define XB_SPIN_CAP (1u << 20)
__device__ __forceinline__ unsigned xb_ld(unsigned* p)              { return __hip_atomic_load(p, __ATOMIC_RELAXED, __HIP_MEMORY_SCOPE_AGENT); }
__device__ __forceinline__ unsigned xb_add(unsigned* p, unsigned v) { return __hip_atomic_fetch_add(p, v, __ATOMIC_RELAXED, __HIP_MEMORY_SCOPE_AGENT); }
__device__ __forceinline__ unsigned xb_xcc_id() { return (unsigned)__builtin_amdgcn_s_getreg((3 << 11) | 20) & 0xFu; }
#define XB_SPIN(cond, bar) do { unsigned _sp = 0; while (cond) { __builtin_amdgcn_s_sleep(1); \
    if ((++_sp & 255u) == 0u) { if (xb_ld(&(bar)[XB_TMO])) break; if (_sp > XB_SPIN_CAP) { atomicAdd(&(bar)[XB_TMO], 1u); break; } } } } while (0)
struct XcdBarrier { unsigned* bar; unsigned x; volatile LAS unsigned* st; };
__device__ __forceinline__ XcdBarrier xcd_barrier_post(unsigned* bar, volatile LAS unsigned* st) {
    XcdBarrier b; b.bar = bar; b.x = xb_xcc_id(); b.st = st;
    if (threadIdx.x == 0) (void)xb_add(&bar[XB_XCNT(b.x)], 1u);
    return b;
}
__device__ __forceinline__ void xcd_barrier_complete(unsigned* bar, unsigned x, unsigned& nloc, unsigned& nx) {
    const unsigned G = gridDim.x * gridDim.y * gridDim.z;
    unsigned sum, cnt, mine, sp = 0u;
    for (;;) {
        sum = 0u; cnt = 0u; mine = 0u;
#pragma unroll
        for (unsigned j = 0; j < 16; ++j) { const unsigned c = xb_ld(&bar[XB_XCNT(j)]); sum += c; cnt += (c > 0u) ? 1u : 0u; mine = (j == x) ? c : mine; }
        if (sum == G) break;
        __builtin_amdgcn_s_sleep(1);
        if ((++sp & 255u) == 0u) { if (xb_ld(&bar[XB_TMO])) break; if (sp > XB_SPIN_CAP) { atomicAdd(&bar[XB_TMO], 1u); break; } }
    }
    nloc = mine > 0u ? mine : 1u; nx = cnt > 0u ? cnt : 1u;
}
__device__ __forceinline__ void xcd_barrier(const XcdBarrier& b) {
    asm volatile("s_waitcnt vmcnt(0)" ::: "memory");
    __syncthreads();
    if (threadIdx.x == 0) {
        unsigned* bar = b.bar;
        __builtin_amdgcn_s_waitcnt(0);
        unsigned nloc = b.st[0], nx = b.st[1];
        if (nloc == 0u) { xcd_barrier_complete(bar, b.x, nloc, nx); b.st[0] = nloc; b.st[1] = nx; }
        const unsigned old = xb_add(&bar[XB_XSUB(b.x)], 1u);
        const unsigned gen = old / nloc;
        if (old + 1u == (gen + 1u) * nloc) {
            __builtin_amdgcn_fence(__ATOMIC_RELEASE, "agent");
            asm volatile("s_waitcnt vmcnt(0)" ::: "memory");
            const unsigned og = xb_add(&bar[XB_TOP], 1u);
            const unsigned tg = og / nx;
            if (og + 1u == (tg + 1u) * nx) xb_add(&bar[XB_TOPGEN], 1u);
            else XB_SPIN(xb_ld(&bar[XB_TOPGEN]) == tg, bar);
            __builtin_amdgcn_fence(__ATOMIC_ACQUIRE, "agent");
            xb_add(&bar[XB_XGEN(b.x)], 1u);
            asm volatile("s_waitcnt vmcnt(0)" ::: "memory");
        } else {
            XB_SPIN(xb_ld(&bar[XB_XGEN(b.x)]) == gen, bar);
            __builtin_amdgcn_fence(__ATOMIC_ACQUIRE, "agent");
            asm volatile("s_waitcnt vmcnt(0)" ::: "memory");
        }
    }
    __syncthreads();
}

struct Args { const float* in[25]; float* out; unsigned char* ws; int ph_lo, ph_hi; };
enum { I_X = 0, I_GMIX, I_WIN, I_MIX, I_QG, I_KG, I_W0, I_WDEC, I_A0, I_WAICL, I_WGATE, I_KK, I_KA, I_RK, I_LNW, I_LNB, I_WOUT, I_GFFN, I_WRG, I_BRG, I_WRE, I_BRE, I_WEG, I_WEU, I_WED };

struct Frame {
    LAS unsigned char* lds; unsigned char* ldsg;
    unsigned* ctl;
    int tid, lane, wave, vcu, G;
    const float* const* in; float* out; unsigned char* ws;
};

__device__ __forceinline__ int win_dmap(int n) {
    if (n < DSA_COLS) return n;
    const int m = n - DSA_COLS;
    if (m < 1024) return PR + m;
    if (m < 1088) return PDW + (m - 1024);
    if (m < 2112) return PKR + (m - 1088);
    if (m < 3136) return PVR + (m - 2112);
    if (m < 3200) return PDA + (m - 3136);
    return PDG + (m - 3200);
}
template <int MODE>
__device__ __forceinline__ void transpose_item(const float* W, int N, bf16_t* WT, int ldd, LAS float* scr, int kb, int nb, int lane) {
    const int k0 = 64 * kb, n0 = 32 * nb;
    const int nn = n0 + (lane & 31);
    float tv[32];
#pragma unroll
    for (int i = 0; i < 32; ++i) { const int kk = 2 * i + (lane >> 5); tv[i] = (nn < N) ? W[(size_t)(k0 + kk) * N + nn] : 0.f; }
#pragma unroll
    for (int i = 0; i < 32; ++i) { const int kk = 2 * i + (lane >> 5); scr[kk * 33 + (lane & 31)] = tv[i]; }
    LDS_WAIT(); asm volatile("" ::: "memory");
    const int c = lane & 7;
#pragma unroll
    for (int j = 0; j < 4; ++j) { const int nl = (lane >> 3) + 8 * j; const int n = n0 + nl; const LAS float* s = scr + (8 * c) * 33 + nl;
        u32x4 o; o.x = pk2(s[0 * 33], s[1 * 33]); o.y = pk2(s[2 * 33], s[3 * 33]); o.z = pk2(s[4 * 33], s[5 * 33]); o.w = pk2(s[6 * 33], s[7 * 33]);
        int dr = n;
        if (MODE == 1) dr = win_dmap(n);
        if (MODE == 2) dr = (n >> 7) * 256 + (n & 127);
        if (MODE == 3) dr = (n >> 7) * 256 + 128 + (n & 127);
        if (n < N) *(u32x4*)(WT + (size_t)dr * ldd + k0 + 8 * c) = o; }
    LDS_WAIT(); asm volatile("" ::: "memory");
}

__device__ __forceinline__ void phase0(Frame& F) {
    LAS float* scr = (LAS float*)(F.lds + F.wave * 16384);
    const int gw = F.vcu * 8 + F.wave, NGW = F.G * 8, lane = F.lane;
    constexpr int NB_IN = (IN_COLS + 31) / 32;
    constexpr int I_IN = (DM / 64) * NB_IN, I_OUT = (DM / 64) * (DM / 32);
    bf16_t* WIN = (bf16_t*)(F.ws + WS_WIN); bf16_t* WOUT = (bf16_t*)(F.ws + WS_WOUT);
    for (int it = gw; it < I_IN + I_OUT; it += NGW) {
        if (it < I_IN) transpose_item<1>(F.in[I_WIN], IN_COLS, WIN, DM, scr, it / NB_IN, it % NB_IN, lane);
        else { const int r = it - I_IN; transpose_item<0>(F.in[I_WOUT], DM, WOUT, DM, scr, r / (DM / 32), r % (DM / 32), lane); }
    }
    for (int i = gw; i < 144 * 4; i += NGW) { const int r = i >> 2, q = i & 3; const int row = r < 48 ? 4176 + r : 7584 + (r - 48);
        *(u32x4*)(WIN + (size_t)row * DM + q * 512 + lane * 8) = (u32x4){0u, 0u, 0u, 0u}; }
    { bf16_t* WL = (bf16_t*)(F.ws + WS_WLORA); const float* wd = F.in[I_WDEC]; const float* wa = F.in[I_WAICL]; const float* wg = F.in[I_WGATE];
      for (int i = gw * 64 + lane; i < NL * KL; i += NGW * 64) { const int n = i / KL, k = i % KL; const int typ = n >> 10, c = n & 1023; float v = 0.f;
          if (typ == 0 && k < 64) v = wd[k * 1024 + c];
          else if (typ == 1 && k >= 64 && k < 128) v = wa[(k - 64) * 1024 + c];
          else if (typ == 2 && k >= 128 && k < 288) v = wg[(k - 128) * 1024 + c];
          WL[i] = (bf16_t)f2bf(v); } }
    { bf16_t* WRH = (bf16_t*)(F.ws + WS_WRT); bf16_t* WRL = WRH + 32 * DM; const float* wrg = F.in[I_WRG]; const float* wre = F.in[I_WRE]; const float* gf = F.in[I_GFFN];
      for (int i = gw * 64 + lane; i < 32 * DM; i += NGW * 64) { const int o = i / DM, k = i % DM; float v = 0.f;
          if (o < 4) v = gf[k] * wrg[k * 4 + o]; else if (o < 20) v = gf[k] * wre[k * 16 + (o - 4)];
          const unsigned hb = f2bf(v); const float lo = v - bf2f((unsigned short)hb); WRH[i] = (bf16_t)hb; WRL[i] = (bf16_t)f2bf(lo); } }
    { const float* x = F.in[I_X]; const float* g = F.in[I_GMIX]; bf16_t* HN = (bf16_t*)(F.ws + WS_HN);
      f32x4 gv[8];
#pragma unroll
      for (int j = 0; j < 8; ++j) gv[j] = ((const f32x4*)g)[64 * j + lane];
      for (int m = gw; m < T; m += NGW) { const f32x4* xr = (const f32x4*)(x + (size_t)m * DM) + lane; f32x4 v[8]; float s = 0.f;
#pragma unroll
          for (int j = 0; j < 8; ++j) { v[j] = xr[64 * j]; s += (v[j].x * v[j].x + v[j].y * v[j].y) + (v[j].z * v[j].z + v[j].w * v[j].w); }
          const float rstd = rsqrtf(wave_sum(s) * (1.f / DM) + NORM_EPS);
          u32x2* o = (u32x2*)(HN + (size_t)m * DM) + lane;
#pragma unroll
          for (int j = 0; j < 8; ++j) { u32x2 w; w.x = pk2(v[j].x * rstd * gv[j].x, v[j].y * rstd * gv[j].y); w.y = pk2(v[j].z * rstd * gv[j].z, v[j].w * rstd * gv[j].w); o[64 * j] = w; } } }
}

__device__ __forceinline__ void rope4(float& y0, float& y1, float& y2, float& y3, float c0, float s0, float c1, float s1) {
    const float o0 = y0 * c0 - y2 * s0, o2 = y2 * c0 + y0 * s0, o1 = y1 * c1 - y3 * s1, o3 = y3 * c1 + y1 * s1; y0 = o0; y1 = o1; y2 = o2; y3 = o3;
}
__device__ __forceinline__ void phase2(Frame& F, const bool dry) {
    const int gw = F.vcu * 8 + F.wave, NGW = F.G * 8, lane = F.lane;
    bf16_t* P = (bf16_t*)(F.ws + WS_P); bf16_t* KI = (bf16_t*)(F.ws + WS_KI); bf16_t* AL = (bf16_t*)(F.ws + WS_ALORA);
    const float* mix = F.in[I_MIX];
    const int l5 = lane & 31, hsel = lane >> 5, l4 = lane & 15, hq = lane >> 4;
    float qg[4], kg[4];
    { const float* a = F.in[I_QG]; const float* b = F.in[I_KG];
      qg[0] = a[2 * l5]; qg[1] = a[2 * l5 + 1]; qg[2] = a[64 + 2 * l5]; qg[3] = a[65 + 2 * l5];
      kg[0] = b[2 * l5]; kg[1] = b[2 * l5 + 1]; kg[2] = b[64 + 2 * l5]; kg[3] = b[65 + 2 * l5]; }
    const float L2T = 13.287712379549449f;
    const float inv128_0 = exp2f(-(float)(2 * l5) * (1.0f / 64.0f) * L2T), inv128_1 = exp2f(-(float)(2 * l5 + 1) * (1.0f / 64.0f) * L2T);
    const float inv64_0 = exp2f(-(float)(2 * l4) * (1.0f / 32.0f) * L2T), inv64_1 = exp2f(-(float)(2 * l4 + 1) * (1.0f / 32.0f) * L2T);
    const float mu_dw = mix[1024 + lane], mu_da = mix[3136 + lane], mu_g0 = mix[3200 + lane], mu_g1 = mix[3264 + lane], mu_g2 = (lane < 32) ? mix[3328 + lane] : 0.f;
    for (int tp = gw; tp < T / 2; tp += NGW) {
        unsigned qa[2][4], qb[2][4], ka[2][4], kb[2][4], ia[2][4], ib[2][4], xa[2], xb[2];
        float ap[2][5], apv[2][5];
#pragma unroll
        for (int u = 0; u < 2; ++u) {
            const int t = 2 * tp + u; const int pos = t & (SEQ - 1);
            const bf16_t* row = P + (size_t)t * NP;
#pragma unroll
            for (int hh = 0; hh < 4; ++hh) {
                const unsigned* bq = (const unsigned*)(row + PQ + (2 * hh + hsel) * 128); const unsigned* bk = (const unsigned*)(row + PK + (2 * hh + hsel) * 128);
                qa[u][hh] = bq[l5]; qb[u][hh] = bq[32 + l5]; ka[u][hh] = bk[l5]; kb[u][hh] = bk[32 + l5];
                const unsigned* bi = (const unsigned*)(row + PQI + (4 * hh + hq) * 64);
                ia[u][hh] = bi[l4]; ib[u][hh] = bi[16 + l4];
            }
            { const unsigned* bx = (const unsigned*)(row + PKI); xa[u] = bx[l4]; xb[u] = bx[16 + l4]; }
            const bool hp = pos > 0; const bf16_t* prow = row - NP;
            ap[u][0] = bf2f(row[PDW + lane]); ap[u][1] = bf2f(row[PDA + lane]); ap[u][2] = bf2f(row[PDG + lane]); ap[u][3] = bf2f(row[PDG + 64 + lane]); ap[u][4] = (lane < 32) ? bf2f(row[PDG + 128 + lane]) : 0.f;
            apv[u][0] = hp ? bf2f(prow[PDW + lane]) : 0.f; apv[u][1] = hp ? bf2f(prow[PDA + lane]) : 0.f; apv[u][2] = hp ? bf2f(prow[PDG + lane]) : 0.f;
            apv[u][3] = hp ? bf2f(prow[PDG + 64 + lane]) : 0.f; apv[u][4] = (hp && lane < 32) ? bf2f(prow[PDG + 128 + lane]) : 0.f;
        }
        asm volatile("" ::: "memory");
#pragma unroll
        for (int u = 0; u < 2; ++u) {
            const int t = 2 * tp + u; const int pos = t & (SEQ - 1); const float fp = (float)pos;
            bf16_t* row = P + (size_t)t * NP;
            float c0, s0, c1, s1, d0, e0, d1, e1;
            sincosf(fp * inv128_0, &s0, &c0); sincosf(fp * inv128_1, &s1, &c1);
            sincosf(fp * inv64_0, &e0, &d0); sincosf(fp * inv64_1, &e1, &d1);
#pragma unroll
            for (int which = 0; which < 2; ++which) {
#pragma unroll
                for (int hh = 0; hh < 4; ++hh) {
                    unsigned* base = (unsigned*)(row + (which ? PK : PQ) + (2 * hh + hsel) * 128);
                    const unsigned a = which ? ka[u][hh] : qa[u][hh], b = which ? kb[u][hh] : qb[u][hh];
                    float y0 = bflo(a), y1 = bfhi(a), y2 = bflo(b), y3 = bfhi(b);
                    const float ss = half_sum((y0 * y0 + y1 * y1) + (y2 * y2 + y3 * y3));
                    const float rstd = rsqrtf(ss * (1.0f / 128.0f) + NORM_EPS) * (which ? 1.0f : QSCALE);
                    const float* gg = which ? kg : qg;
                    y0 *= rstd * gg[0]; y1 *= rstd * gg[1]; y2 *= rstd * gg[2]; y3 *= rstd * gg[3];
                    rope4(y0, y1, y2, y3, c0, s0, c1, s1);
                    if (!dry) { base[l5] = pk2(y0, y1); base[32 + l5] = pk2(y2, y3); }
                }
            }
#pragma unroll
            for (int it = 0; it < 4; ++it) {
                unsigned* base = (unsigned*)(row + PQI + (4 * it + hq) * 64);
                float y0 = bflo(ia[u][it]), y1 = bfhi(ia[u][it]), y2 = bflo(ib[u][it]), y3 = bfhi(ib[u][it]);
                rope4(y0, y1, y2, y3, d0, e0, d1, e1);
                if (!dry) { base[l4] = pk2(y0, y1); base[16 + l4] = pk2(y2, y3); }
            }
            if (lane < 16 && !dry) {
                float y0 = bflo(xa[u]), y1 = bfhi(xa[u]), y2 = bflo(xb[u]), y3 = bfhi(xb[u]);
                rope4(y0, y1, y2, y3, d0, e0, d1, e1);
                unsigned* o = (unsigned*)(KI + (size_t)t * 64);
                o[l4] = pk2(y0, y1); o[16 + l4] = pk2(y2, y3);
            }
            if (!dry) {
                bf16_t* al = AL + (size_t)t * KL;
                float sh;
                sh = ap[u][0] + (apv[u][0] - ap[u][0]) * mu_dw; al[lane] = (bf16_t)f2bf(tanhf(sh));
                sh = ap[u][1] + (apv[u][1] - ap[u][1]) * mu_da; al[64 + lane] = (bf16_t)f2bf(sh);
                sh = ap[u][2] + (apv[u][2] - ap[u][2]) * mu_g0; al[128 + lane] = (bf16_t)f2bf(sigmoidf_(sh));
                sh = ap[u][3] + (apv[u][3] - ap[u][3]) * mu_g1; al[192 + lane] = (bf16_t)f2bf(sigmoidf_(sh));
                if (lane < 32) { sh = ap[u][4] + (apv[u][4] - ap[u][4]) * mu_g2; al[256 + lane] = (bf16_t)f2bf(sigmoidf_(sh)); }
                al[288 + lane] = 0; if (lane < 32) al[352 + lane] = 0;
            }
        }
    }
}

__device__ __forceinline__ unsigned fkey(float f) { const unsigned u = __builtin_bit_cast(unsigned, f); return (u & 0x80000000u) ? ~u : (u | 0x80000000u); }
constexpr int CW_QIDX = 192;
constexpr int IDX_BUF = 256 * 128;
__device__ __forceinline__ void half_sum_i(int v, int& lo, int& hi) {
#define DPP_ADDI(v, ctrl, rm) (v) += __builtin_amdgcn_update_dpp(0, (v), (ctrl), (rm), 0xF, false)
    DPP_ADDI(v, 0xB1, 0xF); DPP_ADDI(v, 0x4E, 0xF); DPP_ADDI(v, 0x141, 0xF); DPP_ADDI(v, 0x140, 0xF); DPP_ADDI(v, 0x142, 0xA);
#undef DPP_ADDI
    lo = __builtin_amdgcn_readlane(v, 31); hi = __builtin_amdgcn_readlane(v, 63);
}
__device__ __forceinline__ void idx_unit(Frame& F, int u) {
    int tid_ = F.tid; asm volatile("" : "+v"(tid_));
    const int lane = tid_ & 63, wave = F.wave;
    const bf16_t* P = (const bf16_t*)(F.ws + WS_P); const unsigned char* KI = F.ws + WS_KI; unsigned* MSK = (unsigned*)(F.ws + WS_MSK);
    const int r = lane & 31, h = lane >> 5;
    const int i = 63 - (u >> 4), b = (u & 15) >> 2, g = u & 3;
    const int t0 = b * SEQ + i * 64 + g * 16 + 2 * wave;
    const int njt = 2 * (i + 1), nst = (njt + 7) >> 3;
    bf16x8 a[4];
    { const bf16_t* ap = P + (size_t)(t0 + ((r >> 2) & 1)) * NP + PQI + ((r & 3) + 4 * (r >> 3)) * 64 + 8 * h;
#pragma unroll
      for (int s = 0; s < 4; ++s) a[s] = *(const bf16x8*)(ap + 16 * s); }
    typedef _Float16 h16x2 __attribute__((ext_vector_type(2)));
    h16x2 wq[8];
    { const bf16_t* wp = P + (size_t)(t0 + h) * NP + PWI;
#pragma unroll
      for (int e = 0; e < 8; ++e) { wq[e].x = (_Float16)(bf2f(wp[2 * e]) * (1.0f / 32.0f)); wq[e].y = (_Float16)(bf2f(wp[2 * e + 1]) * (1.0f / 32.0f)); } }
    const unsigned char* kg = KI + ((size_t)b * SEQ) * 128 + (size_t)(wave * 8 + (lane >> 3)) * 128 + (size_t)(((lane & 7) ^ (lane >> 3)) * 16);
#define IDX_STAGE(st_, buf_) do { _Pragma("unroll") for (int q = 0; q < 4; ++q) \
        __builtin_amdgcn_global_load_lds((const unsigned*)(kg + (size_t)(st_) * 32768 + q * 8192), (LAS unsigned*)(F.lds + (buf_) * IDX_BUF + (q * 8 + wave) * 1024), 16, 0, 0); } while (0)
    IDX_STAGE(0, 0);
    __syncthreads();
    unsigned sc[128];
    const int lr = r * 128, sw = r & 7;
#pragma unroll
    for (int st = 0; st < 16; ++st) {
        if (st < nst) {
            if (st + 1 < nst) IDX_STAGE(st + 1, (st + 1) & 1);
            const LAS unsigned char* kb = F.lds + (st & 1) * IDX_BUF + lr;
#pragma unroll
            for (int jb = 0; jb < 8; ++jb) {
                const int j = 8 * st + jb;
                const unsigned adm = (j < njt) ? 0xFFFFFFFFu : 0u;
                f32x16 acc = {0.f, 0.f, 0.f, 0.f, 0.f, 0.f, 0.f, 0.f, 0.f, 0.f, 0.f, 0.f, 0.f, 0.f, 0.f, 0.f};
#pragma unroll
                for (int s = 0; s < 4; ++s) acc = __builtin_amdgcn_mfma_f32_32x32x16_bf16(a[s], *(const LAS bf16x8*)(kb + jb * 4096 + (((2 * s + h) ^ sw) * 16)), acc, 0, 0, 0);
                float sum = 0.f, sum1 = 0.f;
#pragma unroll
                for (int e = 0; e < 16; ++e) { const float rl = __builtin_amdgcn_fmed3f(acc[e], 0.f, 3.0e38f);
                    const unsigned wpk = __builtin_bit_cast(unsigned, wq[e >> 1]);
                    if (e & 1) asm("v_fma_mix_f32 %0, %1, %2, %0 op_sel:[1,0,0] op_sel_hi:[1,0,0]" : "+v"(sum1) : "v"(wpk), "v"(rl));
                    else asm("v_fma_mix_f32 %0, %1, %2, %0 op_sel:[0,0,0] op_sel_hi:[1,0,0]" : "+v"(sum) : "v"(wpk), "v"(rl)); }
                sum += sum1;
                sc[j] = fkey(sum) & adm;
            }
            __syncthreads();
        } else {
#pragma unroll
            for (int jb = 0; jb < 8; ++jb) sc[8 * st + jb] = 0u;
        }
    }
#undef IDX_STAGE
    unsigned thr = 1u;
    if (njt > 8) {
        thr = 0u; bool dlo = false, dhi = false;
        for (int bit = 31; bit >= 0; --bit) {
            const unsigned cand = thr | (1u << bit);
            int cnt = 0;
#pragma unroll
            for (int jg = 0; jg < 16; ++jg) {
                if (8 * jg < njt) {
#pragma unroll
                    for (int jj = 0; jj < 8; ++jj) cnt += (sc[8 * jg + jj] >= cand) ? 1 : 0;
                }
            }
            int clo, chi; half_sum_i(cnt, clo, chi);
            const int mine = h ? chi : clo;
            if (mine >= 256) thr = cand;
            dlo |= (clo == 256); dhi |= (chi == 256);
            if (dlo && dhi) break;
        }
    }
    unsigned m0a = 0u, m0b = 0u, m1a = 0u, m1b = 0u;
#pragma unroll
    for (int j = 0; j < 128; ++j) {
        const unsigned long long bal = __ballot(sc[j] >= thr);
        const unsigned lo = (unsigned)bal, hi = (unsigned)(bal >> 32);
        if (j < 64) { asm volatile("s_nop 3\n\tv_writelane_b32 %0, %1, %2" : "+v"(m0a) : "s"(lo), "n"(j)); asm volatile("v_writelane_b32 %0, %1, %2" : "+v"(m1a) : "s"(hi), "n"(j)); }
        else { asm volatile("s_nop 3\n\tv_writelane_b32 %0, %1, %2" : "+v"(m0b) : "s"(lo), "n"(j - 64)); asm volatile("v_writelane_b32 %0, %1, %2" : "+v"(m1b) : "s"(hi), "n"(j - 64)); }
        if ((j & 7) == 7) __builtin_amdgcn_sched_barrier(0);
    }
    MSK[(size_t)t0 * 128 + lane] = m0a; MSK[(size_t)t0 * 128 + 64 + lane] = m0b;
    MSK[(size_t)(t0 + 1) * 128 + lane] = m1a; MSK[(size_t)(t0 + 1) * 128 + 64 + lane] = m1b;
}

__device__ __forceinline__ void attn_task_naive(Frame& F, int task, unsigned char* wl) {
    const int lane = F.lane;
    const bf16_t* P = (const bf16_t*)(F.ws + WS_P); const unsigned* MSK = (const unsigned*)(F.ws + WS_MSK); bf16_t* Y = (bf16_t*)(F.ws + WS_YCAT);
    int* list = (int*)wl; float* qs = (float*)(wl + 1024); float* ps = (float*)(wl + 1536);
    const int t = task >> 3, hd = task & 7, b = t >> 12, i = (t & (SEQ - 1)) >> 6;
    const int ntile = i + 1;
    int cnt = 0;
    for (int jj = 0; jj < ntile; ++jj) {
        const unsigned w0 = MSK[(size_t)t * 128 + 2 * jj], w1 = MSK[(size_t)t * 128 + 2 * jj + 1];
        const unsigned long long m = (unsigned long long)w0 | ((unsigned long long)w1 << 32);
        const int pre = __popcll(m & ((1ull << lane) - 1ull));
        if (((m >> lane) & 1ull) && (cnt + pre < 256)) list[cnt + pre] = 64 * jj + lane;
        cnt += __popcll(m);
    }
    const int nsel = cnt < 256 ? cnt : 256;
    { const bf16_t* qp = P + (size_t)t * NP + PQ + hd * 128; qs[lane] = bf2f(qp[lane]); qs[64 + lane] = bf2f(qp[64 + lane]); }
    LDS_WAIT(); asm volatile("" ::: "memory");
    float lg[4]; float mx = -INFINITY;
#pragma unroll
    for (int rr = 0; rr < 4; ++rr) {
        const int e = lane + 64 * rr; lg[rr] = -INFINITY;
        if (e < nsel) { const int key = list[e]; const u32x4* kp = (const u32x4*)(P + ((size_t)b * SEQ + key) * NP + PK + hd * 128); float d = 0.f;
#pragma unroll
            for (int c = 0; c < 16; ++c) { const u32x4 kv = kp[c]; const float* q = qs + 8 * c;
                d += q[0] * bflo(kv.x) + q[1] * bfhi(kv.x) + q[2] * bflo(kv.y) + q[3] * bfhi(kv.y) + q[4] * bflo(kv.z) + q[5] * bfhi(kv.z) + q[6] * bflo(kv.w) + q[7] * bfhi(kv.w); }
            lg[rr] = d; mx = fmaxf(mx, d); }
    }
#pragma unroll
    for (int o = 1; o < 64; o <<= 1) mx = fmaxf(mx, __shfl_xor(mx, o));
    float sum = 0.f;
#pragma unroll
    for (int rr = 0; rr < 4; ++rr) { const int e = lane + 64 * rr; const float p = (e < nsel) ? exp2f(lg[rr] - mx) : 0.f; ps[e] = p; sum += p; }
    sum = wave_sum(sum);
    LDS_WAIT(); asm volatile("" ::: "memory");
    float o0 = 0.f, o1 = 0.f;
    const bf16_t* vb = P + (size_t)b * SEQ * NP + PV + hd * 128 + 2 * lane;
    for (int e = 0; e < nsel; ++e) { const int key = list[e]; const float p = ps[e]; const unsigned v = *(const unsigned*)(vb + (size_t)key * NP); o0 += p * bflo(v); o1 += p * bfhi(v); }
    const float inv = 1.0f / sum;
    *(unsigned*)(Y + (size_t)t * DM + hd * 128 + 2 * lane) = pk2(o0 * inv, o1 * inv);
    LDS_WAIT(); asm volatile("" ::: "memory");
}

__device__ __forceinline__ void rwkv_scan_naive(Frame& F, int bh, unsigned char* wl) {
    const int lane = F.lane, b = bh >> 4, hd = bh & 15, ch = hd * 64 + lane;
    const bf16_t* P = (const bf16_t*)(F.ws + WS_P); const bf16_t* L3 = (const bf16_t*)(F.ws + WS_L3); bf16_t* Y = (bf16_t*)(F.ws + WS_YCAT);
    const float* mix = F.in[I_MIX];
    const float mu_r = mix[ch], mu_k = mix[1088 + ch], mu_v = mix[2112 + ch];
    const float kkc = F.in[I_KK][ch], kac = F.in[I_KA][ch], rkc = F.in[I_RK][ch], lnw = F.in[I_LNW][ch], lnb = F.in[I_LNB][ch];
    float* vec = (float*)wl;
    f32x4 S4[16];
#pragma unroll
    for (int k = 0; k < 16; ++k) S4[k] = (f32x4){0.f, 0.f, 0.f, 0.f};
    float prev_r = 0.f, prev_k = 0.f, prev_v = 0.f;
    constexpr int PF = 4;
    float in_r[PF], in_k[PF], in_v[PF], in_ld[PF], in_a[PF], in_g[PF];
    const bf16_t* prow = P + (size_t)b * SEQ * NP + ch; const bf16_t* lrow = L3 + (size_t)b * SEQ * NL + ch;
#pragma unroll
    for (int j = 0; j < PF; ++j) { const bf16_t* pr = prow + (size_t)j * NP; const bf16_t* lr = lrow + (size_t)j * NL;
        in_r[j] = bf2f(pr[PR]); in_k[j] = bf2f(pr[PKR]); in_v[j] = bf2f(pr[PVR]); in_ld[j] = bf2f(lr[0]); in_a[j] = bf2f(lr[1024]); in_g[j] = bf2f(lr[2048]); }
    const f32x4* vec4 = (const f32x4*)vec;
    for (int tb = 0; tb < SEQ; tb += PF) {
        float c_r[PF], c_k[PF], c_v[PF], c_ld[PF], c_a[PF], c_g[PF];
#pragma unroll
        for (int j = 0; j < PF; ++j) { c_r[j] = in_r[j]; c_k[j] = in_k[j]; c_v[j] = in_v[j]; c_ld[j] = in_ld[j]; c_a[j] = in_a[j]; c_g[j] = in_g[j]; }
        {
            const int tn = (tb + PF < SEQ) ? tb + PF : tb;
#pragma unroll
            for (int j = 0; j < PF; ++j) { const bf16_t* pr = prow + (size_t)(tn + j) * NP; const bf16_t* lr = lrow + (size_t)(tn + j) * NL;
                in_r[j] = bf2f(pr[PR]); in_k[j] = bf2f(pr[PKR]); in_v[j] = bf2f(pr[PVR]); in_ld[j] = bf2f(lr[0]); in_a[j] = bf2f(lr[1024]); in_g[j] = bf2f(lr[2048]); }
        }
#pragma unroll
        for (int j = 0; j < PF; ++j) {
            const float r_t = c_r[j] + (prev_r - c_r[j]) * mu_r, k_t = c_k[j] + (prev_k - c_k[j]) * mu_k, v_t = c_v[j] + (prev_v - c_v[j]) * mu_v;
            prev_r = c_r[j]; prev_k = c_k[j]; prev_v = c_v[j];
            const float a = c_a[j];
            const float kkr = k_t * kkc; const float n2 = wave_sum(kkr * kkr); const float kk = kkr * (1.0f / fmaxf(sqrtf(n2), 1e-12f));
            const float kp = k_t * (1.0f + (a - 1.0f) * kac); const float w = __expf(c_ld[j]); const float bb = kk * a;
            vec[lane] = -kk; vec[64 + lane] = w; vec[128 + lane] = bb; vec[192 + lane] = kp; vec[256 + lane] = r_t;
            LDS_WAIT(); asm volatile("" ::: "memory");
            f32x4 sa4 = (f32x4){0.f, 0.f, 0.f, 0.f};
#pragma unroll
            for (int k = 0; k < 16; ++k) { sa4 += S4[k] * vec4[k]; if ((k & 3) == 3) asm volatile("" ::: "memory"); }
            const float sa = (sa4.x + sa4.y) + (sa4.z + sa4.w);
            f32x4 y4 = (f32x4){0.f, 0.f, 0.f, 0.f};
#pragma unroll
            for (int k = 0; k < 16; ++k) {
                const f32x4 wv = vec4[16 + k], bv = vec4[32 + k], kv = vec4[48 + k], rv = vec4[64 + k];
                S4[k] = S4[k] * wv + bv * sa + kv * v_t; y4 += S4[k] * rv;
                if (k & 1) asm volatile("" ::: "memory"); }
            const float y = (y4.x + y4.y) + (y4.z + y4.w);
            const float mean = wave_sum(y) * (1.0f / 64.0f); const float dv = y - mean; const float var = wave_sum(dv * dv) * (1.0f / 64.0f);
            const float yn = dv * rsqrtf(var + GN_EPS) * lnw + lnb;
            const float bonus = wave_sum(r_t * kp * rkc) * v_t;
            const float o = (yn + bonus) * c_g[j];
            Y[((size_t)b * SEQ + tb + j) * DM + 1024 + ch] = (bf16_t)f2bf(o);
            asm volatile("" ::: "memory");
        }
    }
}


namespace rw {
constexpr int TP = 72, TILE_B = 64 * TP * 2;
enum { T_ATM = 0, T_RTM, T_BTM, T_KTM, T_ACM, T_VCM, T_BCM, T_KCM, T_MAB, T_MAK, T_MRB, T_MRK, T_TINV, NTILE };
constexpr int T_G1 = T_ATM, T_AP = T_BTM, T_U0 = T_KTM;
constexpr int OFF_X11T = NTILE * TILE_B, OFF_T1T = OFF_X11T + 2560, OFF_SEG = OFF_T1T + 2560, OFF_PC = OFF_SEG + 2048, LDS_END = OFF_PC + 256;
static_assert(LDS_END <= RING_BYTES, "rwkv pass A LDS");
__device__ __forceinline__ int crow(int e, int h) { return (e & 3) + 8 * (e >> 2) + 4 * h; }
__device__ __forceinline__ f32x16 zero16() { return (f32x16){0.f, 0.f, 0.f, 0.f, 0.f, 0.f, 0.f, 0.f, 0.f, 0.f, 0.f, 0.f, 0.f, 0.f, 0.f, 0.f}; }
template <int KS>
__device__ __forceinline__ f32x16 mmt(const LAS bf16_t* A, int ap, int ar0, int ac0, const LAS bf16_t* B, int bp, int br0, int bc0, f32x16 acc, int r, int h) {
    const LAS bf16_t* pa = A + (ar0 + r) * ap + ac0 + 8 * h; const LAS bf16_t* pb = B + (br0 + r) * bp + bc0 + 8 * h;
#pragma unroll
    for (int s = 0; s < KS; ++s) acc = __builtin_amdgcn_mfma_f32_32x32x16_bf16(*(const LAS bf16x8*)(pa + 16 * s), *(const LAS bf16x8*)(pb + 16 * s), acc, 0, 0, 0);
    return acc;
}
__device__ __forceinline__ void store_rm(LAS bf16_t* D, int r0, int c0, const f32x16& acc, int r, int h) {
#pragma unroll
    for (int e = 0; e < 16; ++e) D[(r0 + crow(e, h)) * TP + c0 + r] = (bf16_t)f2bf(acc[e]);
}
__device__ __forceinline__ u32x4 pack8(const f32x16& a, int s) { u32x4 w; w.x = pk2(a[8 * s], a[8 * s + 1]); w.y = pk2(a[8 * s + 2], a[8 * s + 3]); w.z = pk2(a[8 * s + 4], a[8 * s + 5]); w.w = pk2(a[8 * s + 6], a[8 * s + 7]); return w; }
__device__ __forceinline__ void unpack8(const u32x4 w, f32x16& a, int s) { a[8 * s] = bflo(w.x); a[8 * s + 1] = bfhi(w.x); a[8 * s + 2] = bflo(w.y); a[8 * s + 3] = bfhi(w.y); a[8 * s + 4] = bflo(w.z); a[8 * s + 5] = bfhi(w.z); a[8 * s + 6] = bflo(w.w); a[8 * s + 7] = bfhi(w.w); }
__device__ __forceinline__ unsigned char* l3_slot(unsigned char* l3, int tg0, int col0, int bo) { return l3 + ((size_t)(tg0 + (bo >> 7)) * NL + col0) * 2 + (bo & 127); }

__device__ __forceinline__ void pass_a(Frame& F) {
    const int lane = F.lane, wave = F.wave, r = lane & 31, h = lane >> 5;
    LAS bf16_t* tiles = (LAS bf16_t*)F.lds;
#define TL(i) (tiles + (i) * (TILE_B / 2))
    LAS bf16_t* X11T = (LAS bf16_t*)(F.lds + OFF_X11T); LAS bf16_t* T1T = (LAS bf16_t*)(F.lds + OFF_T1T);
    LAS float* seg = (LAS float*)(F.lds + OFF_SEG); LAS float* pc = (LAS float*)(F.lds + OFF_PC);
    const bf16_t* P = (const bf16_t*)(F.ws + WS_P); unsigned char* L3 = F.ws + WS_L3;
    bf16_t* MT = (bf16_t*)(F.ws + WS_MT); bf16_t* SA = (bf16_t*)(F.ws + WS_SA); float* BON = (float*)(F.ws + WS_BON);
    const float* mix = F.in[I_MIX];
    struct Raw { float pr, pk, pv, cr[8], ck[8], cv[8], l[8], a[8]; };
    auto load_raw = [&](int unit, Raw& w) {
        const int b = unit >> 10, hd = (unit >> 6) & 15, ci = unit & 63, tg0 = b * SEQ + ci * 64, ch = hd * 64 + lane;
        const bf16_t* p0 = P + (size_t)(tg0 + 8 * wave) * NP + ch; const bf16_t* l0 = (const bf16_t*)L3 + (size_t)(tg0 + 8 * wave) * NL + ch;
        if (ci == 0 && wave == 0) { w.pr = 0.f; w.pk = 0.f; w.pv = 0.f; } else { w.pr = bf2f(p0[PR - NP]); w.pk = bf2f(p0[PKR - NP]); w.pv = bf2f(p0[PVR - NP]); }
#pragma unroll
        for (int j = 0; j < 8; ++j) { w.cr[j] = bf2f(p0[(size_t)j * NP + PR]); w.ck[j] = bf2f(p0[(size_t)j * NP + PKR]); w.cv[j] = bf2f(p0[(size_t)j * NP + PVR]);
            w.l[j] = bf2f(l0[(size_t)j * NL]); w.a[j] = bf2f(l0[(size_t)j * NL + 1024]); }
    };
    Raw cur;
    if (F.vcu < 4096) load_raw(F.vcu, cur);
    for (int unit = F.vcu; unit < 4096; unit += F.G) {
        const int b = unit >> 10, hd = (unit >> 6) & 15, ci = unit & 63, tg0 = b * SEQ + ci * 64;
        Raw nxt;
        {
            const int c = lane, ch = hd * 64 + c, sg = wave;
            const float mu_r = mix[ch], mu_k = mix[1088 + ch], mu_v = mix[2112 + ch];
            const float kkc = F.in[I_KK][ch], kac = F.in[I_KA][ch], rkc = F.in[I_RK][ch];
            float pr = cur.pr, pk = cur.pk, pv = cur.pv;
            float rr[8], kp[8], vv[8], kk[8], bb[8], ld[8], cl[8];
            float run = 0.f;
#pragma unroll
            for (int j = 0; j < 8; ++j) {
                const float cr = cur.cr[j], ck = cur.ck[j], cv = cur.cv[j];
                const float l = cur.l[j], a = cur.a[j];
                const float r_t = cr + (pr - cr) * mu_r, k_t = ck + (pk - ck) * mu_k, v_t = cv + (pv - cv) * mu_v; pr = cr; pk = ck; pv = cv;
                const float kkr = k_t * kkc; const float n2 = wave_sum(kkr * kkr); const float kkn = kkr * (1.0f / fmaxf(sqrtf(n2), 1e-12f));
                const float kpp = k_t * (1.0f + (a - 1.0f) * kac);
                const float bon = wave_sum(r_t * kpp * rkc);
                if (lane == 0) BON[(size_t)(tg0 + 8 * sg + j) * 16 + hd] = bon;
                run += l; rr[j] = r_t; kp[j] = kpp; vv[j] = v_t; kk[j] = kkn; bb[j] = kkn * a; ld[j] = l; cl[j] = run;
            }
            seg[sg * 64 + c] = run;
            __syncthreads();
            float off = 0.f, tot = 0.f;
#pragma unroll
            for (int q = 0; q < 8; ++q) { const float v = seg[q * 64 + c]; tot += v; off += (q < sg) ? v : 0.f; }
            if (sg == 0) pc[c] = __expf(tot);
            float ta[8], tr[8], tb[8], tk[8];
#pragma unroll
            for (int j = 0; j < 8; ++j) { const float lp = off + cl[j]; const float ep = __expf(lp), em = __expf(-lp), epm = __expf(lp - ld[j]);
                ta[j] = -kk[j] * epm; tr[j] = rr[j] * ep; tb[j] = bb[j] * em; tk[j] = kp[j] * em; }
#pragma unroll
            for (int j = 0; j < 8; ++j) { const int o = (8 * sg + j) * TP + c;
                TL(T_ATM)[o] = (bf16_t)f2bf(ta[j]); TL(T_RTM)[o] = (bf16_t)f2bf(tr[j]); TL(T_BTM)[o] = (bf16_t)f2bf(tb[j]); TL(T_KTM)[o] = (bf16_t)f2bf(tk[j]); }
            { const int o = c * TP + 8 * sg;
              *(LAS u32x4*)(TL(T_ACM) + o) = (u32x4){pk2(ta[0], ta[1]), pk2(ta[2], ta[3]), pk2(ta[4], ta[5]), pk2(ta[6], ta[7])};
              *(LAS u32x4*)(TL(T_VCM) + o) = (u32x4){pk2(vv[0], vv[1]), pk2(vv[2], vv[3]), pk2(vv[4], vv[5]), pk2(vv[6], vv[7])};
              *(LAS u32x4*)(TL(T_BCM) + o) = (u32x4){pk2(tb[0], tb[1]), pk2(tb[2], tb[3]), pk2(tb[4], tb[5]), pk2(tb[6], tb[7])};
              *(LAS u32x4*)(TL(T_KCM) + o) = (u32x4){pk2(tk[0], tk[1]), pk2(tk[2], tk[3]), pk2(tk[4], tk[5]), pk2(tk[6], tk[7])}; }
        }
        __syncthreads();
#pragma unroll
        for (int q = 0; q < 2; ++q) {
            const int id = 2 * wave + q, rt = id >> 2, ct = id & 3;
            const LAS bf16_t* Z = (rt < 2) ? TL(T_ATM) : TL(T_RTM); const LAS bf16_t* X = (ct < 2) ? TL(T_BTM) : TL(T_KTM);
            LAS bf16_t* D = (rt < 2) ? ((ct < 2) ? TL(T_MAB) : TL(T_MAK)) : ((ct < 2) ? TL(T_MRB) : TL(T_MRK));
            const int zr0 = (rt & 1) * 32, xr0 = (ct & 1) * 32; const bool strict = rt < 2;
            f32x16 acc = zero16();
            if (xr0 <= zr0) acc = mmt<4>(Z, TP, zr0, 0, X, TP, xr0, 0, acc, r, h);
#pragma unroll
            for (int e = 0; e < 16; ++e) { const int t = zr0 + crow(e, h), i = xr0 + r; const bool keep = strict ? (i < t) : (i <= t); D[t * TP + i] = keep ? (bf16_t)f2bf(acc[e]) : (bf16_t)0; }
        }
        __syncthreads();
        if (unit + F.G < 4096) load_raw(unit + F.G, nxt); else nxt = cur;
        if (wave == 0) {
            const LAS bf16_t* Lm = TL(T_MAB); LAS bf16_t* TI = TL(T_TINV);
            const int n = r, o = 32 * h;
            float x[32];
#pragma unroll
            for (int t = 0; t < 32; ++t) {
                float acc = (t == n) ? 1.0f : 0.0f;
#pragma unroll
                for (int i8 = 0; i8 < (t + 7) / 8; ++i8) { const u32x4 w = *(const LAS u32x4*)(Lm + (o + t) * TP + o + 8 * i8);
                    const float l0 = bflo(w.x), l1 = bfhi(w.x), l2 = bflo(w.y), l3 = bfhi(w.y), l4 = bflo(w.z), l5 = bfhi(w.z), l6 = bflo(w.w), l7 = bfhi(w.w);
                    if (8 * i8 + 0 < t) acc += l0 * x[8 * i8 + 0]; if (8 * i8 + 1 < t) acc += l1 * x[8 * i8 + 1]; if (8 * i8 + 2 < t) acc += l2 * x[8 * i8 + 2]; if (8 * i8 + 3 < t) acc += l3 * x[8 * i8 + 3];
                    if (8 * i8 + 4 < t) acc += l4 * x[8 * i8 + 4]; if (8 * i8 + 5 < t) acc += l5 * x[8 * i8 + 5]; if (8 * i8 + 6 < t) acc += l6 * x[8 * i8 + 6]; if (8 * i8 + 7 < t) acc += l7 * x[8 * i8 + 7]; }
                x[t] = acc;
            }
#pragma unroll
            for (int t = 0; t < 32; ++t) { TI[(o + t) * TP + o + n] = (bf16_t)f2bf(x[t]); if (h == 0) TI[t * TP + 32 + n] = (bf16_t)0; }
            if (h == 0) {
#pragma unroll
                for (int q = 0; q < 4; ++q) *(LAS u32x4*)(X11T + n * 40 + 8 * q) = (u32x4){pk2(x[8 * q], x[8 * q + 1]), pk2(x[8 * q + 2], x[8 * q + 3]), pk2(x[8 * q + 4], x[8 * q + 5]), pk2(x[8 * q + 6], x[8 * q + 7])};
            }
            LDS_WAIT(); asm volatile("" ::: "memory");
            f32x16 t1 = mmt<2>(Lm, TP, 32, 0, X11T, 40, 0, 0, zero16(), r, h);
#pragma unroll
            for (int g = 0; g < 4; ++g) *(LAS u32x2*)(T1T + r * 40 + 8 * g + 4 * h) = (u32x2){pk2(t1[4 * g], t1[4 * g + 1]), pk2(t1[4 * g + 2], t1[4 * g + 3])};
            LDS_WAIT(); asm volatile("" ::: "memory");
            f32x16 x21 = mmt<2>(TI, TP, 32, 32, T1T, 40, 0, 0, zero16(), r, h);
            store_rm(TI, 32, 0, x21, r, h);
        } else if (wave >= 4) {
            const int mi = (wave - 4) >> 1, ni = (wave - 4) & 1;
            f32x16 acc = mmt<4>(TL(T_VCM), TP, 32 * mi, 0, TL(T_MAK), TP, 32 * ni, 0, zero16(), r, h);
            store_rm(TL(T_G1), 32 * mi, 32 * ni, acc, r, h);
        }
        __syncthreads();
        {
            const int w4 = wave & 3, mi = w4 >> 1, ni = w4 & 1;
            if (wave < 4) { f32x16 acc = mmt<4>(TL(T_ACM), TP, 32 * mi, 0, TL(T_TINV), TP, 32 * ni, 0, zero16(), r, h); store_rm(TL(T_AP), 32 * mi, 32 * ni, acc, r, h); }
            else { f32x16 acc = mmt<4>(TL(T_G1), TP, 32 * mi, 0, TL(T_TINV), TP, 32 * ni, 0, zero16(), r, h); store_rm(TL(T_U0), 32 * mi, 32 * ni, acc, r, h); }
        }
        __syncthreads();
#pragma unroll
        for (int q = 0; q < 2; ++q) {
            const int id = 2 * wave + q, typ = id >> 2, xx = (id >> 1) & 1, yy = id & 1;
            if (typ == 0) {
                f32x16 acc = mmt<4>(TL(T_AP), TP, 32 * xx, 0, TL(T_MRB), TP, 32 * yy, 0, zero16(), r, h);
#pragma unroll
                for (int g = 0; g < 4; ++g) { const u32x2 w = *(const LAS u32x2*)(TL(T_RTM) + (32 * yy + r) * TP + 32 * xx + 8 * g + 4 * h);
                    acc[4 * g] += bflo(w.x); acc[4 * g + 1] += bfhi(w.x); acc[4 * g + 2] += bflo(w.y); acc[4 * g + 3] += bfhi(w.y); }
#pragma unroll
                for (int s = 0; s < 2; ++s) *(u32x4*)l3_slot(L3, tg0, hd * 64, (((xx * 2 + s) * 2 + yy) * 64 + lane) * 16) = pack8(acc, s);
            } else if (typ == 1) {
                f32x16 acc = mmt<4>(TL(T_U0), TP, 32 * xx, 0, TL(T_MRB), TP, 32 * yy, 0, zero16(), r, h);
                acc = mmt<4>(TL(T_VCM), TP, 32 * xx, 0, TL(T_MRK), TP, 32 * yy, 0, acc, r, h);
#pragma unroll
                for (int s = 0; s < 2; ++s) *(u32x4*)l3_slot(L3, tg0, 1024 + hd * 64, ((xx * 2 + yy) * 64 + lane) * 32 + 16 * s) = pack8(acc, s);
            } else if (typ == 2) {
                f32x16 acc = mmt<4>(TL(T_AP), TP, 32 * xx, 0, TL(T_BCM), TP, 32 * yy, 0, zero16(), r, h);
                const float pcc = pc[32 * yy + r];
#pragma unroll
                for (int e = 0; e < 16; ++e) acc[e] = (acc[e] + ((32 * xx + crow(e, h) == 32 * yy + r) ? 1.0f : 0.0f)) * pcc;
#pragma unroll
                for (int s = 0; s < 2; ++s) *(u32x4*)(MT + (size_t)unit * 4096 + (((yy * 2 + xx) * 2 + s) * 64 + lane) * 8) = pack8(acc, s);
            } else {
                f32x16 acc = mmt<4>(TL(T_BCM), TP, 32 * xx, 0, TL(T_U0), TP, 32 * yy, 0, zero16(), r, h);
                acc = mmt<4>(TL(T_KCM), TP, 32 * xx, 0, TL(T_VCM), TP, 32 * yy, 0, acc, r, h);
#pragma unroll
                for (int e = 0; e < 16; ++e) acc[e] *= pc[32 * xx + crow(e, h)];
#pragma unroll
                for (int s = 0; s < 2; ++s) *(u32x4*)(SA + (size_t)unit * 4096 + ((yy * 2 + xx) * 64 + lane) * 16 + 8 * s) = pack8(acc, s);
            }
        }
        __syncthreads();
        cur = nxt;
    }
#undef TL
}

struct PbSet { bf16x8 A[8]; u32x4 S[4]; };
__device__ __forceinline__ void pb_load(PbSet& d, const bf16_t* MT, const bf16_t* SA, int c, int lane) {
    const int cc = c < 64 ? c : 63;
    const char* mb = (const char*)MT + (size_t)cc * 8192; const char* sb = (const char*)SA + (size_t)cc * 8192;
    const unsigned lo16 = (unsigned)lane * 16u, lo32 = (unsigned)lane * 32u;
#pragma unroll
    for (int f = 0; f < 8; ++f) d.A[f] = *(const bf16x8*)(mb + lo16 + f * 1024);
#pragma unroll
    for (int q = 0; q < 4; ++q) d.S[q] = *(const u32x4*)(sb + lo32 + (q >> 1) * 2048 + 16 * (q & 1));
}
__device__ __forceinline__ void pb_step(const PbSet& d, f32x16 (&X)[2], bf16_t* SA, int c, int lane, const bool dry) {
    bf16x8 Bf[4];
#pragma unroll
    for (int kt = 0; kt < 2; ++kt)
#pragma unroll
        for (int s = 0; s < 2; ++s) { const u32x4 w = pack8(X[kt], s); Bf[kt * 2 + s] = __builtin_bit_cast(bf16x8, w); if (!dry) *(u32x4*)((char*)SA + (size_t)c * 8192 + (unsigned)lane * 16u + (kt * 2 + s) * 1024) = w; }
    f32x16 D[2];
#pragma unroll
    for (int ip = 0; ip < 2; ++ip) { unpack8(d.S[2 * ip], D[ip], 0); unpack8(d.S[2 * ip + 1], D[ip], 1);
#pragma unroll
        for (int ks = 0; ks < 4; ++ks) D[ip] = __builtin_amdgcn_mfma_f32_32x32x16_bf16(d.A[ip * 4 + ks], Bf[ks], D[ip], 0, 0, 0); }
    X[0] = D[0]; X[1] = D[1];
}
__device__ __forceinline__ void pass_b(Frame& F, int bh, int j, const bool dry) {
    const int lane = F.lane;
    const bf16_t* MT = (const bf16_t*)(F.ws + WS_MT) + (size_t)bh * 64 * 4096; bf16_t* SA = (bf16_t*)(F.ws + WS_SA) + (size_t)bh * 64 * 4096 + j * 2048;
    f32x16 X[2] = {zero16(), zero16()};
    PbSet s0, s1, s2;
    pb_load(s0, MT, SA, 0, lane); pb_load(s1, MT, SA, 1, lane);
    for (int c = 0; c < 63; c += 3) {
        pb_load(s2, MT, SA, c + 2, lane); pb_step(s0, X, SA, c, lane, dry);
        pb_load(s0, MT, SA, c + 3, lane); pb_step(s1, X, SA, c + 1, lane, dry);
        pb_load(s1, MT, SA, c + 4, lane); pb_step(s2, X, SA, c + 2, lane, dry);
    }
    pb_step(s0, X, SA, 63, lane, dry);
}

__device__ __forceinline__ void pass_c(Frame& F) {
    const int lane = F.lane, r = lane & 31, h = lane >> 5;
    const int gw = F.vcu * 8 + F.wave, NGW = F.G * 8;
    const bf16_t* P = (const bf16_t*)(F.ws + WS_P); unsigned char* L3 = F.ws + WS_L3; const bf16_t* SA = (const bf16_t*)(F.ws + WS_SA); const float* BON = (const float*)(F.ws + WS_BON);
    bf16_t* Y = (bf16_t*)(F.ws + WS_YCAT); const float* mix = F.in[I_MIX];
    for (int unit = gw; unit < 4096; unit += NGW) {
        const int b = unit >> 10, hd = (unit >> 6) & 15, ci = unit & 63, tg0 = b * SEQ + ci * 64;
        bf16x8 Af[8], Bf[8];
#pragma unroll
        for (int f = 0; f < 8; ++f) Af[f] = *(const bf16x8*)(SA + (size_t)unit * 4096 + (f * 64 + lane) * 8);
#pragma unroll
        for (int f = 0; f < 8; ++f) Bf[f] = *(const bf16x8*)l3_slot(L3, tg0, hd * 64, (f * 64 + lane) * 16);
        f32x16 acc[2][2];
#pragma unroll
        for (int j = 0; j < 2; ++j)
#pragma unroll
            for (int tt = 0; tt < 2; ++tt) {
#pragma unroll
                for (int s = 0; s < 2; ++s) unpack8(*(const u32x4*)l3_slot(L3, tg0, 1024 + hd * 64, ((j * 2 + tt) * 64 + lane) * 32 + 16 * s), acc[j][tt], s);
#pragma unroll
                for (int ks = 0; ks < 4; ++ks) acc[j][tt] = __builtin_amdgcn_mfma_f32_32x32x16_bf16(Af[j * 4 + ks], Bf[ks * 2 + tt], acc[j][tt], 0, 0, 0);
            }
#pragma unroll
        for (int tt = 0; tt < 2; ++tt) {
            const int tl = 32 * tt + r, tg = tg0 + tl;
            float sm = 0.f;
#pragma unroll
            for (int e = 0; e < 16; ++e) sm += acc[0][tt][e] + acc[1][tt][e];
            sm += __shfl_xor(sm, 32); const float mean = sm * (1.0f / 64.0f);
            float sq = 0.f;
#pragma unroll
            for (int e = 0; e < 16; ++e) { const float d0 = acc[0][tt][e] - mean, d1 = acc[1][tt][e] - mean; sq += d0 * d0 + d1 * d1; }
            sq += __shfl_xor(sq, 32); const float rstd = rsqrtf(sq * (1.0f / 64.0f) + GN_EPS);
            const float bon = BON[(size_t)tg * 16 + hd];
            const bool hp = (ci > 0) || (tl > 0);
            const bf16_t* prow = P + (size_t)tg * NP + PVR + hd * 64; const bf16_t* lrow = (const bf16_t*)L3 + (size_t)tg * NL + 2048 + hd * 64; bf16_t* yrow = Y + (size_t)tg * DM + 1024 + hd * 64;
#pragma unroll
            for (int j = 0; j < 2; ++j)
#pragma unroll
                for (int g = 0; g < 4; ++g) { const int v0 = 32 * j + 8 * g + 4 * h, ch = hd * 64 + v0;
                    const u32x2 cv = *(const u32x2*)(prow + v0); u32x2 pv = (u32x2){0u, 0u}; if (hp) pv = *(const u32x2*)(prow - NP + v0);
                    const u32x2 gg = *(const u32x2*)(lrow + v0);
                    const f32x4 mu = *(const f32x4*)(mix + 2112 + ch), lw = *(const f32x4*)(F.in[I_LNW] + ch), lb = *(const f32x4*)(F.in[I_LNB] + ch);
                    const float c0 = bflo(cv.x), c1 = bfhi(cv.x), c2 = bflo(cv.y), c3 = bfhi(cv.y);
                    const float v_0 = c0 + (bflo(pv.x) - c0) * mu.x, v_1 = c1 + (bfhi(pv.x) - c1) * mu.y, v_2 = c2 + (bflo(pv.y) - c2) * mu.z, v_3 = c3 + (bfhi(pv.y) - c3) * mu.w;
                    const float o0 = ((acc[j][tt][4 * g] - mean) * rstd * lw.x + lb.x + bon * v_0) * bflo(gg.x);
                    const float o1 = ((acc[j][tt][4 * g + 1] - mean) * rstd * lw.y + lb.y + bon * v_1) * bfhi(gg.x);
                    const float o2 = ((acc[j][tt][4 * g + 2] - mean) * rstd * lw.z + lb.z + bon * v_2) * bflo(gg.y);
                    const float o3 = ((acc[j][tt][4 * g + 3] - mean) * rstd * lw.w + lb.w + bon * v_3) * bfhi(gg.y);
                    *(u32x2*)(yrow + v0) = (u32x2){pk2(o0, o1), pk2(o2, o3)}; }
        }
    }
}
}


namespace att {
using s16x4 = __attribute__((ext_vector_type(4))) short;
constexpr int D = 128, NW = 8, QBLK = 32, KVBLK = 64;
constexpr float THRL = 8.0f * 1.4426950408889634f;
constexpr size_t SHM_V = KVBLK * D * 2, SHM_K = KVBLK * D * 2, SHM_ATTN = 2 * SHM_V + 2 * SHM_K + NW * 64 * 4;
static_assert(SHM_ATTN <= RING_BYTES, "attention LDS");
#define KSWZ(row, colB) ((row) * 256 + ((colB) ^ (((row) & 7) << 4)))
#define SBAR() __builtin_amdgcn_sched_barrier(0)
__device__ __forceinline__ int crow(int r, int hi) { return (r & 3) + 8 * (r >> 2) + 4 * hi; }
__device__ __forceinline__ unsigned cvtpk(float lo, float hi) { unsigned r; asm volatile("v_cvt_pk_bf16_f32 %0, %1, %2" : "=v"(r) : "v"(lo), "v"(hi)); return r; }
__device__ __forceinline__ void partialSM(f32x16& p0, f32x16& p1, const u32x2 mk, float& m_reg, float& mn, float& alpha) {
#pragma unroll
  for (int r = 0; r < 16; ++r) { const unsigned bit = 1u << ((r & 3) + 8 * (r >> 2)); p0[r] = (mk.x & bit) ? p0[r] : -INFINITY; p1[r] = (mk.y & bit) ? p1[r] : -INFINITY; }
  float pmax = p0[0];
#pragma unroll
  for (int r = 1; r < 16; ++r) pmax = fmaxf(pmax, p0[r]);
#pragma unroll
  for (int r = 0; r < 16; ++r) pmax = fmaxf(pmax, p1[r]);
  { auto rr = __builtin_amdgcn_permlane32_swap(__float_as_uint(pmax), __float_as_uint(pmax), false, false);
    pmax = fmaxf(__uint_as_float(rr[0]), __uint_as_float(rr[1])); }
  if (__builtin_expect(__all(pmax - m_reg <= THRL), 1)) { mn = m_reg; alpha = 1.f; }
  else { mn = fmaxf(m_reg, pmax); alpha = __builtin_amdgcn_exp2f(m_reg - mn); m_reg = mn; }
#pragma unroll
  for (int r = 0; r < 16; ++r) { p0[r] = __builtin_amdgcn_exp2f(p0[r] - mn); p1[r] = p1[r] - mn; }
}
__device__ __forceinline__ void finishSM(f32x16& p0, f32x16& p1, float alpha, float& l_reg, bf16x8& pa0, bf16x8& pa1, bf16x8& pa2, bf16x8& pa3) {
#pragma unroll
  for (int r = 0; r < 16; ++r) p1[r] = __builtin_amdgcn_exp2f(p1[r]);
  float ps = 0;
#pragma unroll
  for (int r = 0; r < 16; ++r) ps += p0[r];
#pragma unroll
  for (int r = 0; r < 16; ++r) ps += p1[r];
  { auto rr = __builtin_amdgcn_permlane32_swap(__float_as_uint(ps), __float_as_uint(ps), false, false);
    ps = __uint_as_float(rr[0]) + __uint_as_float(rr[1]); }
  l_reg = l_reg * alpha + ps;
#define PK4(P, BASE, OUT) do { unsigned a0 = cvtpk(P[BASE + 0], P[BASE + 1]), a1 = cvtpk(P[BASE + 2], P[BASE + 3]);   \
    unsigned b0 = cvtpk(P[BASE + 4], P[BASE + 5]), b1 = cvtpk(P[BASE + 6], P[BASE + 7]);                              \
    auto r0 = __builtin_amdgcn_permlane32_swap(a0, b0, false, false); auto r1 = __builtin_amdgcn_permlane32_swap(a1, b1, false, false); \
    u32x4 w = {r0[0], r1[0], r0[1], r1[1]}; OUT = __builtin_bit_cast(bf16x8, w); } while (0)
  PK4(p0, 0, pa0); PK4(p0, 8, pa1); PK4(p1, 0, pa2); PK4(p1, 8, pa3);
#undef PK4
}
__device__ __forceinline__ void qkt(f32x16& p0, f32x16& p1, const char* Ks, const bf16x8* qr, int r32, int hi) {
  p0 = f32x16{}; p1 = f32x16{};
#pragma unroll
  for (int d0 = 0; d0 < 8; ++d0) { int cb = (d0 * 16 + hi * 8) * 2;
    bf16x8 b0 = *reinterpret_cast<const bf16x8*>(Ks + KSWZ(r32, cb));
    bf16x8 b1 = *reinterpret_cast<const bf16x8*>(Ks + KSWZ(32 + r32, cb));
    p0 = __builtin_amdgcn_mfma_f32_32x32x16_bf16(b0, qr[d0], p0, 0, 0, 0);
    p1 = __builtin_amdgcn_mfma_f32_32x32x16_bf16(b1, qr[d0], p1, 0, 0, 0); }
}
__device__ __forceinline__ int v_st(int k, int c) { const int kk = (k & ~0xC) | ((k & 4) << 1) | ((k & 8) >> 1); return ((kk >> 3) * 4 + (c >> 5)) * 512 + ((kk & 7) * 32 + (c & 31)) * 2; }
__device__ __forceinline__ int v_rd_base(int lane) { return ((lane & 3) << 3) | (((lane >> 2) & 3) << 6) | (((lane >> 4) & 1) << 5) | (((lane >> 5) & 1) << 8); }
constexpr int v_rd_off(int d0, int ks, int half) { return d0 * 512 + ks * 4096 + half * 2048; }
template <int OFF> __device__ __forceinline__ s16x4 tr_read(int vb) { s16x4 r; asm volatile("ds_read_b64_tr_b16 %0, %1 offset:%2" : "=&v"(r) : "v"(vb), "i"(OFF) : "memory"); return r; }
template <int D0> __device__ __forceinline__ void pv_one(f32x16& od, int vb, bf16x8 pa0, bf16x8 pa1, bf16x8 pa2, bf16x8 pa3) {
  const s16x4 l0 = tr_read<v_rd_off(D0, 0, 0)>(vb), h0 = tr_read<v_rd_off(D0, 0, 1)>(vb), l1 = tr_read<v_rd_off(D0, 1, 0)>(vb), h1 = tr_read<v_rd_off(D0, 1, 1)>(vb);
  const s16x4 l2 = tr_read<v_rd_off(D0, 2, 0)>(vb), h2 = tr_read<v_rd_off(D0, 2, 1)>(vb), l3 = tr_read<v_rd_off(D0, 3, 0)>(vb), h3 = tr_read<v_rd_off(D0, 3, 1)>(vb);
  asm volatile("s_waitcnt lgkmcnt(0)" ::: "memory"); SBAR();
#define PK(L, H) (bf16x8){L[0], L[1], L[2], L[3], H[0], H[1], H[2], H[3]}
  od = __builtin_amdgcn_mfma_f32_32x32x16_bf16(pa0, PK(l0, h0), od, 0, 0, 0);
  od = __builtin_amdgcn_mfma_f32_32x32x16_bf16(pa1, PK(l1, h1), od, 0, 0, 0);
  od = __builtin_amdgcn_mfma_f32_32x32x16_bf16(pa2, PK(l2, h2), od, 0, 0, 0);
  od = __builtin_amdgcn_mfma_f32_32x32x16_bf16(pa3, PK(l3, h3), od, 0, 0, 0);
#undef PK
}
__device__ __forceinline__ void pv_d0(f32x16* o, int vb, bf16x8 pa0, bf16x8 pa1, bf16x8 pa2, bf16x8 pa3) {
  pv_one<0>(o[0], vb, pa0, pa1, pa2, pa3); pv_one<1>(o[1], vb, pa0, pa1, pa2, pa3); pv_one<2>(o[2], vb, pa0, pa1, pa2, pa3); pv_one<3>(o[3], vb, pa0, pa1, pa2, pa3);
}
__device__ __forceinline__ void attn_unit(const bf16_t* __restrict__ Qb, const bf16_t* __restrict__ Kh, const bf16_t* __restrict__ Vh, const unsigned* __restrict__ Mb,
                                          bf16_t* __restrict__ Ob, int seq, char* lds) {
  constexpr int LDQ = NP, LDK = NP, LDO = DM;
  int tid_ = threadIdx.x; asm volatile("" : "+v"(tid_));
  const int tid = tid_, wid = tid >> 6, lane = tid & 63, r32 = lane & 31, hi = lane >> 5;
  char* V_lds = lds; char* K_lds = lds + 2 * SHM_V;
  float* wsf = (float*)(lds + 2 * SHM_V + 2 * SHM_K) + wid * 64; float* li_l = wsf; float* al_l = wsf + 32;
  float m_reg = -1e30f, l_reg = 0; f32x16 o[4] = {}; bf16x8 qr[8];
  const bf16_t* Qw = Qb + (long)(wid * QBLK + r32) * LDQ + hi * 8;
#pragma unroll
  for (int d0 = 0; d0 < 8; ++d0) qr[d0] = *reinterpret_cast<const bf16x8*>(Qw + d0 * 16);
  const unsigned* Mw = Mb + (long)(wid * QBLK + r32) * 128;
  const int sh = 4 * hi;
  const int sr = tid >> 4, sc = (tid & 15) * 8, vst0 = v_st(sr, sc), vst1 = v_st(32 + sr, sc);
  const int vb0 = (int)(uintptr_t)V_lds + v_rd_base(lane);
  struct { bf16x8 vs0, vs1, ks0, ks1; } sr_[2];
#define SLOAD(i, k0) do { sr_[i].vs0 = *(const bf16x8*)(&Vh[(long)((k0) + sr) * LDK + sc]); sr_[i].vs1 = *(const bf16x8*)(&Vh[(long)((k0) + 32 + sr) * LDK + sc]); \
    sr_[i].ks0 = *(const bf16x8*)(&Kh[(long)((k0) + sr) * LDK + sc]); sr_[i].ks1 = *(const bf16x8*)(&Kh[(long)((k0) + 32 + sr) * LDK + sc]); } while (0)
#define SWRITE(b, i) do { *(bf16x8*)(V_lds + (b) * SHM_V + vst0) = sr_[i].vs0;          \
    *(bf16x8*)(V_lds + (b) * SHM_V + vst1) = sr_[i].vs1; int kc = sc * 2;               \
    *(bf16x8*)(K_lds + (b) * SHM_K + KSWZ(sr, kc)) = sr_[i].ks0;                       \
    *(bf16x8*)(K_lds + (b) * SHM_K + KSWZ(32 + sr, kc)) = sr_[i].ks1; } while (0)
#define SWAIT() asm volatile("s_waitcnt vmcnt(4)" ::: "memory")
#define RESC(a) do { if (__any((a) < 1.f)) { if (hi == 0) al_l[r32] = (a); asm volatile("s_waitcnt lgkmcnt(0)" ::: "memory"); \
    _Pragma("unroll") for (int d = 0; d < 4; ++d) _Pragma("unroll") for (int r = 0; r < 16; ++r) o[d][r] *= al_l[crow(r, hi)]; } } while (0)
#define MLOAD(j) ({ u32x2 _m = *(const u32x2*)(Mw + 2 * (j)); _m.x >>= sh; _m.y >>= sh; _m; })
  f32x16 pA0, pA1, pB0, pB1; float mnA, mnB, alA, alB; bf16x8 pa0, pa1, pa2, pa3; const int NT = seq / KVBLK;
  constexpr int SE = 0, SO = 1;
  u32x2 mkA = MLOAD(0), mkB = MLOAD(1);
  SLOAD(SE, 0); asm volatile("s_waitcnt vmcnt(0)" ::: "memory"); SWRITE(0, SE); __syncthreads();
  qkt(pA0, pA1, K_lds, qr, r32, hi); partialSM(pA0, pA1, mkA, m_reg, mnA, alA);
  SLOAD(SO, KVBLK); if (2 < NT) SLOAD(SE, 2 * KVBLK);
  SWAIT(); SWRITE(1, SO); __syncthreads();
  for (int j = 1; j + 1 < NT; j += 2) {
    mkA = MLOAD(j + 1);
    SBAR(); qkt(pB0, pB1, K_lds + SHM_K, qr, r32, hi);
    finishSM(pA0, pA1, alA, l_reg, pa0, pa1, pa2, pa3); SBAR();
    SLOAD(SO, (j + 2) * KVBLK); SBAR();
    pv_d0(o, vb0, pa0, pa1, pa2, pa3); partialSM(pB0, pB1, mkB, m_reg, mnB, alB);
    __syncthreads(); SWAIT(); SWRITE(0, SE);
    RESC(alB); __syncthreads();
    mkB = MLOAD(j + 2);
    SBAR(); qkt(pA0, pA1, K_lds, qr, r32, hi);
    finishSM(pB0, pB1, alB, l_reg, pa0, pa1, pa2, pa3); SBAR();
    if (j + 3 < NT) SLOAD(SE, (j + 3) * KVBLK); SBAR();
    pv_d0(o, vb0 + (int)SHM_V, pa0, pa1, pa2, pa3); partialSM(pA0, pA1, mkA, m_reg, mnA, alA);
    __syncthreads(); SWAIT(); SWRITE(1, SO);
    RESC(alA); __syncthreads();
  }
  SBAR(); qkt(pB0, pB1, K_lds + SHM_K, qr, r32, hi);
  finishSM(pA0, pA1, alA, l_reg, pa0, pa1, pa2, pa3); SBAR();
  pv_d0(o, vb0, pa0, pa1, pa2, pa3); partialSM(pB0, pB1, mkB, m_reg, mnB, alB);
  __syncthreads(); RESC(alB);
  finishSM(pB0, pB1, alB, l_reg, pa0, pa1, pa2, pa3); SBAR();
  pv_d0(o, vb0 + (int)SHM_V, pa0, pa1, pa2, pa3);
  if (hi == 0) li_l[r32] = l_reg; asm volatile("s_waitcnt lgkmcnt(0)" ::: "memory");
  float rli[16];
#pragma unroll
  for (int r = 0; r < 16; ++r) rli[r] = __builtin_amdgcn_rcpf(li_l[crow(r, hi)]);
  bf16_t* Ow = Ob + (long)(wid * QBLK) * LDO;
#pragma unroll
  for (int r = 0; r < 16; ++r) { int orow = crow(r, hi);
#pragma unroll
    for (int d0 = 0; d0 < 4; ++d0) Ow[(long)orow * LDO + d0 * 32 + r32] = (bf16_t)f2bf(o[d0][r] * rli[r]); }
  __syncthreads();
#undef SLOAD
#undef SWRITE
#undef SWAIT
#undef RESC
#undef MLOAD
}
__device__ __forceinline__ void attn_phase(Frame& F) {
  const bf16_t* P = (const bf16_t*)(F.ws + WS_P); const unsigned* MSK = (const unsigned*)(F.ws + WS_MSK); bf16_t* Y = (bf16_t*)(F.ws + WS_YCAT);
  for (int u = F.vcu; u < 512; u += F.G) {
    const int pairi = u & 255, second = u >> 8; const int bh = pairi >> 3, ql = pairi & 7; const int qb = second ? ql : 15 - ql;
    const int b = bh >> 3, hd = bh & 7; const long t0 = (long)b * SEQ + qb * 256;
    attn_unit(P + t0 * NP + PQ + hd * 128, P + (long)b * SEQ * NP + PK + hd * 128, P + (long)b * SEQ * NP + PV + hd * 128, MSK + t0 * 128, Y + t0 * DM + hd * 128, (qb + 1) * 256, (char*)F.ldsg);
  }
}
#undef KSWZ
#undef SBAR
}

__device__ __forceinline__ void phase_idx_passb(Frame& F, const bool dry, const int qw) {
    const int npb = (F.G >= 64) ? 16 : 0;
    if (npb) { if (F.vcu < npb) { const int ch = F.vcu * 8 + F.wave; rw::pass_b(F, ch >> 1, ch & 1, dry); return; } }
    else { for (int ch = F.vcu * 8 + F.wave; ch < 128; ch += F.G * 8) rw::pass_b(F, ch >> 1, ch & 1, dry); __syncthreads(); }
    volatile LAS int* qs = (volatile LAS int*)(F.lds + MISC_OFF + 64);
    for (;;) {
        if (F.tid == 0) qs[0] = (int)atomicAdd(F.ctl + CW_QIDX + 64 * qw, 1u);
        __syncthreads();
        const int u = qs[0];
        __syncthreads();
        if (u >= 1024) break;
        idx_unit(F, u);
    }
}

struct RouteRec { int cls, pos; float g_lo, g_hi, rstd; int pad0, pad1, pad2; };
__device__ __forceinline__ void phase7(Frame& F, const bool dry, const int mode = 3) {
    const int gw = F.vcu * 8 + F.wave, NGW = F.G * 8, lane = F.lane;
    { int* rowtok = (int*)(F.ws + WS_ROWTOK); for (int i = gw * 64 + lane; i < MPAD; i += NGW * 64) rowtok[i] = -1; }
    if (mode & 1) { LAS float* scr = (LAS float*)(F.lds + F.wave * 16384);
      bf16_t* WGU = (bf16_t*)(F.ws + WS_WGU); bf16_t* WDN = (bf16_t*)(F.ws + WS_WDN);
      constexpr int IG = (DM / 64) * (512 / 32), ID = (512 / 64) * (DM / 32);
      for (int it = gw; it < 16 * (2 * IG + ID); it += NGW) { const int e = it / (2 * IG + ID); int r = it % (2 * IG + ID);
          if (r < IG) transpose_item<2>(F.in[I_WEG] + (size_t)e * DM * 512, 512, WGU + (size_t)e * 1024 * DM, DM, scr, r / 16, r % 16, lane);
          else if (r < 2 * IG) { r -= IG; transpose_item<3>(F.in[I_WEU] + (size_t)e * DM * 512, 512, WGU + (size_t)e * 1024 * DM, DM, scr, r / 16, r % 16, lane); }
          else { r -= 2 * IG; transpose_item<0>(F.in[I_WED] + (size_t)e * 512 * DM, DM, WDN + (size_t)e * DM * 512, 512, scr, r / 64, r % 64, lane); } } }
    if (mode & 2) {
    const float* x1 = F.out; const bf16_t* WRH = (const bf16_t*)(F.ws + WS_WRT); const bf16_t* WRL = WRH + 32 * DM;
    RouteRec* rr = (RouteRec*)(F.ws + WS_ROUTE); unsigned* cnt = F.ctl + CW_CNT;
    const int r = lane & 31, h = lane >> 5;
    __syncthreads();
    const int grp = F.wave >> 2, kq = F.wave & 3;
    LAS float* part = (LAS float*)F.lds;
    for (int tbase = F.vcu * 2; tbase < T / 32; tbase += F.G * 2) {
        const int task = tbase + grp;
        const int t = task * 32 + r;
        const float* xp = x1 + (size_t)t * DM + 512 * kq + 8 * h; const bf16_t* ah = WRH + (size_t)r * DM + 512 * kq + 8 * h; const bf16_t* al = WRL + (size_t)r * DM + 512 * kq + 8 * h;
        f32x16 acc = {0.f, 0.f, 0.f, 0.f, 0.f, 0.f, 0.f, 0.f, 0.f, 0.f, 0.f, 0.f, 0.f, 0.f, 0.f, 0.f};
        float ssq = 0.f;
#pragma unroll 4
        for (int s = 0; s < 512 / 16; ++s) {
            const f32x4 x0 = *(const f32x4*)(xp + 16 * s), x4 = *(const f32x4*)(xp + 16 * s + 4);
            const bf16x8 wh = *(const bf16x8*)(ah + 16 * s), wl = *(const bf16x8*)(al + 16 * s);
            ssq += (x0.x * x0.x + x0.y * x0.y) + (x0.z * x0.z + x0.w * x0.w) + (x4.x * x4.x + x4.y * x4.y) + (x4.z * x4.z + x4.w * x4.w);
            u32x4 xh, xl;
            xh.x = pk2(x0.x, x0.y); xh.y = pk2(x0.z, x0.w); xh.z = pk2(x4.x, x4.y); xh.w = pk2(x4.z, x4.w);
            xl.x = pk2(x0.x - bflo(xh.x), x0.y - bfhi(xh.x)); xl.y = pk2(x0.z - bflo(xh.y), x0.w - bfhi(xh.y)); xl.z = pk2(x4.x - bflo(xh.z), x4.y - bfhi(xh.z)); xl.w = pk2(x4.z - bflo(xh.w), x4.w - bfhi(xh.w));
            acc = __builtin_amdgcn_mfma_f32_32x32x16_bf16(wh, __builtin_bit_cast(bf16x8, xh), acc, 0, 0, 0);
            acc = __builtin_amdgcn_mfma_f32_32x32x16_bf16(wl, __builtin_bit_cast(bf16x8, xh), acc, 0, 0, 0);
            acc = __builtin_amdgcn_mfma_f32_32x32x16_bf16(wh, __builtin_bit_cast(bf16x8, xl), acc, 0, 0, 0);
        }
        { LAS float* pp = part + ((grp * 4 + kq) * 64 + lane) * 17;
#pragma unroll
          for (int e = 0; e < 12; ++e) pp[e] = acc[e];
          pp[16] = ssq; }
        __syncthreads();
        if (kq == 0) {
#pragma unroll
            for (int q = 1; q < 4; ++q) { const LAS float* pp = part + ((grp * 4 + q) * 64 + lane) * 17;
#pragma unroll
                for (int e = 0; e < 12; ++e) acc[e] += pp[e];
                ssq += pp[16]; }
        }
        __syncthreads();
        if (kq != 0 || task >= T / 32) continue;
        ssq += __shfl_xor(ssq, 32);
        const float rstd = rsqrtf(ssq * (1.f / DM) + NORM_EPS);
        float ot[8];
#pragma unroll
        for (int e = 0; e < 8; ++e) ot[e] = __shfl_xor(acc[e], 32);
        float lg[20];
#pragma unroll
        for (int q = 0; q < 4; ++q) { lg[q] = acc[q] * rstd; lg[8 + q] = acc[4 + q] * rstd; lg[16 + q] = acc[8 + q] * rstd; lg[4 + q] = ot[q] * rstd; lg[12 + q] = ot[4 + q] * rstd; }
        float gl[4]; float gm = -INFINITY;
#pragma unroll
        for (int o = 0; o < 4; ++o) { gl[o] = lg[o] + F.in[I_BRG][o]; gm = fmaxf(gm, gl[o]); }
        float gs = 0.f; int gsel = 0; float gbest = -INFINITY;
#pragma unroll
        for (int o = 0; o < 4; ++o) { gs += __expf(gl[o] - gm); if (gl[o] > gbest) { gbest = gl[o]; gsel = o; } }
        const float pgrp = __expf(gbest - gm) / gs;
        float el[4]; float em = -INFINITY;
#pragma unroll
        for (int q = 0; q < 4; ++q) { float vsel = 0.f;
#pragma unroll
            for (int g2 = 0; g2 < 4; ++g2) vsel = (gsel == g2) ? lg[4 + 4 * g2 + q] + F.in[I_BRE][4 * g2 + q] : vsel;
            el[q] = vsel; em = fmaxf(em, vsel); }
        int i1 = 0; float b1 = -INFINITY;
#pragma unroll
        for (int q = 0; q < 4; ++q) if (el[q] > b1) { b1 = el[q]; i1 = q; }
        int i2 = 0; float b2 = -INFINITY;
#pragma unroll
        for (int q = 0; q < 4; ++q) if (q != i1 && el[q] > b2) { b2 = el[q]; i2 = q; }
        const float p1 = __expf(b1 - em), p2 = __expf(b2 - em); const float inv = 1.0f / (p1 + p2);
        const float gw1 = pgrp * p1 * inv, gw2 = pgrp * p2 * inv;
        const int elo = i1 < i2 ? i1 : i2, ehi = i1 < i2 ? i2 : i1; const float glo = i1 < i2 ? gw1 : gw2, ghi = i1 < i2 ? gw2 : gw1;
        const int pair = (elo == 0) ? (ehi - 1) : (elo == 1 ? ehi + 1 : 5);
        const int cls = gsel * 6 + pair;
        if (h == 0 && !dry) { const unsigned pos = atomicAdd(&cnt[cls], 1u); RouteRec rc; rc.cls = cls; rc.pos = (int)pos; rc.g_lo = glo; rc.g_hi = ghi; rc.rstd = rstd; rc.pad0 = rc.pad1 = rc.pad2 = 0; rr[t] = rc; }
    }
    }
}

__device__ __forceinline__ void class_bases(Frame& F, volatile LAS int* tb) {
    if (F.tid == 0) { int acc = 0; for (int c = 0; c < NCLS; ++c) { tb[c] = acc; const int n = (int)__hip_atomic_load(F.ctl + CW_CNT + c, __ATOMIC_RELAXED, __HIP_MEMORY_SCOPE_AGENT); acc += (n + 255) & ~255; } tb[NCLS] = acc; }
    __syncthreads();
}

__device__ __forceinline__ void phase8(Frame& F) {
    const int gw = F.vcu * 8 + F.wave, NGW = F.G * 8, lane = F.lane;
    volatile LAS int* tb = (volatile LAS int*)(F.lds + MISC_OFF + 128);
    class_bases(F, tb);
    const float* x1 = F.out; const float* gf = F.in[I_GFFN];
    const RouteRec* rr = (const RouteRec*)(F.ws + WS_ROUTE); int* rowtok = (int*)(F.ws + WS_ROWTOK); float* gates = (float*)(F.ws + WS_ROWTOK + 128 * 1024);
    bf16_t* H2S = (bf16_t*)(F.ws + WS_H2S);
    f32x4 gv[8];
#pragma unroll
    for (int j = 0; j < 8; ++j) gv[j] = ((const f32x4*)gf)[64 * j + lane];
    for (int t = gw; t < T; t += NGW) {
        const RouteRec r = rr[t]; const int row = tb[r.cls] + r.pos;
        const f32x4* xr = (const f32x4*)(x1 + (size_t)t * DM) + lane; u32x2* o = (u32x2*)(H2S + (size_t)row * DM) + lane;
#pragma unroll
        for (int j = 0; j < 8; ++j) { const f32x4 v = xr[64 * j]; u32x2 w; w.x = pk2(v.x * r.rstd * gv[j].x, v.y * r.rstd * gv[j].y); w.y = pk2(v.z * r.rstd * gv[j].z, v.w * r.rstd * gv[j].w); o[64 * j] = w; }
        if (lane == 0) { rowtok[row] = t; gates[2 * row] = r.g_lo; gates[2 * row + 1] = r.g_hi; }
    }
    for (int idx = gw; idx < NCLS * 256; idx += NGW) { const int c = idx >> 8, off = idx & 255; const int n = (int)__hip_atomic_load(F.ctl + CW_CNT + c, __ATOMIC_RELAXED, __HIP_MEMORY_SCOPE_AGENT);
        const int row = tb[c] + n + off;
        if (row < tb[c + 1]) { u32x2* o = (u32x2*)(H2S + (size_t)row * DM) + lane;
#pragma unroll
            for (int j = 0; j < 8; ++j) o[64 * j] = (u32x2){0u, 0u};
            if (lane == 0) { gates[2 * row] = 0.f; gates[2 * row + 1] = 0.f; } } }
}

__device__ __forceinline__ int class_of_tile(volatile LAS int* tb, int rt) { int c = 0; const int r0 = rt * 256; for (int k = 1; k < NCLS; ++k) c = (r0 >= tb[k]) ? k : c; return c; }
__device__ __forceinline__ int class_expert(int cls, int half) { const int g = cls / 6, p = cls % 6; const int elo = p < 3 ? 0 : (p < 5 ? 1 : 2); const int ehi = p < 3 ? p + 1 : (p < 5 ? p - 1 : 3); return 4 * g + (half ? ehi : elo); }
struct Moe1Sched {
    volatile LAS int* tb; const char* A; const char* B; int G, c, nu;
    __device__ bool seg(int i, pg8::Seg& s) const { const int L = i * G + c; if (L >= nu) return false; const int rt = L >> 3, pn = L & 7; const int cls = class_of_tile(tb, rt); const int e = class_expert(cls, pn >> 2);
        s.A = A + (size_t)rt * 256 * DM * 2; s.B = B + ((size_t)e * 1024 + (pn & 3) * 256) * DM * 2; s.u.pm = rt; s.u.pn = pn; s.u.aux = 0; s.last = 1; return true; }
};
struct Moe2Sched {
    volatile LAS int* tb; const char* A; const char* B; int G, c, nu;
    __device__ bool seg(int i, pg8::Seg& s) const { const int ui = i >> 1, half = i & 1; const int L = ui * G + c; if (L >= nu) return false; const int rt = L >> 3, pn = L & 7; const int cls = class_of_tile(tb, rt); const int e = class_expert(cls, half);
        s.A = A + ((size_t)rt * 256 * 1024 + half * 512) * 2; s.B = B + ((size_t)e * DM + pn * 256) * 512 * 2; s.u.pm = rt; s.u.pn = pn; s.u.aux = 0; s.last = half; return true; }
};

constexpr int NPHASE = 12;
__global__ void __launch_bounds__(512, 2) fwd_kernel(Args args) {
    extern __shared__ __attribute__((aligned(16))) unsigned char lds_raw[];
    Frame F;
    F.lds = (LAS unsigned char*)lds_raw; F.ldsg = lds_raw;
    F.tid = threadIdx.x; F.lane = F.tid & 63; F.wave = __builtin_amdgcn_readfirstlane(F.tid >> 6);
    F.G = gridDim.x; { const int bx = blockIdx.x; F.vcu = (F.G % 8 == 0) ? (bx % 8) * (F.G / 8) + bx / 8 : bx; }
    F.in = args.in; F.out = args.out; F.ws = args.ws; F.ctl = (unsigned*)(args.ws + WS_CTL);
    volatile LAS unsigned* MISC = (volatile LAS unsigned*)(F.lds + MISC_OFF);
    for (int u = F.tid; u < (LDS_BYTES - LDSCTL_OFF) / 4; u += 512) ((LAS unsigned*)(F.lds + LDSCTL_OFF))[u] = 0u;
    __syncthreads();
    const int lo = args.ph_lo, hi = args.ph_hi;
    const bool DRY_T = (args.ph_hi != 999), DRY_F = (args.ph_hi == 999);
    const bool multi = (hi - lo) > 1;
    XcdBarrier bar; bar.bar = F.ctl + CW_BAR; bar.x = 0; bar.st = nullptr;
    if (multi) bar = xcd_barrier_post(F.ctl + CW_BAR, MISC + 8);
#ifndef PH_MASK
#define PH_MASK 0xfff
#endif
#define IN(k) (((PH_MASK >> (k)) & 1) && lo <= (k) && (k) < hi)
#define SEAM(k) do { if (IN(k) && IN((k) + 1)) xcd_barrier(bar); } while (0)
#ifndef DUP_MASK
#define DUP_MASK 0
#endif
#ifndef DUP_MODE
#define DUP_MODE 3
#endif
    unsigned char* ws = args.ws;
    bf16_t* P = (bf16_t*)(ws + WS_P);

    if (IN(0)) { phase0(F); SEAM(0); }
    if (IN(1)) {
        pg8::PlainSched S; S.init((const bf16_t*)(ws + WS_HN), (const bf16_t*)(ws + WS_WIN), T, NP, DM, DM, F.G, (int)blockIdx.x);
        pg8::EpiBf16 E{P, NP};
        pg8::gemm_phase<pg8::EpiBf16, pg8::PlainSched, true>(F.lds, DM, DM, DM / 64, S, E);
        SEAM(1);
    }
    if (IN(2)) { if ((DUP_MASK >> 2) & 1) { phase2(F, DRY_T); if (multi) xcd_barrier(bar); } phase2(F, DRY_F); SEAM(2); }
    if (IN(3)) {
        pg8::PlainSched S; S.init((const bf16_t*)(ws + WS_ALORA), (const bf16_t*)(ws + WS_WLORA), T, NL, KL, KL, F.G, (int)blockIdx.x);
        pg8::EpiLora E{(bf16_t*)(ws + WS_L3), F.in[I_W0], F.in[I_A0]};
        if ((DUP_MASK >> 3) & 1) { pg8::gemm_phase<pg8::EpiLora, pg8::PlainSched, true>(F.lds, KL, KL, KL / 64, S, E); if (multi) xcd_barrier(bar); }
        pg8::gemm_phase<pg8::EpiLora, pg8::PlainSched, true>(F.lds, KL, KL, KL / 64, S, E);
        SEAM(3);
    }
    if (IN(4)) { rw::pass_a(F); SEAM(4); }
    if (IN(5)) { if ((DUP_MASK >> 5) & 1) { phase_idx_passb(F, DRY_T, 1); if (multi) xcd_barrier(bar); } phase_idx_passb(F, DRY_F, 0); SEAM(5); }
    if (IN(6)) { att::attn_phase(F); rw::pass_c(F); SEAM(6); }
    if (IN(7)) {
        pg8::PlainSched S; S.init((const bf16_t*)(ws + WS_YCAT), (const bf16_t*)(ws + WS_WOUT), T, DM, DM, DM, F.G, (int)blockIdx.x);
        pg8::EpiResF32 E{F.in[I_X], F.out, DM};
        pg8::gemm_phase<pg8::EpiResF32, pg8::PlainSched, true>(F.lds, DM, DM, DM / 64, S, E);
        SEAM(7);
    }
    if (IN(8)) { if ((DUP_MASK >> 8) & 1) { phase7(F, DRY_T, DUP_MODE); if (multi) xcd_barrier(bar); } phase7(F, DRY_F); SEAM(8); }
    if (IN(9)) { if ((DUP_MASK >> 9) & 1) { phase8(F); if (multi) xcd_barrier(bar); } phase8(F); SEAM(9); }
    if (IN(10)) {
        volatile LAS int* tb = (volatile LAS int*)(F.lds + MISC_OFF + 128);
        class_bases(F, tb);
        Moe1Sched S; S.tb = tb; S.A = (const char*)(ws + WS_H2S); S.B = (const char*)(ws + WS_WGU); S.G = F.G; S.c = (int)blockIdx.x; S.nu = (tb[NCLS] >> 8) * 8;
        pg8::EpiMoe1 E{(bf16_t*)(ws + WS_HS), (const float*)(ws + WS_ROWTOK + 128 * 1024)};
        pg8::gemm_phase<pg8::EpiMoe1, Moe1Sched, true>(F.lds, DM, DM, DM / 64, S, E);
        SEAM(10);
    }
    if (IN(11)) {
        volatile LAS int* tb = (volatile LAS int*)(F.lds + MISC_OFF + 128);
        class_bases(F, tb);
        Moe2Sched S; S.tb = tb; S.A = (const char*)(ws + WS_HS); S.B = (const char*)(ws + WS_WDN); S.G = F.G; S.c = (int)blockIdx.x; S.nu = (tb[NCLS] >> 8) * 8;
        if ((DUP_MASK >> 11) & 1) { pg8::EpiMoe2 E0{F.out, (const int*)(ws + WS_ROWTOK), DRY_T ? 1 : 0}; pg8::gemm_phase<pg8::EpiMoe2, Moe2Sched, true>(F.lds, 1024, 512, 512 / 64, S, E0); if (multi) xcd_barrier(bar); }
        pg8::EpiMoe2 E{F.out, (const int*)(ws + WS_ROWTOK), DRY_F ? 1 : 0};
        pg8::gemm_phase<pg8::EpiMoe2, Moe2Sched, true>(F.lds, 1024, 512, 512 / 64, S, E);
    }
#undef IN
#undef SEAM
}

extern "C" void kernel_launch(void* const* d_in, const int* in_sizes, int n_in, void* d_out, int out_size, void* d_ws, size_t ws_size, hipStream_t stream) {
    static int grid = 0;
    if (grid == 0) {
        if (n_in != 25 || in_sizes[0] != T * DM || out_size != T * DM || ws_size < WS_END) { fprintf(stderr, "kernel_launch: unexpected shapes (n_in %d, in0 %d, out %d, ws %zu)\n", n_in, n_in > 0 ? in_sizes[0] : -1, out_size, ws_size); grid = -1; return; }
        int dev = 0, cus = 0, per_cu = 0;
        if (hipGetDevice(&dev) != hipSuccess || hipDeviceGetAttribute(&cus, hipDeviceAttributeMultiprocessorCount, dev) != hipSuccess) { grid = -1; return; }
        if (hipFuncSetAttribute((const void*)fwd_kernel, hipFuncAttributeMaxDynamicSharedMemorySize, LDS_BYTES) != hipSuccess) { fprintf(stderr, "kernel_launch: hipFuncSetAttribute failed\n"); grid = -1; return; }
        if (hipOccupancyMaxActiveBlocksPerMultiprocessor(&per_cu, (const void*)fwd_kernel, 512, LDS_BYTES) != hipSuccess || per_cu < 1) { fprintf(stderr, "kernel_launch: occupancy query says %d blocks per CU\n", per_cu); (void)hipGetLastError(); grid = -1; return; }
        grid = cus;
    }
    if (grid < 0) return;
    (void)hipMemsetAsync((char*)d_ws + WS_CTL, 0, CTL_ZERO_BYTES, stream);
    Args a{};
    for (int i = 0; i < 25; ++i) a.in[i] = (const float*)d_in[i];
    a.out = (float*)d_out; a.ws = (unsigned char*)d_ws;
#if MK_SINGLE
    a.ph_lo = 0; a.ph_hi = NPHASE;
    void* kargs[] = {&a};
    hipError_t e = hipLaunchCooperativeKernel((const void*)fwd_kernel, dim3(grid), dim3(512), kargs, LDS_BYTES, stream);
    if (e != hipSuccess) fprintf(stderr, "kernel_launch: cooperative launch failed: %s (grid %d)\n", hipGetErrorString(e), grid);
#else
    for (int p = 0; p < NPHASE; ++p) { a.ph_lo = p; a.ph_hi = p + 1; hipLaunchKernelGGL(fwd_kernel, dim3(grid), dim3(512), LDS_BYTES, stream, a); }
#endif
}
```

```cpp
#include <hip/hip_runtime.h>
#include <hip/hip_cooperative_groups.h>
#include <cstdio>
#include <cstdint>
#include <cmath>

#ifndef PROBE_K
#define PROBE_K -1
#endif
#ifndef MK_SINGLE
#define MK_SINGLE 1
#endif

#define GAS __attribute__((address_space(1)))
#define LAS __attribute__((address_space(3)))
typedef unsigned short bf16_t;
typedef short bf16x8 __attribute__((ext_vector_type(8)));
typedef float f32x4 __attribute__((ext_vector_type(4)));
typedef float f32x16 __attribute__((ext_vector_type(16)));
typedef float f32x2 __attribute__((ext_vector_type(2)));
typedef unsigned u32x4 __attribute__((ext_vector_type(4)));
typedef unsigned u32x2 __attribute__((ext_vector_type(2)));

constexpr int BATCH = 4, SEQ = 4096, DM = 2048, T = BATCH * SEQ;
constexpr int NP = 7680;
constexpr int PQ = 0, PK = 1024, PV = 2048, PQI = 3072, PKI = 4096, PWI = 4160, PDW = 4224, PDA = 4288, PR = 4352, PKR = 5376, PVR = 6400, PDG = 7424;
constexpr int IN_COLS = 7536, DSA_COLS = 4176;
constexpr int KL = 384, NL = 3072;
constexpr int MPAD = 22528;
constexpr int NCLS = 24;
constexpr float NORM_EPS = 1e-6f, GN_EPS = 64e-5f;
constexpr float QSCALE = 0.08838834764831845f * 1.4426950408889634f;

constexpr size_t MiB = 1u << 20;
constexpr size_t WS_CTL = 0, CTL_ZERO_BYTES = 32 * 1024;
constexpr size_t WS_WLORA = 1 * MiB;
constexpr size_t WS_WOUT = 4 * MiB;
constexpr size_t WS_MSK = 12 * MiB;
constexpr size_t WS_KI = 20 * MiB;
constexpr size_t WS_ROUTE = 22 * MiB;
constexpr size_t WS_ROWTOK = 23 * MiB;
constexpr size_t WS_WRT = 23 * MiB + 512 * 1024;
constexpr size_t WS_ALORA = 24 * MiB;
constexpr size_t WS_WIN = 36 * MiB;
constexpr size_t WS_HN = 66 * MiB;
constexpr size_t WS_YCAT = WS_HN;
constexpr size_t WS_L3 = 130 * MiB;
constexpr size_t WS_P = 226 * MiB;
constexpr size_t WS_H2S = 226 * MiB;
constexpr size_t WS_HS = 314 * MiB;
constexpr size_t WS_WGU = 358 * MiB;
constexpr size_t WS_WDN = 422 * MiB;
constexpr size_t WS_MT = 24 * MiB;
constexpr size_t WS_BON = 56 * MiB;
constexpr size_t WS_SA = 466 * MiB;
constexpr size_t WS_SC = 57 * MiB;
constexpr size_t WS_XS = 498 * MiB;
constexpr size_t WS_SINK = 499 * MiB;
constexpr size_t WS_END = 500 * MiB;
constexpr int CW_CNT = 64;
constexpr int CW_TS = 512;
constexpr int CW_BAR = 4096;
constexpr int CW_HSCNT = 1024;

constexpr int RING_BYTES = 131072;
constexpr int LDSCTL_OFF = RING_BYTES, MISC_OFF = LDSCTL_OFF + 320;
constexpr int LDS_BYTES = 147456;

#define LDS_WAIT() asm volatile("s_waitcnt lgkmcnt(0)" ::: "memory")
#define VM_WAIT() asm volatile("s_waitcnt vmcnt(0)" ::: "memory")
typedef __bf16 hwbf16x2 __attribute__((ext_vector_type(2)));
__device__ __forceinline__ unsigned pk2(float lo, float hi) { const f32x2 v = {lo, hi}; return __builtin_bit_cast(unsigned, __builtin_convertvector(v, hwbf16x2)); }
__device__ __forceinline__ unsigned f2bf(float f) { return pk2(f, 0.f) & 0xffffu; }
__device__ __forceinline__ float bf2f(unsigned short h) { return __builtin_bit_cast(float, (unsigned)h << 16); }
__device__ __forceinline__ float bflo(unsigned w) { return __builtin_bit_cast(float, w << 16); }
__device__ __forceinline__ float bfhi(unsigned w) { return __builtin_bit_cast(float, w & 0xffff0000u); }
#define DPP_ADD(v, ctrl, rm) (v) += __builtin_bit_cast(float, __builtin_amdgcn_update_dpp(0, __builtin_bit_cast(int, (v)), (ctrl), (rm), 0xF, false))
__device__ __forceinline__ float row_sum16(float v) {
    DPP_ADD(v, 0xB1, 0xF); DPP_ADD(v, 0x4E, 0xF); DPP_ADD(v, 0x141, 0xF); DPP_ADD(v, 0x140, 0xF); return v;
}
__device__ __forceinline__ float wave_sum(float v) {
    v = row_sum16(v); DPP_ADD(v, 0x142, 0xA); DPP_ADD(v, 0x143, 0xC);
    return __builtin_bit_cast(float, __builtin_amdgcn_readlane(__builtin_bit_cast(int, v), 63));
}
__device__ __forceinline__ float half_sum(float v) {
    v = row_sum16(v); DPP_ADD(v, 0x142, 0xA);
    const float lo = __builtin_bit_cast(float, __builtin_amdgcn_readlane(__builtin_bit_cast(int, v), 31)), hi = __builtin_bit_cast(float, __builtin_amdgcn_readlane(__builtin_bit_cast(int, v), 63));
    return (threadIdx.x & 32) ? hi : lo;
}
__device__ __forceinline__ float sigmoidf_(float x) { return __builtin_amdgcn_rcpf(1.0f + __expf(-x)); }

namespace pg8 {
constexpr int BM = 256, BK = 64, HALF = 128, HTB = HALF * BK * 2, STAGE_BYTES = 8 * HTB, NXCD = 8, WGM = 8;
__host__ __device__ __forceinline__ int lds_byte(int r, int c) { const int st = (r >> 4) * 2 + (c >> 5), rr = r & 15, cc = c & 31, ob = rr * 64 + cc * 2; return st * 1024 + (ob ^ (((ob >> 9) & 1) << 5)); }
__host__ __device__ __forceinline__ void stage_rc(int b, int& R, int& C) { const int st = b / 1024, sb = b % 1024, swz = sb ^ (((sb >> 9) & 1) << 5); R = (st >> 1) * 16 + swz / 64; C = (st & 1) * 32 + (swz % 64) / 2; }
__host__ __device__ __forceinline__ int perm32(int rho) { const int n = rho >> 4, i = rho & 15; return 8 * (i >> 2) + 4 * n + (i & 3); }

struct Unit { int pm, pn, aux; };
struct Seg { const char* A; const char* B; Unit u; int last, nt; };

struct TileOrder {
    int nM, nN, nwg, G, c;
    __device__ void init(int nM_, int nN_, int G_, int c_) { nM = nM_; nN = nN_; nwg = nM * nN; G = G_; c = c_; }
    __device__ bool next(int i, int& pm, int& pn) const {
        const long L = (long)i * G + c; if (L >= nwg) return false;
        int wgid = (int)L; { const int q = nwg / NXCD, r = nwg % NXCD, xcd = wgid % NXCD, off = wgid / NXCD; wgid = (xcd < r ? xcd * (q + 1) : r * (q + 1) + (xcd - r) * q) + off; }
        const int nig = WGM * nN, gid = wgid / nig, fm = gid * WGM, gsz = (nM - fm) < WGM ? (nM - fm) : WGM;
        pm = fm + ((wgid % nig) % gsz); pn = (wgid % nig) / gsz; return true;
    }
};
struct PlainSched {
    TileOrder o; const char* A; const char* B; size_t tA, tB; int nt;
    __device__ void init(const bf16_t* A_, const bf16_t* B_, int M, int N, int lda, int ldb, int G, int c, int nt_) { o.init(M / BM, N / BM, G, c); A = (const char*)A_; B = (const char*)B_; tA = (size_t)BM * lda * 2; tB = (size_t)BM * ldb * 2; nt = nt_; }
    __device__ bool seg(int i, Seg& s) const { int pm, pn; if (!o.next(i, pm, pn)) return false; s.A = A + pm * tA; s.B = B + pn * tB; s.u.pm = pm; s.u.pn = pn; s.u.aux = 0; s.last = 1; s.nt = nt; return true; }
    static constexpr bool GATED = false, PUBLISH = false;
    __device__ __forceinline__ unsigned peek(const Unit&) const { return 0u; }
    __device__ __forceinline__ void wait(const Unit&, unsigned) const {}
    __device__ __forceinline__ void done(const Unit&) const {}
};
struct LoraSched {
    TileOrder o; const char* A; const char* B;
    __device__ void init(const bf16_t* A_, const bf16_t* B_, int G, int c) { o.init(T / BM, NL / BM, G, c); A = (const char*)A_; B = (const char*)B_; }
    __device__ bool seg(int i, Seg& s) const { int pm, pn; if (!o.next(i, pm, pn)) return false; const int gate = pn >= 8; s.A = A + (size_t)pm * BM * KL * 2 + (gate ? 256 : 0); s.B = B + (size_t)pn * BM * KL * 2 + (gate ? 256 : 0); s.u.pm = pm; s.u.pn = pn; s.u.aux = 0; s.last = 1; s.nt = gate ? 4 : 2; return true; }
    static constexpr bool GATED = false, PUBLISH = false;
    __device__ __forceinline__ unsigned peek(const Unit&) const { return 0u; }
    __device__ __forceinline__ void wait(const Unit&, unsigned) const {}
    __device__ __forceinline__ void done(const Unit&) const {}
};

struct InSched {
    TileOrder o; const char* A; const char* B; size_t tA, tB; int G, c;
    __device__ void init(const bf16_t* A_, const bf16_t* B_, int G_, int c_) { o.init(T / BM, 28, G_, c_); A = (const char*)A_; B = (const char*)B_; tA = (size_t)BM * DM * 2; tB = (size_t)BM * DM * 2; G = G_; c = c_; }
    __device__ bool seg(int i, Seg& s) const { int pm, q; s.last = 1;
        if (o.next(i, pm, q)) { const int pn = q + (q >= 16); s.A = A + pm * tA; s.B = B + pn * tB; s.u.pm = pm; s.u.pn = pn; s.u.aux = 0; s.nt = DM / 64; return true; }
        const int L = i * G + c - 28 * (T / BM); if (L >= 4 * (T / BM)) return false;
        const int j = (G == 256) ? (L & 7) * 32 + (L >> 3) : L;
        pm = j >> 2; const int ct = j & 1, kh = (j >> 1) & 1, pn = ct ? 29 : 16;
        s.A = A + pm * tA + kh * (DM / 2) * 2; s.B = B + pn * tB + kh * (DM / 2) * 2; s.u.pm = pm; s.u.pn = pn; s.u.aux = 1 + ct + 2 * kh; s.nt = DM / 128; return true; }
    static constexpr bool GATED = false, PUBLISH = false;
    __device__ __forceinline__ unsigned peek(const Unit&) const { return 0u; }
    __device__ __forceinline__ void wait(const Unit&, unsigned) const {}
    __device__ __forceinline__ void done(const Unit&) const {}
};

__device__ __forceinline__ unsigned cvt_pk_bf16(float lo, float hi) { unsigned r; asm volatile("v_cvt_pk_bf16_f32 %0, %1, %2" : "=v"(r) : "v"(lo), "v"(hi)); return r; }

typedef f32x4 Acc[2][2][4][2];

template <class Epi, class Sched, bool ALIGN_EPI>
__device__ __forceinline__ void gemm_phase(LAS unsigned char* lds, const int lda, const int ldb, const int nt, const Sched& S, const Epi& E) {
    const int tid = threadIdx.x, wid = __builtin_amdgcn_readfirstlane(tid >> 6), lane = tid & 63, wr = wid >> 2, wc = wid & 3, fr = lane & 15, fq = lane >> 4;
    unsigned voffA[2], voffB[2];
#pragma unroll
    for (int i = 0; i < 2; ++i) { int R, C; stage_rc(tid * 16 + i * 8192, R, C); const int Rb = Epi::PERM ? ((R & ~31) + perm32(R & 31)) : R;
        voffA[i] = (unsigned)(R * lda + C) * 2u; voffB[i] = (unsigned)(Rb * ldb + C) * 2u; }
    const size_t kstep = (size_t)(BK * 2);
    const size_t hstepA = (size_t)HALF * lda * 2, hstepB = (size_t)HALF * ldb * 2;
    const unsigned ldsw = (unsigned)wid * 1024u;
    const int aoff = lds_byte(wr * 64 + fr, fq * 8), boff = lds_byte(wc * 32 + fr, fq * 8);
#define PG8_SA(b, h) (((b) * 2 + (h)) * HTB)
#define PG8_SB(b, h) ((4 + (b) * 2 + (h)) * HTB)
#define PG8_STAGE(bufoff, gbase, voff) do { _Pragma("unroll") for (int _i = 0; _i < 2; ++_i) \
        __builtin_amdgcn_global_load_lds((const unsigned*)((const char*)(gbase) + (voff)[_i]), (LAS unsigned*)(lds + (bufoff) + ldsw + _i * 8192), 16, 0, 0); } while (0)
#define PG8_LDA(dst, b, h) do { _Pragma("unroll") for (int m = 0; m < 4; ++m) _Pragma("unroll") for (int k = 0; k < 2; ++k) dst[m][k] = *(const LAS bf16x8*)(lds + PG8_SA(b, h) + aoff + m * 2048 + k * 1024); } while (0)
#define PG8_LDB(dst, b, h) do { _Pragma("unroll") for (int n = 0; n < 2; ++n) _Pragma("unroll") for (int k = 0; k < 2; ++k) dst[n][k] = *(const LAS bf16x8*)(lds + PG8_SB(b, h) + boff + n * 2048 + k * 1024); } while (0)
#define PG8_MMA(ai, bj, At, Bt) do { __builtin_amdgcn_s_setprio(1); _Pragma("unroll") for (int m = 0; m < 4; ++m) _Pragma("unroll") for (int n = 0; n < 2; ++n) _Pragma("unroll") for (int k = 0; k < 2; ++k) \
        acc[ai][bj][m][n] = __builtin_amdgcn_mfma_f32_16x16x32_bf16(Bt[n][k], At[m][k], acc[ai][bj][m][n], 0, 0, 0); __builtin_amdgcn_s_setprio(0); } while (0)
#define PG8_WAIT_V(n) asm volatile("s_waitcnt vmcnt(" #n ")" ::: "memory")
#define PG8_WAIT_L(n) asm volatile("s_waitcnt lgkmcnt(" #n ")" ::: "memory")
#define PG8_BAR __builtin_amdgcn_s_barrier()
#define PG8_SCHED __builtin_amdgcn_sched_barrier(0)
#define PG8_ZERO() do { _Pragma("unroll") for (int a = 0; a < 2; ++a) _Pragma("unroll") for (int b = 0; b < 2; ++b) _Pragma("unroll") for (int m = 0; m < 4; ++m) _Pragma("unroll") for (int n = 0; n < 2; ++n) acc[a][b][m][n] = (f32x4){0.f, 0.f, 0.f, 0.f}; } while (0)
    Seg cur, nxt; int qi = 0;
    if (!S.seg(0, cur)) return;
    Acc acc;
    PG8_ZERO();
    bf16x8 At[4][2], B0[2][2], B1[2][2];
    const char* cA = cur.A; const char* cB = cur.B;
    if constexpr (Sched::GATED) S.wait(cur.u, S.peek(cur.u));
    PG8_STAGE(PG8_SB(0, 0), cB, voffB); PG8_STAGE(PG8_SB(0, 1), cB + hstepB, voffB); PG8_STAGE(PG8_SA(0, 0), cA, voffA); PG8_STAGE(PG8_SA(0, 1), cA + hstepA, voffA);
    if (wr == 1) PG8_BAR;
    PG8_WAIT_V(2); PG8_BAR;
    PG8_STAGE(PG8_SB(1, 0), cB + kstep, voffB); PG8_STAGE(PG8_SA(1, 0), cA + kstep, voffA); PG8_STAGE(PG8_SB(1, 1), cB + hstepB + kstep, voffB);
    PG8_WAIT_V(6); PG8_BAR;
    for (;;) {
        bool has_next; const char* nA; const char* nB;
        for (;;) {
        has_next = S.seg(qi + 1, nxt);
        nA = has_next ? nxt.A : cA; nB = has_next ? nxt.B : cB;
        const int nt_ = cur.nt;
        const bool gate = Sched::GATED && has_next && cur.last;
        unsigned rdy; if constexpr (Sched::GATED) { if (gate) rdy = S.peek(nxt.u); }
#pragma unroll 1
        for (int t = 0; t < nt_; t += 2) {
            const bool last = (t == nt_ - 2);
            if constexpr (Sched::GATED) { if (last && gate) S.wait(nxt.u, rdy); }
            const char* a1 = cA + (size_t)(t + 1) * kstep;
            const char* a2 = last ? nA : cA + (size_t)(t + 2) * kstep; const char* b2 = last ? nB : cB + (size_t)(t + 2) * kstep;
            const char* a3 = a2 + kstep; const char* b3 = b2 + kstep;
            PG8_LDB(B0, 0, 0); PG8_LDB(B1, 0, 1); PG8_SCHED; PG8_LDA(At, 0, 0); PG8_STAGE(PG8_SA(1, 1), a1 + hstepA, voffA);
            PG8_WAIT_V(8); PG8_WAIT_L(0); PG8_BAR; PG8_MMA(0, 0, At, B0); PG8_MMA(0, 1, At, B1); PG8_BAR; PG8_SCHED;
            PG8_LDA(At, 0, 1); PG8_STAGE(PG8_SB(0, 0), b2, voffB); PG8_STAGE(PG8_SB(0, 1), b2 + hstepB, voffB); PG8_STAGE(PG8_SA(0, 0), a2, voffA);
            PG8_WAIT_V(8); PG8_WAIT_L(0); PG8_BAR; PG8_MMA(1, 0, At, B0); PG8_MMA(1, 1, At, B1); PG8_BAR; PG8_SCHED;
            PG8_LDB(B0, 1, 0); PG8_LDB(B1, 1, 1); PG8_SCHED; PG8_LDA(At, 1, 0); PG8_STAGE(PG8_SA(0, 1), a2 + hstepA, voffA);
            PG8_WAIT_V(8); PG8_WAIT_L(0); PG8_BAR; PG8_MMA(0, 0, At, B0); PG8_MMA(0, 1, At, B1); PG8_BAR; PG8_SCHED;
            PG8_LDA(At, 1, 1); PG8_STAGE(PG8_SB(1, 0), b3, voffB); PG8_STAGE(PG8_SB(1, 1), b3 + hstepB, voffB); PG8_STAGE(PG8_SA(1, 0), a3, voffA);
            PG8_WAIT_V(8); PG8_WAIT_L(0); PG8_BAR; PG8_MMA(1, 0, At, B0); PG8_MMA(1, 1, At, B1); PG8_BAR; PG8_SCHED;
        }
        if (cur.last || !has_next) break;
        cur = nxt; cA = nA; cB = nB; ++qi;
        }
        if constexpr (ALIGN_EPI) { if (wr == 0) PG8_BAR; }
        E(acc, cur.u, wr, wc, fr, fq);
        if constexpr (Sched::PUBLISH) S.done(cur.u);
        if (!has_next) break;
        PG8_ZERO();
        cur = nxt; cA = nA; cB = nB; ++qi;
        if constexpr (ALIGN_EPI) { if (wr == 1) PG8_BAR; }
    }
    PG8_WAIT_V(0);
    if constexpr (!ALIGN_EPI) { if (wr == 0) PG8_BAR; }
    PG8_BAR;
#undef PG8_SA
#undef PG8_SB
#undef PG8_STAGE
#undef PG8_LDA
#undef PG8_LDB
#undef PG8_MMA
#undef PG8_WAIT_V
#undef PG8_WAIT_L
#undef PG8_BAR
#undef PG8_SCHED
#undef PG8_ZERO
}

struct EpiBf16 {
    static constexpr bool PERM = true;
    bf16_t* O; int ldc;
    __device__ __forceinline__ void operator()(const Acc& acc, const Unit& u, int wr, int wc, int fr, int fq) const {
        const int row0 = u.pm * BM + wr * 64 + fr; const int col0 = u.pn * BM + wc * 32 + 8 * fq;
#pragma unroll
        for (int ai = 0; ai < 2; ++ai)
#pragma unroll
            for (int m = 0; m < 4; ++m) { bf16_t* rowp = O + (size_t)(row0 + ai * HALF + m * 16) * ldc + col0;
#pragma unroll
                for (int bj = 0; bj < 2; ++bj) { const f32x4 v0 = acc[ai][bj][m][0], v1 = acc[ai][bj][m][1];
                    u32x4 w; w.x = cvt_pk_bf16(v0[0], v0[1]); w.y = cvt_pk_bf16(v0[2], v0[3]); w.z = cvt_pk_bf16(v1[0], v1[1]); w.w = cvt_pk_bf16(v1[2], v1[3]);
                    *(u32x4*)(rowp + bj * HALF) = w; } }
    }
};
struct EpiIn {
    static constexpr bool PERM = true;
    bf16_t* O; int ldc; float* part;
    __device__ __forceinline__ void operator()(const Acc& acc, const Unit& u, int wr, int wc, int fr, int fq) const {
        const int row0 = u.pm * BM + wr * 64 + fr;
        if (u.aux == 0) {
            const int col0 = u.pn * BM + wc * 32 + 8 * fq;
#pragma unroll
            for (int ai = 0; ai < 2; ++ai)
#pragma unroll
                for (int m = 0; m < 4; ++m) { bf16_t* rowp = O + (size_t)(row0 + ai * HALF + m * 16) * ldc + col0;
#pragma unroll
                    for (int bj = 0; bj < 2; ++bj) { const f32x4 v0 = acc[ai][bj][m][0], v1 = acc[ai][bj][m][1];
                        u32x4 w; w.x = cvt_pk_bf16(v0[0], v0[1]); w.y = cvt_pk_bf16(v0[2], v0[3]); w.z = cvt_pk_bf16(v1[0], v1[1]); w.w = cvt_pk_bf16(v1[2], v1[3]);
                        *(u32x4*)(rowp + bj * HALF) = w; } }
        } else {
            const int ct = (u.aux - 1) & 1, kh = (u.aux - 1) >> 1;
            float* pp = part + (size_t)kh * T * 512 + ct * 256 + wc * 32 + 8 * fq;
#pragma unroll
            for (int ai = 0; ai < 2; ++ai)
#pragma unroll
                for (int m = 0; m < 4; ++m) { float* rowp = pp + (size_t)(row0 + ai * HALF + m * 16) * 512;
#pragma unroll
                    for (int bj = 0; bj < 2; ++bj) { *(f32x4*)(rowp + bj * HALF) = acc[ai][bj][m][0]; *(f32x4*)(rowp + bj * HALF + 4) = acc[ai][bj][m][1]; } }
        }
    }
};
struct EpiLora {
    static constexpr bool PERM = true;
    bf16_t* O; const float* w0; const float* a0;
    __device__ __forceinline__ void operator()(const Acc& acc, const Unit& u, int wr, int wc, int fr, int fq) const {
        const int row0 = u.pm * BM + wr * 64 + fr; const int col0 = u.pn * BM + wc * 32 + 8 * fq; const int typ = u.pn >> 2;
        if (typ == 2) {
#pragma unroll
            for (int bj = 0; bj < 2; ++bj)
#pragma unroll
                for (int ai = 0; ai < 2; ++ai)
#pragma unroll
                    for (int m = 0; m < 4; ++m) { const f32x4 v0 = acc[ai][bj][m][0], v1 = acc[ai][bj][m][1];
                        u32x4 w; w.x = cvt_pk_bf16(v0.x, v0.y); w.y = cvt_pk_bf16(v0.z, v0.w); w.z = cvt_pk_bf16(v1.x, v1.y); w.w = cvt_pk_bf16(v1.z, v1.w);
                        *(u32x4*)(O + (size_t)(row0 + ai * HALF + m * 16) * NL + col0 + bj * HALF) = w; }
            return;
        }
        const float* bsrc = (typ == 0) ? w0 : a0;
        const float mul = (typ == 0) ? -0.6065306597126334f : 1.0f;
#pragma unroll
        for (int bj = 0; bj < 2; ++bj) {
            const int ch = (col0 + bj * HALF) & 1023;
            const f32x4 b0 = *(const f32x4*)(bsrc + ch), b1 = *(const f32x4*)(bsrc + ch + 4);
#pragma unroll
            for (int ai = 0; ai < 2; ++ai)
#pragma unroll
                for (int m = 0; m < 4; ++m) {
                    f32x4 v0 = acc[ai][bj][m][0], v1 = acc[ai][bj][m][1];
                    {
                        const f32x4 s0 = v0 + b0, s1 = v1 + b1;
                        v0.x = mul * sigmoidf_(s0.x); v0.y = mul * sigmoidf_(s0.y); v0.z = mul * sigmoidf_(s0.z); v0.w = mul * sigmoidf_(s0.w);
                        v1.x = mul * sigmoidf_(s1.x); v1.y = mul * sigmoidf_(s1.y); v1.z = mul * sigmoidf_(s1.z); v1.w = mul * sigmoidf_(s1.w);
                    }
                    u32x4 w; w.x = cvt_pk_bf16(v0.x, v0.y); w.y = cvt_pk_bf16(v0.z, v0.w); w.z = cvt_pk_bf16(v1.x, v1.y); w.w = cvt_pk_bf16(v1.z, v1.w);
                    *(u32x4*)(O + (size_t)(row0 + ai * HALF + m * 16) * NL + col0 + bj * HALF) = w;
                    asm volatile("" ::: "memory"); }
        }
    }
};
struct EpiResF32 {
    static constexpr bool PERM = false;
    const float* base; float* out; int ldc;
    __device__ __forceinline__ void operator()(const Acc& acc, const Unit& u, int wr, int wc, int fr, int fq) const {
        const int col0 = u.pn * BM + wc * 32 + 4 * fq;
#pragma unroll
        for (int ai = 0; ai < 2; ++ai) {
            f32x4 v[4][2][2];
#pragma unroll
            for (int m = 0; m < 4; ++m) { const size_t off = (size_t)(u.pm * BM + ai * HALF + wr * 64 + m * 16 + fr) * ldc + col0;
#pragma unroll
                for (int bj = 0; bj < 2; ++bj)
#pragma unroll
                    for (int n = 0; n < 2; ++n) v[m][bj][n] = *(const f32x4*)(base + off + bj * HALF + n * 16); }
            asm volatile("" ::: "memory");
#pragma unroll
            for (int m = 0; m < 4; ++m) { const size_t off = (size_t)(u.pm * BM + ai * HALF + wr * 64 + m * 16 + fr) * ldc + col0;
#pragma unroll
                for (int bj = 0; bj < 2; ++bj)
#pragma unroll
                    for (int n = 0; n < 2; ++n) *(f32x4*)(out + off + bj * HALF + n * 16) = v[m][bj][n] + acc[ai][bj][m][n]; }
            asm volatile("" ::: "memory");
        }
    }
};
struct EpiMoe1 {
    static constexpr bool PERM = true;
    bf16_t* O; const float* gates;
    __device__ __forceinline__ void operator()(const Acc& acc, const Unit& u, int wr, int wc, int fr, int fq) const {
        const int row0 = u.pm * BM + wr * 64 + fr; const int half = u.pn >> 2; const int col0 = half * 512 + (u.pn & 3) * 128 + wc * 32 + 8 * fq;
        const __amdgpu_buffer_rsrc_t rs = __builtin_amdgcn_make_buffer_rsrc(O, 0, MPAD * 1024 * 2, 0x00020000);
#pragma unroll
        for (int ai = 0; ai < 2; ++ai)
#pragma unroll
            for (int m = 0; m < 4; ++m) { const int row = row0 + ai * HALF + m * 16; const float gw = gates[(size_t)row * 2 + half];
                float v[8];
#pragma unroll
                for (int e = 0; e < 8; ++e) { const float g = acc[ai][0][m][e >> 2][e & 3], up = acc[ai][1][m][e >> 2][e & 3]; v[e] = g * sigmoidf_(g) * up * gw; }
                u32x4 w; w.x = cvt_pk_bf16(v[0], v[1]); w.y = cvt_pk_bf16(v[2], v[3]); w.z = cvt_pk_bf16(v[4], v[5]); w.w = cvt_pk_bf16(v[6], v[7]);
                __builtin_amdgcn_raw_buffer_store_b128(w, rs, (unsigned)(row * 1024 + col0) * 2u, 0, 16); }
    }
};
struct EpiMoe2 {
    static constexpr bool PERM = false;
    float* out; const int* rowtok; int dry;
    __device__ __forceinline__ void operator()(const Acc& acc, const Unit& u, int wr, int wc, int fr, int fq) const {
        const int col0 = u.pn * BM + wc * 32 + 4 * fq;
#pragma unroll
        for (int ai = 0; ai < 2; ++ai) {
            int tok[4]; f32x4 v[4][2][2];
#pragma unroll
            for (int m = 0; m < 4; ++m) tok[m] = rowtok[u.pm * BM + ai * HALF + wr * 64 + m * 16 + fr];
#pragma unroll
            for (int m = 0; m < 4; ++m) { const float* o = out + (size_t)(tok[m] < 0 ? 0 : tok[m]) * DM + col0;
#pragma unroll
                for (int bj = 0; bj < 2; ++bj)
#pragma unroll
                    for (int n = 0; n < 2; ++n) v[m][bj][n] = *(const f32x4*)(o + bj * HALF + n * 16); }
            asm volatile("" ::: "memory");
#pragma unroll
            for (int m = 0; m < 4; ++m) { if (tok[m] >= 0 && !dry) { float* o = out + (size_t)tok[m] * DM + col0;
#pragma unroll
                for (int bj = 0; bj < 2; ++bj)
#pragma unroll
                    for (int n = 0; n < 2; ++n) *(f32x4*)(o + bj * HALF + n * 16) = v[m][bj][n] + acc[ai][bj][m][n]; } }
            asm volatile("" ::: "memory");
        }
    }
};
}

#define XB_TMO      128
#define XB_XCNT(j)  (256  + 64 * (j))
#define XB_XSUB(j)  (1280 + 64 * (j))
#define XB_XGEN(j)  (2304 + 64 * (j))
#define XB_TOP      3328
#define XB_TOPGEN   3392
#define XCD_BAR_WORDS 3456
#define XB_SPIN_CAP (1u << 20)
__device__ __forceinline__ unsigned xb_ld(unsigned* p)              { return __hip_atomic_load(p, __ATOMIC_RELAXED, __HIP_MEMORY_SCOPE_AGENT); }
__device__ __forceinline__ unsigned xb_add(unsigned* p, unsigned v) { return __hip_atomic_fetch_add(p, v, __ATOMIC_RELAXED, __HIP_MEMORY_SCOPE_AGENT); }
__device__ __forceinline__ unsigned xb_xcc_id() { return (unsigned)__builtin_amdgcn_s_getreg((3 << 11) | 20) & 0xFu; }
#define XB_SPIN(cond, bar) do { unsigned _sp = 0; while (cond) { __builtin_amdgcn_s_sleep(1); \
    if ((++_sp & 255u) == 0u) { if (xb_ld(&(bar)[XB_TMO])) break; if (_sp > XB_SPIN_CAP) { atomicAdd(&(bar)[XB_TMO], 1u); break; } } } } while (0)
struct XcdBarrier { unsigned* bar; unsigned x; volatile LAS unsigned* st; };
__device__ __forceinline__ XcdBarrier xcd_barrier_post(unsigned* bar, volatile LAS unsigned* st) {
    XcdBarrier b; b.bar = bar; b.x = xb_xcc_id(); b.st = st;
    if (threadIdx.x == 0) (void)xb_add(&bar[XB_XCNT(b.x)], 1u);
    return b;
}
__device__ __forceinline__ void xcd_barrier_complete(unsigned* bar, unsigned x, unsigned& nloc, unsigned& nx) {
    const unsigned G = gridDim.x * gridDim.y * gridDim.z;
    unsigned sum, cnt, mine, sp = 0u;
    for (;;) {
        sum = 0u; cnt = 0u; mine = 0u;
#pragma unroll
        for (unsigned j = 0; j < 16; ++j) { const unsigned c = xb_ld(&bar[XB_XCNT(j)]); sum += c; cnt += (c > 0u) ? 1u : 0u; mine = (j == x) ? c : mine; }
        if (sum == G) break;
        __builtin_amdgcn_s_sleep(1);
        if ((++sp & 255u) == 0u) { if (xb_ld(&bar[XB_TMO])) break; if (sp > XB_SPIN_CAP) { atomicAdd(&bar[XB_TMO], 1u); break; } }
    }
    nloc = mine > 0u ? mine : 1u; nx = cnt > 0u ? cnt : 1u;
}
__device__ __forceinline__ void xcd_barrier(const XcdBarrier& b) {
    asm volatile("s_waitcnt vmcnt(0)" ::: "memory");
    __syncthreads();
    if (threadIdx.x == 0) {
        unsigned* bar = b.bar;
        __builtin_amdgcn_s_waitcnt(0);
        unsigned nloc = b.st[0], nx = b.st[1];
        if (nloc == 0u) { xcd_barrier_complete(bar, b.x, nloc, nx); b.st[0] = nloc; b.st[1] = nx; }
        const unsigned old = xb_add(&bar[XB_XSUB(b.x)], 1u);
        const unsigned gen = old / nloc;
        if (old + 1u == (gen + 1u) * nloc) {
            __builtin_amdgcn_fence(__ATOMIC_RELEASE, "agent");
            asm volatile("s_waitcnt vmcnt(0)" ::: "memory");
            const unsigned og = xb_add(&bar[XB_TOP], 1u);
            const unsigned tg = og / nx;
            if (og + 1u == (tg + 1u) * nx) xb_add(&bar[XB_TOPGEN], 1u);
            else XB_SPIN(xb_ld(&bar[XB_TOPGEN]) == tg, bar);
            __builtin_amdgcn_fence(__ATOMIC_ACQUIRE, "agent");
            xb_add(&bar[XB_XGEN(b.x)], 1u);
            asm volatile("s_waitcnt vmcnt(0)" ::: "memory");
        } else {
            XB_SPIN(xb_ld(&bar[XB_XGEN(b.x)]) == gen, bar);
            __builtin_amdgcn_fence(__ATOMIC_ACQUIRE, "agent");
            asm volatile("s_waitcnt vmcnt(0)" ::: "memory");
        }
    }
    __syncthreads();
}

struct Args { const float* in[25]; float* out; unsigned char* ws; int ph_lo, ph_hi; };
enum { I_X = 0, I_GMIX, I_WIN, I_MIX, I_QG, I_KG, I_W0, I_WDEC, I_A0, I_WAICL, I_WGATE, I_KK, I_KA, I_RK, I_LNW, I_LNB, I_WOUT, I_GFFN, I_WRG, I_BRG, I_WRE, I_BRE, I_WEG, I_WEU, I_WED };

struct Frame {
    LAS unsigned char* lds; unsigned char* ldsg;
    unsigned* ctl;
    int tid, lane, wave, vcu, G;
    const float* const* in; float* out; unsigned char* ws;
};

__device__ __forceinline__ int win_dmap(int n) {
    if (n < DSA_COLS) return n;
    const int m = n - DSA_COLS;
    if (m < 1024) return PR + m;
    if (m < 1088) return PDW + (m - 1024);
    if (m < 2112) return PKR + (m - 1088);
    if (m < 3136) return PVR + (m - 2112);
    if (m < 3200) return PDA + (m - 3136);
    return PDG + (m - 3200);
}
template <int MODE, int KMAX = (1 << 30)>
__device__ __forceinline__ void transpose_item(const float* W, int N, bf16_t* WT, int ldd, LAS float* scr, int kb, int nb, int lane) {
    const int k0 = 64 * kb, n0 = 32 * nb;
    const int nn = n0 + (lane & 31);
    float tv[32];
#pragma unroll
    for (int i = 0; i < 32; ++i) { const int kk = 2 * i + (lane >> 5); tv[i] = (nn < N && (KMAX == (1 << 30) || k0 + kk < KMAX)) ? W[(size_t)(k0 + kk) * N + nn] : 0.f; }
#pragma unroll
    for (int i = 0; i < 32; ++i) { const int kk = 2 * i + (lane >> 5); scr[kk * 33 + (lane & 31)] = tv[i]; }
    LDS_WAIT(); asm volatile("" ::: "memory");
    const int c = lane & 7;
#pragma unroll
    for (int j = 0; j < 4; ++j) { const int nl = (lane >> 3) + 8 * j; const int n = n0 + nl; const LAS float* s = scr + (8 * c) * 33 + nl;
        u32x4 o; o.x = pk2(s[0 * 33], s[1 * 33]); o.y = pk2(s[2 * 33], s[3 * 33]); o.z = pk2(s[4 * 33], s[5 * 33]); o.w = pk2(s[6 * 33], s[7 * 33]);
        int dr = n;
        if (MODE == 1) dr = win_dmap(n);
        if (MODE == 2) dr = (n >> 7) * 256 + (n & 127);
        if (MODE == 3) dr = (n >> 7) * 256 + 128 + (n & 127);
        if (n < N) *(u32x4*)(WT + (size_t)dr * ldd + k0 + 8 * c) = o; }
    LDS_WAIT(); asm volatile("" ::: "memory");
}

__device__ __forceinline__ void phase0(Frame& F) {
    LAS float* scr = (LAS float*)(F.lds + F.wave * 16384);
    const int gw = F.vcu * 8 + F.wave, NGW = F.G * 8, lane = F.lane;
    constexpr int NB_IN = (IN_COLS + 31) / 32;
    constexpr int I_IN = (DM / 64) * NB_IN, I_OUT = (DM / 64) * (DM / 32);
    bf16_t* WIN = (bf16_t*)(F.ws + WS_WIN); bf16_t* WOUT = (bf16_t*)(F.ws + WS_WOUT);
    bf16_t* WL = (bf16_t*)(F.ws + WS_WLORA);
    for (int it = gw; it < I_IN + I_OUT + 160; it += NGW) {
        if (it < I_IN) transpose_item<1>(F.in[I_WIN], IN_COLS, WIN, DM, scr, it / NB_IN, it % NB_IN, lane);
        else if (it < I_IN + I_OUT) { const int r = it - I_IN; transpose_item<0>(F.in[I_WOUT], DM, WOUT, DM, scr, r / (DM / 32), r % (DM / 32), lane); }
        else { const int r = it - I_IN - I_OUT;
            if (r < 32) transpose_item<0>(F.in[I_WDEC], 1024, WL, KL, scr, 0, r, lane);
            else if (r < 64) transpose_item<0>(F.in[I_WAICL], 1024, WL + (size_t)1024 * KL + 64, KL, scr, 0, r - 32, lane);
            else transpose_item<0, 160>(F.in[I_WGATE], 1024, WL + (size_t)2048 * KL + 128, KL, scr, (r - 64) >> 5, (r - 64) & 31, lane); }
    }
    for (int i = gw * 64 + lane; i < NL * 8; i += NGW * 64) { const int n = i >> 3, q = i & 7, typ = n >> 10; const int col = (typ == 0 ? 64 : (typ == 1 ? 0 : 320)) + 8 * q;
        *(u32x4*)(WL + (size_t)n * KL + col) = (u32x4){0u, 0u, 0u, 0u}; }
    for (int i = gw; i < 144 * 4; i += NGW) { const int r = i >> 2, q = i & 3; const int row = r < 48 ? 4176 + r : 7584 + (r - 48);
        *(u32x4*)(WIN + (size_t)row * DM + q * 512 + lane * 8) = (u32x4){0u, 0u, 0u, 0u}; }
    { bf16_t* WRH = (bf16_t*)(F.ws + WS_WRT); bf16_t* WRL = WRH + 32 * DM; const float* wrg = F.in[I_WRG]; const float* wre = F.in[I_WRE]; const float* gf = F.in[I_GFFN];
      for (int i = gw * 64 + lane; i < 32 * DM; i += NGW * 64) { const int o = i / DM, k = i % DM; float v = 0.f;
          if (o < 4) v = gf[k] * wrg[k * 4 + o]; else if (o < 20) v = gf[k] * wre[k * 16 + (o - 4)];
          const unsigned hb = f2bf(v); const float lo = v - bf2f((unsigned short)hb); WRH[i] = (bf16_t)hb; WRL[i] = (bf16_t)f2bf(lo); } }
    { const float* x = F.in[I_X]; const float* g = F.in[I_GMIX]; bf16_t* HN = (bf16_t*)(F.ws + WS_HN);
      f32x4 gv[8];
#pragma unroll
      for (int j = 0; j < 8; ++j) gv[j] = ((const f32x4*)g)[64 * j + lane];
      for (int m2 = gw; m2 < T / 2; m2 += NGW) {
          f32x4 v[2][8]; float s2[2] = {0.f, 0.f};
#pragma unroll
          for (int u = 0; u < 2; ++u) { const f32x4* xr = (const f32x4*)(x + (size_t)(2 * m2 + u) * DM) + lane;
#pragma unroll
              for (int j = 0; j < 8; ++j) v[u][j] = xr[64 * j]; }
#pragma unroll
          for (int u = 0; u < 2; ++u) {
#pragma unroll
              for (int j = 0; j < 8; ++j) s2[u] += (v[u][j].x * v[u][j].x + v[u][j].y * v[u][j].y) + (v[u][j].z * v[u][j].z + v[u][j].w * v[u][j].w);
              const float rstd = rsqrtf(wave_sum(s2[u]) * (1.f / DM) + NORM_EPS);
              u32x2* o = (u32x2*)(HN + (size_t)(2 * m2 + u) * DM) + lane;
#pragma unroll
              for (int j = 0; j < 8; ++j) { u32x2 w; w.x = pk2(v[u][j].x * rstd * gv[j].x, v[u][j].y * rstd * gv[j].y); w.y = pk2(v[u][j].z * rstd * gv[j].z, v[u][j].w * rstd * gv[j].w); o[64 * j] = w; } } } }
}

__device__ __forceinline__ void rope4(float& y0, float& y1, float& y2, float& y3, float c0, float s0, float c1, float s1) {
    const float o0 = y0 * c0 - y2 * s0, o2 = y2 * c0 + y0 * s0, o1 = y1 * c1 - y3 * s1, o3 = y3 * c1 + y1 * s1; y0 = o0; y1 = o1; y2 = o2; y3 = o3;
}
__device__ __forceinline__ void phase2(Frame& F, const bool dry) {
    const int gw = F.vcu * 8 + F.wave, NGW = F.G * 8, lane = F.lane;
    bf16_t* P = (bf16_t*)(F.ws + WS_P); bf16_t* KI = (bf16_t*)(F.ws + WS_KI); bf16_t* AL = (bf16_t*)(F.ws + WS_ALORA);
    const float* mix = F.in[I_MIX];
    const int l5 = lane & 31, hsel = lane >> 5, l4 = lane & 15, hq = lane >> 4;
    float qg[4], kg[4];
    { const float* a = F.in[I_QG]; const float* b = F.in[I_KG];
      qg[0] = a[2 * l5]; qg[1] = a[2 * l5 + 1]; qg[2] = a[64 + 2 * l5]; qg[3] = a[65 + 2 * l5];
      kg[0] = b[2 * l5]; kg[1] = b[2 * l5 + 1]; kg[2] = b[64 + 2 * l5]; kg[3] = b[65 + 2 * l5]; }
    const float L2T = 13.287712379549449f;
    const float inv128_0 = exp2f(-(float)(2 * l5) * (1.0f / 64.0f) * L2T), inv128_1 = exp2f(-(float)(2 * l5 + 1) * (1.0f / 64.0f) * L2T);
    const float inv64_0 = exp2f(-(float)(2 * l4) * (1.0f / 32.0f) * L2T), inv64_1 = exp2f(-(float)(2 * l4 + 1) * (1.0f / 32.0f) * L2T);
    const float mu_dw = mix[1024 + lane], mu_da = mix[3136 + lane], mu_g0 = mix[3200 + lane], mu_g1 = mix[3264 + lane], mu_g2 = (lane < 32) ? mix[3328 + lane] : 0.f;
    for (int tp = gw; tp < T / 2; tp += NGW) {
        unsigned qa[2][4], qb[2][4], ka[2][4], kb[2][4], ia[2][4], ib[2][4];
        float ap[2][5], apv[2][5], xk[2][4], wsum[2];
#pragma unroll
        for (int u = 0; u < 2; ++u) {
            const int t = 2 * tp + u; const int pos = t & (SEQ - 1);
            const bf16_t* row = P + (size_t)t * NP;
#pragma unroll
            for (int hh = 0; hh < 4; ++hh) {
                const unsigned* bq = (const unsigned*)(row + PQ + (2 * hh + hsel) * 128); const unsigned* bk = (const unsigned*)(row + PK + (2 * hh + hsel) * 128);
                qa[u][hh] = bq[l5]; qb[u][hh] = bq[32 + l5]; ka[u][hh] = bk[l5]; kb[u][hh] = bk[32 + l5];
                const unsigned* bi = (const unsigned*)(row + PQI + (4 * hh + hq) * 64);
                ia[u][hh] = bi[l4]; ib[u][hh] = bi[16 + l4];
            }
            const float* s0 = F.out + (size_t)t * 512; const float* s1 = s0 + (size_t)T * 512;
            { const f32x2 a0 = *(const f32x2*)(s0 + 2 * l4), a1 = *(const f32x2*)(s1 + 2 * l4), b0 = *(const f32x2*)(s0 + 32 + 2 * l4), b1 = *(const f32x2*)(s1 + 32 + 2 * l4);
              xk[u][0] = a0.x + a1.x; xk[u][1] = a0.y + a1.y; xk[u][2] = b0.x + b1.x; xk[u][3] = b0.y + b1.y; }
            wsum[u] = s0[64 + lane] + s1[64 + lane];
            const bool hp = pos > 0;
            ap[u][0] = s0[128 + lane] + s1[128 + lane]; ap[u][1] = s0[192 + lane] + s1[192 + lane]; ap[u][2] = s0[256 + lane] + s1[256 + lane]; ap[u][3] = s0[320 + lane] + s1[320 + lane];
            ap[u][4] = (lane < 32) ? s0[384 + lane] + s1[384 + lane] : 0.f;
            apv[u][0] = hp ? s0[128 + lane - 512] + s1[128 + lane - 512] : 0.f; apv[u][1] = hp ? s0[192 + lane - 512] + s1[192 + lane - 512] : 0.f; apv[u][2] = hp ? s0[256 + lane - 512] + s1[256 + lane - 512] : 0.f;
            apv[u][3] = hp ? s0[320 + lane - 512] + s1[320 + lane - 512] : 0.f; apv[u][4] = (hp && lane < 32) ? s0[384 + lane - 512] + s1[384 + lane - 512] : 0.f;
        }
        asm volatile("" ::: "memory");
#pragma unroll
        for (int u = 0; u < 2; ++u) {
            const int t = 2 * tp + u; const int pos = t & (SEQ - 1); const float fp = (float)pos;
            bf16_t* row = P + (size_t)t * NP;
            float c0, s0, c1, s1, d0, e0, d1, e1;
            { const float a0 = fp * inv128_0, a1 = fp * inv128_1, a2 = fp * inv64_0, a3 = fp * inv64_1;
              const float r0 = __builtin_amdgcn_fractf(a0 * 0.15915494309189535f), r1 = __builtin_amdgcn_fractf(a1 * 0.15915494309189535f), r2 = __builtin_amdgcn_fractf(a2 * 0.15915494309189535f), r3 = __builtin_amdgcn_fractf(a3 * 0.15915494309189535f);
              s0 = __builtin_amdgcn_sinf(r0); c0 = __builtin_amdgcn_cosf(r0); s1 = __builtin_amdgcn_sinf(r1); c1 = __builtin_amdgcn_cosf(r1);
              e0 = __builtin_amdgcn_sinf(r2); d0 = __builtin_amdgcn_cosf(r2); e1 = __builtin_amdgcn_sinf(r3); d1 = __builtin_amdgcn_cosf(r3); }
#pragma unroll
            for (int which = 0; which < 2; ++which) {
#pragma unroll
                for (int hh = 0; hh < 4; ++hh) {
                    unsigned* base = (unsigned*)(row + (which ? PK : PQ) + (2 * hh + hsel) * 128);
                    const unsigned a = which ? ka[u][hh] : qa[u][hh], b = which ? kb[u][hh] : qb[u][hh];
                    float y0 = bflo(a), y1 = bfhi(a), y2 = bflo(b), y3 = bfhi(b);
                    const float ss = half_sum((y0 * y0 + y1 * y1) + (y2 * y2 + y3 * y3));
                    const float rstd = rsqrtf(ss * (1.0f / 128.0f) + NORM_EPS) * (which ? 1.0f : QSCALE);
                    const float* gg = which ? kg : qg;
                    y0 *= rstd * gg[0]; y1 *= rstd * gg[1]; y2 *= rstd * gg[2]; y3 *= rstd * gg[3];
                    rope4(y0, y1, y2, y3, c0, s0, c1, s1);
                    if (!dry) { base[l5] = pk2(y0, y1); base[32 + l5] = pk2(y2, y3); }
                }
            }
#pragma unroll
            for (int it = 0; it < 4; ++it) {
                unsigned* base = (unsigned*)(row + PQI + (4 * it + hq) * 64);
                float y0 = bflo(ia[u][it]), y1 = bfhi(ia[u][it]), y2 = bflo(ib[u][it]), y3 = bfhi(ib[u][it]);
                rope4(y0, y1, y2, y3, d0, e0, d1, e1);
                if (!dry) { base[l4] = pk2(y0, y1); base[16 + l4] = pk2(y2, y3); }
            }
            if (lane < 16 && !dry) {
                float y0 = xk[u][0], y1 = xk[u][1], y2 = xk[u][2], y3 = xk[u][3];
                rope4(y0, y1, y2, y3, d0, e0, d1, e1);
                unsigned* o = (unsigned*)(KI + (size_t)t * 64);
                o[l4] = pk2(y0, y1); o[16 + l4] = pk2(y2, y3);
                row[PWI + lane] = (bf16_t)f2bf(wsum[u]);
            }
            if (!dry) {
                bf16_t* al = AL + (size_t)t * KL;
                float sh;
                sh = ap[u][0] + (apv[u][0] - ap[u][0]) * mu_dw; al[lane] = (bf16_t)f2bf(1.0f - 2.0f * __builtin_amdgcn_rcpf(1.0f + __expf(2.0f * sh)));
                sh = ap[u][1] + (apv[u][1] - ap[u][1]) * mu_da; al[64 + lane] = (bf16_t)f2bf(sh);
                sh = ap[u][2] + (apv[u][2] - ap[u][2]) * mu_g0; al[128 + lane] = (bf16_t)f2bf(sigmoidf_(sh));
                sh = ap[u][3] + (apv[u][3] - ap[u][3]) * mu_g1; al[192 + lane] = (bf16_t)f2bf(sigmoidf_(sh));
                if (lane < 32) { sh = ap[u][4] + (apv[u][4] - ap[u][4]) * mu_g2; al[256 + lane] = (bf16_t)f2bf(sigmoidf_(sh)); }
                al[288 + lane] = 0; if (lane < 32) al[352 + lane] = 0;
            }
        }
    }
}

__device__ __forceinline__ unsigned fkey(float f) { const unsigned u = __builtin_bit_cast(unsigned, f); return (u & 0x80000000u) ? ~u : (u | 0x80000000u); }
constexpr int CW_QIDX = 192;
constexpr int IDX_BUF = 256 * 128;
constexpr int SC_BATCH = 4096 * 2080;
constexpr int NSCU = 4 * 544;
__device__ __forceinline__ size_t sc_row_off(int b, int i, int q) { return (size_t)b * SC_BATCH + (size_t)2048 * i * (i + 1) + (size_t)q * 64 * (i + 1); }
typedef _Float16 h16x2 __attribute__((ext_vector_type(2)));
struct IdxQ { bf16x8 a[4]; h16x2 wq[8]; };
__device__ __forceinline__ void idxq_load(IdxQ& d, const bf16_t* P, int tq, int r, int h) {
    const bf16_t* ap = P + (size_t)(tq + ((r >> 2) & 1)) * NP + PQI + ((r & 3) + 4 * (r >> 3)) * 64 + 8 * h;
#pragma unroll
    for (int s = 0; s < 4; ++s) d.a[s] = *(const bf16x8*)(ap + 16 * s);
    const u32x4* wp = (const u32x4*)(P + (size_t)(tq + h) * NP + PWI);
    const u32x4 w0 = wp[0], w1 = wp[1];
#pragma unroll
    for (int e = 0; e < 8; ++e) { const unsigned w = e < 4 ? w0[e] : w1[e - 4]; d.wq[e].x = (_Float16)(bflo(w) * (1.0f / 32.0f)); d.wq[e].y = (_Float16)(bfhi(w) * (1.0f / 32.0f)); }
}
constexpr int NSCU2 = 640;
__device__ __forceinline__ void idx_decode(int u, int& b, int& i, int& st0, int& st1) {
    b = u / 160; const int v = 159 - (u % 160);
    const int band = v < 16 ? 0 : (v < 48 ? 1 : (v < 96 ? 2 : 3)), cum = band == 0 ? 0 : (band == 1 ? 16 : (band == 2 ? 48 : 96));
    const int rem = v - cum; i = 16 * band + rem / (band + 1); const int sg = rem % (band + 1);
    const int nst = (i >> 2) + 1; st0 = 4 * sg; st1 = (4 * sg + 3 < nst - 1) ? 4 * sg + 3 : nst - 1;
}
__device__ __forceinline__ void idx_stage(Frame& F, int b, int st, int buf) {
    const int lane = F.lane, wave = F.wave;
    const unsigned char* kg = F.ws + WS_KI + ((size_t)b * SEQ + 256 * st) * 128 + (size_t)(wave * 8 + (lane >> 3)) * 128 + (size_t)(((lane & 7) ^ (lane >> 3)) * 16);
#pragma unroll
    for (int q = 0; q < 4; ++q) __builtin_amdgcn_global_load_lds((const unsigned*)(kg + q * 8192), (LAS unsigned*)(F.lds + buf * IDX_BUF + (q * 8 + wave) * 1024), 16, 0, 0);
}
__device__ __forceinline__ void idx_score_tile(Frame& F, const IdxQ (&qv)[4], int b, int i, int st, int buf) {
    int lane_ = F.lane; asm volatile("" : "+v"(lane_));
    const int lane = lane_, wave = F.wave, r = lane & 31, h = lane >> 5;
    _Float16* SC = (_Float16*)(F.ws + WS_SC);
    const int nvb = (2 * (i + 1) - 8 * st) < 8 ? (2 * (i + 1) - 8 * st) : 8;
    const LAS unsigned char* kb = F.lds + buf * IDX_BUF + r * 128; const int sw = r & 7;
    _Float16* dummy = (_Float16*)(F.ws + WS_SINK) + (blockIdx.x * 512 + threadIdx.x) % 32768;
#pragma unroll
    for (int g = 0; g < 4; ++g) {
        _Float16* srow = SC + sc_row_off(b, i, 16 * g + 2 * wave + h) + 256 * st + r;
#pragma unroll
        for (int jb = 0; jb < 8; ++jb) {
            f32x16 acc = {0.f, 0.f, 0.f, 0.f, 0.f, 0.f, 0.f, 0.f, 0.f, 0.f, 0.f, 0.f, 0.f, 0.f, 0.f, 0.f};
#pragma unroll
            for (int s = 0; s < 4; ++s) acc = __builtin_amdgcn_mfma_f32_32x32x16_bf16(qv[g].a[s], *(const LAS bf16x8*)(kb + jb * 4096 + (((2 * s + h) ^ sw) * 16)), acc, 0, 0, 0);
            float sum = 0.f, sum1 = 0.f;
#pragma unroll
            for (int e = 0; e < 16; ++e) { const float rl = __builtin_amdgcn_fmed3f(acc[e], 0.f, 3.0e38f);
                const unsigned wpk = __builtin_bit_cast(unsigned, qv[g].wq[e >> 1]);
                if (e & 1) asm("v_fma_mix_f32 %0, %1, %2, %0 op_sel:[1,0,0] op_sel_hi:[1,0,0]" : "+v"(sum1) : "v"(wpk), "v"(rl));
                else asm("v_fma_mix_f32 %0, %1, %2, %0 op_sel:[0,0,0] op_sel_hi:[1,0,0]" : "+v"(sum) : "v"(wpk), "v"(rl)); }
            { _Float16* dst = (jb < nvb) ? srow + 32 * jb : dummy; *dst = (_Float16)(sum + sum1); }
        }
        __builtin_amdgcn_sched_barrier(0);
    }
}
__device__ __forceinline__ unsigned pk_lt(unsigned cand2, unsigned k2) {
    unsigned d; asm("v_pk_sub_u16 %0, %1, %2 clamp" : "=v"(d) : "v"(cand2), "v"(k2)); asm("v_pk_min_u16 %0, %1, %2" : "=v"(d) : "v"(d), "v"(0x00010001u)); return d;
}
__device__ __forceinline__ int wave_sum_i(int v) {
#define DPP_ADDI(v, ctrl, rm) (v) += __builtin_amdgcn_update_dpp(0, (v), (ctrl), (rm), 0xF, false)
    DPP_ADDI(v, 0xB1, 0xF); DPP_ADDI(v, 0x4E, 0xF); DPP_ADDI(v, 0x141, 0xF); DPP_ADDI(v, 0x140, 0xF); DPP_ADDI(v, 0x142, 0xA); DPP_ADDI(v, 0x143, 0xC);
#undef DPP_ADDI
    return __builtin_amdgcn_readlane(v, 63);
}
__device__ __forceinline__ int wave_excl_prefix_i(int v, int lane) {
    int x = v;
#pragma unroll
    for (int o = 1; o < 64; o <<= 1) { const int y = __shfl_up(x, o); x += (lane >= o) ? y : 0; }
    return x - v;
}
__device__ __forceinline__ void idx_row_load(Frame& F, int b, int pos, u32x4 (&raw)[8]) {
    const int lane = F.lane, i = pos >> 6, q0 = pos & 63, n = 64 * (i + 1), nch = (n + 511) >> 9;
    const u32x4* sp = (const u32x4*)((const unsigned short*)(F.ws + WS_SC) + sc_row_off(b, i, q0)) + lane;
#pragma unroll
    for (int q = 0; q < 8; ++q) { raw[q] = (u32x4){0u, 0u, 0u, 0u}; if (q < nch && i >= 4) raw[q] = sp[64 * q]; }
}
__device__ __forceinline__ void idx_select_row(Frame& F, int b, int pos, const u32x4 (&raw)[8]) {
    const int lane = F.lane, i = pos >> 6, nj = i + 1, n = 64 * nj, t = b * SEQ + pos;
    unsigned* MSK = (unsigned*)(F.ws + WS_MSK) + (size_t)t * 128;
    if (nj <= 4) { MSK[lane] = (lane < 2 * nj) ? 0xFFFFFFFFu : 0u; MSK[64 + lane] = 0u; return; }
    const int nch = (n + 511) >> 9;
    unsigned k2[32];
#pragma unroll
    for (int q = 0; q < 8; ++q) {
        const u32x4 v = raw[q];
        const bool ok = (512 * q + 8 * lane) < n;
#pragma unroll
        for (int e = 0; e < 4; ++e) { const unsigned x = v[e]; unsigned m; asm("v_pk_ashrrev_i16 %0, %1, %2" : "=v"(m) : "v"(0x000F000Fu), "v"(x)); m |= 0x80008000u; k2[4 * q + e] = ok ? (x ^ m) : 0u; }
    }
    unsigned thr = 0u;
    for (int bit = 15; bit >= 0; --bit) {
        const unsigned cand = thr | (1u << bit), cand2 = cand * 0x00010001u;
        unsigned acc = 0u;
#pragma unroll
        for (int q = 0; q < 8; ++q) { if (q < nch) {
#pragma unroll
            for (int e = 0; e < 4; ++e) acc += pk_lt(cand2, k2[4 * q + e]); } }
        const int lt = wave_sum_i((int)((acc & 0xFFFFu) + (acc >> 16)));
        const int ge = 512 * nch - lt;
        if (ge >= 256) thr = cand;
        if (ge == 256) break;
    }
    const unsigned t2 = thr * 0x00010001u, t2p = (thr + 1u) * 0x00010001u;
    int ngt, nge;
    { unsigned a0 = 0u, a1 = 0u;
#pragma unroll
      for (int q = 0; q < 8; ++q) { if (q < nch) {
#pragma unroll
          for (int e = 0; e < 4; ++e) { a0 += pk_lt(t2p, k2[4 * q + e]); a1 += pk_lt(t2, k2[4 * q + e]); } } }
      ngt = 512 * nch - wave_sum_i((int)((a0 & 0xFFFFu) + (a0 >> 16))); nge = 512 * nch - wave_sum_i((int)((a1 & 0xFFFFu) + (a1 >> 16))); }
    const bool alltied = (nge == 256);
    int tiebase = 0, need = 256 - ngt;
#pragma unroll
    for (int q = 0; q < 8; ++q) {
        if (q < nch) {
            unsigned byte_gt = 0u, byte_ge = 0u;
#pragma unroll
            for (int e = 0; e < 4; ++e) { const unsigned g1 = pk_lt(t2p, k2[4 * q + e]) ^ 0x00010001u, g0 = pk_lt(t2, k2[4 * q + e]) ^ 0x00010001u;
                byte_gt |= ((g1 & 1u) << (2 * e)) | ((g1 >> 16) << (2 * e + 1)); byte_ge |= ((g0 & 1u) << (2 * e)) | ((g0 >> 16) << (2 * e + 1)); }
            unsigned sel = byte_ge;
            if (!alltied) {
                const unsigned tie = byte_ge & ~byte_gt; const int nt = __popc(tie);
                const int pre = tiebase + wave_excl_prefix_i(nt, lane);
                unsigned keep = 0u; int rank = pre;
#pragma unroll
                for (int tt = 0; tt < 8; ++tt) { const unsigned bit = (tie >> tt) & 1u; keep |= (bit && rank < need) ? (1u << tt) : 0u; rank += (int)bit; }
                sel = byte_gt | keep; tiebase += wave_sum_i(nt);
            }
            unsigned w = sel << (8 * (lane & 3));
            w |= (unsigned)__builtin_amdgcn_update_dpp(0, (int)w, 0xB1, 0xF, 0xF, false);
            w |= (unsigned)__builtin_amdgcn_update_dpp(0, (int)w, 0x4E, 0xF, 0xF, false);
            if ((lane & 3) == 0) MSK[16 * q + (lane >> 2)] = w;
        } else if ((lane & 3) == 0) MSK[16 * q + (lane >> 2)] = 0u;
    }
}

__device__ __forceinline__ void attn_task_naive(Frame& F, int task, unsigned char* wl) {
    const int lane = F.lane;
    const bf16_t* P = (const bf16_t*)(F.ws + WS_P); const unsigned* MSK = (const unsigned*)(F.ws + WS_MSK); bf16_t* Y = (bf16_t*)(F.ws + WS_YCAT);
    int* list = (int*)wl; float* qs = (float*)(wl + 1024); float* ps = (float*)(wl + 1536);
    const int t = task >> 3, hd = task & 7, b = t >> 12, i = (t & (SEQ - 1)) >> 6;
    const int ntile = i + 1;
    int cnt = 0;
    for (int jj = 0; jj < ntile; ++jj) {
        const unsigned w0 = MSK[(size_t)t * 128 + 2 * jj], w1 = MSK[(size_t)t * 128 + 2 * jj + 1];
        const unsigned long long m = (unsigned long long)w0 | ((unsigned long long)w1 << 32);
        const int pre = __popcll(m & ((1ull << lane) - 1ull));
        if (((m >> lane) & 1ull) && (cnt + pre < 256)) list[cnt + pre] = 64 * jj + lane;
        cnt += __popcll(m);
    }
    const int nsel = cnt < 256 ? cnt : 256;
    { const bf16_t* qp = P + (size_t)t * NP + PQ + hd * 128; qs[lane] = bf2f(qp[lane]); qs[64 + lane] = bf2f(qp[64 + lane]); }
    LDS_WAIT(); asm volatile("" ::: "memory");
    float lg[4]; float mx = -INFINITY;
#pragma unroll
    for (int rr = 0; rr < 4; ++rr) {
        const int e = lane + 64 * rr; lg[rr] = -INFINITY;
        if (e < nsel) { const int key = list[e]; const u32x4* kp = (const u32x4*)(P + ((size_t)b * SEQ + key) * NP + PK + hd * 128); float d = 0.f;
#pragma unroll
            for (int c = 0; c < 16; ++c) { const u32x4 kv = kp[c]; const float* q = qs + 8 * c;
                d += q[0] * bflo(kv.x) + q[1] * bfhi(kv.x) + q[2] * bflo(kv.y) + q[3] * bfhi(kv.y) + q[4] * bflo(kv.z) + q[5] * bfhi(kv.z) + q[6] * bflo(kv.w) + q[7] * bfhi(kv.w); }
            lg[rr] = d; mx = fmaxf(mx, d); }
    }
#pragma unroll
    for (int o = 1; o < 64; o <<= 1) mx = fmaxf(mx, __shfl_xor(mx, o));
    float sum = 0.f;
#pragma unroll
    for (int rr = 0; rr < 4; ++rr) { const int e = lane + 64 * rr; const float p = (e < nsel) ? exp2f(lg[rr] - mx) : 0.f; ps[e] = p; sum += p; }
    sum = wave_sum(sum);
    LDS_WAIT(); asm volatile("" ::: "memory");
    float o0 = 0.f, o1 = 0.f;
    const bf16_t* vb = P + (size_t)b * SEQ * NP + PV + hd * 128 + 2 * lane;
    for (int e = 0; e < nsel; ++e) { const int key = list[e]; const float p = ps[e]; const unsigned v = *(const unsigned*)(vb + (size_t)key * NP); o0 += p * bflo(v); o1 += p * bfhi(v); }
    const float inv = 1.0f / sum;
    *(unsigned*)(Y + (size_t)t * DM + hd * 128 + 2 * lane) = pk2(o0 * inv, o1 * inv);
    LDS_WAIT(); asm volatile("" ::: "memory");
}

__device__ __forceinline__ void rwkv_scan_naive(Frame& F, int bh, unsigned char* wl) {
    const int lane = F.lane, b = bh >> 4, hd = bh & 15, ch = hd * 64 + lane;
    const bf16_t* P = (const bf16_t*)(F.ws + WS_P); const bf16_t* L3 = (const bf16_t*)(F.ws + WS_L3); bf16_t* Y = (bf16_t*)(F.ws + WS_YCAT);
    const float* mix = F.in[I_MIX];
    const float mu_r = mix[ch], mu_k = mix[1088 + ch], mu_v = mix[2112 + ch];
    const float kkc = F.in[I_KK][ch], kac = F.in[I_KA][ch], rkc = F.in[I_RK][ch], lnw = F.in[I_LNW][ch], lnb = F.in[I_LNB][ch];
    float* vec = (float*)wl;
    f32x4 S4[16];
#pragma unroll
    for (int k = 0; k < 16; ++k) S4[k] = (f32x4){0.f, 0.f, 0.f, 0.f};
    float prev_r = 0.f, prev_k = 0.f, prev_v = 0.f;
    constexpr int PF = 4;
    float in_r[PF], in_k[PF], in_v[PF], in_ld[PF], in_a[PF], in_g[PF];
    const bf16_t* prow = P + (size_t)b * SEQ * NP + ch; const bf16_t* lrow = L3 + (size_t)b * SEQ * NL + ch;
#pragma unroll
    for (int j = 0; j < PF; ++j) { const bf16_t* pr = prow + (size_t)j * NP; const bf16_t* lr = lrow + (size_t)j * NL;
        in_r[j] = bf2f(pr[PR]); in_k[j] = bf2f(pr[PKR]); in_v[j] = bf2f(pr[PVR]); in_ld[j] = bf2f(lr[0]); in_a[j] = bf2f(lr[1024]); in_g[j] = bf2f(lr[2048]); }
    const f32x4* vec4 = (const f32x4*)vec;
    for (int tb = 0; tb < SEQ; tb += PF) {
        float c_r[PF], c_k[PF], c_v[PF], c_ld[PF], c_a[PF], c_g[PF];
#pragma unroll
        for (int j = 0; j < PF; ++j) { c_r[j] = in_r[j]; c_k[j] = in_k[j]; c_v[j] = in_v[j]; c_ld[j] = in_ld[j]; c_a[j] = in_a[j]; c_g[j] = in_g[j]; }
        {
            const int tn = (tb + PF < SEQ) ? tb + PF : tb;
#pragma unroll
            for (int j = 0; j < PF; ++j) { const bf16_t* pr = prow + (size_t)(tn + j) * NP; const bf16_t* lr = lrow + (size_t)(tn + j) * NL;
                in_r[j] = bf2f(pr[PR]); in_k[j] = bf2f(pr[PKR]); in_v[j] = bf2f(pr[PVR]); in_ld[j] = bf2f(lr[0]); in_a[j] = bf2f(lr[1024]); in_g[j] = bf2f(lr[2048]); }
        }
#pragma unroll
        for (int j = 0; j < PF; ++j) {
            const float r_t = c_r[j] + (prev_r - c_r[j]) * mu_r, k_t = c_k[j] + (prev_k - c_k[j]) * mu_k, v_t = c_v[j] + (prev_v - c_v[j]) * mu_v;
            prev_r = c_r[j]; prev_k = c_k[j]; prev_v = c_v[j];
            const float a = c_a[j];
            const float kkr = k_t * kkc; const float n2 = wave_sum(kkr * kkr); const float kk = kkr * (1.0f / fmaxf(sqrtf(n2), 1e-12f));
            const float kp = k_t * (1.0f + (a - 1.0f) * kac); const float w = __expf(c_ld[j]); const float bb = kk * a;
            vec[lane] = -kk; vec[64 + lane] = w; vec[128 + lane] = bb; vec[192 + lane] = kp; vec[256 + lane] = r_t;
            LDS_WAIT(); asm volatile("" ::: "memory");
            f32x4 sa4 = (f32x4){0.f, 0.f, 0.f, 0.f};
#pragma unroll
            for (int k = 0; k < 16; ++k) { sa4 += S4[k] * vec4[k]; if ((k & 3) == 3) asm volatile("" ::: "memory"); }
            const float sa = (sa4.x + sa4.y) + (sa4.z + sa4.w);
            f32x4 y4 = (f32x4){0.f, 0.f, 0.f, 0.f};
#pragma unroll
            for (int k = 0; k < 16; ++k) {
                const f32x4 wv = vec4[16 + k], bv = vec4[32 + k], kv = vec4[48 + k], rv = vec4[64 + k];
                S4[k] = S4[k] * wv + bv * sa + kv * v_t; y4 += S4[k] * rv;
                if (k & 1) asm volatile("" ::: "memory"); }
            const float y = (y4.x + y4.y) + (y4.z + y4.w);
            const float mean = wave_sum(y) * (1.0f / 64.0f); const float dv = y - mean; const float var = wave_sum(dv * dv) * (1.0f / 64.0f);
            const float yn = dv * rsqrtf(var + GN_EPS) * lnw + lnb;
            const float bonus = wave_sum(r_t * kp * rkc) * v_t;
            const float o = (yn + bonus) * c_g[j];
            Y[((size_t)b * SEQ + tb + j) * DM + 1024 + ch] = (bf16_t)f2bf(o);
            asm volatile("" ::: "memory");
        }
    }
}


namespace rw {
constexpr int TP = 72, TILE_B = 64 * TP * 2;
enum { T_ATM = 0, T_RTM, T_BTM, T_KTM, T_ACM, T_VCM, T_BCM, T_KCM, T_MAB, T_MAK, T_MRB, T_MRK, T_TINV, NTILE };
constexpr int T_G1 = T_ATM, T_AP = T_BTM, T_U0 = T_KTM;
constexpr int OFF_X11T = NTILE * TILE_B, OFF_T1T = OFF_X11T + 2560, OFF_SEG = OFF_T1T + 2560, OFF_PC = OFF_SEG + 2048, LDS_END = OFF_PC + 256;
static_assert(LDS_END <= RING_BYTES, "rwkv pass A LDS");
__device__ __forceinline__ int crow(int e, int h) { return (e & 3) + 8 * (e >> 2) + 4 * h; }
__device__ __forceinline__ f32x16 zero16() { return (f32x16){0.f, 0.f, 0.f, 0.f, 0.f, 0.f, 0.f, 0.f, 0.f, 0.f, 0.f, 0.f, 0.f, 0.f, 0.f, 0.f}; }
template <int KS>
__device__ __forceinline__ f32x16 mmt(const LAS bf16_t* A, int ap, int ar0, int ac0, const LAS bf16_t* B, int bp, int br0, int bc0, f32x16 acc, int r, int h) {
    const LAS bf16_t* pa = A + (ar0 + r) * ap + ac0 + 8 * h; const LAS bf16_t* pb = B + (br0 + r) * bp + bc0 + 8 * h;
#pragma unroll
    for (int s = 0; s < KS; ++s) acc = __builtin_amdgcn_mfma_f32_32x32x16_bf16(*(const LAS bf16x8*)(pa + 16 * s), *(const LAS bf16x8*)(pb + 16 * s), acc, 0, 0, 0);
    return acc;
}
__device__ __forceinline__ void store_rm(LAS bf16_t* D, int r0, int c0, const f32x16& acc, int r, int h) {
#pragma unroll
    for (int e = 0; e < 16; ++e) D[(r0 + crow(e, h)) * TP + c0 + r] = (bf16_t)f2bf(acc[e]);
}
__device__ __forceinline__ u32x4 pack8(const f32x16& a, int s) { u32x4 w; w.x = pk2(a[8 * s], a[8 * s + 1]); w.y = pk2(a[8 * s + 2], a[8 * s + 3]); w.z = pk2(a[8 * s + 4], a[8 * s + 5]); w.w = pk2(a[8 * s + 6], a[8 * s + 7]); return w; }
__device__ __forceinline__ void unpack8(const u32x4 w, f32x16& a, int s) { a[8 * s] = bflo(w.x); a[8 * s + 1] = bfhi(w.x); a[8 * s + 2] = bflo(w.y); a[8 * s + 3] = bfhi(w.y); a[8 * s + 4] = bflo(w.z); a[8 * s + 5] = bfhi(w.z); a[8 * s + 6] = bflo(w.w); a[8 * s + 7] = bfhi(w.w); }
__device__ __forceinline__ unsigned char* l3_slot(unsigned char* l3, int tg0, int col0, int bo) { return l3 + ((size_t)(tg0 + (bo >> 7)) * NL + col0) * 2 + (bo & 127); }

__device__ __forceinline__ void pass_a(Frame& F) {
    const int lane = F.lane, wave = F.wave, r = lane & 31, h = lane >> 5;
    LAS bf16_t* tiles = (LAS bf16_t*)F.lds;
#define TL(i) (tiles + (i) * (TILE_B / 2))
    LAS bf16_t* X11T = (LAS bf16_t*)(F.lds + OFF_X11T); LAS bf16_t* T1T = (LAS bf16_t*)(F.lds + OFF_T1T);
    LAS float* seg = (LAS float*)(F.lds + OFF_SEG); LAS float* pc = (LAS float*)(F.lds + OFF_PC);
    const bf16_t* P = (const bf16_t*)(F.ws + WS_P); unsigned char* L3 = F.ws + WS_L3;
    bf16_t* MT = (bf16_t*)(F.ws + WS_MT); bf16_t* SA = (bf16_t*)(F.ws + WS_SA); float* BON = (float*)(F.ws + WS_BON);
    const float* mix = F.in[I_MIX];
    struct Raw { float pr, pk, pv, cr[8], ck[8], cv[8], l[8], a[8]; };
    auto load_raw = [&](int unit, Raw& w) {
        const int b = unit >> 10, hd = (unit >> 6) & 15, ci = unit & 63, tg0 = b * SEQ + ci * 64, ch = hd * 64 + lane;
        const bf16_t* p0 = P + (size_t)(tg0 + 8 * wave) * NP + ch; const bf16_t* l0 = (const bf16_t*)L3 + (size_t)(tg0 + 8 * wave) * NL + ch;
        if (ci == 0 && wave == 0) { w.pr = 0.f; w.pk = 0.f; w.pv = 0.f; } else { w.pr = bf2f(p0[PR - NP]); w.pk = bf2f(p0[PKR - NP]); w.pv = bf2f(p0[PVR - NP]); }
#pragma unroll
        for (int j = 0; j < 8; ++j) { w.cr[j] = bf2f(p0[(size_t)j * NP + PR]); w.ck[j] = bf2f(p0[(size_t)j * NP + PKR]); w.cv[j] = bf2f(p0[(size_t)j * NP + PVR]);
            w.l[j] = bf2f(l0[(size_t)j * NL]); w.a[j] = bf2f(l0[(size_t)j * NL + 1024]); }
    };
    Raw cur;
    if (F.vcu < 4096) load_raw(F.vcu, cur);
    for (int unit = F.vcu; unit < 4096; unit += F.G) {
        const int b = unit >> 10, hd = (unit >> 6) & 15, ci = unit & 63, tg0 = b * SEQ + ci * 64;
        Raw nxt;
        {
            const int c = lane, ch = hd * 64 + c, sg = wave;
            const float mu_r = mix[ch], mu_k = mix[1088 + ch], mu_v = mix[2112 + ch];
            const float kkc = F.in[I_KK][ch], kac = F.in[I_KA][ch], rkc = F.in[I_RK][ch];
            float pr = cur.pr, pk = cur.pk, pv = cur.pv;
            float rr[8], kp[8], vv[8], kk[8], bb[8], ld[8], cl[8];
            float run = 0.f;
#pragma unroll
            for (int j = 0; j < 8; ++j) {
                const float cr = cur.cr[j], ck = cur.ck[j], cv = cur.cv[j];
                const float l = cur.l[j], a = cur.a[j];
                const float r_t = cr + (pr - cr) * mu_r, k_t = ck + (pk - ck) * mu_k, v_t = cv + (pv - cv) * mu_v; pr = cr; pk = ck; pv = cv;
                const float kkr = k_t * kkc; const float n2 = wave_sum(kkr * kkr); const float kkn = kkr * __builtin_amdgcn_rsqf(fmaxf(n2, 1e-24f));
                const float kpp = k_t * (1.0f + (a - 1.0f) * kac);
                const float bon = wave_sum(r_t * kpp * rkc);
                if (lane == 0) BON[(size_t)(tg0 + 8 * sg + j) * 16 + hd] = bon;
                run += l; rr[j] = r_t; kp[j] = kpp; vv[j] = v_t; kk[j] = kkn; bb[j] = kkn * a; ld[j] = l; cl[j] = run;
            }
            seg[sg * 64 + c] = run;
            __syncthreads();
            float off = 0.f, tot = 0.f;
#pragma unroll
            for (int q = 0; q < 8; ++q) { const float v = seg[q * 64 + c]; tot += v; off += (q < sg) ? v : 0.f; }
            if (sg == 0) pc[c] = __expf(tot);
            float ta[8], tr[8], tb[8], tk[8];
#pragma unroll
            for (int j = 0; j < 8; ++j) { const float lp = off + cl[j]; const float ep = __expf(lp), em = __builtin_amdgcn_rcpf(ep), epm = __expf(lp - ld[j]);
                ta[j] = -kk[j] * epm; tr[j] = rr[j] * ep; tb[j] = bb[j] * em; tk[j] = kp[j] * em; }
#pragma unroll
            for (int j = 0; j < 8; ++j) { const int o = (8 * sg + j) * TP + c;
                TL(T_ATM)[o] = (bf16_t)f2bf(ta[j]); TL(T_RTM)[o] = (bf16_t)f2bf(tr[j]); TL(T_BTM)[o] = (bf16_t)f2bf(tb[j]); TL(T_KTM)[o] = (bf16_t)f2bf(tk[j]); }
            { const int o = c * TP + 8 * sg;
              *(LAS u32x4*)(TL(T_ACM) + o) = (u32x4){pk2(ta[0], ta[1]), pk2(ta[2], ta[3]), pk2(ta[4], ta[5]), pk2(ta[6], ta[7])};
              *(LAS u32x4*)(TL(T_VCM) + o) = (u32x4){pk2(vv[0], vv[1]), pk2(vv[2], vv[3]), pk2(vv[4], vv[5]), pk2(vv[6], vv[7])};
              *(LAS u32x4*)(TL(T_BCM) + o) = (u32x4){pk2(tb[0], tb[1]), pk2(tb[2], tb[3]), pk2(tb[4], tb[5]), pk2(tb[6], tb[7])};
              *(LAS u32x4*)(TL(T_KCM) + o) = (u32x4){pk2(tk[0], tk[1]), pk2(tk[2], tk[3]), pk2(tk[4], tk[5]), pk2(tk[6], tk[7])}; }
        }
        __syncthreads();
#pragma unroll
        for (int q = 0; q < 2; ++q) {
            const int id = 2 * wave + q, rt = id >> 2, ct = id & 3;
            const LAS bf16_t* Z = (rt < 2) ? TL(T_ATM) : TL(T_RTM); const LAS bf16_t* X = (ct < 2) ? TL(T_BTM) : TL(T_KTM);
            LAS bf16_t* D = (rt < 2) ? ((ct < 2) ? TL(T_MAB) : TL(T_MAK)) : ((ct < 2) ? TL(T_MRB) : TL(T_MRK));
            const int zr0 = (rt & 1) * 32, xr0 = (ct & 1) * 32; const bool strict = rt < 2;
            f32x16 acc = zero16();
            if (xr0 <= zr0) acc = mmt<4>(Z, TP, zr0, 0, X, TP, xr0, 0, acc, r, h);
#pragma unroll
            for (int e = 0; e < 16; ++e) { const int t = zr0 + crow(e, h), i = xr0 + r; const bool keep = strict ? (i < t) : (i <= t); D[t * TP + i] = keep ? (bf16_t)f2bf(acc[e]) : (bf16_t)0; }
            if (rt < 2 && ct < 2 && zr0 == xr0) {
                LAS bf16_t* LT = zr0 ? T1T : X11T;
#pragma unroll
                for (int g = 0; g < 4; ++g) { float v[4];
#pragma unroll
                    for (int k = 0; k < 4; ++k) v[k] = (r < crow(4 * g + k, h)) ? acc[4 * g + k] : 0.f;
                    *(LAS u32x2*)(LT + r * 40 + 8 * g + 4 * h) = (u32x2){pk2(v[0], v[1]), pk2(v[2], v[3])}; }
            }
        }
        __syncthreads();
        if (unit + F.G < 4096) load_raw(unit + F.G, nxt); else nxt = cur;
        if (wave < 2) {
            const LAS bf16_t* Lm = TL(T_MAB); LAS bf16_t* TI = TL(T_TINV);
            const int o = 32 * wave;
            LAS bf16_t* Pt = (wave ? TL(T_U0) : TL(T_AP)); LAS bf16_t* Ss = Pt + 1280; LAS bf16_t* STs = Pt + 2560;
            f32x16 accP;
#pragma unroll
            for (int e = 0; e < 16; ++e) { accP[e] = (crow(e, h) == r) ? 1.0f : 0.0f; Pt[crow(e, h) * 40 + r] = (crow(e, h) == r) ? (bf16_t)0x3F80 : (bf16_t)0; }
            LDS_WAIT(); asm volatile("" ::: "memory");
            const LAS bf16_t* Sa = Lm + o * TP + o; int sap = TP;
            const LAS bf16_t* Sb = wave ? T1T : X11T; int sbp = 40;
#pragma unroll
            for (int k = 0; k < 5; ++k) {
                accP = mmt<2>(Pt, 40, 0, 0, Sb, sbp, 0, 0, accP, r, h);
                f32x16 accS = zero16();
                if (k < 4) accS = mmt<2>(Sa, sap, 0, 0, Sb, sbp, 0, 0, accS, r, h);
                LDS_WAIT(); asm volatile("" ::: "memory");
#pragma unroll
                for (int e = 0; e < 16; ++e) Pt[crow(e, h) * 40 + r] = (bf16_t)f2bf(accP[e]);
                if (k < 4) {
#pragma unroll
                    for (int e = 0; e < 16; ++e) Ss[crow(e, h) * 40 + r] = (bf16_t)f2bf(accS[e]);
#pragma unroll
                    for (int g = 0; g < 4; ++g) *(LAS u32x2*)(STs + r * 40 + 8 * g + 4 * h) = (u32x2){pk2(accS[4 * g], accS[4 * g + 1]), pk2(accS[4 * g + 2], accS[4 * g + 3])};
                    Sa = Ss; sap = 40; Sb = STs; sbp = 40;
                }
                LDS_WAIT(); asm volatile("" ::: "memory");
            }
            store_rm(TI, o, o, accP, r, h);
            if (wave == 0) {
#pragma unroll
                for (int e = 0; e < 16; ++e) TI[crow(e, h) * TP + 32 + r] = (bf16_t)0;
#pragma unroll
                for (int g = 0; g < 4; ++g) *(LAS u32x2*)(X11T + r * 40 + 8 * g + 4 * h) = (u32x2){pk2(accP[4 * g], accP[4 * g + 1]), pk2(accP[4 * g + 2], accP[4 * g + 3])};
                LDS_WAIT(); asm volatile("" ::: "memory");
                f32x16 t1 = mmt<2>(Lm, TP, 32, 0, X11T, 40, 0, 0, zero16(), r, h);
#pragma unroll
                for (int g = 0; g < 4; ++g) *(LAS u32x2*)(Ss + r * 40 + 8 * g + 4 * h) = (u32x2){pk2(t1[4 * g], t1[4 * g + 1]), pk2(t1[4 * g + 2], t1[4 * g + 3])};
            }
        } else if (wave >= 4) {
            const int mi = (wave - 4) >> 1, ni = (wave - 4) & 1;
            f32x16 acc = mmt<4>(TL(T_VCM), TP, 32 * mi, 0, TL(T_MAK), TP, 32 * ni, 0, zero16(), r, h);
            store_rm(TL(T_G1), 32 * mi, 32 * ni, acc, r, h);
        }
        __syncthreads();
        if (wave == 0) {
            LAS bf16_t* TI = TL(T_TINV);
            f32x16 x21 = mmt<2>(TI, TP, 32, 32, TL(T_AP) + 1280, 40, 0, 0, zero16(), r, h);
            store_rm(TI, 32, 0, x21, r, h);
        }
        __syncthreads();
        {
            const int w4 = wave & 3, mi = w4 >> 1, ni = w4 & 1;
            if (wave < 4) { f32x16 acc = mmt<4>(TL(T_ACM), TP, 32 * mi, 0, TL(T_TINV), TP, 32 * ni, 0, zero16(), r, h); store_rm(TL(T_AP), 32 * mi, 32 * ni, acc, r, h); }
            else { f32x16 acc = mmt<4>(TL(T_G1), TP, 32 * mi, 0, TL(T_TINV), TP, 32 * ni, 0, zero16(), r, h); store_rm(TL(T_U0), 32 * mi, 32 * ni, acc, r, h); }
        }
        __syncthreads();
#pragma unroll
        for (int q = 0; q < 2; ++q) {
            const int id = 2 * wave + q, typ = id >> 2, xx = (id >> 1) & 1, yy = id & 1;
            if (typ == 0) {
                f32x16 acc = mmt<4>(TL(T_AP), TP, 32 * xx, 0, TL(T_MRB), TP, 32 * yy, 0, zero16(), r, h);
#pragma unroll
                for (int g = 0; g < 4; ++g) { const u32x2 w = *(const LAS u32x2*)(TL(T_RTM) + (32 * yy + r) * TP + 32 * xx + 8 * g + 4 * h);
                    acc[4 * g] += bflo(w.x); acc[4 * g + 1] += bfhi(w.x); acc[4 * g + 2] += bflo(w.y); acc[4 * g + 3] += bfhi(w.y); }
#pragma unroll
                for (int s = 0; s < 2; ++s) *(u32x4*)l3_slot(L3, tg0, hd * 64, (((xx * 2 + s) * 2 + yy) * 64 + lane) * 16) = pack8(acc, s);
            } else if (typ == 1) {
                f32x16 acc = mmt<4>(TL(T_U0), TP, 32 * xx, 0, TL(T_MRB), TP, 32 * yy, 0, zero16(), r, h);
                acc = mmt<4>(TL(T_VCM), TP, 32 * xx, 0, TL(T_MRK), TP, 32 * yy, 0, acc, r, h);
#pragma unroll
                for (int s = 0; s < 2; ++s) *(u32x4*)l3_slot(L3, tg0, 1024 + hd * 64, ((xx * 2 + yy) * 64 + lane) * 32 + 16 * s) = pack8(acc, s);
            } else if (typ == 2) {
                f32x16 acc = mmt<4>(TL(T_AP), TP, 32 * xx, 0, TL(T_BCM), TP, 32 * yy, 0, zero16(), r, h);
                const float pcc = pc[32 * yy + r];
#pragma unroll
                for (int e = 0; e < 16; ++e) acc[e] = (acc[e] + ((32 * xx + crow(e, h) == 32 * yy + r) ? 1.0f : 0.0f)) * pcc;
#pragma unroll
                for (int s = 0; s < 2; ++s) *(u32x4*)(MT + (size_t)unit * 4096 + (((yy * 2 + xx) * 2 + s) * 64 + lane) * 8) = pack8(acc, s);
            } else {
                f32x16 acc = mmt<4>(TL(T_BCM), TP, 32 * xx, 0, TL(T_U0), TP, 32 * yy, 0, zero16(), r, h);
                acc = mmt<4>(TL(T_KCM), TP, 32 * xx, 0, TL(T_VCM), TP, 32 * yy, 0, acc, r, h);
#pragma unroll
                for (int e = 0; e < 16; ++e) acc[e] *= pc[32 * xx + crow(e, h)];
#pragma unroll
                for (int s = 0; s < 2; ++s) *(u32x4*)(SA + (size_t)unit * 4096 + ((yy * 2 + xx) * 64 + lane) * 16 + 8 * s) = pack8(acc, s);
            }
        }
        __syncthreads();
        cur = nxt;
    }
#undef TL
}

struct PbSet { bf16x8 A[8]; u32x4 S[4]; };
__device__ __forceinline__ void pb_load(PbSet& d, const bf16_t* MT, const bf16_t* SA, int c, int lane) {
    const int cc = c < 64 ? c : 63;
    const char* mb = (const char*)MT + (size_t)cc * 8192; const char* sb = (const char*)SA + (size_t)cc * 8192;
    const unsigned lo16 = (unsigned)lane * 16u, lo32 = (unsigned)lane * 32u;
#pragma unroll
    for (int f = 0; f < 8; ++f) d.A[f] = *(const bf16x8*)(mb + lo16 + f * 1024);
#pragma unroll
    for (int q = 0; q < 4; ++q) d.S[q] = *(const u32x4*)(sb + lo32 + (q >> 1) * 2048 + 16 * (q & 1));
}
__device__ __forceinline__ void pb_step(const PbSet& d, f32x16 (&X)[2], bf16_t* SA, int c, int lane, const bool dry) {
    bf16x8 Bf[4];
#pragma unroll
    for (int kt = 0; kt < 2; ++kt)
#pragma unroll
        for (int s = 0; s < 2; ++s) { const u32x4 w = pack8(X[kt], s); Bf[kt * 2 + s] = __builtin_bit_cast(bf16x8, w); if (!dry) *(u32x4*)((char*)SA + (size_t)c * 8192 + (unsigned)lane * 16u + (kt * 2 + s) * 1024) = w; }
    f32x16 D[2];
#pragma unroll
    for (int ip = 0; ip < 2; ++ip) { unpack8(d.S[2 * ip], D[ip], 0); unpack8(d.S[2 * ip + 1], D[ip], 1);
#pragma unroll
        for (int ks = 0; ks < 4; ++ks) D[ip] = __builtin_amdgcn_mfma_f32_32x32x16_bf16(d.A[ip * 4 + ks], Bf[ks], D[ip], 0, 0, 0); }
    X[0] = D[0]; X[1] = D[1];
}
__device__ __forceinline__ void pass_b(Frame& F, int bh, int j, const bool dry, const int part) {
    const int lane = F.lane;
    const bf16_t* MT = (const bf16_t*)(F.ws + WS_MT) + (size_t)bh * 64 * 4096; bf16_t* SA = (bf16_t*)(F.ws + WS_SA) + (size_t)bh * 64 * 4096 + j * 2048;
    f32x4* XS = (f32x4*)(F.ws + WS_XS) + (size_t)(bh * 2 + j) * 512 + lane * 8;
    f32x16 X[2] = {zero16(), zero16()};
    const int c0 = part ? 33 : 0, c1 = part ? 63 : 33;
    if (part) {
#pragma unroll
        for (int q = 0; q < 8; ++q) { const f32x4 v = XS[q]; X[q >> 2][4 * (q & 3)] = v.x; X[q >> 2][4 * (q & 3) + 1] = v.y; X[q >> 2][4 * (q & 3) + 2] = v.z; X[q >> 2][4 * (q & 3) + 3] = v.w; }
    }
    PbSet s0, s1, s2;
    pb_load(s0, MT, SA, c0, lane); pb_load(s1, MT, SA, c0 + 1, lane);
    for (int c = c0; c < c1; c += 3) {
        pb_load(s2, MT, SA, c + 2, lane); pb_step(s0, X, SA, c, lane, dry);
        pb_load(s0, MT, SA, c + 3, lane); pb_step(s1, X, SA, c + 1, lane, dry);
        pb_load(s1, MT, SA, c + 4, lane); pb_step(s2, X, SA, c + 2, lane, dry);
    }
    if (part) pb_step(s0, X, SA, 63, lane, dry);
    else if (!dry) {
#pragma unroll
        for (int q = 0; q < 8; ++q) XS[q] = (f32x4){X[q >> 2][4 * (q & 3)], X[q >> 2][4 * (q & 3) + 1], X[q >> 2][4 * (q & 3) + 2], X[q >> 2][4 * (q & 3) + 3]};
    }
}

__device__ __forceinline__ void pass_b_block(Frame& F, int bh, const bool dry) {
    const int lane = F.lane, wave = F.wave;
    const unsigned char* MTg = F.ws + WS_MT + (size_t)bh * 64 * 8192; unsigned char* SAg = F.ws + WS_SA + (size_t)bh * 64 * 8192;
    constexpr int DEP = 6;
#define PB_ISSUE(c_) do { const int cc_ = (c_) < 64 ? (c_) : 63; const int sl_ = (c_) & 7; _Pragma("unroll") for (int q = 0; q < 4; ++q) { const int p_ = 4 * (wave - 4) + q; \
        const unsigned char* src_ = (p_ < 8 ? MTg + (size_t)cc_ * 8192 + p_ * 1024 : SAg + (size_t)cc_ * 8192 + (p_ - 8) * 1024) + lane * 16; \
        __builtin_amdgcn_global_load_lds((const unsigned*)src_, (LAS unsigned*)(F.lds + sl_ * 16384 + p_ * 1024), 16, 0, 0); } } while (0)
    if (wave >= 4) {
#pragma unroll
        for (int c = 0; c < DEP; ++c) PB_ISSUE(c);
        asm volatile("s_waitcnt vmcnt(20)" ::: "memory");
    }
    asm volatile("s_waitcnt lgkmcnt(0)\n\ts_barrier" ::: "memory");
    f32x16 X[2] = {zero16(), zero16()};
    for (int c = 0; c < 64; ++c) {
        if (wave >= 4) { PB_ISSUE(c + DEP); asm volatile("s_waitcnt vmcnt(20)" ::: "memory"); }
        if (wave < 2) {
            const int j = wave;
            const LAS unsigned char* base = F.lds + (c & 7) * 16384;
            bf16x8 Af[8]; u32x4 Sd[4];
#pragma unroll
            for (int f = 0; f < 8; ++f) Af[f] = *(const LAS bf16x8*)(base + f * 1024 + lane * 16);
#pragma unroll
            for (int q = 0; q < 4; ++q) Sd[q] = *(const LAS u32x4*)(base + 8192 + j * 4096 + (q >> 1) * 2048 + lane * 32 + 16 * (q & 1));
            bf16x8 Bf[4];
#pragma unroll
            for (int kt = 0; kt < 2; ++kt)
#pragma unroll
                for (int s2 = 0; s2 < 2; ++s2) { const u32x4 w = pack8(X[kt], s2); Bf[kt * 2 + s2] = __builtin_bit_cast(bf16x8, w);
                    if (!dry) *(u32x4*)(SAg + (size_t)c * 8192 + j * 4096 + (kt * 2 + s2) * 1024 + lane * 16) = w; }
            f32x16 D[2];
#pragma unroll
            for (int ip = 0; ip < 2; ++ip) { unpack8(Sd[2 * ip], D[ip], 0); unpack8(Sd[2 * ip + 1], D[ip], 1);
#pragma unroll
                for (int ks = 0; ks < 4; ++ks) D[ip] = __builtin_amdgcn_mfma_f32_32x32x16_bf16(Af[ip * 4 + ks], Bf[ks], D[ip], 0, 0, 0); }
            X[0] = D[0]; X[1] = D[1];
        }
        asm volatile("s_waitcnt lgkmcnt(0)\n\ts_barrier" ::: "memory");
    }
#undef PB_ISSUE
    asm volatile("s_waitcnt vmcnt(0)" ::: "memory");
    __syncthreads();
}

__device__ __forceinline__ void pass_c(Frame& F) {
    const int lane = F.lane, r = lane & 31, h = lane >> 5;
    const int gw = F.vcu * 8 + F.wave, NGW = F.G * 8;
    const bf16_t* P = (const bf16_t*)(F.ws + WS_P); unsigned char* L3 = F.ws + WS_L3; const bf16_t* SA = (const bf16_t*)(F.ws + WS_SA); const float* BON = (const float*)(F.ws + WS_BON);
    bf16_t* Y = (bf16_t*)(F.ws + WS_YCAT); const float* mix = F.in[I_MIX];
    LAS float* cst = (LAS float*)F.lds;
    for (int i = F.tid; i < 1024; i += 512) { cst[i] = mix[2112 + i]; cst[1024 + i] = F.in[I_LNW][i]; cst[2048 + i] = F.in[I_LNB][i]; }
    __syncthreads();
    LAS bf16_t* wt = (LAS bf16_t*)(F.lds + 12288 + F.wave * 9472);
    const int lrow = lane >> 3, lpc = (lane & 7) * 8;
    for (int unit = gw; unit < 4096; unit += NGW) {
        const int b = unit >> 10, hd = (unit >> 6) & 15, ci = unit & 63, tg0 = b * SEQ + ci * 64;
        bf16x8 Af[8], Bf[8];
#pragma unroll
        for (int f = 0; f < 8; ++f) Af[f] = *(const bf16x8*)(SA + (size_t)unit * 4096 + (f * 64 + lane) * 8);
#pragma unroll
        for (int f = 0; f < 8; ++f) Bf[f] = *(const bf16x8*)l3_slot(L3, tg0, hd * 64, (f * 64 + lane) * 16);
        f32x16 acc[2][2];
#pragma unroll
        for (int j = 0; j < 2; ++j)
#pragma unroll
            for (int tt = 0; tt < 2; ++tt) {
#pragma unroll
                for (int s = 0; s < 2; ++s) unpack8(*(const u32x4*)l3_slot(L3, tg0, 1024 + hd * 64, ((j * 2 + tt) * 64 + lane) * 32 + 16 * s), acc[j][tt], s);
#pragma unroll
                for (int ks = 0; ks < 4; ++ks) acc[j][tt] = __builtin_amdgcn_mfma_f32_32x32x16_bf16(Af[j * 4 + ks], Bf[ks * 2 + tt], acc[j][tt], 0, 0, 0);
            }
        asm volatile("" ::: "memory");
        u32x4 vr[9];
        { const bf16_t* vp = P + (size_t)(tg0 - 1 + lrow) * NP + PVR + hd * 64 + lpc;
#pragma unroll
          for (int it = 0; it < 9; ++it) { const int row = 8 * it + lrow; vr[it] = (u32x4){0u, 0u, 0u, 0u};
              if (row < 65 && (row > 0 || ci > 0)) vr[it] = *(const u32x4*)vp;
              vp += 8 * NP; asm volatile("" : "+v"(vp)); } }
        u32x4 gr[8];
        { const bf16_t* gp = (const bf16_t*)L3 + (size_t)(tg0 + lrow) * NL + 2048 + hd * 64 + lpc;
#pragma unroll
          for (int it = 0; it < 8; ++it) { gr[it] = *(const u32x4*)gp; gp += 8 * NL; asm volatile("" : "+v"(gp)); } }
        const float bon0 = BON[(size_t)(tg0 + r) * 16 + hd], bon1 = BON[(size_t)(tg0 + 32 + r) * 16 + hd];
#pragma unroll
        for (int it = 0; it < 9; ++it) { const int row = 8 * it + lrow; if (row < 65) *(LAS u32x4*)(wt + row * 72 + lpc) = vr[it]; }
        LDS_WAIT(); asm volatile("" ::: "memory");
        u32x2 cvq[2][8], pvq[2][8];
#pragma unroll
        for (int tt = 0; tt < 2; ++tt)
#pragma unroll
            for (int q = 0; q < 8; ++q) { const int v0 = 32 * (q >> 2) + 8 * (q & 3) + 4 * h; cvq[tt][q] = *(const LAS u32x2*)(wt + (1 + 32 * tt + r) * 72 + v0); pvq[tt][q] = *(const LAS u32x2*)(wt + (32 * tt + r) * 72 + v0); }
        LDS_WAIT(); asm volatile("" ::: "memory");
#pragma unroll
        for (int it = 0; it < 8; ++it) *(LAS u32x4*)(wt + (8 * it + lrow) * 72 + lpc) = gr[it];
        LDS_WAIT(); asm volatile("" ::: "memory");
#pragma unroll
        for (int tt = 0; tt < 2; ++tt) {
            float sm = 0.f;
#pragma unroll
            for (int e = 0; e < 16; ++e) sm += acc[0][tt][e] + acc[1][tt][e];
            sm += __shfl_xor(sm, 32); const float mean = sm * (1.0f / 64.0f);
            float sq = 0.f;
#pragma unroll
            for (int e = 0; e < 16; ++e) { const float d0 = acc[0][tt][e] - mean, d1 = acc[1][tt][e] - mean; sq += d0 * d0 + d1 * d1; }
            sq += __shfl_xor(sq, 32); const float rstd = rsqrtf(sq * (1.0f / 64.0f) + GN_EPS);
            const float bon = tt ? bon1 : bon0;
#pragma unroll
            for (int q = 0; q < 8; ++q) { const int j = q >> 2, g = q & 3; const int v0 = 32 * j + 8 * g + 4 * h, ch = hd * 64 + v0;
                const u32x2 cv = cvq[tt][q], pv = pvq[tt][q]; const u32x2 gg = *(const LAS u32x2*)(wt + (32 * tt + r) * 72 + v0);
                const f32x4 mu = *(const LAS f32x4*)(cst + ch), lw = *(const LAS f32x4*)(cst + 1024 + ch), lb = *(const LAS f32x4*)(cst + 2048 + ch);
                const float c0 = bflo(cv.x), c1 = bfhi(cv.x), c2 = bflo(cv.y), c3 = bfhi(cv.y);
                const float v_0 = c0 + (bflo(pv.x) - c0) * mu.x, v_1 = c1 + (bfhi(pv.x) - c1) * mu.y, v_2 = c2 + (bflo(pv.y) - c2) * mu.z, v_3 = c3 + (bfhi(pv.y) - c3) * mu.w;
                const float o0 = ((acc[j][tt][4 * g] - mean) * rstd * lw.x + lb.x + bon * v_0) * bflo(gg.x);
                const float o1 = ((acc[j][tt][4 * g + 1] - mean) * rstd * lw.y + lb.y + bon * v_1) * bfhi(gg.x);
                const float o2 = ((acc[j][tt][4 * g + 2] - mean) * rstd * lw.z + lb.z + bon * v_2) * bflo(gg.y);
                const float o3 = ((acc[j][tt][4 * g + 3] - mean) * rstd * lw.w + lb.w + bon * v_3) * bfhi(gg.y);
                *(LAS u32x2*)(wt + (32 * tt + r) * 72 + v0) = (u32x2){pk2(o0, o1), pk2(o2, o3)};
                asm volatile("" ::: "memory"); }
        }
        LDS_WAIT(); asm volatile("" ::: "memory");
#pragma unroll
        for (int it = 0; it < 8; ++it) *(u32x4*)(Y + (size_t)(tg0 + 8 * it + lrow) * DM + 1024 + hd * 64 + lpc) = *(const LAS u32x4*)(wt + (8 * it + lrow) * 72 + lpc);
        LDS_WAIT(); asm volatile("" ::: "memory");
    }
    __syncthreads();
}
}


namespace att {
using s16x4 = __attribute__((ext_vector_type(4))) short;
constexpr int D = 128, NW = 8, QBLK = 32, KVBLK = 64;
constexpr float THRL = 8.0f * 1.4426950408889634f;
constexpr size_t SHM_V = KVBLK * D * 2, SHM_K = KVBLK * D * 2, SHM_ATTN = 2 * SHM_V + 2 * SHM_K + NW * 64 * 4;
static_assert(SHM_ATTN <= RING_BYTES, "attention LDS");
#define KSWZ(row, colB) ((row) * 256 + ((colB) ^ (((row) & 7) << 4)))
#define SBAR() __builtin_amdgcn_sched_barrier(0)
__device__ __forceinline__ int crow(int r, int hi) { return (r & 3) + 8 * (r >> 2) + 4 * hi; }
__device__ __forceinline__ unsigned cvtpk(float lo, float hi) { unsigned r; asm volatile("v_cvt_pk_bf16_f32 %0, %1, %2" : "=v"(r) : "v"(lo), "v"(hi)); return r; }
__device__ __forceinline__ void partialSM(f32x16& p0, f32x16& p1, const u32x2 mk, float& m_reg, float& mn, float& alpha) {
#pragma unroll
  for (int r = 0; r < 16; ++r) { const unsigned bit = 1u << ((r & 3) + 8 * (r >> 2)); p0[r] = (mk.x & bit) ? p0[r] : -INFINITY; p1[r] = (mk.y & bit) ? p1[r] : -INFINITY; }
  float pmax = p0[0];
#pragma unroll
  for (int r = 1; r < 16; ++r) pmax = fmaxf(pmax, p0[r]);
#pragma unroll
  for (int r = 0; r < 16; ++r) pmax = fmaxf(pmax, p1[r]);
  { auto rr = __builtin_amdgcn_permlane32_swap(__float_as_uint(pmax), __float_as_uint(pmax), false, false);
    pmax = fmaxf(__uint_as_float(rr[0]), __uint_as_float(rr[1])); }
  if (__builtin_expect(__all(pmax - m_reg <= THRL), 1)) { mn = m_reg; alpha = 1.f; }
  else { mn = fmaxf(m_reg, pmax); alpha = __builtin_amdgcn_exp2f(m_reg - mn); m_reg = mn; }
#pragma unroll
  for (int r = 0; r < 16; ++r) { p0[r] = __builtin_amdgcn_exp2f(p0[r] - mn); p1[r] = p1[r] - mn; }
}
__device__ __forceinline__ void finishSM(f32x16& p0, f32x16& p1, float alpha, float& l_reg, bf16x8& pa0, bf16x8& pa1, bf16x8& pa2, bf16x8& pa3) {
#pragma unroll
  for (int r = 0; r < 16; ++r) p1[r] = __builtin_amdgcn_exp2f(p1[r]);
  float ps = 0;
#pragma unroll
  for (int r = 0; r < 16; ++r) ps += p0[r];
#pragma unroll
  for (int r = 0; r < 16; ++r) ps += p1[r];
  { auto rr = __builtin_amdgcn_permlane32_swap(__float_as_uint(ps), __float_as_uint(ps), false, false);
    ps = __uint_as_float(rr[0]) + __uint_as_float(rr[1]); }
  l_reg = l_reg * alpha + ps;
#define PK4(P, BASE, OUT) do { unsigned a0 = cvtpk(P[BASE + 0], P[BASE + 1]), a1 = cvtpk(P[BASE + 2], P[BASE + 3]);   \
    unsigned b0 = cvtpk(P[BASE + 4], P[BASE + 5]), b1 = cvtpk(P[BASE + 6], P[BASE + 7]);                              \
    auto r0 = __builtin_amdgcn_permlane32_swap(a0, b0, false, false); auto r1 = __builtin_amdgcn_permlane32_swap(a1, b1, false, false); \
    u32x4 w = {r0[0], r1[0], r0[1], r1[1]}; OUT = __builtin_bit_cast(bf16x8, w); } while (0)
  PK4(p0, 0, pa0); PK4(p0, 8, pa1); PK4(p1, 0, pa2); PK4(p1, 8, pa3);
#undef PK4
}
__device__ __forceinline__ void qkt(f32x16& p0, f32x16& p1, const char* Ks, const bf16x8* qr, int r32, int hi) {
  p0 = f32x16{}; p1 = f32x16{};
#pragma unroll
  for (int d0 = 0; d0 < 8; ++d0) { int cb = (d0 * 16 + hi * 8) * 2;
    bf16x8 b0 = *reinterpret_cast<const bf16x8*>(Ks + KSWZ(r32, cb));
    bf16x8 b1 = *reinterpret_cast<const bf16x8*>(Ks + KSWZ(32 + r32, cb));
    p0 = __builtin_amdgcn_mfma_f32_32x32x16_bf16(b0, qr[d0], p0, 0, 0, 0);
    p1 = __builtin_amdgcn_mfma_f32_32x32x16_bf16(b1, qr[d0], p1, 0, 0, 0); }
}
__device__ __forceinline__ int v_st(int k, int c) { const int kk = (k & ~0xC) | ((k & 4) << 1) | ((k & 8) >> 1); return ((kk >> 3) * 4 + (c >> 5)) * 512 + ((kk & 7) * 32 + (c & 31)) * 2; }
__device__ __forceinline__ int v_rd_base(int lane) { return ((lane & 3) << 3) | (((lane >> 2) & 3) << 6) | (((lane >> 4) & 1) << 5) | (((lane >> 5) & 1) << 8); }
constexpr int v_rd_off(int d0, int ks, int half) { return d0 * 512 + ks * 4096 + half * 2048; }
template <int OFF> __device__ __forceinline__ s16x4 tr_read(int vb) { s16x4 r; asm volatile("ds_read_b64_tr_b16 %0, %1 offset:%2" : "=&v"(r) : "v"(vb), "i"(OFF) : "memory"); return r; }
template <int D0> __device__ __forceinline__ void pv_one(f32x16& od, int vb, bf16x8 pa0, bf16x8 pa1, bf16x8 pa2, bf16x8 pa3) {
  const s16x4 l0 = tr_read<v_rd_off(D0, 0, 0)>(vb), h0 = tr_read<v_rd_off(D0, 0, 1)>(vb), l1 = tr_read<v_rd_off(D0, 1, 0)>(vb), h1 = tr_read<v_rd_off(D0, 1, 1)>(vb);
  const s16x4 l2 = tr_read<v_rd_off(D0, 2, 0)>(vb), h2 = tr_read<v_rd_off(D0, 2, 1)>(vb), l3 = tr_read<v_rd_off(D0, 3, 0)>(vb), h3 = tr_read<v_rd_off(D0, 3, 1)>(vb);
  asm volatile("s_waitcnt lgkmcnt(0)" ::: "memory"); SBAR();
#define PK(L, H) (bf16x8){L[0], L[1], L[2], L[3], H[0], H[1], H[2], H[3]}
  od = __builtin_amdgcn_mfma_f32_32x32x16_bf16(pa0, PK(l0, h0), od, 0, 0, 0);
  od = __builtin_amdgcn_mfma_f32_32x32x16_bf16(pa1, PK(l1, h1), od, 0, 0, 0);
  od = __builtin_amdgcn_mfma_f32_32x32x16_bf16(pa2, PK(l2, h2), od, 0, 0, 0);
  od = __builtin_amdgcn_mfma_f32_32x32x16_bf16(pa3, PK(l3, h3), od, 0, 0, 0);
#undef PK
}
__device__ __forceinline__ void pv_d0(f32x16* o, int vb, bf16x8 pa0, bf16x8 pa1, bf16x8 pa2, bf16x8 pa3) {
  pv_one<0>(o[0], vb, pa0, pa1, pa2, pa3); pv_one<1>(o[1], vb, pa0, pa1, pa2, pa3); pv_one<2>(o[2], vb, pa0, pa1, pa2, pa3); pv_one<3>(o[3], vb, pa0, pa1, pa2, pa3);
}
__device__ __forceinline__ void attn_unit(const bf16_t* __restrict__ Qb, const bf16_t* __restrict__ Kh, const bf16_t* __restrict__ Vh, const unsigned* __restrict__ Mb,
                                          bf16_t* __restrict__ Ob, int seq, char* lds) {
  constexpr int LDQ = NP, LDK = NP, LDO = DM;
  int tid_ = threadIdx.x; asm volatile("" : "+v"(tid_));
  const int tid = tid_, wid = tid >> 6, lane = tid & 63, r32 = lane & 31, hi = lane >> 5;
  char* V_lds = lds; char* K_lds = lds + 2 * SHM_V;
  float* wsf = (float*)(lds + 2 * SHM_V + 2 * SHM_K) + wid * 64; float* li_l = wsf; float* al_l = wsf + 32;
  float m_reg = -1e30f, l_reg = 0; f32x16 o[4] = {}; bf16x8 qr[8];
  const bf16_t* Qw = Qb + (long)(wid * QBLK + r32) * LDQ + hi * 8;
#pragma unroll
  for (int d0 = 0; d0 < 8; ++d0) qr[d0] = *reinterpret_cast<const bf16x8*>(Qw + d0 * 16);
  const unsigned* Mw = Mb + (long)(wid * QBLK + r32) * 128;
  const int sh = 4 * hi;
  const int sr = tid >> 4, sc = (tid & 15) * 8, vst0 = v_st(sr, sc), vst1 = v_st(32 + sr, sc);
  const int vb0 = (int)(uintptr_t)V_lds + v_rd_base(lane);
  struct { bf16x8 vs0, vs1, ks0, ks1; } sr_[2];
#define SLOAD(i, k0) do { sr_[i].vs0 = *(const bf16x8*)(&Vh[(long)((k0) + sr) * LDK + sc]); sr_[i].vs1 = *(const bf16x8*)(&Vh[(long)((k0) + 32 + sr) * LDK + sc]); \
    sr_[i].ks0 = *(const bf16x8*)(&Kh[(long)((k0) + sr) * LDK + sc]); sr_[i].ks1 = *(const bf16x8*)(&Kh[(long)((k0) + 32 + sr) * LDK + sc]); } while (0)
#define SWRITE(b, i) do { *(bf16x8*)(V_lds + (b) * SHM_V + vst0) = sr_[i].vs0;          \
    *(bf16x8*)(V_lds + (b) * SHM_V + vst1) = sr_[i].vs1; int kc = sc * 2;               \
    *(bf16x8*)(K_lds + (b) * SHM_K + KSWZ(sr, kc)) = sr_[i].ks0;                       \
    *(bf16x8*)(K_lds + (b) * SHM_K + KSWZ(32 + sr, kc)) = sr_[i].ks1; } while (0)
#define SWAIT() asm volatile("s_waitcnt vmcnt(4)" ::: "memory")
#define RESC(a) do { if (__any((a) < 1.f)) { if (hi == 0) al_l[r32] = (a); asm volatile("s_waitcnt lgkmcnt(0)" ::: "memory"); \
    _Pragma("unroll") for (int d = 0; d < 4; ++d) _Pragma("unroll") for (int r = 0; r < 16; ++r) o[d][r] *= al_l[crow(r, hi)]; } } while (0)
#define MLOAD(j) ({ u32x2 _m = *(const u32x2*)(Mw + 2 * (j)); _m.x >>= sh; _m.y >>= sh; _m; })
  f32x16 pA0, pA1, pB0, pB1; float mnA, mnB, alA, alB; bf16x8 pa0, pa1, pa2, pa3; const int NT = seq / KVBLK;
  constexpr int SE = 0, SO = 1;
  u32x2 mkA = MLOAD(0), mkB = MLOAD(1);
  SLOAD(SE, 0); asm volatile("s_waitcnt vmcnt(0)" ::: "memory"); SWRITE(0, SE); __syncthreads();
  qkt(pA0, pA1, K_lds, qr, r32, hi); partialSM(pA0, pA1, mkA, m_reg, mnA, alA);
  SLOAD(SO, KVBLK); if (2 < NT) SLOAD(SE, 2 * KVBLK);
  SWAIT(); SWRITE(1, SO); __syncthreads();
  for (int j = 1; j + 1 < NT; j += 2) {
    mkA = MLOAD(j + 1);
    SBAR(); qkt(pB0, pB1, K_lds + SHM_K, qr, r32, hi);
    finishSM(pA0, pA1, alA, l_reg, pa0, pa1, pa2, pa3); SBAR();
    SLOAD(SO, (j + 2) * KVBLK); SBAR();
    pv_d0(o, vb0, pa0, pa1, pa2, pa3); partialSM(pB0, pB1, mkB, m_reg, mnB, alB);
    __syncthreads(); SWAIT(); SWRITE(0, SE);
    RESC(alB); __syncthreads();
    mkB = MLOAD(j + 2);
    SBAR(); qkt(pA0, pA1, K_lds, qr, r32, hi);
    finishSM(pB0, pB1, alB, l_reg, pa0, pa1, pa2, pa3); SBAR();
    if (j + 3 < NT) SLOAD(SE, (j + 3) * KVBLK); SBAR();
    pv_d0(o, vb0 + (int)SHM_V, pa0, pa1, pa2, pa3); partialSM(pA0, pA1, mkA, m_reg, mnA, alA);
    __syncthreads(); SWAIT(); SWRITE(1, SO);
    RESC(alA); __syncthreads();
  }
  SBAR(); qkt(pB0, pB1, K_lds + SHM_K, qr, r32, hi);
  finishSM(pA0, pA1, alA, l_reg, pa0, pa1, pa2, pa3); SBAR();
  pv_d0(o, vb0, pa0, pa1, pa2, pa3); partialSM(pB0, pB1, mkB, m_reg, mnB, alB);
  __syncthreads(); RESC(alB);
  finishSM(pB0, pB1, alB, l_reg, pa0, pa1, pa2, pa3); SBAR();
  pv_d0(o, vb0 + (int)SHM_V, pa0, pa1, pa2, pa3);
  if (hi == 0) li_l[r32] = l_reg; asm volatile("s_waitcnt lgkmcnt(0)" ::: "memory");
  float rli[16];
#pragma unroll
  for (int r = 0; r < 16; ++r) rli[r] = __builtin_amdgcn_rcpf(li_l[crow(r, hi)]);
  bf16_t* Ow = Ob + (long)(wid * QBLK) * LDO;
#pragma unroll
  for (int r = 0; r < 16; ++r) { int orow = crow(r, hi);
#pragma unroll
    for (int d0 = 0; d0 < 4; ++d0) Ow[(long)orow * LDO + d0 * 32 + r32] = (bf16_t)f2bf(o[d0][r] * rli[r]); }
  __syncthreads();
#undef SLOAD
#undef SWRITE
#undef SWAIT
#undef RESC
#undef MLOAD
}
__device__ __forceinline__ void attn_phase(Frame& F) {
  const bf16_t* P = (const bf16_t*)(F.ws + WS_P); const unsigned* MSK = (const unsigned*)(F.ws + WS_MSK); bf16_t* Y = (bf16_t*)(F.ws + WS_YCAT);
  for (int u = F.vcu; u < 512; u += F.G) {
    const int pairi = u & 255, second = u >> 8; const int bh = pairi >> 3, ql = pairi & 7; const int qb = second ? ql : 15 - ql;
    const int b = bh >> 3, hd = bh & 7; const long t0 = (long)b * SEQ + qb * 256;
    attn_unit(P + t0 * NP + PQ + hd * 128, P + (long)b * SEQ * NP + PK + hd * 128, P + (long)b * SEQ * NP + PV + hd * 128, MSK + t0 * 128, Y + t0 * DM + hd * 128, (qb + 1) * 256, (char*)F.ldsg);
  }
}
#undef KSWZ
#undef SBAR
}

__device__ __forceinline__ void phase_score_passb(Frame& F, const bool dry, const int qw) {
    if (F.G >= 256) { if ((F.vcu & 3) == 0 && (F.vcu >> 2) < 64) rw::pass_b_block(F, F.vcu >> 2, dry); }
    else { for (int bh = F.vcu; bh < 64; bh += F.G) rw::pass_b_block(F, bh, dry); }
    volatile LAS int* qs = (volatile LAS int*)(F.lds + MISC_OFF + 64);
    const bf16_t* P = (const bf16_t*)(F.ws + WS_P);
    const int r = F.lane & 31, h = F.lane >> 5;
    if (F.tid == 0) qs[0] = (int)atomicAdd(F.ctl + CW_QIDX + 64 * qw, 1u);
    __syncthreads();
    int cu = qs[0], it = 0;
    if (cu >= NSCU2) return;
    int b, i, st, st1; idx_decode(cu, b, i, st, st1);
    IdxQ qv[4];
#pragma unroll
    for (int g = 0; g < 4; ++g) idxq_load(qv[g], P, b * SEQ + i * 64 + 16 * g + 2 * F.wave, r, h);
    idx_stage(F, b, st, 0);
    for (;;) {
        const bool same = st < st1;
        if (!same && F.tid == 0) qs[1 + (it & 1)] = (int)atomicAdd(F.ctl + CW_QIDX + 64 * qw, 1u);
        __syncthreads();
        int nu = cu, nb = b, ni = i, nst = st + 1, nst1 = st1;
        if (!same) { nu = qs[1 + (it & 1)]; if (nu < NSCU2) idx_decode(nu, nb, ni, nst, nst1); }
        if (nu < NSCU2) idx_stage(F, nb, nst, (it + 1) & 1);
        idx_score_tile(F, qv, b, i, st, it & 1);
        if (nu >= NSCU2) break;
        if (!same) {
#pragma unroll
            for (int g = 0; g < 4; ++g) idxq_load(qv[g], P, nb * SEQ + ni * 64 + 16 * g + 2 * F.wave, r, h);
        }
        cu = nu; b = nb; i = ni; st = nst; st1 = nst1; ++it;
    }
}
__device__ __forceinline__ void phase_select_passb(Frame& F, const bool dry) {
    const int nw = F.G * 8, w = F.vcu * 8 + F.wave;
    for (int idx = w; idx < T / 2; idx += nw) { const int b = idx >> 11, p = idx & 2047; u32x4 ra[8], rb[8]; idx_row_load(F, b, p, ra); idx_row_load(F, b, 4095 - p, rb); idx_select_row(F, b, p, ra); idx_select_row(F, b, 4095 - p, rb); }
}

struct RouteRec { int cls, pos; float g_lo, g_hi, rstd; int pad0, pad1, pad2; };
__device__ __forceinline__ void phase7(Frame& F, const bool dry, const int mode = 3) {
    const int gw = F.vcu * 8 + F.wave, NGW = F.G * 8, lane = F.lane;
    { int* rowtok = (int*)(F.ws + WS_ROWTOK); for (int i = gw * 64 + lane; i < MPAD; i += NGW * 64) rowtok[i] = -1; }
    if (mode & 1) { LAS float* scr = (LAS float*)(F.lds + F.wave * 16384);
      bf16_t* WGU = (bf16_t*)(F.ws + WS_WGU); bf16_t* WDN = (bf16_t*)(F.ws + WS_WDN);
      constexpr int IG = (DM / 64) * (512 / 32), ID = (512 / 64) * (DM / 32);
      for (int it = gw; it < 16 * (2 * IG + ID); it += NGW) { const int e = it / (2 * IG + ID); int r = it % (2 * IG + ID);
          if (r < IG) transpose_item<2>(F.in[I_WEG] + (size_t)e * DM * 512, 512, WGU + (size_t)e * 1024 * DM, DM, scr, r / 16, r % 16, lane);
          else if (r < 2 * IG) { r -= IG; transpose_item<3>(F.in[I_WEU] + (size_t)e * DM * 512, 512, WGU + (size_t)e * 1024 * DM, DM, scr, r / 16, r % 16, lane); }
          else { r -= 2 * IG; transpose_item<0>(F.in[I_WED] + (size_t)e * 512 * DM, DM, WDN + (size_t)e * DM * 512, 512, scr, r / 64, r % 64, lane); } } }
    if (mode & 2) {
    const float* x1 = F.out; const bf16_t* WRH = (const bf16_t*)(F.ws + WS_WRT); const bf16_t* WRL = WRH + 32 * DM;
    RouteRec* rr = (RouteRec*)(F.ws + WS_ROUTE); unsigned* cnt = F.ctl + CW_CNT;
    const int r = lane & 31, h = lane >> 5;
    __syncthreads();
    const int grp = F.wave >> 2, kq = F.wave & 3;
    LAS float* part = (LAS float*)F.lds;
    for (int tbase = F.vcu * 2; tbase < T / 32; tbase += F.G * 2) {
        const int task = tbase + grp;
        const int t = task * 32 + r;
        const float* xp = x1 + (size_t)t * DM + 512 * kq + 8 * h; const bf16_t* ah = WRH + (size_t)r * DM + 512 * kq + 8 * h; const bf16_t* al = WRL + (size_t)r * DM + 512 * kq + 8 * h;
        f32x16 acc = {0.f, 0.f, 0.f, 0.f, 0.f, 0.f, 0.f, 0.f, 0.f, 0.f, 0.f, 0.f, 0.f, 0.f, 0.f, 0.f};
        float ssq = 0.f;
#pragma unroll 4
        for (int s = 0; s < 512 / 16; ++s) {
            const f32x4 x0 = *(const f32x4*)(xp + 16 * s), x4 = *(const f32x4*)(xp + 16 * s + 4);
            const bf16x8 wh = *(const bf16x8*)(ah + 16 * s), wl = *(const bf16x8*)(al + 16 * s);
            ssq += (x0.x * x0.x + x0.y * x0.y) + (x0.z * x0.z + x0.w * x0.w) + (x4.x * x4.x + x4.y * x4.y) + (x4.z * x4.z + x4.w * x4.w);
            u32x4 xh, xl;
            xh.x = pk2(x0.x, x0.y); xh.y = pk2(x0.z, x0.w); xh.z = pk2(x4.x, x4.y); xh.w = pk2(x4.z, x4.w);
            xl.x = pk2(x0.x - bflo(xh.x), x0.y - bfhi(xh.x)); xl.y = pk2(x0.z - bflo(xh.y), x0.w - bfhi(xh.y)); xl.z = pk2(x4.x - bflo(xh.z), x4.y - bfhi(xh.z)); xl.w = pk2(x4.z - bflo(xh.w), x4.w - bfhi(xh.w));
            acc = __builtin_amdgcn_mfma_f32_32x32x16_bf16(wh, __builtin_bit_cast(bf16x8, xh), acc, 0, 0, 0);
            acc = __builtin_amdgcn_mfma_f32_32x32x16_bf16(wl, __builtin_bit_cast(bf16x8, xh), acc, 0, 0, 0);
            acc = __builtin_amdgcn_mfma_f32_32x32x16_bf16(wh, __builtin_bit_cast(bf16x8, xl), acc, 0, 0, 0);
        }
        { LAS float* pp = part + ((grp * 4 + kq) * 64 + lane) * 17;
#pragma unroll
          for (int e = 0; e < 12; ++e) pp[e] = acc[e];
          pp[16] = ssq; }
        __syncthreads();
        if (kq == 0) {
#pragma unroll
            for (int q = 1; q < 4; ++q) { const LAS float* pp = part + ((grp * 4 + q) * 64 + lane) * 17;
#pragma unroll
                for (int e = 0; e < 12; ++e) acc[e] += pp[e];
                ssq += pp[16]; }
        }
        __syncthreads();
        if (kq != 0 || task >= T / 32) continue;
        ssq += __shfl_xor(ssq, 32);
        const float rstd = rsqrtf(ssq * (1.f / DM) + NORM_EPS);
        float ot[8];
#pragma unroll
        for (int e = 0; e < 8; ++e) ot[e] = __shfl_xor(acc[e], 32);
        float lg[20];
#pragma unroll
        for (int q = 0; q < 4; ++q) { lg[q] = acc[q] * rstd; lg[8 + q] = acc[4 + q] * rstd; lg[16 + q] = acc[8 + q] * rstd; lg[4 + q] = ot[q] * rstd; lg[12 + q] = ot[4 + q] * rstd; }
        float gl[4]; float gm = -INFINITY;
#pragma unroll
        for (int o = 0; o < 4; ++o) { gl[o] = lg[o] + F.in[I_BRG][o]; gm = fmaxf(gm, gl[o]); }
        float gs = 0.f; int gsel = 0; float gbest = -INFINITY;
#pragma unroll
        for (int o = 0; o < 4; ++o) { gs += __expf(gl[o] - gm); if (gl[o] > gbest) { gbest = gl[o]; gsel = o; } }
        const float pgrp = __expf(gbest - gm) / gs;
        float el[4]; float em = -INFINITY;
#pragma unroll
        for (int q = 0; q < 4; ++q) { float vsel = 0.f;
#pragma unroll
            for (int g2 = 0; g2 < 4; ++g2) vsel = (gsel == g2) ? lg[4 + 4 * g2 + q] + F.in[I_BRE][4 * g2 + q] : vsel;
            el[q] = vsel; em = fmaxf(em, vsel); }
        int i1 = 0; float b1 = -INFINITY;
#pragma unroll
        for (int q = 0; q < 4; ++q) if (el[q] > b1) { b1 = el[q]; i1 = q; }
        int i2 = 0; float b2 = -INFINITY;
#pragma unroll
        for (int q = 0; q < 4; ++q) if (q != i1 && el[q] > b2) { b2 = el[q]; i2 = q; }
        const float p1 = __expf(b1 - em), p2 = __expf(b2 - em); const float inv = 1.0f / (p1 + p2);
        const float gw1 = pgrp * p1 * inv, gw2 = pgrp * p2 * inv;
        const int elo = i1 < i2 ? i1 : i2, ehi = i1 < i2 ? i2 : i1; const float glo = i1 < i2 ? gw1 : gw2, ghi = i1 < i2 ? gw2 : gw1;
        const int pair = (elo == 0) ? (ehi - 1) : (elo == 1 ? ehi + 1 : 5);
        const int cls = gsel * 6 + pair;
        if (h == 0 && !dry) { const unsigned pos = atomicAdd(&cnt[cls], 1u); RouteRec rc; rc.cls = cls; rc.pos = (int)pos; rc.g_lo = glo; rc.g_hi = ghi; rc.rstd = rstd; rc.pad0 = rc.pad1 = rc.pad2 = 0; rr[t] = rc; }
    }
    }
}

__device__ __forceinline__ void class_bases(Frame& F, volatile LAS int* tb) {
    if (F.tid == 0) { int acc = 0; for (int c = 0; c < NCLS; ++c) { tb[c] = acc; const int n = (int)__hip_atomic_load(F.ctl + CW_CNT + c, __ATOMIC_RELAXED, __HIP_MEMORY_SCOPE_AGENT); acc += (n + 255) & ~255; } tb[NCLS] = acc; }
    __syncthreads();
}

__device__ __forceinline__ void phase8(Frame& F) {
    const int gw = F.vcu * 8 + F.wave, NGW = F.G * 8, lane = F.lane;
    volatile LAS int* tb = (volatile LAS int*)(F.lds + MISC_OFF + 128);
    class_bases(F, tb);
    const float* x1 = F.out; const float* gf = F.in[I_GFFN];
    const RouteRec* rr = (const RouteRec*)(F.ws + WS_ROUTE); int* rowtok = (int*)(F.ws + WS_ROWTOK); float* gates = (float*)(F.ws + WS_ROWTOK + 128 * 1024);
    bf16_t* H2S = (bf16_t*)(F.ws + WS_H2S);
    f32x4 gv[8];
#pragma unroll
    for (int j = 0; j < 8; ++j) gv[j] = ((const f32x4*)gf)[64 * j + lane];
    for (int t2 = gw; t2 < T / 2; t2 += NGW) {
        const RouteRec r0 = rr[2 * t2], r1 = rr[2 * t2 + 1];
        f32x4 v[2][8];
#pragma unroll
        for (int u = 0; u < 2; ++u) { const f32x4* xr = (const f32x4*)(x1 + (size_t)(2 * t2 + u) * DM) + lane;
#pragma unroll
            for (int j = 0; j < 8; ++j) v[u][j] = xr[64 * j]; }
#pragma unroll
        for (int u = 0; u < 2; ++u) { const RouteRec r = u ? r1 : r0; const int t = 2 * t2 + u; const int row = tb[r.cls] + r.pos;
            u32x2* o = (u32x2*)(H2S + (size_t)row * DM) + lane;
#pragma unroll
            for (int j = 0; j < 8; ++j) { u32x2 w; w.x = pk2(v[u][j].x * r.rstd * gv[j].x, v[u][j].y * r.rstd * gv[j].y); w.y = pk2(v[u][j].z * r.rstd * gv[j].z, v[u][j].w * r.rstd * gv[j].w); o[64 * j] = w; }
            if (lane == 0) { rowtok[row] = t; gates[2 * row] = r.g_lo; gates[2 * row + 1] = r.g_hi; } }
    }
    for (int idx = gw; idx < NCLS * 256; idx += NGW) { const int c = idx >> 8, off = idx & 255; const int n = (int)__hip_atomic_load(F.ctl + CW_CNT + c, __ATOMIC_RELAXED, __HIP_MEMORY_SCOPE_AGENT);
        const int row = tb[c] + n + off;
        if (row < tb[c + 1]) { u32x2* o = (u32x2*)(H2S + (size_t)row * DM) + lane;
#pragma unroll
            for (int j = 0; j < 8; ++j) o[64 * j] = (u32x2){0u, 0u};
            if (lane == 0) { gates[2 * row] = 0.f; gates[2 * row + 1] = 0.f; } } }
}

__device__ __forceinline__ int class_of_tile(volatile LAS int* tb, int rt) { int c = 0; const int r0 = rt * 256; for (int k = 1; k < NCLS; ++k) c = (r0 >= tb[k]) ? k : c; return c; }
__device__ __forceinline__ int class_expert(int cls, int half) { const int g = cls / 6, p = cls % 6; const int elo = p < 3 ? 0 : (p < 5 ? 1 : 2); const int ehi = p < 3 ? p + 1 : (p < 5 ? p - 1 : 3); return 4 * g + (half ? ehi : elo); }
__device__ __forceinline__ void class_tables(Frame& F, volatile LAS int* tb, volatile LAS int* te) {
    if (F.wave == 0) {
        const int c = F.lane; const int n = (c < NCLS) ? (int)__hip_atomic_load(F.ctl + CW_CNT + c, __ATOMIC_RELAXED, __HIP_MEMORY_SCOPE_AGENT) : 0;
        int base = 0;
#pragma unroll
        for (int j = 0; j < NCLS; ++j) { const int nj = __builtin_amdgcn_readlane(n, j); base += (j < c) ? ((nj + 255) & ~255) : 0; }
        if (c < NCLS) { tb[c] = base; const int ee = class_expert(c, 0) | (class_expert(c, 1) << 8); const int nt = (n + 255) >> 8; for (int f = 0; f < nt; ++f) te[(base >> 8) + f] = ee; }
        if (c == NCLS - 1) tb[NCLS] = base + ((n + 255) & ~255);
    }
    __syncthreads();
}
struct Moe1Sched {
    volatile LAS int* te; const char* A; const char* B; int G, c, nu;
    __device__ bool seg(int i, pg8::Seg& s) const { const int L = i * G + c; if (L >= nu) return false; const int rt = L >> 3, pn = L & 7; const int ee = te[rt]; const int e = (pn >> 2) ? (ee >> 8) : (ee & 255);
        s.A = A + (size_t)rt * 256 * DM * 2; s.B = B + ((size_t)e * 1024 + (pn & 3) * 256) * DM * 2; s.u.pm = rt; s.u.pn = pn; s.u.aux = 0; s.last = 1; s.nt = DM / 64; return true; }
    unsigned* cnt;
    static constexpr bool GATED = false, PUBLISH = true;
    __device__ __forceinline__ unsigned peek(const pg8::Unit&) const { return 0u; }
    __device__ __forceinline__ void wait(const pg8::Unit&, unsigned) const {}
    __device__ __forceinline__ void done(const pg8::Unit& u) const { asm volatile("s_waitcnt vmcnt(0)" ::: "memory"); if ((threadIdx.x & 63) == 0) (void)__hip_atomic_fetch_add(cnt + 16 * u.pm, 1u, __ATOMIC_RELAXED, __HIP_MEMORY_SCOPE_AGENT); }
};
struct Moe2Sched {
    volatile LAS int* te; const char* A; const char* B; int G, c, nu;
    __device__ bool seg(int i, pg8::Seg& s) const { const int ui = i >> 1, half = i & 1; const int L = ui * G + c; if (L >= nu) return false; const int rt = L >> 3, pn = L & 7; const int ee = te[rt]; const int e = half ? (ee >> 8) : (ee & 255);
        s.A = A + ((size_t)rt * 256 * 1024 + half * 512) * 2; s.B = B + ((size_t)e * DM + pn * 256) * 512 * 2; s.u.pm = rt; s.u.pn = pn; s.u.aux = 0; s.last = half; s.nt = 512 / 64; return true; }
    unsigned* cnt;
    static constexpr bool GATED = true, PUBLISH = false;
    __device__ __forceinline__ unsigned peek(const pg8::Unit& u) const { return __hip_atomic_load(cnt + 16 * u.pm, __ATOMIC_RELAXED, __HIP_MEMORY_SCOPE_AGENT); }
    __device__ __forceinline__ void wait(const pg8::Unit& u, unsigned v) const {
        unsigned sp = 0u;
        while ((unsigned)__builtin_amdgcn_readfirstlane(v) < 64u) { __builtin_amdgcn_s_sleep(2); if (++sp > (1u << 22)) break; v = __hip_atomic_load(cnt + 16 * u.pm, __ATOMIC_RELAXED, __HIP_MEMORY_SCOPE_AGENT); }
        __builtin_amdgcn_fence(__ATOMIC_ACQUIRE, "agent");
    }
    __device__ __forceinline__ void done(const pg8::Unit&) const {}
};

constexpr int NPHASE = 12;
__global__ void __launch_bounds__(512, 2) fwd_kernel(Args args) {
    extern __shared__ __attribute__((aligned(16))) unsigned char lds_raw[];
    Frame F;
    F.lds = (LAS unsigned char*)lds_raw; F.ldsg = lds_raw;
    F.tid = threadIdx.x; F.lane = F.tid & 63; F.wave = __builtin_amdgcn_readfirstlane(F.tid >> 6);
    F.G = gridDim.x; { const int bx = blockIdx.x; F.vcu = (F.G % 8 == 0) ? (bx % 8) * (F.G / 8) + bx / 8 : bx; }
    F.in = args.in; F.out = args.out; F.ws = args.ws; F.ctl = (unsigned*)(args.ws + WS_CTL);
    volatile LAS unsigned* MISC = (volatile LAS unsigned*)(F.lds + MISC_OFF);
    for (int u = F.tid; u < (LDS_BYTES - LDSCTL_OFF) / 4; u += 512) ((LAS unsigned*)(F.lds + LDSCTL_OFF))[u] = 0u;
    __syncthreads();
    const int lo = args.ph_lo, hi = args.ph_hi;
    const bool DRY_T = (args.ph_hi != 999), DRY_F = (args.ph_hi == 999);
    const bool multi = (hi - lo) > 1;
    XcdBarrier bar; bar.bar = F.ctl + CW_BAR; bar.x = 0; bar.st = nullptr;
    if (multi) bar = xcd_barrier_post(F.ctl + CW_BAR, MISC + 8);
#ifndef PH_MASK
#define PH_MASK 0xfff
#endif
#define IN(k) (((PH_MASK >> (k)) & 1) && lo <= (k) && (k) < hi)
#define STAMP(k) do { if (PROBE_K >= 0 && blockIdx.x == 0 && F.tid == 0) ((volatile unsigned long long*)(F.ctl + CW_TS))[(k)] = __builtin_amdgcn_s_memrealtime(); } while (0)
#define SEAM(k) do { if (IN(k) && IN((k) + 1)) xcd_barrier(bar); STAMP((k) + 1); } while (0)
#ifndef DUP_MASK
#define DUP_MASK 0
#endif
#ifndef DUP_MODE
#define DUP_MODE 3
#endif
    unsigned char* ws = args.ws;
    bf16_t* P = (bf16_t*)(ws + WS_P);
    STAMP(0);

    if (IN(0)) { phase0(F); SEAM(0); }
    if (IN(1)) {
        pg8::InSched S; S.init((const bf16_t*)(ws + WS_HN), (const bf16_t*)(ws + WS_WIN), F.G, (int)blockIdx.x);
        pg8::EpiIn E{P, NP, F.out};
        pg8::gemm_phase<pg8::EpiIn, pg8::InSched, true>(F.lds, DM, DM, DM / 64, S, E);
        SEAM(1);
    }
    if (IN(2)) { if ((DUP_MASK >> 2) & 1) { phase2(F, DRY_T); if (multi) xcd_barrier(bar); } phase2(F, DRY_F); SEAM(2); }
    if (IN(3)) {
        pg8::LoraSched S; S.init((const bf16_t*)(ws + WS_ALORA), (const bf16_t*)(ws + WS_WLORA), F.G, (int)blockIdx.x);
        pg8::EpiLora E{(bf16_t*)(ws + WS_L3), F.in[I_W0], F.in[I_A0]};
        pg8::gemm_phase<pg8::EpiLora, pg8::LoraSched, true>(F.lds, KL, KL, KL / 64, S, E);
        SEAM(3);
    }
    if (IN(4)) { rw::pass_a(F); SEAM(4); }
    if (IN(5)) { if ((DUP_MASK >> 5) & 1) { phase_score_passb(F, DRY_T, 1); if (multi) xcd_barrier(bar); phase_select_passb(F, DRY_T); if (multi) xcd_barrier(bar); }
                 phase_score_passb(F, DRY_F, 0); if (multi) xcd_barrier(bar); STAMP(13); phase_select_passb(F, DRY_F); SEAM(5); }
    if (IN(6)) { att::attn_phase(F); if (PROBE_K >= 0) { xcd_barrier(bar); STAMP(14); } rw::pass_c(F); SEAM(6); }
    if (IN(7)) {
        pg8::PlainSched S; S.init((const bf16_t*)(ws + WS_YCAT), (const bf16_t*)(ws + WS_WOUT), T, DM, DM, DM, F.G, (int)blockIdx.x, DM / 64);
        pg8::EpiResF32 E{F.in[I_X], F.out, DM};
        pg8::gemm_phase<pg8::EpiResF32, pg8::PlainSched, true>(F.lds, DM, DM, DM / 64, S, E);
        SEAM(7);
    }
    if (IN(8)) { if ((DUP_MASK >> 8) & 1) { phase7(F, DRY_T, DUP_MODE); if (multi) xcd_barrier(bar); } phase7(F, DRY_F); SEAM(8); }
    if (IN(9)) { if ((DUP_MASK >> 9) & 1) { phase8(F); if (multi) xcd_barrier(bar); } phase8(F); SEAM(9); }
    if (IN(10)) {
        volatile LAS int* tb = (volatile LAS int*)(F.lds + MISC_OFF + 128); volatile LAS int* te = (volatile LAS int*)(F.lds + MISC_OFF + 256);
        class_tables(F, tb, te);
        Moe1Sched S; S.te = te; S.A = (const char*)(ws + WS_H2S); S.B = (const char*)(ws + WS_WGU); S.G = F.G; S.c = (int)blockIdx.x; S.nu = (tb[NCLS] >> 8) * 8; S.cnt = F.ctl + CW_HSCNT;
        pg8::EpiMoe1 E{(bf16_t*)(ws + WS_HS), (const float*)(ws + WS_ROWTOK + 128 * 1024)};
        pg8::gemm_phase<pg8::EpiMoe1, Moe1Sched, true>(F.lds, DM, DM, DM / 64, S, E);
        STAMP(11);
    }
    if (IN(11)) {
        volatile LAS int* tb = (volatile LAS int*)(F.lds + MISC_OFF + 128); volatile LAS int* te = (volatile LAS int*)(F.lds + MISC_OFF + 256);
        class_tables(F, tb, te);
        Moe2Sched S; S.te = te; S.A = (const char*)(ws + WS_HS); S.B = (const char*)(ws + WS_WDN); S.G = F.G; S.nu = (tb[NCLS] >> 8) * 8; S.cnt = F.ctl + CW_HSCNT;
        S.c = ((int)blockIdx.x + F.G - S.nu % F.G) % F.G;
        if ((DUP_MASK >> 11) & 1) { pg8::EpiMoe2 E0{F.out, (const int*)(ws + WS_ROWTOK), DRY_T ? 1 : 0}; pg8::gemm_phase<pg8::EpiMoe2, Moe2Sched, true>(F.lds, 1024, 512, 512 / 64, S, E0); if (multi) xcd_barrier(bar); }
        pg8::EpiMoe2 E{F.out, (const int*)(ws + WS_ROWTOK), DRY_F ? 1 : 0};
        pg8::gemm_phase<pg8::EpiMoe2, Moe2Sched, true>(F.lds, 1024, 512, 512 / 64, S, E);
    }
    if (PROBE_K >= 0) {
        xcd_barrier(bar); STAMP(12); xcd_barrier(bar);
        const volatile unsigned long long* ts = (const volatile unsigned long long*)(F.ctl + CW_TS);
        constexpr int K = PROBE_K;
        constexpr int ka = K == 20 ? 5 : K == 21 ? 13 : K == 22 ? 6 : K == 23 ? 14 : K == 30 ? 0 : K;
        constexpr int kb = K == 20 ? 13 : K == 21 ? 6 : K == 22 ? 14 : K == 23 ? 7 : K == 30 ? 12 : K + 1;
        const float tau = (float)(long long)(ts[kb] - ts[ka]) * 1.25e-6f;
        f32x4* o = (f32x4*)F.out;
        for (size_t i = (size_t)blockIdx.x * 512 + F.tid; i < (size_t)T * DM / 4; i += (size_t)F.G * 512) { f32x4 v = o[i]; v = v * (1.0f + tau); o[i] = v; }
    }
#undef IN
#undef SEAM
}

extern "C" void kernel_launch(void* const* d_in, const int* in_sizes, int n_in, void* d_out, int out_size, void* d_ws, size_t ws_size, hipStream_t stream) {
    static int grid = 0;
    if (grid == 0) {
        if (n_in != 25 || in_sizes[0] != T * DM || out_size != T * DM || ws_size < WS_END) { fprintf(stderr, "kernel_launch: unexpected shapes (n_in %d, in0 %d, out %d, ws %zu)\n", n_in, n_in > 0 ? in_sizes[0] : -1, out_size, ws_size); grid = -1; return; }
        int dev = 0, cus = 0, per_cu = 0;
        if (hipGetDevice(&dev) != hipSuccess || hipDeviceGetAttribute(&cus, hipDeviceAttributeMultiprocessorCount, dev) != hipSuccess) { grid = -1; return; }
        if (hipFuncSetAttribute((const void*)fwd_kernel, hipFuncAttributeMaxDynamicSharedMemorySize, LDS_BYTES) != hipSuccess) { fprintf(stderr, "kernel_launch: hipFuncSetAttribute failed\n"); grid = -1; return; }
        if (hipOccupancyMaxActiveBlocksPerMultiprocessor(&per_cu, (const void*)fwd_kernel, 512, LDS_BYTES) != hipSuccess || per_cu < 1) { fprintf(stderr, "kernel_launch: occupancy query says %d blocks per CU\n", per_cu); (void)hipGetLastError(); grid = -1; return; }
        grid = cus;
    }
    if (grid < 0) return;
    (void)hipMemsetAsync((char*)d_ws + WS_CTL, 0, CTL_ZERO_BYTES, stream);
    Args a{};
    for (int i = 0; i < 25; ++i) a.in[i] = (const float*)d_in[i];
    a.out = (float*)d_out; a.ws = (unsigned char*)d_ws;
#if MK_SINGLE
    a.ph_lo = 0; a.ph_hi = NPHASE;
    void* kargs[] = {&a};
    hipError_t e = hipLaunchCooperativeKernel((const void*)fwd_kernel, dim3(grid), dim3(512), kargs, LDS_BYTES, stream);
    if (e != hipSuccess) fprintf(stderr, "kernel_launch: cooperative launch failed: %s (grid %d)\n", hipGetErrorString(e), grid);
#else
    for (int p = 0; p < NPHASE; ++p) { a.ph_lo = p; a.ph_hi = p + 1; hipLaunchKernelGGL(fwd_kernel, dim3(grid), dim3(512), LDS_BYTES, stream, a); }
#endif
}
```

```cpp
#include <hip/hip_runtime.h>
#include <hip/hip_cooperative_groups.h>
#include <cstdio>
#include <cstdint>
#include <cmath>

#ifndef PROBE_K
#define PROBE_K -1
#endif
#ifndef MK_SINGLE
#define MK_SINGLE 1
#endif

#define GAS __attribute__((address_space(1)))
#define LAS __attribute__((address_space(3)))
typedef unsigned short bf16_t;
typedef short bf16x8 __attribute__((ext_vector_type(8)));
typedef float f32x4 __attribute__((ext_vector_type(4)));
typedef float f32x16 __attribute__((ext_vector_type(16)));
typedef float f32x2 __attribute__((ext_vector_type(2)));
typedef unsigned u32x4 __attribute__((ext_vector_type(4)));
typedef unsigned u32x2 __attribute__((ext_vector_type(2)));

constexpr int BATCH = 4, SEQ = 4096, DM = 2048, T = BATCH * SEQ;
constexpr int NP = 7680;
constexpr int PQ = 0, PK = 1024, PV = 2048, PQI = 3072, PKI = 4096, PWI = 4160, PDW = 4224, PDA = 4288, PR = 4352, PKR = 5376, PVR = 6400, PDG = 7424;
constexpr int IN_COLS = 7536, DSA_COLS = 4176;
constexpr int KL = 384, NL = 3072;
constexpr int MPAD = 22528;
constexpr int NCLS = 24;
constexpr float NORM_EPS = 1e-6f, GN_EPS = 64e-5f;
constexpr float QSCALE = 0.08838834764831845f * 1.4426950408889634f;

constexpr size_t MiB = 1u << 20;
constexpr size_t WS_CTL = 0, CTL_ZERO_BYTES = 32 * 1024;
constexpr size_t WS_WLORA = 1 * MiB;
constexpr size_t WS_WOUT = 4 * MiB;
constexpr size_t WS_MSK = 12 * MiB;
constexpr size_t WS_KI = 20 * MiB;
constexpr size_t WS_ROUTE = 22 * MiB;
constexpr size_t WS_ROWTOK = 23 * MiB;
constexpr size_t WS_WRT = 23 * MiB + 512 * 1024;
constexpr size_t WS_ALORA = 24 * MiB;
constexpr size_t WS_WIN = 36 * MiB;
constexpr size_t WS_HN = 66 * MiB;
constexpr size_t WS_YCAT = WS_HN;
constexpr size_t WS_L3 = 130 * MiB;
constexpr size_t WS_P = 226 * MiB;
constexpr size_t WS_H2S = 226 * MiB;
constexpr size_t WS_HS = 314 * MiB;
constexpr size_t WS_WGU = 358 * MiB;
constexpr size_t WS_WDN = 422 * MiB;
constexpr size_t WS_MT = 24 * MiB;
constexpr size_t WS_BON = 56 * MiB;
constexpr size_t WS_SA = 466 * MiB;
constexpr size_t WS_SC = 57 * MiB;
constexpr size_t WS_XS = 498 * MiB;
constexpr size_t WS_SINK = 499 * MiB;
constexpr size_t WS_END = 500 * MiB;
constexpr int CW_CNT = 64;
constexpr int CW_TS = 512;
constexpr int CW_BAR = 4096;
constexpr int CW_HSCNT = 1024;

constexpr int RING_BYTES = 131072;
constexpr int LDSCTL_OFF = RING_BYTES, MISC_OFF = LDSCTL_OFF + 320;
constexpr int LDS_BYTES = 147456;

#define LDS_WAIT() asm volatile("s_waitcnt lgkmcnt(0)" ::: "memory")
#define VM_WAIT() asm volatile("s_waitcnt vmcnt(0)" ::: "memory")
typedef __bf16 hwbf16x2 __attribute__((ext_vector_type(2)));
__device__ __forceinline__ unsigned pk2(float lo, float hi) { const f32x2 v = {lo, hi}; return __builtin_bit_cast(unsigned, __builtin_convertvector(v, hwbf16x2)); }
__device__ __forceinline__ unsigned f2bf(float f) { return pk2(f, 0.f) & 0xffffu; }
__device__ __forceinline__ float bf2f(unsigned short h) { return __builtin_bit_cast(float, (unsigned)h << 16); }
__device__ __forceinline__ float bflo(unsigned w) { return __builtin_bit_cast(float, w << 16); }
__device__ __forceinline__ float bfhi(unsigned w) { return __builtin_bit_cast(float, w & 0xffff0000u); }
#define DPP_ADD(v, ctrl, rm) (v) += __builtin_bit_cast(float, __builtin_amdgcn_update_dpp(0, __builtin_bit_cast(int, (v)), (ctrl), (rm), 0xF, false))
__device__ __forceinline__ float row_sum16(float v) {
    DPP_ADD(v, 0xB1, 0xF); DPP_ADD(v, 0x4E, 0xF); DPP_ADD(v, 0x141, 0xF); DPP_ADD(v, 0x140, 0xF); return v;
}
__device__ __forceinline__ float wave_sum(float v) {
    v = row_sum16(v); DPP_ADD(v, 0x142, 0xA); DPP_ADD(v, 0x143, 0xC);
    return __builtin_bit_cast(float, __builtin_amdgcn_readlane(__builtin_bit_cast(int, v), 63));
}
__device__ __forceinline__ float half_sum(float v) {
    v = row_sum16(v); DPP_ADD(v, 0x142, 0xA);
    const float lo = __builtin_bit_cast(float, __builtin_amdgcn_readlane(__builtin_bit_cast(int, v), 31)), hi = __builtin_bit_cast(float, __builtin_amdgcn_readlane(__builtin_bit_cast(int, v), 63));
    return (threadIdx.x & 32) ? hi : lo;
}
__device__ __forceinline__ float sigmoidf_(float x) { return __builtin_amdgcn_rcpf(1.0f + __expf(-x)); }

namespace pg8 {
constexpr int BM = 256, BK = 64, HALF = 128, HTB = HALF * BK * 2, STAGE_BYTES = 8 * HTB, NXCD = 8, WGM = 8;
__host__ __device__ __forceinline__ int lds_byte(int r, int c) { const int st = (r >> 4) * 2 + (c >> 5), rr = r & 15, cc = c & 31, ob = rr * 64 + cc * 2; return st * 1024 + (ob ^ (((ob >> 9) & 1) << 5)); }
__host__ __device__ __forceinline__ void stage_rc(int b, int& R, int& C) { const int st = b / 1024, sb = b % 1024, swz = sb ^ (((sb >> 9) & 1) << 5); R = (st >> 1) * 16 + swz / 64; C = (st & 1) * 32 + (swz % 64) / 2; }
__host__ __device__ __forceinline__ int perm32(int rho) { const int n = rho >> 4, i = rho & 15; return 8 * (i >> 2) + 4 * n + (i & 3); }

struct Unit { int pm, pn, aux; };
struct Seg { const char* A; const char* B; Unit u; int last, nt; };

struct TileOrder {
    int nM, nN, nwg, G, c;
    __device__ void init(int nM_, int nN_, int G_, int c_) { nM = nM_; nN = nN_; nwg = nM * nN; G = G_; c = c_; }
    __device__ bool next(int i, int& pm, int& pn) const {
        const long L = (long)i * G + c; if (L >= nwg) return false;
        int wgid = (int)L; { const int q = nwg / NXCD, r = nwg % NXCD, xcd = wgid % NXCD, off = wgid / NXCD; wgid = (xcd < r ? xcd * (q + 1) : r * (q + 1) + (xcd - r) * q) + off; }
        const int nig = WGM * nN, gid = wgid / nig, fm = gid * WGM, gsz = (nM - fm) < WGM ? (nM - fm) : WGM;
        pm = fm + ((wgid % nig) % gsz); pn = (wgid % nig) / gsz; return true;
    }
};
struct PlainSched {
    TileOrder o; const char* A; const char* B; size_t tA, tB; int nt;
    __device__ void init(const bf16_t* A_, const bf16_t* B_, int M, int N, int lda, int ldb, int G, int c, int nt_) { o.init(M / BM, N / BM, G, c); A = (const char*)A_; B = (const char*)B_; tA = (size_t)BM * lda * 2; tB = (size_t)BM * ldb * 2; nt = nt_; }
    __device__ bool seg(int i, Seg& s) const { int pm, pn; if (!o.next(i, pm, pn)) return false; s.A = A + pm * tA; s.B = B + pn * tB; s.u.pm = pm; s.u.pn = pn; s.u.aux = 0; s.last = 1; s.nt = nt; return true; }
    static constexpr bool GATED = false, PUBLISH = false;
    __device__ __forceinline__ unsigned peek(const Unit&) const { return 0u; }
    __device__ __forceinline__ void wait(const Unit&, unsigned) const {}
    __device__ __forceinline__ void done(const Unit&) const {}
};
struct LoraSched {
    TileOrder o; const char* A; const char* B;
    __device__ void init(const bf16_t* A_, const bf16_t* B_, int G, int c) { o.init(T / BM, NL / BM, G, c); A = (const char*)A_; B = (const char*)B_; }
    __device__ bool seg(int i, Seg& s) const { int pm, pn; if (!o.next(i, pm, pn)) return false; const int gate = pn >= 8; s.A = A + (size_t)pm * BM * KL * 2 + (gate ? 256 : 0); s.B = B + (size_t)pn * BM * KL * 2 + (gate ? 256 : 0); s.u.pm = pm; s.u.pn = pn; s.u.aux = 0; s.last = 1; s.nt = gate ? 4 : 2; return true; }
    static constexpr bool GATED = false, PUBLISH = false;
    __device__ __forceinline__ unsigned peek(const Unit&) const { return 0u; }
    __device__ __forceinline__ void wait(const Unit&, unsigned) const {}
    __device__ __forceinline__ void done(const Unit&) const {}
};

struct InSched {
    TileOrder o; const char* A; const char* B; size_t tA, tB; int G, c;
    __device__ void init(const bf16_t* A_, const bf16_t* B_, int G_, int c_) { o.init(T / BM, 28, G_, c_); A = (const char*)A_; B = (const char*)B_; tA = (size_t)BM * DM * 2; tB = (size_t)BM * DM * 2; G = G_; c = c_; }
    __device__ bool seg(int i, Seg& s) const { int pm, q; s.last = 1;
        if (o.next(i, pm, q)) { const int pn = q + (q >= 16); s.A = A + pm * tA; s.B = B + pn * tB; s.u.pm = pm; s.u.pn = pn; s.u.aux = 0; s.nt = DM / 64; return true; }
        const int L = i * G + c - 28 * (T / BM); if (L >= 4 * (T / BM)) return false;
        const int j = (G == 256) ? (L & 7) * 32 + (L >> 3) : L;
        pm = j >> 2; const int ct = j & 1, kh = (j >> 1) & 1, pn = ct ? 29 : 16;
        s.A = A + pm * tA + kh * (DM / 2) * 2; s.B = B + pn * tB + kh * (DM / 2) * 2; s.u.pm = pm; s.u.pn = pn; s.u.aux = 1 + ct + 2 * kh; s.nt = DM / 128; return true; }
    static constexpr bool GATED = false, PUBLISH = false;
    __device__ __forceinline__ unsigned peek(const Unit&) const { return 0u; }
    __device__ __forceinline__ void wait(const Unit&, unsigned) const {}
    __device__ __forceinline__ void done(const Unit&) const {}
};

__device__ __forceinline__ unsigned cvt_pk_bf16(float lo, float hi) { unsigned r; asm volatile("v_cvt_pk_bf16_f32 %0, %1, %2" : "=v"(r) : "v"(lo), "v"(hi)); return r; }

typedef f32x4 Acc[2][2][4][2];

template <class Epi, class Sched, bool ALIGN_EPI>
__device__ __forceinline__ void gemm_phase(LAS unsigned char* lds, const int lda, const int ldb, const int nt, const Sched& S, const Epi& E) {
    const int tid = threadIdx.x, wid = __builtin_amdgcn_readfirstlane(tid >> 6), lane = tid & 63, wr = wid >> 2, wc = wid & 3, fr = lane & 15, fq = lane >> 4;
    unsigned voffA[2], voffB[2];
#pragma unroll
    for (int i = 0; i < 2; ++i) { int R, C; stage_rc(tid * 16 + i * 8192, R, C); const int Rb = Epi::PERM ? ((R & ~31) + perm32(R & 31)) : R;
        voffA[i] = (unsigned)(R * lda + C) * 2u; voffB[i] = (unsigned)(Rb * ldb + C) * 2u; }
    const size_t kstep = (size_t)(BK * 2);
    const size_t hstepA = (size_t)HALF * lda * 2, hstepB = (size_t)HALF * ldb * 2;
    const unsigned ldsw = (unsigned)wid * 1024u;
    const int aoff = lds_byte(wr * 64 + fr, fq * 8), boff = lds_byte(wc * 32 + fr, fq * 8);
#define PG8_SA(b, h) (((b) * 2 + (h)) * HTB)
#define PG8_SB(b, h) ((4 + (b) * 2 + (h)) * HTB)
#define PG8_STAGE(bufoff, gbase, voff) do { _Pragma("unroll") for (int _i = 0; _i < 2; ++_i) \
        __builtin_amdgcn_global_load_lds((const unsigned*)((const char*)(gbase) + (voff)[_i]), (LAS unsigned*)(lds + (bufoff) + ldsw + _i * 8192), 16, 0, 0); } while (0)
#define PG8_LDA(dst, b, h) do { _Pragma("unroll") for (int m = 0; m < 4; ++m) _Pragma("unroll") for (int k = 0; k < 2; ++k) dst[m][k] = *(const LAS bf16x8*)(lds + PG8_SA(b, h) + aoff + m * 2048 + k * 1024); } while (0)
#define PG8_LDB(dst, b, h) do { _Pragma("unroll") for (int n = 0; n < 2; ++n) _Pragma("unroll") for (int k = 0; k < 2; ++k) dst[n][k] = *(const LAS bf16x8*)(lds + PG8_SB(b, h) + boff + n * 2048 + k * 1024); } while (0)
#define PG8_MMA(ai, bj, At, Bt) do { __builtin_amdgcn_s_setprio(1); _Pragma("unroll") for (int m = 0; m < 4; ++m) _Pragma("unroll") for (int n = 0; n < 2; ++n) _Pragma("unroll") for (int k = 0; k < 2; ++k) \
        acc[ai][bj][m][n] = __builtin_amdgcn_mfma_f32_16x16x32_bf16(Bt[n][k], At[m][k], acc[ai][bj][m][n], 0, 0, 0); __builtin_amdgcn_s_setprio(0); } while (0)
#define PG8_WAIT_V(n) asm volatile("s_waitcnt vmcnt(" #n ")" ::: "memory")
#define PG8_WAIT_L(n) asm volatile("s_waitcnt lgkmcnt(" #n ")" ::: "memory")
#define PG8_BAR __builtin_amdgcn_s_barrier()
#define PG8_SCHED __builtin_amdgcn_sched_barrier(0)
#define PG8_ZERO() do { _Pragma("unroll") for (int a = 0; a < 2; ++a) _Pragma("unroll") for (int b = 0; b < 2; ++b) _Pragma("unroll") for (int m = 0; m < 4; ++m) _Pragma("unroll") for (int n = 0; n < 2; ++n) acc[a][b][m][n] = (f32x4){0.f, 0.f, 0.f, 0.f}; } while (0)
    Seg cur, nxt; int qi = 0;
    if (!S.seg(0, cur)) return;
    Acc acc;
    PG8_ZERO();
    bf16x8 At[4][2], B0[2][2], B1[2][2];
    const char* cA = cur.A; const char* cB = cur.B;
    if constexpr (Sched::GATED) S.wait(cur.u, S.peek(cur.u));
    PG8_STAGE(PG8_SB(0, 0), cB, voffB); PG8_STAGE(PG8_SB(0, 1), cB + hstepB, voffB); PG8_STAGE(PG8_SA(0, 0), cA, voffA); PG8_STAGE(PG8_SA(0, 1), cA + hstepA, voffA);
    if (wr == 1) PG8_BAR;
    PG8_WAIT_V(2); PG8_BAR;
    PG8_STAGE(PG8_SB(1, 0), cB + kstep, voffB); PG8_STAGE(PG8_SA(1, 0), cA + kstep, voffA); PG8_STAGE(PG8_SB(1, 1), cB + hstepB + kstep, voffB);
    PG8_WAIT_V(6); PG8_BAR;
    for (;;) {
        bool has_next; const char* nA; const char* nB;
        for (;;) {
        has_next = S.seg(qi + 1, nxt);
        nA = has_next ? nxt.A : cA; nB = has_next ? nxt.B : cB;
        const int nt_ = cur.nt;
        const bool gate = Sched::GATED && has_next && cur.last;
        unsigned rdy; if constexpr (Sched::GATED) { if (gate) rdy = S.peek(nxt.u); }
#pragma unroll 1
        for (int t = 0; t < nt_; t += 2) {
            const bool last = (t == nt_ - 2);
            if constexpr (Sched::GATED) { if (last && gate) S.wait(nxt.u, rdy); }
            const char* a1 = cA + (size_t)(t + 1) * kstep;
            const char* a2 = last ? nA : cA + (size_t)(t + 2) * kstep; const char* b2 = last ? nB : cB + (size_t)(t + 2) * kstep;
            const char* a3 = a2 + kstep; const char* b3 = b2 + kstep;
            PG8_LDB(B0, 0, 0); PG8_LDB(B1, 0, 1); PG8_SCHED; PG8_LDA(At, 0, 0); PG8_STAGE(PG8_SA(1, 1), a1 + hstepA, voffA);
            PG8_WAIT_V(8); PG8_WAIT_L(0); PG8_BAR; PG8_MMA(0, 0, At, B0); PG8_MMA(0, 1, At, B1); PG8_BAR; PG8_SCHED;
            PG8_LDA(At, 0, 1); PG8_STAGE(PG8_SB(0, 0), b2, voffB); PG8_STAGE(PG8_SB(0, 1), b2 + hstepB, voffB); PG8_STAGE(PG8_SA(0, 0), a2, voffA);
            PG8_WAIT_V(8); PG8_WAIT_L(0); PG8_BAR; PG8_MMA(1, 0, At, B0); PG8_MMA(1, 1, At, B1); PG8_BAR; PG8_SCHED;
            PG8_LDB(B0, 1, 0); PG8_LDB(B1, 1, 1); PG8_SCHED; PG8_LDA(At, 1, 0); PG8_STAGE(PG8_SA(0, 1), a2 + hstepA, voffA);
            PG8_WAIT_V(8); PG8_WAIT_L(0); PG8_BAR; PG8_MMA(0, 0, At, B0); PG8_MMA(0, 1, At, B1); PG8_BAR; PG8_SCHED;
            PG8_LDA(At, 1, 1); PG8_STAGE(PG8_SB(1, 0), b3, voffB); PG8_STAGE(PG8_SB(1, 1), b3 + hstepB, voffB); PG8_STAGE(PG8_SA(1, 0), a3, voffA);
            PG8_WAIT_V(8); PG8_WAIT_L(0); PG8_BAR; PG8_MMA(1, 0, At, B0); PG8_MMA(1, 1, At, B1); PG8_BAR; PG8_SCHED;
        }
        if (cur.last || !has_next) break;
        cur = nxt; cA = nA; cB = nB; ++qi;
        }
        if constexpr (ALIGN_EPI) { if (wr == 0) PG8_BAR; }
        E(acc, cur.u, wr, wc, fr, fq);
        if constexpr (Sched::PUBLISH) S.done(cur.u);
        if (!has_next) break;
        PG8_ZERO();
        cur = nxt; cA = nA; cB = nB; ++qi;
        if constexpr (ALIGN_EPI) { if (wr == 1) PG8_BAR; }
    }
    PG8_WAIT_V(0);
    if constexpr (!ALIGN_EPI) { if (wr == 0) PG8_BAR; }
    PG8_BAR;
#undef PG8_SA
#undef PG8_SB
#undef PG8_STAGE
#undef PG8_LDA
#undef PG8_LDB
#undef PG8_MMA
#undef PG8_WAIT_V
#undef PG8_WAIT_L
#undef PG8_BAR
#undef PG8_SCHED
#undef PG8_ZERO
}

struct EpiBf16 {
    static constexpr bool PERM = true;
    bf16_t* O; int ldc;
    __device__ __forceinline__ void operator()(const Acc& acc, const Unit& u, int wr, int wc, int fr, int fq) const {
        const int row0 = u.pm * BM + wr * 64 + fr; const int col0 = u.pn * BM + wc * 32 + 8 * fq;
#pragma unroll
        for (int ai = 0; ai < 2; ++ai)
#pragma unroll
            for (int m = 0; m < 4; ++m) { bf16_t* rowp = O + (size_t)(row0 + ai * HALF + m * 16) * ldc + col0;
#pragma unroll
                for (int bj = 0; bj < 2; ++bj) { const f32x4 v0 = acc[ai][bj][m][0], v1 = acc[ai][bj][m][1];
                    u32x4 w; w.x = cvt_pk_bf16(v0[0], v0[1]); w.y = cvt_pk_bf16(v0[2], v0[3]); w.z = cvt_pk_bf16(v1[0], v1[1]); w.w = cvt_pk_bf16(v1[2], v1[3]);
                    *(u32x4*)(rowp + bj * HALF) = w; } }
    }
};
struct EpiIn {
    static constexpr bool PERM = true;
    bf16_t* O; int ldc; float* part;
    __device__ __forceinline__ void operator()(const Acc& acc, const Unit& u, int wr, int wc, int fr, int fq) const {
        const int row0 = u.pm * BM + wr * 64 + fr;
        if (u.aux == 0) {
            const int col0 = u.pn * BM + wc * 32 + 8 * fq;
#pragma unroll
            for (int ai = 0; ai < 2; ++ai)
#pragma unroll
                for (int m = 0; m < 4; ++m) { bf16_t* rowp = O + (size_t)(row0 + ai * HALF + m * 16) * ldc + col0;
#pragma unroll
                    for (int bj = 0; bj < 2; ++bj) { const f32x4 v0 = acc[ai][bj][m][0], v1 = acc[ai][bj][m][1];
                        u32x4 w; w.x = cvt_pk_bf16(v0[0], v0[1]); w.y = cvt_pk_bf16(v0[2], v0[3]); w.z = cvt_pk_bf16(v1[0], v1[1]); w.w = cvt_pk_bf16(v1[2], v1[3]);
                        *(u32x4*)(rowp + bj * HALF) = w; } }
        } else {
            const int ct = (u.aux - 1) & 1, kh = (u.aux - 1) >> 1;
            float* pp = part + (size_t)kh * T * 512 + ct * 256 + wc * 32 + 8 * fq;
#pragma unroll
            for (int ai = 0; ai < 2; ++ai)
#pragma unroll
                for (int m = 0; m < 4; ++m) { float* rowp = pp + (size_t)(row0 + ai * HALF + m * 16) * 512;
#pragma unroll
                    for (int bj = 0; bj < 2; ++bj) { *(f32x4*)(rowp + bj * HALF) = acc[ai][bj][m][0]; *(f32x4*)(rowp + bj * HALF + 4) = acc[ai][bj][m][1]; } }
        }
    }
};
struct EpiLora {
    static constexpr bool PERM = true;
    bf16_t* O; const float* w0; const float* a0;
    __device__ __forceinline__ void operator()(const Acc& acc, const Unit& u, int wr, int wc, int fr, int fq) const {
        const int row0 = u.pm * BM + wr * 64 + fr; const int col0 = u.pn * BM + wc * 32 + 8 * fq; const int typ = u.pn >> 2;
        if (typ == 2) {
#pragma unroll
            for (int bj = 0; bj < 2; ++bj)
#pragma unroll
                for (int ai = 0; ai < 2; ++ai)
#pragma unroll
                    for (int m = 0; m < 4; ++m) { const f32x4 v0 = acc[ai][bj][m][0], v1 = acc[ai][bj][m][1];
                        u32x4 w; w.x = cvt_pk_bf16(v0.x, v0.y); w.y = cvt_pk_bf16(v0.z, v0.w); w.z = cvt_pk_bf16(v1.x, v1.y); w.w = cvt_pk_bf16(v1.z, v1.w);
                        *(u32x4*)(O + (size_t)(row0 + ai * HALF + m * 16) * NL + col0 + bj * HALF) = w; }
            return;
        }
        const float* bsrc = (typ == 0) ? w0 : a0;
        const float mul = (typ == 0) ? -0.6065306597126334f : 1.0f;
#pragma unroll
        for (int bj = 0; bj < 2; ++bj) {
            const int ch = (col0 + bj * HALF) & 1023;
            const f32x4 b0 = *(const f32x4*)(bsrc + ch), b1 = *(const f32x4*)(bsrc + ch + 4);
#pragma unroll
            for (int ai = 0; ai < 2; ++ai)
#pragma unroll
                for (int m = 0; m < 4; ++m) {
                    f32x4 v0 = acc[ai][bj][m][0], v1 = acc[ai][bj][m][1];
                    {
                        const f32x4 s0 = v0 + b0, s1 = v1 + b1;
                        v0.x = mul * sigmoidf_(s0.x); v0.y = mul * sigmoidf_(s0.y); v0.z = mul * sigmoidf_(s0.z); v0.w = mul * sigmoidf_(s0.w);
                        v1.x = mul * sigmoidf_(s1.x); v1.y = mul * sigmoidf_(s1.y); v1.z = mul * sigmoidf_(s1.z); v1.w = mul * sigmoidf_(s1.w);
                    }
                    u32x4 w; w.x = cvt_pk_bf16(v0.x, v0.y); w.y = cvt_pk_bf16(v0.z, v0.w); w.z = cvt_pk_bf16(v1.x, v1.y); w.w = cvt_pk_bf16(v1.z, v1.w);
                    *(u32x4*)(O + (size_t)(row0 + ai * HALF + m * 16) * NL + col0 + bj * HALF) = w;
                    asm volatile("" ::: "memory"); }
        }
    }
};
struct EpiResF32 {
    static constexpr bool PERM = false;
    const float* base; float* out; int ldc;
    __device__ __forceinline__ void operator()(const Acc& acc, const Unit& u, int wr, int wc, int fr, int fq) const {
        const int col0 = u.pn * BM + wc * 32 + 4 * fq;
#pragma unroll
        for (int ai = 0; ai < 2; ++ai) {
            f32x4 v[4][2][2];
#pragma unroll
            for (int m = 0; m < 4; ++m) { const size_t off = (size_t)(u.pm * BM + ai * HALF + wr * 64 + m * 16 + fr) * ldc + col0;
#pragma unroll
                for (int bj = 0; bj < 2; ++bj)
#pragma unroll
                    for (int n = 0; n < 2; ++n) v[m][bj][n] = *(const f32x4*)(base + off + bj * HALF + n * 16); }
            asm volatile("" ::: "memory");
#pragma unroll
            for (int m = 0; m < 4; ++m) { const size_t off = (size_t)(u.pm * BM + ai * HALF + wr * 64 + m * 16 + fr) * ldc + col0;
#pragma unroll
                for (int bj = 0; bj < 2; ++bj)
#pragma unroll
                    for (int n = 0; n < 2; ++n) *(f32x4*)(out + off + bj * HALF + n * 16) = v[m][bj][n] + acc[ai][bj][m][n]; }
            asm volatile("" ::: "memory");
        }
    }
};
struct EpiMoe1 {
    static constexpr bool PERM = true;
    bf16_t* O; const float* gates;
    __device__ __forceinline__ void operator()(const Acc& acc, const Unit& u, int wr, int wc, int fr, int fq) const {
        const int row0 = u.pm * BM + wr * 64 + fr; const int half = u.pn >> 2; const int col0 = half * 512 + (u.pn & 3) * 128 + wc * 32 + 8 * fq;
        const __amdgpu_buffer_rsrc_t rs = __builtin_amdgcn_make_buffer_rsrc(O, 0, MPAD * 1024 * 2, 0x00020000);
#pragma unroll
        for (int ai = 0; ai < 2; ++ai)
#pragma unroll
            for (int m = 0; m < 4; ++m) { const int row = row0 + ai * HALF + m * 16; const float gw = gates[(size_t)row * 2 + half];
                float v[8];
#pragma unroll
                for (int e = 0; e < 8; ++e) { const float g = acc[ai][0][m][e >> 2][e & 3], up = acc[ai][1][m][e >> 2][e & 3]; v[e] = g * sigmoidf_(g) * up * gw; }
                u32x4 w; w.x = cvt_pk_bf16(v[0], v[1]); w.y = cvt_pk_bf16(v[2], v[3]); w.z = cvt_pk_bf16(v[4], v[5]); w.w = cvt_pk_bf16(v[6], v[7]);
                __builtin_amdgcn_raw_buffer_store_b128(w, rs, (unsigned)(row * 1024 + col0) * 2u, 0, 16); }
    }
};
struct EpiMoe2 {
    static constexpr bool PERM = false;
    float* out; const int* rowtok; int dry;
    __device__ __forceinline__ void operator()(const Acc& acc, const Unit& u, int wr, int wc, int fr, int fq) const {
        const int col0 = u.pn * BM + wc * 32 + 4 * fq;
#pragma unroll
        for (int ai = 0; ai < 2; ++ai) {
            int tok[4]; f32x4 v[4][2][2];
#pragma unroll
            for (int m = 0; m < 4; ++m) tok[m] = rowtok[u.pm * BM + ai * HALF + wr * 64 + m * 16 + fr];
#pragma unroll
            for (int m = 0; m < 4; ++m) { const float* o = out + (size_t)(tok[m] < 0 ? 0 : tok[m]) * DM + col0;
#pragma unroll
                for (int bj = 0; bj < 2; ++bj)
#pragma unroll
                    for (int n = 0; n < 2; ++n) v[m][bj][n] = *(const f32x4*)(o + bj * HALF + n * 16); }
            asm volatile("" ::: "memory");
#pragma unroll
            for (int m = 0; m < 4; ++m) { if (tok[m] >= 0 && !dry) { float* o = out + (size_t)tok[m] * DM + col0;
#pragma unroll
                for (int bj = 0; bj < 2; ++bj)
#pragma unroll
                    for (int n = 0; n < 2; ++n) *(f32x4*)(o + bj * HALF + n * 16) = v[m][bj][n] + acc[ai][bj][m][n]; } }
            asm volatile("" ::: "memory");
        }
    }
};
}

#define XB_TMO      128
#define XB_XCNT(j)  (256  + 64 * (j))
#define XB_XSUB(j)  (1280 + 64 * (j))
#define XB_XGEN(j)  (2304 + 64 * (j))
#define XB_TOP      3328
#define XB_TOPGEN   3392
#define XCD_BAR_WORDS 3456
#define XB_SPIN_CAP (1u << 20)
__device__ __forceinline__ unsigned xb_ld(unsigned* p)              { return __hip_atomic_load(p, __ATOMIC_RELAXED, __HIP_MEMORY_SCOPE_AGENT); }
__device__ __forceinline__ unsigned xb_add(unsigned* p, unsigned v) { return __hip_atomic_fetch_add(p, v, __ATOMIC_RELAXED, __HIP_MEMORY_SCOPE_AGENT); }
__device__ __forceinline__ unsigned xb_xcc_id() { return (unsigned)__builtin_amdgcn_s_getreg((3 << 11) | 20) & 0xFu; }
#define XB_SPIN(cond, bar) do { unsigned _sp = 0; while (cond) { __builtin_amdgcn_s_sleep(1); \
    if ((++_sp & 255u) == 0u) { if (xb_ld(&(bar)[XB_TMO])) break; if (_sp > XB_SPIN_CAP) { atomicAdd(&(bar)[XB_TMO], 1u); break; } } } } while (0)
struct XcdBarrier { unsigned* bar; unsigned x; volatile LAS unsigned* st; };
__device__ __forceinline__ XcdBarrier xcd_barrier_post(unsigned* bar, volatile LAS unsigned* st) {
    XcdBarrier b; b.bar = bar; b.x = xb_xcc_id(); b.st = st;
    if (threadIdx.x == 0) (void)xb_add(&bar[XB_XCNT(b.x)], 1u);
    return b;
}
__device__ __forceinline__ void xcd_barrier_complete(unsigned* bar, unsigned x, unsigned& nloc, unsigned& nx) {
    const unsigned G = gridDim.x * gridDim.y * gridDim.z;
    unsigned sum, cnt, mine, sp = 0u;
    for (;;) {
        sum = 0u; cnt = 0u; mine = 0u;
#pragma unroll
        for (unsigned j = 0; j < 16; ++j) { const unsigned c = xb_ld(&bar[XB_XCNT(j)]); sum += c; cnt += (c > 0u) ? 1u : 0u; mine = (j == x) ? c : mine; }
        if (sum == G) break;
        __builtin_amdgcn_s_sleep(1);
        if ((++sp & 255u) == 0u) { if (xb_ld(&bar[XB_TMO])) break; if (sp > XB_SPIN_CAP) { atomicAdd(&bar[XB_TMO], 1u); break; } }
    }
    nloc = mine > 0u ? mine : 1u; nx = cnt > 0u ? cnt : 1u;
}
__device__ __forceinline__ void xcd_barrier(const XcdBarrier& b) {
    asm volatile("s_waitcnt vmcnt(0)" ::: "memory");
    __syncthreads();
    if (threadIdx.x == 0) {
        unsigned* bar = b.bar;
        __builtin_amdgcn_s_waitcnt(0);
        unsigned nloc = b.st[0], nx = b.st[1];
        if (nloc == 0u) { xcd_barrier_complete(bar, b.x, nloc, nx); b.st[0] = nloc; b.st[1] = nx; }
        const unsigned old = xb_add(&bar[XB_XSUB(b.x)], 1u);
        const unsigned gen = old / nloc;
        if (old + 1u == (gen + 1u) * nloc) {
            __builtin_amdgcn_fence(__ATOMIC_RELEASE, "agent");
            asm volatile("s_waitcnt vmcnt(0)" ::: "memory");
            const unsigned og = xb_add(&bar[XB_TOP], 1u);
            const unsigned tg = og / nx;
            if (og + 1u == (tg + 1u) * nx) xb_add(&bar[XB_TOPGEN], 1u);
            else XB_SPIN(xb_ld(&bar[XB_TOPGEN]) == tg, bar);
            __builtin_amdgcn_fence(__ATOMIC_ACQUIRE, "agent");
            xb_add(&bar[XB_XGEN(b.x)], 1u);
            asm volatile("s_waitcnt vmcnt(0)" ::: "memory");
        } else {
            XB_SPIN(xb_ld(&bar[XB_XGEN(b.x)]) == gen, bar);
            __builtin_amdgcn_fence(__ATOMIC_ACQUIRE, "agent");
            asm volatile("s_waitcnt vmcnt(0)" ::: "memory");
        }
    }
    __syncthreads();
}

struct Args { const float* in[25]; float* out; unsigned char* ws; int ph_lo, ph_hi; };
enum { I_X = 0, I_GMIX, I_WIN, I_MIX, I_QG, I_KG, I_W0, I_WDEC, I_A0, I_WAICL, I_WGATE, I_KK, I_KA, I_RK, I_LNW, I_LNB, I_WOUT, I_GFFN, I_WRG, I_BRG, I_WRE, I_BRE, I_WEG, I_WEU, I_WED };

struct Frame {
    LAS unsigned char* lds; unsigned char* ldsg;
    unsigned* ctl;
    int tid, lane, wave, vcu, G;
    const float* const* in; float* out; unsigned char* ws;
};

__device__ __forceinline__ int win_dmap(int n) {
    if (n < DSA_COLS) return n;
    const int m = n - DSA_COLS;
    if (m < 1024) return PR + m;
    if (m < 1088) return PDW + (m - 1024);
    if (m < 2112) return PKR + (m - 1088);
    if (m < 3136) return PVR + (m - 2112);
    if (m < 3200) return PDA + (m - 3136);
    return PDG + (m - 3200);
}
template <int MODE, int KMAX = (1 << 30)>
__device__ __forceinline__ void transpose_item(const float* W, int N, bf16_t* WT, int ldd, LAS float* scr, int kb, int nb, int lane) {
    const int k0 = 64 * kb, n0 = 32 * nb;
    const int nn = n0 + (lane & 31);
    float tv[32];
#pragma unroll
    for (int i = 0; i < 32; ++i) { const int kk = 2 * i + (lane >> 5); tv[i] = (nn < N && (KMAX == (1 << 30) || k0 + kk < KMAX)) ? W[(size_t)(k0 + kk) * N + nn] : 0.f; }
#pragma unroll
    for (int i = 0; i < 32; ++i) { const int kk = 2 * i + (lane >> 5); scr[kk * 33 + (lane & 31)] = tv[i]; }
    LDS_WAIT(); asm volatile("" ::: "memory");
    const int c = lane & 7;
#pragma unroll
    for (int j = 0; j < 4; ++j) { const int nl = (lane >> 3) + 8 * j; const int n = n0 + nl; const LAS float* s = scr + (8 * c) * 33 + nl;
        u32x4 o; o.x = pk2(s[0 * 33], s[1 * 33]); o.y = pk2(s[2 * 33], s[3 * 33]); o.z = pk2(s[4 * 33], s[5 * 33]); o.w = pk2(s[6 * 33], s[7 * 33]);
        int dr = n;
        if (MODE == 1) dr = win_dmap(n);
        if (MODE == 2) dr = (n >> 7) * 256 + (n & 127);
        if (MODE == 3) dr = (n >> 7) * 256 + 128 + (n & 127);
        if (n < N) *(u32x4*)(WT + (size_t)dr * ldd + k0 + 8 * c) = o; }
    LDS_WAIT(); asm volatile("" ::: "memory");
}

__device__ __forceinline__ void phase0(Frame& F) {
    LAS float* scr = (LAS float*)(F.lds + F.wave * 16384);
    const int gw = F.vcu * 8 + F.wave, NGW = F.G * 8, lane = F.lane;
    constexpr int NB_IN = (IN_COLS + 31) / 32;
    constexpr int I_IN = (DM / 64) * NB_IN, I_OUT = (DM / 64) * (DM / 32);
    bf16_t* WIN = (bf16_t*)(F.ws + WS_WIN); bf16_t* WOUT = (bf16_t*)(F.ws + WS_WOUT);
    bf16_t* WL = (bf16_t*)(F.ws + WS_WLORA);
    for (int it = gw; it < I_IN + I_OUT + 160; it += NGW) {
        if (it < I_IN) transpose_item<1>(F.in[I_WIN], IN_COLS, WIN, DM, scr, it / NB_IN, it % NB_IN, lane);
        else if (it < I_IN + I_OUT) { const int r = it - I_IN; transpose_item<0>(F.in[I_WOUT], DM, WOUT, DM, scr, r / (DM / 32), r % (DM / 32), lane); }
        else { const int r = it - I_IN - I_OUT;
            if (r < 32) transpose_item<0>(F.in[I_WDEC], 1024, WL, KL, scr, 0, r, lane);
            else if (r < 64) transpose_item<0>(F.in[I_WAICL], 1024, WL + (size_t)1024 * KL + 64, KL, scr, 0, r - 32, lane);
            else transpose_item<0, 160>(F.in[I_WGATE], 1024, WL + (size_t)2048 * KL + 128, KL, scr, (r - 64) >> 5, (r - 64) & 31, lane); }
    }
    for (int i = gw * 64 + lane; i < NL * 8; i += NGW * 64) { const int n = i >> 3, q = i & 7, typ = n >> 10; const int col = (typ == 0 ? 64 : (typ == 1 ? 0 : 320)) + 8 * q;
        *(u32x4*)(WL + (size_t)n * KL + col) = (u32x4){0u, 0u, 0u, 0u}; }
    for (int i = gw; i < 144 * 4; i += NGW) { const int r = i >> 2, q = i & 3; const int row = r < 48 ? 4176 + r : 7584 + (r - 48);
        *(u32x4*)(WIN + (size_t)row * DM + q * 512 + lane * 8) = (u32x4){0u, 0u, 0u, 0u}; }
    { bf16_t* WRH = (bf16_t*)(F.ws + WS_WRT); bf16_t* WRL = WRH + 32 * DM; const float* wrg = F.in[I_WRG]; const float* wre = F.in[I_WRE]; const float* gf = F.in[I_GFFN];
      for (int i = gw * 64 + lane; i < 32 * DM; i += NGW * 64) { const int o = i / DM, k = i % DM; float v = 0.f;
          if (o < 4) v = gf[k] * wrg[k * 4 + o]; else if (o < 20) v = gf[k] * wre[k * 16 + (o - 4)];
          const unsigned hb = f2bf(v); const float lo = v - bf2f((unsigned short)hb); WRH[i] = (bf16_t)hb; WRL[i] = (bf16_t)f2bf(lo); } }
    { const float* x = F.in[I_X]; const float* g = F.in[I_GMIX]; bf16_t* HN = (bf16_t*)(F.ws + WS_HN);
      f32x4 gv[8];
#pragma unroll
      for (int j = 0; j < 8; ++j) gv[j] = ((const f32x4*)g)[64 * j + lane];
      for (int m2 = gw; m2 < T / 2; m2 += NGW) {
          f32x4 v[2][8]; float s2[2] = {0.f, 0.f};
#pragma unroll
          for (int u = 0; u < 2; ++u) { const f32x4* xr = (const f32x4*)(x + (size_t)(2 * m2 + u) * DM) + lane;
#pragma unroll
              for (int j = 0; j < 8; ++j) v[u][j] = xr[64 * j]; }
#pragma unroll
          for (int u = 0; u < 2; ++u) {
#pragma unroll
              for (int j = 0; j < 8; ++j) s2[u] += (v[u][j].x * v[u][j].x + v[u][j].y * v[u][j].y) + (v[u][j].z * v[u][j].z + v[u][j].w * v[u][j].w);
              const float rstd = rsqrtf(wave_sum(s2[u]) * (1.f / DM) + NORM_EPS);
              u32x2* o = (u32x2*)(HN + (size_t)(2 * m2 + u) * DM) + lane;
#pragma unroll
              for (int j = 0; j < 8; ++j) { u32x2 w; w.x = pk2(v[u][j].x * rstd * gv[j].x, v[u][j].y * rstd * gv[j].y); w.y = pk2(v[u][j].z * rstd * gv[j].z, v[u][j].w * rstd * gv[j].w); o[64 * j] = w; } } } }
}

__device__ __forceinline__ void rope4(float& y0, float& y1, float& y2, float& y3, float c0, float s0, float c1, float s1) {
    const float o0 = y0 * c0 - y2 * s0, o2 = y2 * c0 + y0 * s0, o1 = y1 * c1 - y3 * s1, o3 = y3 * c1 + y1 * s1; y0 = o0; y1 = o1; y2 = o2; y3 = o3;
}
__device__ __forceinline__ void phase2(Frame& F, const bool dry) {
    const int gw = F.vcu * 8 + F.wave, NGW = F.G * 8, lane = F.lane;
    bf16_t* P = (bf16_t*)(F.ws + WS_P); bf16_t* KI = (bf16_t*)(F.ws + WS_KI); bf16_t* AL = (bf16_t*)(F.ws + WS_ALORA);
    const float* mix = F.in[I_MIX];
    const int l5 = lane & 31, hsel = lane >> 5, l4 = lane & 15, hq = lane >> 4;
    float qg[4], kg[4];
    { const float* a = F.in[I_QG]; const float* b = F.in[I_KG];
      qg[0] = a[2 * l5]; qg[1] = a[2 * l5 + 1]; qg[2] = a[64 + 2 * l5]; qg[3] = a[65 + 2 * l5];
      kg[0] = b[2 * l5]; kg[1] = b[2 * l5 + 1]; kg[2] = b[64 + 2 * l5]; kg[3] = b[65 + 2 * l5]; }
    const float L2T = 13.287712379549449f;
    const float inv128_0 = exp2f(-(float)(2 * l5) * (1.0f / 64.0f) * L2T), inv128_1 = exp2f(-(float)(2 * l5 + 1) * (1.0f / 64.0f) * L2T);
    const float inv64_0 = exp2f(-(float)(2 * l4) * (1.0f / 32.0f) * L2T), inv64_1 = exp2f(-(float)(2 * l4 + 1) * (1.0f / 32.0f) * L2T);
    const float mu_dw = mix[1024 + lane], mu_da = mix[3136 + lane], mu_g0 = mix[3200 + lane], mu_g1 = mix[3264 + lane], mu_g2 = (lane < 32) ? mix[3328 + lane] : 0.f;
    for (int tp = gw; tp < T / 2; tp += NGW) {
        unsigned qa[2][4], qb[2][4], ka[2][4], kb[2][4], ia[2][4], ib[2][4];
        float ap[2][5], apv[2][5], xk[2][4], wsum[2];
#pragma unroll
        for (int u = 0; u < 2; ++u) {
            const int t = 2 * tp + u; const int pos = t & (SEQ - 1);
            const bf16_t* row = P + (size_t)t * NP;
#pragma unroll
            for (int hh = 0; hh < 4; ++hh) {
                const unsigned* bq = (const unsigned*)(row + PQ + (2 * hh + hsel) * 128); const unsigned* bk = (const unsigned*)(row + PK + (2 * hh + hsel) * 128);
                qa[u][hh] = bq[l5]; qb[u][hh] = bq[32 + l5]; ka[u][hh] = bk[l5]; kb[u][hh] = bk[32 + l5];
                const unsigned* bi = (const unsigned*)(row + PQI + (4 * hh + hq) * 64);
                ia[u][hh] = bi[l4]; ib[u][hh] = bi[16 + l4];
            }
            const float* s0 = F.out + (size_t)t * 512; const float* s1 = s0 + (size_t)T * 512;
            { const f32x2 a0 = *(const f32x2*)(s0 + 2 * l4), a1 = *(const f32x2*)(s1 + 2 * l4), b0 = *(const f32x2*)(s0 + 32 + 2 * l4), b1 = *(const f32x2*)(s1 + 32 + 2 * l4);
              xk[u][0] = a0.x + a1.x; xk[u][1] = a0.y + a1.y; xk[u][2] = b0.x + b1.x; xk[u][3] = b0.y + b1.y; }
            wsum[u] = s0[64 + lane] + s1[64 + lane];
            const bool hp = pos > 0;
            ap[u][0] = s0[128 + lane] + s1[128 + lane]; ap[u][1] = s0[192 + lane] + s1[192 + lane]; ap[u][2] = s0[256 + lane] + s1[256 + lane]; ap[u][3] = s0[320 + lane] + s1[320 + lane];
            ap[u][4] = (lane < 32) ? s0[384 + lane] + s1[384 + lane] : 0.f;
            apv[u][0] = hp ? s0[128 + lane - 512] + s1[128 + lane - 512] : 0.f; apv[u][1] = hp ? s0[192 + lane - 512] + s1[192 + lane - 512] : 0.f; apv[u][2] = hp ? s0[256 + lane - 512] + s1[256 + lane - 512] : 0.f;
            apv[u][3] = hp ? s0[320 + lane - 512] + s1[320 + lane - 512] : 0.f; apv[u][4] = (hp && lane < 32) ? s0[384 + lane - 512] + s1[384 + lane - 512] : 0.f;
        }
        asm volatile("" ::: "memory");
#pragma unroll
        for (int u = 0; u < 2; ++u) {
            const int t = 2 * tp + u; const int pos = t & (SEQ - 1); const float fp = (float)pos;
            bf16_t* row = P + (size_t)t * NP;
            float c0, s0, c1, s1, d0, e0, d1, e1;
            { const float a0 = fp * inv128_0, a1 = fp * inv128_1, a2 = fp * inv64_0, a3 = fp * inv64_1;
              const float r0 = __builtin_amdgcn_fractf(a0 * 0.15915494309189535f), r1 = __builtin_amdgcn_fractf(a1 * 0.15915494309189535f), r2 = __builtin_amdgcn_fractf(a2 * 0.15915494309189535f), r3 = __builtin_amdgcn_fractf(a3 * 0.15915494309189535f);
              s0 = __builtin_amdgcn_sinf(r0); c0 = __builtin_amdgcn_cosf(r0); s1 = __builtin_amdgcn_sinf(r1); c1 = __builtin_amdgcn_cosf(r1);
              e0 = __builtin_amdgcn_sinf(r2); d0 = __builtin_amdgcn_cosf(r2); e1 = __builtin_amdgcn_sinf(r3); d1 = __builtin_amdgcn_cosf(r3); }
#pragma unroll
            for (int which = 0; which < 2; ++which) {
#pragma unroll
                for (int hh = 0; hh < 4; ++hh) {
                    unsigned* base = (unsigned*)(row + (which ? PK : PQ) + (2 * hh + hsel) * 128);
                    const unsigned a = which ? ka[u][hh] : qa[u][hh], b = which ? kb[u][hh] : qb[u][hh];
                    float y0 = bflo(a), y1 = bfhi(a), y2 = bflo(b), y3 = bfhi(b);
                    const float ss = half_sum((y0 * y0 + y1 * y1) + (y2 * y2 + y3 * y3));
                    const float rstd = rsqrtf(ss * (1.0f / 128.0f) + NORM_EPS) * (which ? 1.0f : QSCALE);
                    const float* gg = which ? kg : qg;
                    y0 *= rstd * gg[0]; y1 *= rstd * gg[1]; y2 *= rstd * gg[2]; y3 *= rstd * gg[3];
                    rope4(y0, y1, y2, y3, c0, s0, c1, s1);
                    if (!dry) { base[l5] = pk2(y0, y1); base[32 + l5] = pk2(y2, y3); }
                }
            }
#pragma unroll
            for (int it = 0; it < 4; ++it) {
                unsigned* base = (unsigned*)(row + PQI + (4 * it + hq) * 64);
                float y0 = bflo(ia[u][it]), y1 = bfhi(ia[u][it]), y2 = bflo(ib[u][it]), y3 = bfhi(ib[u][it]);
                rope4(y0, y1, y2, y3, d0, e0, d1, e1);
                if (!dry) { base[l4] = pk2(y0, y1); base[16 + l4] = pk2(y2, y3); }
            }
            if (lane < 16 && !dry) {
                float y0 = xk[u][0], y1 = xk[u][1], y2 = xk[u][2], y3 = xk[u][3];
                rope4(y0, y1, y2, y3, d0, e0, d1, e1);
                unsigned* o = (unsigned*)(KI + (size_t)t * 64);
                o[l4] = pk2(y0, y1); o[16 + l4] = pk2(y2, y3);
                row[PWI + lane] = (bf16_t)f2bf(wsum[u]);
            }
            if (!dry) {
                bf16_t* al = AL + (size_t)t * KL;
                float sh;
                sh = ap[u][0] + (apv[u][0] - ap[u][0]) * mu_dw; al[lane] = (bf16_t)f2bf(1.0f - 2.0f * __builtin_amdgcn_rcpf(1.0f + __expf(2.0f * sh)));
                sh = ap[u][1] + (apv[u][1] - ap[u][1]) * mu_da; al[64 + lane] = (bf16_t)f2bf(sh);
                sh = ap[u][2] + (apv[u][2] - ap[u][2]) * mu_g0; al[128 + lane] = (bf16_t)f2bf(sigmoidf_(sh));
                sh = ap[u][3] + (apv[u][3] - ap[u][3]) * mu_g1; al[192 + lane] = (bf16_t)f2bf(sigmoidf_(sh));
                if (lane < 32) { sh = ap[u][4] + (apv[u][4] - ap[u][4]) * mu_g2; al[256 + lane] = (bf16_t)f2bf(sigmoidf_(sh)); }
                al[288 + lane] = 0; if (lane < 32) al[352 + lane] = 0;
            }
        }
    }
}

__device__ __forceinline__ unsigned fkey(float f) { const unsigned u = __builtin_bit_cast(unsigned, f); return (u & 0x80000000u) ? ~u : (u | 0x80000000u); }
constexpr int CW_QIDX = 192;
constexpr int IDX_BUF = 256 * 128;
constexpr int SC_BATCH = 4096 * 2080;
constexpr int NSCU = 4 * 544;
__device__ __forceinline__ size_t sc_row_off(int b, int i, int q) { return (size_t)b * SC_BATCH + (size_t)2048 * i * (i + 1) + (size_t)q * 64 * (i + 1); }
typedef _Float16 h16x2 __attribute__((ext_vector_type(2)));
struct IdxQ { bf16x8 a[4]; h16x2 wq[8]; };
__device__ __forceinline__ void idxq_load(IdxQ& d, const bf16_t* P, int tq, int r, int h) {
    const bf16_t* ap = P + (size_t)(tq + ((r >> 2) & 1)) * NP + PQI + ((r & 3) + 4 * (r >> 3)) * 64 + 8 * h;
#pragma unroll
    for (int s = 0; s < 4; ++s) d.a[s] = *(const bf16x8*)(ap + 16 * s);
    const u32x4* wp = (const u32x4*)(P + (size_t)(tq + h) * NP + PWI);
    const u32x4 w0 = wp[0], w1 = wp[1];
#pragma unroll
    for (int e = 0; e < 8; ++e) { const unsigned w = e < 4 ? w0[e] : w1[e - 4]; d.wq[e].x = (_Float16)(bflo(w) * (1.0f / 32.0f)); d.wq[e].y = (_Float16)(bfhi(w) * (1.0f / 32.0f)); }
}
constexpr int NSCU2 = 640;
__device__ __forceinline__ void idx_decode(int u, int& b, int& i, int& st0, int& st1) {
    b = u / 160; const int v = 159 - (u % 160);
    const int band = v < 16 ? 0 : (v < 48 ? 1 : (v < 96 ? 2 : 3)), cum = band == 0 ? 0 : (band == 1 ? 16 : (band == 2 ? 48 : 96));
    const int rem = v - cum; i = 16 * band + rem / (band + 1); const int sg = rem % (band + 1);
    const int nst = (i >> 2) + 1; st0 = 4 * sg; st1 = (4 * sg + 3 < nst - 1) ? 4 * sg + 3 : nst - 1;
}
__device__ __forceinline__ void idx_stage(Frame& F, int b, int st, int buf) {
    const int lane = F.lane, wave = F.wave;
    const unsigned char* kg = F.ws + WS_KI + ((size_t)b * SEQ + 256 * st) * 128 + (size_t)(wave * 8 + (lane >> 3)) * 128 + (size_t)(((lane & 7) ^ (lane >> 3)) * 16);
#pragma unroll
    for (int q = 0; q < 4; ++q) __builtin_amdgcn_global_load_lds((const unsigned*)(kg + q * 8192), (LAS unsigned*)(F.lds + buf * IDX_BUF + (q * 8 + wave) * 1024), 16, 0, 0);
}
__device__ __forceinline__ void idx_score_tile(Frame& F, const IdxQ (&qv)[4], int b, int i, int st, int buf) {
    int lane_ = F.lane; asm volatile("" : "+v"(lane_));
    const int lane = lane_, wave = F.wave, r = lane & 31, h = lane >> 5;
    _Float16* SC = (_Float16*)(F.ws + WS_SC);
    const int nvb = (2 * (i + 1) - 8 * st) < 8 ? (2 * (i + 1) - 8 * st) : 8;
    const LAS unsigned char* kb = F.lds + buf * IDX_BUF + r * 128; const int sw = r & 7;
    _Float16* dummy = (_Float16*)(F.ws + WS_SINK) + (blockIdx.x * 512 + threadIdx.x) % 32768;
#pragma unroll
    for (int g = 0; g < 4; ++g) {
        _Float16* srow = SC + sc_row_off(b, i, 16 * g + 2 * wave + h) + 256 * st + r;
#pragma unroll
        for (int jb = 0; jb < 8; ++jb) {
            f32x16 acc = {0.f, 0.f, 0.f, 0.f, 0.f, 0.f, 0.f, 0.f, 0.f, 0.f, 0.f, 0.f, 0.f, 0.f, 0.f, 0.f};
#pragma unroll
            for (int s = 0; s < 4; ++s) acc = __builtin_amdgcn_mfma_f32_32x32x16_bf16(qv[g].a[s], *(const LAS bf16x8*)(kb + jb * 4096 + (((2 * s + h) ^ sw) * 16)), acc, 0, 0, 0);
            float sum = 0.f, sum1 = 0.f;
#pragma unroll
            for (int e = 0; e < 16; ++e) { const float rl = __builtin_amdgcn_fmed3f(acc[e], 0.f, 3.0e38f);
                const unsigned wpk = __builtin_bit_cast(unsigned, qv[g].wq[e >> 1]);
                if (e & 1) asm("v_fma_mix_f32 %0, %1, %2, %0 op_sel:[1,0,0] op_sel_hi:[1,0,0]" : "+v"(sum1) : "v"(wpk), "v"(rl));
                else asm("v_fma_mix_f32 %0, %1, %2, %0 op_sel:[0,0,0] op_sel_hi:[1,0,0]" : "+v"(sum) : "v"(wpk), "v"(rl)); }
            { _Float16* dst = (jb < nvb) ? srow + 32 * jb : dummy; *dst = (_Float16)(sum + sum1); }
        }
        __builtin_amdgcn_sched_barrier(0);
    }
}
__device__ __forceinline__ unsigned pk_lt(unsigned cand2, unsigned k2) {
    unsigned d; asm("v_pk_sub_u16 %0, %1, %2 clamp" : "=v"(d) : "v"(cand2), "v"(k2)); asm("v_pk_min_u16 %0, %1, %2" : "=v"(d) : "v"(d), "v"(0x00010001u)); return d;
}
__device__ __forceinline__ int wave_sum_i(int v) {
#define DPP_ADDI(v, ctrl, rm) (v) += __builtin_amdgcn_update_dpp(0, (v), (ctrl), (rm), 0xF, false)
    DPP_ADDI(v, 0xB1, 0xF); DPP_ADDI(v, 0x4E, 0xF); DPP_ADDI(v, 0x141, 0xF); DPP_ADDI(v, 0x140, 0xF); DPP_ADDI(v, 0x142, 0xA); DPP_ADDI(v, 0x143, 0xC);
#undef DPP_ADDI
    return __builtin_amdgcn_readlane(v, 63);
}
__device__ __forceinline__ int wave_excl_prefix_i(int v, int lane) {
    int x = v;
#pragma unroll
    for (int o = 1; o < 64; o <<= 1) { const int y = __shfl_up(x, o); x += (lane >= o) ? y : 0; }
    return x - v;
}
__device__ __forceinline__ void idx_row_load(Frame& F, int b, int pos, u32x4 (&raw)[8]) {
    const int lane = F.lane, i = pos >> 6, q0 = pos & 63, n = 64 * (i + 1), nch = (n + 511) >> 9;
    const u32x4* sp = (const u32x4*)((const unsigned short*)(F.ws + WS_SC) + sc_row_off(b, i, q0)) + lane;
#pragma unroll
    for (int q = 0; q < 8; ++q) { raw[q] = (u32x4){0u, 0u, 0u, 0u}; if (q < nch && i >= 4) raw[q] = sp[64 * q]; }
}
__device__ __forceinline__ void idx_select_row(Frame& F, int b, int pos, const u32x4 (&raw)[8]) {
    const int lane = F.lane, i = pos >> 6, nj = i + 1, n = 64 * nj, t = b * SEQ + pos;
    unsigned* MSK = (unsigned*)(F.ws + WS_MSK) + (size_t)t * 128;
    if (nj <= 4) { MSK[lane] = (lane < 2 * nj) ? 0xFFFFFFFFu : 0u; MSK[64 + lane] = 0u; return; }
    const int nch = (n + 511) >> 9;
    unsigned k2[32];
#pragma unroll
    for (int q = 0; q < 8; ++q) {
        const u32x4 v = raw[q];
        const bool ok = (512 * q + 8 * lane) < n;
#pragma unroll
        for (int e = 0; e < 4; ++e) { const unsigned x = v[e]; unsigned m; asm("v_pk_ashrrev_i16 %0, %1, %2" : "=v"(m) : "v"(0x000F000Fu), "v"(x)); m |= 0x80008000u; k2[4 * q + e] = ok ? (x ^ m) : 0u; }
    }
    unsigned thr = 0u;
    for (int bit = 15; bit >= 0; --bit) {
        const unsigned cand = thr | (1u << bit), cand2 = cand * 0x00010001u;
        unsigned acc = 0u;
#pragma unroll
        for (int q = 0; q < 8; ++q) { if (q < nch) {
#pragma unroll
            for (int e = 0; e < 4; ++e) acc += pk_lt(cand2, k2[4 * q + e]); } }
        const int lt = wave_sum_i((int)((acc & 0xFFFFu) + (acc >> 16)));
        const int ge = 512 * nch - lt;
        if (ge >= 256) thr = cand;
        if (ge == 256) break;
    }
    const unsigned t2 = thr * 0x00010001u, t2p = (thr + 1u) * 0x00010001u;
    int ngt, nge;
    { unsigned a0 = 0u, a1 = 0u;
#pragma unroll
      for (int q = 0; q < 8; ++q) { if (q < nch) {
#pragma unroll
          for (int e = 0; e < 4; ++e) { a0 += pk_lt(t2p, k2[4 * q + e]); a1 += pk_lt(t2, k2[4 * q + e]); } } }
      ngt = 512 * nch - wave_sum_i((int)((a0 & 0xFFFFu) + (a0 >> 16))); nge = 512 * nch - wave_sum_i((int)((a1 & 0xFFFFu) + (a1 >> 16))); }
    const bool alltied = (nge == 256);
    int tiebase = 0, need = 256 - ngt;
#pragma unroll
    for (int q = 0; q < 8; ++q) {
        if (q < nch) {
            unsigned byte_gt = 0u, byte_ge = 0u;
#pragma unroll
            for (int e = 0; e < 4; ++e) { const unsigned g1 = pk_lt(t2p, k2[4 * q + e]) ^ 0x00010001u, g0 = pk_lt(t2, k2[4 * q + e]) ^ 0x00010001u;
                byte_gt |= ((g1 & 1u) << (2 * e)) | ((g1 >> 16) << (2 * e + 1)); byte_ge |= ((g0 & 1u) << (2 * e)) | ((g0 >> 16) << (2 * e + 1)); }
            unsigned sel = byte_ge;
            if (!alltied) {
                const unsigned tie = byte_ge & ~byte_gt; const int nt = __popc(tie);
                const int pre = tiebase + wave_excl_prefix_i(nt, lane);
                unsigned keep = 0u; int rank = pre;
#pragma unroll
                for (int tt = 0; tt < 8; ++tt) { const unsigned bit = (tie >> tt) & 1u; keep |= (bit && rank < need) ? (1u << tt) : 0u; rank += (int)bit; }
                sel = byte_gt | keep; tiebase += wave_sum_i(nt);
            }
            unsigned w = sel << (8 * (lane & 3));
            w |= (unsigned)__builtin_amdgcn_update_dpp(0, (int)w, 0xB1, 0xF, 0xF, false);
            w |= (unsigned)__builtin_amdgcn_update_dpp(0, (int)w, 0x4E, 0xF, 0xF, false);
            if ((lane & 3) == 0) MSK[16 * q + (lane >> 2)] = w;
        } else if ((lane & 3) == 0) MSK[16 * q + (lane >> 2)] = 0u;
    }
}

__device__ __forceinline__ void attn_task_naive(Frame& F, int task, unsigned char* wl) {
    const int lane = F.lane;
    const bf16_t* P = (const bf16_t*)(F.ws + WS_P); const unsigned* MSK = (const unsigned*)(F.ws + WS_MSK); bf16_t* Y = (bf16_t*)(F.ws + WS_YCAT);
    int* list = (int*)wl; float* qs = (float*)(wl + 1024); float* ps = (float*)(wl + 1536);
    const int t = task >> 3, hd = task & 7, b = t >> 12, i = (t & (SEQ - 1)) >> 6;
    const int ntile = i + 1;
    int cnt = 0;
    for (int jj = 0; jj < ntile; ++jj) {
        const unsigned w0 = MSK[(size_t)t * 128 + 2 * jj], w1 = MSK[(size_t)t * 128 + 2 * jj + 1];
        const unsigned long long m = (unsigned long long)w0 | ((unsigned long long)w1 << 32);
        const int pre = __popcll(m & ((1ull << lane) - 1ull));
        if (((m >> lane) & 1ull) && (cnt + pre < 256)) list[cnt + pre] = 64 * jj + lane;
        cnt += __popcll(m);
    }
    const int nsel = cnt < 256 ? cnt : 256;
    { const bf16_t* qp = P + (size_t)t * NP + PQ + hd * 128; qs[lane] = bf2f(qp[lane]); qs[64 + lane] = bf2f(qp[64 + lane]); }
    LDS_WAIT(); asm volatile("" ::: "memory");
    float lg[4]; float mx = -INFINITY;
#pragma unroll
    for (int rr = 0; rr < 4; ++rr) {
        const int e = lane + 64 * rr; lg[rr] = -INFINITY;
        if (e < nsel) { const int key = list[e]; const u32x4* kp = (const u32x4*)(P + ((size_t)b * SEQ + key) * NP + PK + hd * 128); float d = 0.f;
#pragma unroll
            for (int c = 0; c < 16; ++c) { const u32x4 kv = kp[c]; const float* q = qs + 8 * c;
                d += q[0] * bflo(kv.x) + q[1] * bfhi(kv.x) + q[2] * bflo(kv.y) + q[3] * bfhi(kv.y) + q[4] * bflo(kv.z) + q[5] * bfhi(kv.z) + q[6] * bflo(kv.w) + q[7] * bfhi(kv.w); }
            lg[rr] = d; mx = fmaxf(mx, d); }
    }
#pragma unroll
    for (int o = 1; o < 64; o <<= 1) mx = fmaxf(mx, __shfl_xor(mx, o));
    float sum = 0.f;
#pragma unroll
    for (int rr = 0; rr < 4; ++rr) { const int e = lane + 64 * rr; const float p = (e < nsel) ? exp2f(lg[rr] - mx) : 0.f; ps[e] = p; sum += p; }
    sum = wave_sum(sum);
    LDS_WAIT(); asm volatile("" ::: "memory");
    float o0 = 0.f, o1 = 0.f;
    const bf16_t* vb = P + (size_t)b * SEQ * NP + PV + hd * 128 + 2 * lane;
    for (int e = 0; e < nsel; ++e) { const int key = list[e]; const float p = ps[e]; const unsigned v = *(const unsigned*)(vb + (size_t)key * NP); o0 += p * bflo(v); o1 += p * bfhi(v); }
    const float inv = 1.0f / sum;
    *(unsigned*)(Y + (size_t)t * DM + hd * 128 + 2 * lane) = pk2(o0 * inv, o1 * inv);
    LDS_WAIT(); asm volatile("" ::: "memory");
}

__device__ __forceinline__ void rwkv_scan_naive(Frame& F, int bh, unsigned char* wl) {
    const int lane = F.lane, b = bh >> 4, hd = bh & 15, ch = hd * 64 + lane;
    const bf16_t* P = (const bf16_t*)(F.ws + WS_P); const bf16_t* L3 = (const bf16_t*)(F.ws + WS_L3); bf16_t* Y = (bf16_t*)(F.ws + WS_YCAT);
    const float* mix = F.in[I_MIX];
    const float mu_r = mix[ch], mu_k = mix[1088 + ch], mu_v = mix[2112 + ch];
    const float kkc = F.in[I_KK][ch], kac = F.in[I_KA][ch], rkc = F.in[I_RK][ch], lnw = F.in[I_LNW][ch], lnb = F.in[I_LNB][ch];
    float* vec = (float*)wl;
    f32x4 S4[16];
#pragma unroll
    for (int k = 0; k < 16; ++k) S4[k] = (f32x4){0.f, 0.f, 0.f, 0.f};
    float prev_r = 0.f, prev_k = 0.f, prev_v = 0.f;
    constexpr int PF = 4;
    float in_r[PF], in_k[PF], in_v[PF], in_ld[PF], in_a[PF], in_g[PF];
    const bf16_t* prow = P + (size_t)b * SEQ * NP + ch; const bf16_t* lrow = L3 + (size_t)b * SEQ * NL + ch;
#pragma unroll
    for (int j = 0; j < PF; ++j) { const bf16_t* pr = prow + (size_t)j * NP; const bf16_t* lr = lrow + (size_t)j * NL;
        in_r[j] = bf2f(pr[PR]); in_k[j] = bf2f(pr[PKR]); in_v[j] = bf2f(pr[PVR]); in_ld[j] = bf2f(lr[0]); in_a[j] = bf2f(lr[1024]); in_g[j] = bf2f(lr[2048]); }
    const f32x4* vec4 = (const f32x4*)vec;
    for (int tb = 0; tb < SEQ; tb += PF) {
        float c_r[PF], c_k[PF], c_v[PF], c_ld[PF], c_a[PF], c_g[PF];
#pragma unroll
        for (int j = 0; j < PF; ++j) { c_r[j] = in_r[j]; c_k[j] = in_k[j]; c_v[j] = in_v[j]; c_ld[j] = in_ld[j]; c_a[j] = in_a[j]; c_g[j] = in_g[j]; }
        {
            const int tn = (tb + PF < SEQ) ? tb + PF : tb;
#pragma unroll
            for (int j = 0; j < PF; ++j) { const bf16_t* pr = prow + (size_t)(tn + j) * NP; const bf16_t* lr = lrow + (size_t)(tn + j) * NL;
                in_r[j] = bf2f(pr[PR]); in_k[j] = bf2f(pr[PKR]); in_v[j] = bf2f(pr[PVR]); in_ld[j] = bf2f(lr[0]); in_a[j] = bf2f(lr[1024]); in_g[j] = bf2f(lr[2048]); }
        }
#pragma unroll
        for (int j = 0; j < PF; ++j) {
            const float r_t = c_r[j] + (prev_r - c_r[j]) * mu_r, k_t = c_k[j] + (prev_k - c_k[j]) * mu_k, v_t = c_v[j] + (prev_v - c_v[j]) * mu_v;
            prev_r = c_r[j]; prev_k = c_k[j]; prev_v = c_v[j];
            const float a = c_a[j];
            const float kkr = k_t * kkc; const float n2 = wave_sum(kkr * kkr); const float kk = kkr * (1.0f / fmaxf(sqrtf(n2), 1e-12f));
            const float kp = k_t * (1.0f + (a - 1.0f) * kac); const float w = __expf(c_ld[j]); const float bb = kk * a;
            vec[lane] = -kk; vec[64 + lane] = w; vec[128 + lane] = bb; vec[192 + lane] = kp; vec[256 + lane] = r_t;
            LDS_WAIT(); asm volatile("" ::: "memory");
            f32x4 sa4 = (f32x4){0.f, 0.f, 0.f, 0.f};
#pragma unroll
            for (int k = 0; k < 16; ++k) { sa4 += S4[k] * vec4[k]; if ((k & 3) == 3) asm volatile("" ::: "memory"); }
            const float sa = (sa4.x + sa4.y) + (sa4.z + sa4.w);
            f32x4 y4 = (f32x4){0.f, 0.f, 0.f, 0.f};
#pragma unroll
            for (int k = 0; k < 16; ++k) {
                const f32x4 wv = vec4[16 + k], bv = vec4[32 + k], kv = vec4[48 + k], rv = vec4[64 + k];
                S4[k] = S4[k] * wv + bv * sa + kv * v_t; y4 += S4[k] * rv;
                if (k & 1) asm volatile("" ::: "memory"); }
            const float y = (y4.x + y4.y) + (y4.z + y4.w);
            const float mean = wave_sum(y) * (1.0f / 64.0f); const float dv = y - mean; const float var = wave_sum(dv * dv) * (1.0f / 64.0f);
            const float yn = dv * rsqrtf(var + GN_EPS) * lnw + lnb;
            const float bonus = wave_sum(r_t * kp * rkc) * v_t;
            const float o = (yn + bonus) * c_g[j];
            Y[((size_t)b * SEQ + tb + j) * DM + 1024 + ch] = (bf16_t)f2bf(o);
            asm volatile("" ::: "memory");
        }
    }
}


namespace rw {
constexpr int TP = 72, TILE_B = 64 * TP * 2;
enum { T_ATM = 0, T_RTM, T_BTM, T_KTM, T_ACM, T_VCM, T_BCM, T_KCM, T_MAB, T_MAK, T_MRB, T_MRK, T_TINV, NTILE };
constexpr int T_G1 = T_ATM, T_AP = T_BTM, T_U0 = T_KTM;
constexpr int OFF_X11T = NTILE * TILE_B, OFF_T1T = OFF_X11T + 2560, OFF_SEG = OFF_T1T + 2560, OFF_PC = OFF_SEG + 2048, LDS_END = OFF_PC + 256;
static_assert(LDS_END <= RING_BYTES, "rwkv pass A LDS");
__device__ __forceinline__ int crow(int e, int h) { return (e & 3) + 8 * (e >> 2) + 4 * h; }
__device__ __forceinline__ f32x16 zero16() { return (f32x16){0.f, 0.f, 0.f, 0.f, 0.f, 0.f, 0.f, 0.f, 0.f, 0.f, 0.f, 0.f, 0.f, 0.f, 0.f, 0.f}; }
template <int KS>
__device__ __forceinline__ f32x16 mmt(const LAS bf16_t* A, int ap, int ar0, int ac0, const LAS bf16_t* B, int bp, int br0, int bc0, f32x16 acc, int r, int h) {
    const LAS bf16_t* pa = A + (ar0 + r) * ap + ac0 + 8 * h; const LAS bf16_t* pb = B + (br0 + r) * bp + bc0 + 8 * h;
#pragma unroll
    for (int s = 0; s < KS; ++s) acc = __builtin_amdgcn_mfma_f32_32x32x16_bf16(*(const LAS bf16x8*)(pa + 16 * s), *(const LAS bf16x8*)(pb + 16 * s), acc, 0, 0, 0);
    return acc;
}
__device__ __forceinline__ void store_rm(LAS bf16_t* D, int r0, int c0, const f32x16& acc, int r, int h) {
#pragma unroll
    for (int e = 0; e < 16; ++e) D[(r0 + crow(e, h)) * TP + c0 + r] = (bf16_t)f2bf(acc[e]);
}
__device__ __forceinline__ u32x4 pack8(const f32x16& a, int s) { u32x4 w; w.x = pk2(a[8 * s], a[8 * s + 1]); w.y = pk2(a[8 * s + 2], a[8 * s + 3]); w.z = pk2(a[8 * s + 4], a[8 * s + 5]); w.w = pk2(a[8 * s + 6], a[8 * s + 7]); return w; }
__device__ __forceinline__ void unpack8(const u32x4 w, f32x16& a, int s) { a[8 * s] = bflo(w.x); a[8 * s + 1] = bfhi(w.x); a[8 * s + 2] = bflo(w.y); a[8 * s + 3] = bfhi(w.y); a[8 * s + 4] = bflo(w.z); a[8 * s + 5] = bfhi(w.z); a[8 * s + 6] = bflo(w.w); a[8 * s + 7] = bfhi(w.w); }
__device__ __forceinline__ unsigned char* l3_slot(unsigned char* l3, int tg0, int col0, int bo) { return l3 + ((size_t)(tg0 + (bo >> 7)) * NL + col0) * 2 + (bo & 127); }

__device__ __forceinline__ void pass_a(Frame& F) {
    const int lane = F.lane, wave = F.wave, r = lane & 31, h = lane >> 5;
    LAS bf16_t* tiles = (LAS bf16_t*)F.lds;
#define TL(i) (tiles + (i) * (TILE_B / 2))
    LAS bf16_t* X11T = (LAS bf16_t*)(F.lds + OFF_X11T); LAS bf16_t* T1T = (LAS bf16_t*)(F.lds + OFF_T1T);
    LAS float* seg = (LAS float*)(F.lds + OFF_SEG); LAS float* pc = (LAS float*)(F.lds + OFF_PC);
    const bf16_t* P = (const bf16_t*)(F.ws + WS_P); unsigned char* L3 = F.ws + WS_L3;
    bf16_t* MT = (bf16_t*)(F.ws + WS_MT); bf16_t* SA = (bf16_t*)(F.ws + WS_SA); float* BON = (float*)(F.ws + WS_BON);
    const float* mix = F.in[I_MIX];
    struct Raw { float pr, pk, pv, cr[8], ck[8], cv[8], l[8], a[8]; };
    auto load_raw = [&](int unit, Raw& w) {
        const int b = unit >> 10, hd = (unit >> 6) & 15, ci = unit & 63, tg0 = b * SEQ + ci * 64, ch = hd * 64 + lane;
        const bf16_t* p0 = P + (size_t)(tg0 + 8 * wave) * NP + ch; const bf16_t* l0 = (const bf16_t*)L3 + (size_t)(tg0 + 8 * wave) * NL + ch;
        if (ci == 0 && wave == 0) { w.pr = 0.f; w.pk = 0.f; w.pv = 0.f; } else { w.pr = bf2f(p0[PR - NP]); w.pk = bf2f(p0[PKR - NP]); w.pv = bf2f(p0[PVR - NP]); }
#pragma unroll
        for (int j = 0; j < 8; ++j) { w.cr[j] = bf2f(p0[(size_t)j * NP + PR]); w.ck[j] = bf2f(p0[(size_t)j * NP + PKR]); w.cv[j] = bf2f(p0[(size_t)j * NP + PVR]);
            w.l[j] = bf2f(l0[(size_t)j * NL]); w.a[j] = bf2f(l0[(size_t)j * NL + 1024]); }
    };
    Raw cur;
    if (F.vcu < 4096) load_raw(F.vcu, cur);
    for (int unit = F.vcu; unit < 4096; unit += F.G) {
        const int b = unit >> 10, hd = (unit >> 6) & 15, ci = unit & 63, tg0 = b * SEQ + ci * 64;
        Raw nxt;
        {
            const int c = lane, ch = hd * 64 + c, sg = wave;
            const float mu_r = mix[ch], mu_k = mix[1088 + ch], mu_v = mix[2112 + ch];
            const float kkc = F.in[I_KK][ch], kac = F.in[I_KA][ch], rkc = F.in[I_RK][ch];
            float pr = cur.pr, pk = cur.pk, pv = cur.pv;
            float rr[8], kp[8], vv[8], kk[8], bb[8], ld[8], cl[8];
            float run = 0.f;
#pragma unroll
            for (int j = 0; j < 8; ++j) {
                const float cr = cur.cr[j], ck = cur.ck[j], cv = cur.cv[j];
                const float l = cur.l[j], a = cur.a[j];
                const float r_t = cr + (pr - cr) * mu_r, k_t = ck + (pk - ck) * mu_k, v_t = cv + (pv - cv) * mu_v; pr = cr; pk = ck; pv = cv;
                const float kkr = k_t * kkc; const float n2 = wave_sum(kkr * kkr); const float kkn = kkr * __builtin_amdgcn_rsqf(fmaxf(n2, 1e-24f));
                const float kpp = k_t * (1.0f + (a - 1.0f) * kac);
                const float bon = wave_sum(r_t * kpp * rkc);
                if (lane == 0) BON[(size_t)(tg0 + 8 * sg + j) * 16 + hd] = bon;
                run += l; rr[j] = r_t; kp[j] = kpp; vv[j] = v_t; kk[j] = kkn; bb[j] = kkn * a; ld[j] = l; cl[j] = run;
            }
            seg[sg * 64 + c] = run;
            __syncthreads();
            float off = 0.f, tot = 0.f;
#pragma unroll
            for (int q = 0; q < 8; ++q) { const float v = seg[q * 64 + c]; tot += v; off += (q < sg) ? v : 0.f; }
            if (sg == 0) pc[c] = __expf(tot);
            float ta[8], tr[8], tb[8], tk[8];
#pragma unroll
            for (int j = 0; j < 8; ++j) { const float lp = off + cl[j]; const float ep = __expf(lp), em = __builtin_amdgcn_rcpf(ep), epm = __expf(lp - ld[j]);
                ta[j] = -kk[j] * epm; tr[j] = rr[j] * ep; tb[j] = bb[j] * em; tk[j] = kp[j] * em; }
#pragma unroll
            for (int j = 0; j < 8; ++j) { const int o = (8 * sg + j) * TP + c;
                TL(T_ATM)[o] = (bf16_t)f2bf(ta[j]); TL(T_RTM)[o] = (bf16_t)f2bf(tr[j]); TL(T_BTM)[o] = (bf16_t)f2bf(tb[j]); TL(T_KTM)[o] = (bf16_t)f2bf(tk[j]); }
            { const int o = c * TP + 8 * sg;
              *(LAS u32x4*)(TL(T_ACM) + o) = (u32x4){pk2(ta[0], ta[1]), pk2(ta[2], ta[3]), pk2(ta[4], ta[5]), pk2(ta[6], ta[7])};
              *(LAS u32x4*)(TL(T_VCM) + o) = (u32x4){pk2(vv[0], vv[1]), pk2(vv[2], vv[3]), pk2(vv[4], vv[5]), pk2(vv[6], vv[7])};
              *(LAS u32x4*)(TL(T_BCM) + o) = (u32x4){pk2(tb[0], tb[1]), pk2(tb[2], tb[3]), pk2(tb[4], tb[5]), pk2(tb[6], tb[7])};
              *(LAS u32x4*)(TL(T_KCM) + o) = (u32x4){pk2(tk[0], tk[1]), pk2(tk[2], tk[3]), pk2(tk[4], tk[5]), pk2(tk[6], tk[7])}; }
        }
        __syncthreads();
#pragma unroll
        for (int q = 0; q < 2; ++q) {
            const int id = 2 * wave + q, rt = id >> 2, ct = id & 3;
            const LAS bf16_t* Z = (rt < 2) ? TL(T_ATM) : TL(T_RTM); const LAS bf16_t* X = (ct < 2) ? TL(T_BTM) : TL(T_KTM);
            LAS bf16_t* D = (rt < 2) ? ((ct < 2) ? TL(T_MAB) : TL(T_MAK)) : ((ct < 2) ? TL(T_MRB) : TL(T_MRK));
            const int zr0 = (rt & 1) * 32, xr0 = (ct & 1) * 32; const bool strict = rt < 2;
            f32x16 acc = zero16();
            if (xr0 <= zr0) acc = mmt<4>(Z, TP, zr0, 0, X, TP, xr0, 0, acc, r, h);
#pragma unroll
            for (int e = 0; e < 16; ++e) { const int t = zr0 + crow(e, h), i = xr0 + r; const bool keep = strict ? (i < t) : (i <= t); D[t * TP + i] = keep ? (bf16_t)f2bf(acc[e]) : (bf16_t)0; }
            if (rt < 2 && ct < 2 && zr0 == xr0) {
                LAS bf16_t* LT = zr0 ? T1T : X11T;
#pragma unroll
                for (int g = 0; g < 4; ++g) { float v[4];
#pragma unroll
                    for (int k = 0; k < 4; ++k) v[k] = (r < crow(4 * g + k, h)) ? acc[4 * g + k] : 0.f;
                    *(LAS u32x2*)(LT + r * 40 + 8 * g + 4 * h) = (u32x2){pk2(v[0], v[1]), pk2(v[2], v[3])}; }
            }
        }
        __syncthreads();
        if (unit + F.G < 4096) load_raw(unit + F.G, nxt); else nxt = cur;
        if (wave < 2) {
            const LAS bf16_t* Lm = TL(T_MAB); LAS bf16_t* TI = TL(T_TINV);
            const int o = 32 * wave;
            LAS bf16_t* Pt = (wave ? TL(T_U0) : TL(T_AP)); LAS bf16_t* Ss = Pt + 1280; LAS bf16_t* STs = Pt + 2560;
            f32x16 accP;
#pragma unroll
            for (int e = 0; e < 16; ++e) { accP[e] = (crow(e, h) == r) ? 1.0f : 0.0f; Pt[crow(e, h) * 40 + r] = (crow(e, h) == r) ? (bf16_t)0x3F80 : (bf16_t)0; }
            LDS_WAIT(); asm volatile("" ::: "memory");
            const LAS bf16_t* Sa = Lm + o * TP + o; int sap = TP;
            const LAS bf16_t* Sb = wave ? T1T : X11T; int sbp = 40;
#pragma unroll
            for (int k = 0; k < 5; ++k) {
                accP = mmt<2>(Pt, 40, 0, 0, Sb, sbp, 0, 0, accP, r, h);
                f32x16 accS = zero16();
                if (k < 4) accS = mmt<2>(Sa, sap, 0, 0, Sb, sbp, 0, 0, accS, r, h);
                LDS_WAIT(); asm volatile("" ::: "memory");
#pragma unroll
                for (int e = 0; e < 16; ++e) Pt[crow(e, h) * 40 + r] = (bf16_t)f2bf(accP[e]);
                if (k < 4) {
#pragma unroll
                    for (int e = 0; e < 16; ++e) Ss[crow(e, h) * 40 + r] = (bf16_t)f2bf(accS[e]);
#pragma unroll
                    for (int g = 0; g < 4; ++g) *(LAS u32x2*)(STs + r * 40 + 8 * g + 4 * h) = (u32x2){pk2(accS[4 * g], accS[4 * g + 1]), pk2(accS[4 * g + 2], accS[4 * g + 3])};
                    Sa = Ss; sap = 40; Sb = STs; sbp = 40;
                }
                LDS_WAIT(); asm volatile("" ::: "memory");
            }
            store_rm(TI, o, o, accP, r, h);
            if (wave == 0) {
#pragma unroll
                for (int e = 0; e < 16; ++e) TI[crow(e, h) * TP + 32 + r] = (bf16_t)0;
#pragma unroll
                for (int g = 0; g < 4; ++g) *(LAS u32x2*)(X11T + r * 40 + 8 * g + 4 * h) = (u32x2){pk2(accP[4 * g], accP[4 * g + 1]), pk2(accP[4 * g + 2], accP[4 * g + 3])};
                LDS_WAIT(); asm volatile("" ::: "memory");
                f32x16 t1 = mmt<2>(Lm, TP, 32, 0, X11T, 40, 0, 0, zero16(), r, h);
#pragma unroll
                for (int g = 0; g < 4; ++g) *(LAS u32x2*)(Ss + r * 40 + 8 * g + 4 * h) = (u32x2){pk2(t1[4 * g], t1[4 * g + 1]), pk2(t1[4 * g + 2], t1[4 * g + 3])};
            }
        } else if (wave >= 4) {
            const int mi = (wave - 4) >> 1, ni = (wave - 4) & 1;
            f32x16 acc = mmt<4>(TL(T_VCM), TP, 32 * mi, 0, TL(T_MAK), TP, 32 * ni, 0, zero16(), r, h);
            store_rm(TL(T_G1), 32 * mi, 32 * ni, acc, r, h);
        }
        __syncthreads();
        if (wave == 0) {
            LAS bf16_t* TI = TL(T_TINV);
            f32x16 x21 = mmt<2>(TI, TP, 32, 32, TL(T_AP) + 1280, 40, 0, 0, zero16(), r, h);
            store_rm(TI, 32, 0, x21, r, h);
        }
        __syncthreads();
        {
            const int w4 = wave & 3, mi = w4 >> 1, ni = w4 & 1;
            if (wave < 4) { f32x16 acc = mmt<4>(TL(T_ACM), TP, 32 * mi, 0, TL(T_TINV), TP, 32 * ni, 0, zero16(), r, h); store_rm(TL(T_AP), 32 * mi, 32 * ni, acc, r, h); }
            else { f32x16 acc = mmt<4>(TL(T_G1), TP, 32 * mi, 0, TL(T_TINV), TP, 32 * ni, 0, zero16(), r, h); store_rm(TL(T_U0), 32 * mi, 32 * ni, acc, r, h); }
        }
        __syncthreads();
#pragma unroll
        for (int q = 0; q < 2; ++q) {
            const int id = 2 * wave + q, typ = id >> 2, xx = (id >> 1) & 1, yy = id & 1;
            if (typ == 0) {
                f32x16 acc = mmt<4>(TL(T_AP), TP, 32 * xx, 0, TL(T_MRB), TP, 32 * yy, 0, zero16(), r, h);
#pragma unroll
                for (int g = 0; g < 4; ++g) { const u32x2 w = *(const LAS u32x2*)(TL(T_RTM) + (32 * yy + r) * TP + 32 * xx + 8 * g + 4 * h);
                    acc[4 * g] += bflo(w.x); acc[4 * g + 1] += bfhi(w.x); acc[4 * g + 2] += bflo(w.y); acc[4 * g + 3] += bfhi(w.y); }
#pragma unroll
                for (int s = 0; s < 2; ++s) *(u32x4*)l3_slot(L3, tg0, hd * 64, (((xx * 2 + s) * 2 + yy) * 64 + lane) * 16) = pack8(acc, s);
            } else if (typ == 1) {
                f32x16 acc = mmt<4>(TL(T_U0), TP, 32 * xx, 0, TL(T_MRB), TP, 32 * yy, 0, zero16(), r, h);
                acc = mmt<4>(TL(T_VCM), TP, 32 * xx, 0, TL(T_MRK), TP, 32 * yy, 0, acc, r, h);
#pragma unroll
                for (int s = 0; s < 2; ++s) *(u32x4*)l3_slot(L3, tg0, 1024 + hd * 64, ((xx * 2 + yy) * 64 + lane) * 32 + 16 * s) = pack8(acc, s);
            } else if (typ == 2) {
                f32x16 acc = mmt<4>(TL(T_AP), TP, 32 * xx, 0, TL(T_BCM), TP, 32 * yy, 0, zero16(), r, h);
                const float pcc = pc[32 * yy + r];
#pragma unroll
                for (int e = 0; e < 16; ++e) acc[e] = (acc[e] + ((32 * xx + crow(e, h) == 32 * yy + r) ? 1.0f : 0.0f)) * pcc;
#pragma unroll
                for (int s = 0; s < 2; ++s) *(u32x4*)(MT + (size_t)unit * 4096 + (((yy * 2 + xx) * 2 + s) * 64 + lane) * 8) = pack8(acc, s);
            } else {
                f32x16 acc = mmt<4>(TL(T_BCM), TP, 32 * xx, 0, TL(T_U0), TP, 32 * yy, 0, zero16(), r, h);
                acc = mmt<4>(TL(T_KCM), TP, 32 * xx, 0, TL(T_VCM), TP, 32 * yy, 0, acc, r, h);
#pragma unroll
                for (int e = 0; e < 16; ++e) acc[e] *= pc[32 * xx + crow(e, h)];
#pragma unroll
                for (int s = 0; s < 2; ++s) *(u32x4*)(SA + (size_t)unit * 4096 + ((yy * 2 + xx) * 64 + lane) * 16 + 8 * s) = pack8(acc, s);
            }
        }
        __syncthreads();
        cur = nxt;
    }
#undef TL
}

struct PbSet { bf16x8 A[8]; u32x4 S[4]; };
__device__ __forceinline__ void pb_load(PbSet& d, const bf16_t* MT, const bf16_t* SA, int c, int lane) {
    const int cc = c < 64 ? c : 63;
    const char* mb = (const char*)MT + (size_t)cc * 8192; const char* sb = (const char*)SA + (size_t)cc * 8192;
    const unsigned lo16 = (unsigned)lane * 16u, lo32 = (unsigned)lane * 32u;
#pragma unroll
    for (int f = 0; f < 8; ++f) d.A[f] = *(const bf16x8*)(mb + lo16 + f * 1024);
#pragma unroll
    for (int q = 0; q < 4; ++q) d.S[q] = *(const u32x4*)(sb + lo32 + (q >> 1) * 2048 + 16 * (q & 1));
}
__device__ __forceinline__ void pb_step(const PbSet& d, f32x16 (&X)[2], bf16_t* SA, int c, int lane, const bool dry) {
    bf16x8 Bf[4];
#pragma unroll
    for (int kt = 0; kt < 2; ++kt)
#pragma unroll
        for (int s = 0; s < 2; ++s) { const u32x4 w = pack8(X[kt], s); Bf[kt * 2 + s] = __builtin_bit_cast(bf16x8, w); if (!dry) *(u32x4*)((char*)SA + (size_t)c * 8192 + (unsigned)lane * 16u + (kt * 2 + s) * 1024) = w; }
    f32x16 D[2];
#pragma unroll
    for (int ip = 0; ip < 2; ++ip) { unpack8(d.S[2 * ip], D[ip], 0); unpack8(d.S[2 * ip + 1], D[ip], 1);
#pragma unroll
        for (int ks = 0; ks < 4; ++ks) D[ip] = __builtin_amdgcn_mfma_f32_32x32x16_bf16(d.A[ip * 4 + ks], Bf[ks], D[ip], 0, 0, 0); }
    X[0] = D[0]; X[1] = D[1];
}
__device__ __forceinline__ void pass_b(Frame& F, int bh, int j, const bool dry, const int part) {
    const int lane = F.lane;
    const bf16_t* MT = (const bf16_t*)(F.ws + WS_MT) + (size_t)bh * 64 * 4096; bf16_t* SA = (bf16_t*)(F.ws + WS_SA) + (size_t)bh * 64 * 4096 + j * 2048;
    f32x4* XS = (f32x4*)(F.ws + WS_XS) + (size_t)(bh * 2 + j) * 512 + lane * 8;
    f32x16 X[2] = {zero16(), zero16()};
    const int c0 = part ? 33 : 0, c1 = part ? 63 : 33;
    if (part) {
#pragma unroll
        for (int q = 0; q < 8; ++q) { const f32x4 v = XS[q]; X[q >> 2][4 * (q & 3)] = v.x; X[q >> 2][4 * (q & 3) + 1] = v.y; X[q >> 2][4 * (q & 3) + 2] = v.z; X[q >> 2][4 * (q & 3) + 3] = v.w; }
    }
    PbSet s0, s1, s2;
    pb_load(s0, MT, SA, c0, lane); pb_load(s1, MT, SA, c0 + 1, lane);
    for (int c = c0; c < c1; c += 3) {
        pb_load(s2, MT, SA, c + 2, lane); pb_step(s0, X, SA, c, lane, dry);
        pb_load(s0, MT, SA, c + 3, lane); pb_step(s1, X, SA, c + 1, lane, dry);
        pb_load(s1, MT, SA, c + 4, lane); pb_step(s2, X, SA, c + 2, lane, dry);
    }
    if (part) pb_step(s0, X, SA, 63, lane, dry);
    else if (!dry) {
#pragma unroll
        for (int q = 0; q < 8; ++q) XS[q] = (f32x4){X[q >> 2][4 * (q & 3)], X[q >> 2][4 * (q & 3) + 1], X[q >> 2][4 * (q & 3) + 2], X[q >> 2][4 * (q & 3) + 3]};
    }
}

__device__ __forceinline__ void pass_b_block(Frame& F, int bh, const bool dry) {
    const int lane = F.lane, wave = F.wave;
    const unsigned char* MTg = F.ws + WS_MT + (size_t)bh * 64 * 8192; unsigned char* SAg = F.ws + WS_SA + (size_t)bh * 64 * 8192;
    constexpr int DEP = 6;
#define PB_ISSUE(c_) do { const int cc_ = (c_) < 64 ? (c_) : 63; const int sl_ = (c_) & 7; _Pragma("unroll") for (int q = 0; q < 4; ++q) { const int p_ = 4 * (wave - 4) + q; \
        const unsigned char* src_ = (p_ < 8 ? MTg + (size_t)cc_ * 8192 + p_ * 1024 : SAg + (size_t)cc_ * 8192 + (p_ - 8) * 1024) + lane * 16; \
        __builtin_amdgcn_global_load_lds((const unsigned*)src_, (LAS unsigned*)(F.lds + sl_ * 16384 + p_ * 1024), 16, 0, 0); } } while (0)
    if (wave >= 4) {
#pragma unroll
        for (int c = 0; c < DEP; ++c) PB_ISSUE(c);
        asm volatile("s_waitcnt vmcnt(20)" ::: "memory");
    }
    asm volatile("s_waitcnt lgkmcnt(0)\n\ts_barrier" ::: "memory");
    f32x16 X[2] = {zero16(), zero16()};
    for (int c = 0; c < 64; ++c) {
        if (wave >= 4) { PB_ISSUE(c + DEP); asm volatile("s_waitcnt vmcnt(20)" ::: "memory"); }
        if (wave < 2) {
            const int j = wave;
            const LAS unsigned char* base = F.lds + (c & 7) * 16384;
            bf16x8 Af[8]; u32x4 Sd[4];
#pragma unroll
            for (int f = 0; f < 8; ++f) Af[f] = *(const LAS bf16x8*)(base + f * 1024 + lane * 16);
#pragma unroll
            for (int q = 0; q < 4; ++q) Sd[q] = *(const LAS u32x4*)(base + 8192 + j * 4096 + (q >> 1) * 2048 + lane * 32 + 16 * (q & 1));
            bf16x8 Bf[4];
#pragma unroll
            for (int kt = 0; kt < 2; ++kt)
#pragma unroll
                for (int s2 = 0; s2 < 2; ++s2) { const u32x4 w = pack8(X[kt], s2); Bf[kt * 2 + s2] = __builtin_bit_cast(bf16x8, w);
                    if (!dry) *(u32x4*)(SAg + (size_t)c * 8192 + j * 4096 + (kt * 2 + s2) * 1024 + lane * 16) = w; }
            f32x16 D[2];
#pragma unroll
            for (int ip = 0; ip < 2; ++ip) { unpack8(Sd[2 * ip], D[ip], 0); unpack8(Sd[2 * ip + 1], D[ip], 1);
#pragma unroll
                for (int ks = 0; ks < 4; ++ks) D[ip] = __builtin_amdgcn_mfma_f32_32x32x16_bf16(Af[ip * 4 + ks], Bf[ks], D[ip], 0, 0, 0); }
            X[0] = D[0]; X[1] = D[1];
        }
        asm volatile("s_waitcnt lgkmcnt(0)\n\ts_barrier" ::: "memory");
    }
#undef PB_ISSUE
    asm volatile("s_waitcnt vmcnt(0)" ::: "memory");
    __syncthreads();
}

__device__ __forceinline__ void pass_c(Frame& F) {
    const int lane = F.lane, r = lane & 31, h = lane >> 5;
    const int gw = F.vcu * 8 + F.wave, NGW = F.G * 8;
    const bf16_t* P = (const bf16_t*)(F.ws + WS_P); unsigned char* L3 = F.ws + WS_L3; const bf16_t* SA = (const bf16_t*)(F.ws + WS_SA); const float* BON = (const float*)(F.ws + WS_BON);
    bf16_t* Y = (bf16_t*)(F.ws + WS_YCAT); const float* mix = F.in[I_MIX];
    LAS float* cst = (LAS float*)F.lds;
    for (int i = F.tid; i < 1024; i += 512) { cst[i] = mix[2112 + i]; cst[1024 + i] = F.in[I_LNW][i]; cst[2048 + i] = F.in[I_LNB][i]; }
    __syncthreads();
    LAS bf16_t* wt = (LAS bf16_t*)(F.lds + 12288 + F.wave * 9472);
    const int lrow = lane >> 3, lpc = (lane & 7) * 8;
    for (int unit = gw; unit < 4096; unit += NGW) {
        const int b = unit >> 10, hd = (unit >> 6) & 15, ci = unit & 63, tg0 = b * SEQ + ci * 64;
        bf16x8 Af[8], Bf[8];
#pragma unroll
        for (int f = 0; f < 8; ++f) Af[f] = *(const bf16x8*)(SA + (size_t)unit * 4096 + (f * 64 + lane) * 8);
#pragma unroll
        for (int f = 0; f < 8; ++f) Bf[f] = *(const bf16x8*)l3_slot(L3, tg0, hd * 64, (f * 64 + lane) * 16);
        f32x16 acc[2][2];
#pragma unroll
        for (int j = 0; j < 2; ++j)
#pragma unroll
            for (int tt = 0; tt < 2; ++tt) {
#pragma unroll
                for (int s = 0; s < 2; ++s) unpack8(*(const u32x4*)l3_slot(L3, tg0, 1024 + hd * 64, ((j * 2 + tt) * 64 + lane) * 32 + 16 * s), acc[j][tt], s);
#pragma unroll
                for (int ks = 0; ks < 4; ++ks) acc[j][tt] = __builtin_amdgcn_mfma_f32_32x32x16_bf16(Af[j * 4 + ks], Bf[ks * 2 + tt], acc[j][tt], 0, 0, 0);
            }
        asm volatile("" ::: "memory");
        u32x4 vr[9];
        { const bf16_t* vp = P + (size_t)(tg0 - 1 + lrow) * NP + PVR + hd * 64 + lpc;
#pragma unroll
          for (int it = 0; it < 9; ++it) { const int row = 8 * it + lrow; vr[it] = (u32x4){0u, 0u, 0u, 0u};
              if (row < 65 && (row > 0 || ci > 0)) vr[it] = *(const u32x4*)vp;
              vp += 8 * NP; asm volatile("" : "+v"(vp)); } }
        u32x4 gr[8];
        { const bf16_t* gp = (const bf16_t*)L3 + (size_t)(tg0 + lrow) * NL + 2048 + hd * 64 + lpc;
#pragma unroll
          for (int it = 0; it < 8; ++it) { gr[it] = *(const u32x4*)gp; gp += 8 * NL; asm volatile("" : "+v"(gp)); } }
        const float bon0 = BON[(size_t)(tg0 + r) * 16 + hd], bon1 = BON[(size_t)(tg0 + 32 + r) * 16 + hd];
#pragma unroll
        for (int it = 0; it < 9; ++it) { const int row = 8 * it + lrow; if (row < 65) *(LAS u32x4*)(wt + row * 72 + lpc) = vr[it]; }
        LDS_WAIT(); asm volatile("" ::: "memory");
        u32x2 cvq[2][8], pvq[2][8];
#pragma unroll
        for (int tt = 0; tt < 2; ++tt)
#pragma unroll
            for (int q = 0; q < 8; ++q) { const int v0 = 32 * (q >> 2) + 8 * (q & 3) + 4 * h; cvq[tt][q] = *(const LAS u32x2*)(wt + (1 + 32 * tt + r) * 72 + v0); pvq[tt][q] = *(const LAS u32x2*)(wt + (32 * tt + r) * 72 + v0); }
        LDS_WAIT(); asm volatile("" ::: "memory");
#pragma unroll
        for (int it = 0; it < 8; ++it) *(LAS u32x4*)(wt + (8 * it + lrow) * 72 + lpc) = gr[it];
        LDS_WAIT(); asm volatile("" ::: "memory");
#pragma unroll
        for (int tt = 0; tt < 2; ++tt) {
            float sm = 0.f;
#pragma unroll
            for (int e = 0; e < 16; ++e) sm += acc[0][tt][e] + acc[1][tt][e];
            sm += __shfl_xor(sm, 32); const float mean = sm * (1.0f / 64.0f);
            float sq = 0.f;
#pragma unroll
            for (int e = 0; e < 16; ++e) { const float d0 = acc[0][tt][e] - mean, d1 = acc[1][tt][e] - mean; sq += d0 * d0 + d1 * d1; }
            sq += __shfl_xor(sq, 32); const float rstd = rsqrtf(sq * (1.0f / 64.0f) + GN_EPS);
            const float bon = tt ? bon1 : bon0;
#pragma unroll
            for (int q = 0; q < 8; ++q) { const int j = q >> 2, g = q & 3; const int v0 = 32 * j + 8 * g + 4 * h, ch = hd * 64 + v0;
                const u32x2 cv = cvq[tt][q], pv = pvq[tt][q]; const u32x2 gg = *(const LAS u32x2*)(wt + (32 * tt + r) * 72 + v0);
                const f32x4 mu = *(const LAS f32x4*)(cst + ch), lw = *(const LAS f32x4*)(cst + 1024 + ch), lb = *(const LAS f32x4*)(cst + 2048 + ch);
                const float c0 = bflo(cv.x), c1 = bfhi(cv.x), c2 = bflo(cv.y), c3 = bfhi(cv.y);
                const float v_0 = c0 + (bflo(pv.x) - c0) * mu.x, v_1 = c1 + (bfhi(pv.x) - c1) * mu.y, v_2 = c2 + (bflo(pv.y) - c2) * mu.z, v_3 = c3 + (bfhi(pv.y) - c3) * mu.w;
                const float o0 = ((acc[j][tt][4 * g] - mean) * rstd * lw.x + lb.x + bon * v_0) * bflo(gg.x);
                const float o1 = ((acc[j][tt][4 * g + 1] - mean) * rstd * lw.y + lb.y + bon * v_1) * bfhi(gg.x);
                const float o2 = ((acc[j][tt][4 * g + 2] - mean) * rstd * lw.z + lb.z + bon * v_2) * bflo(gg.y);
                const float o3 = ((acc[j][tt][4 * g + 3] - mean) * rstd * lw.w + lb.w + bon * v_3) * bfhi(gg.y);
                *(LAS u32x2*)(wt + (32 * tt + r) * 72 + v0) = (u32x2){pk2(o0, o1), pk2(o2, o3)};
                asm volatile("" ::: "memory"); }
        }
        LDS_WAIT(); asm volatile("" ::: "memory");
#pragma unroll
        for (int it = 0; it < 8; ++it) *(u32x4*)(Y + (size_t)(tg0 + 8 * it + lrow) * DM + 1024 + hd * 64 + lpc) = *(const LAS u32x4*)(wt + (8 * it + lrow) * 72 + lpc);
        LDS_WAIT(); asm volatile("" ::: "memory");
    }
    __syncthreads();
}
}


namespace att {
using s16x4 = __attribute__((ext_vector_type(4))) short;
constexpr int D = 128, NW = 8, QBLK = 32, KVBLK = 64;
constexpr float THRL = 8.0f * 1.4426950408889634f;
constexpr size_t SHM_V = KVBLK * D * 2, SHM_K = KVBLK * D * 2, SHM_ATTN = 2 * SHM_V + 2 * SHM_K + NW * 64 * 4;
static_assert(SHM_ATTN <= RING_BYTES, "attention LDS");
#define KSWZ(row, colB) ((row) * 256 + ((colB) ^ (((row) & 7) << 4)))
#define SBAR() __builtin_amdgcn_sched_barrier(0)
__device__ __forceinline__ int crow(int r, int hi) { return (r & 3) + 8 * (r >> 2) + 4 * hi; }
__device__ __forceinline__ unsigned cvtpk(float lo, float hi) { unsigned r; asm volatile("v_cvt_pk_bf16_f32 %0, %1, %2" : "=v"(r) : "v"(lo), "v"(hi)); return r; }
__device__ __forceinline__ void partialSM(f32x16& p0, f32x16& p1, const u32x2 mk, float& m_reg, float& mn, float& alpha) {
#pragma unroll
  for (int r = 0; r < 16; ++r) { const int pos = (r & 3) + 8 * (r >> 2);
    const unsigned t0 = (unsigned)(((int)(mk.x << (31 - pos))) >> 31), t1 = (unsigned)(((int)(mk.y << (31 - pos))) >> 31);
    p0[r] = __uint_as_float((t0 & __float_as_uint(p0[r])) | (~t0 & 0xFF800000u)); p1[r] = __uint_as_float((t1 & __float_as_uint(p1[r])) | (~t1 & 0xFF800000u)); }
  float pmax = p0[0];
#pragma unroll
  for (int r = 1; r < 16; ++r) pmax = fmaxf(pmax, p0[r]);
#pragma unroll
  for (int r = 0; r < 16; ++r) pmax = fmaxf(pmax, p1[r]);
  { auto rr = __builtin_amdgcn_permlane32_swap(__float_as_uint(pmax), __float_as_uint(pmax), false, false);
    pmax = fmaxf(__uint_as_float(rr[0]), __uint_as_float(rr[1])); }
  if (__builtin_expect(__all(pmax - m_reg <= THRL), 1)) { mn = m_reg; alpha = 1.f; }
  else { mn = fmaxf(m_reg, pmax); alpha = __builtin_amdgcn_exp2f(m_reg - mn); m_reg = mn; }
#pragma unroll
  for (int r = 0; r < 16; ++r) { p0[r] = __builtin_amdgcn_exp2f(p0[r] - mn); p1[r] = p1[r] - mn; }
}
__device__ __forceinline__ void finishSM(f32x16& p0, f32x16& p1, float alpha, float& l_reg, bf16x8& pa0, bf16x8& pa1, bf16x8& pa2, bf16x8& pa3) {
#pragma unroll
  for (int r = 0; r < 16; ++r) p1[r] = __builtin_amdgcn_exp2f(p1[r]);
  float ps = 0;
#pragma unroll
  for (int r = 0; r < 16; ++r) ps += p0[r];
#pragma unroll
  for (int r = 0; r < 16; ++r) ps += p1[r];
  { auto rr = __builtin_amdgcn_permlane32_swap(__float_as_uint(ps), __float_as_uint(ps), false, false);
    ps = __uint_as_float(rr[0]) + __uint_as_float(rr[1]); }
  l_reg = l_reg * alpha + ps;
#define PK4(P, BASE, OUT) do { unsigned a0 = cvtpk(P[BASE + 0], P[BASE + 1]), a1 = cvtpk(P[BASE + 2], P[BASE + 3]);   \
    unsigned b0 = cvtpk(P[BASE + 4], P[BASE + 5]), b1 = cvtpk(P[BASE + 6], P[BASE + 7]);                              \
    auto r0 = __builtin_amdgcn_permlane32_swap(a0, b0, false, false); auto r1 = __builtin_amdgcn_permlane32_swap(a1, b1, false, false); \
    u32x4 w = {r0[0], r1[0], r0[1], r1[1]}; OUT = __builtin_bit_cast(bf16x8, w); } while (0)
  PK4(p0, 0, pa0); PK4(p0, 8, pa1); PK4(p1, 0, pa2); PK4(p1, 8, pa3);
#undef PK4
}
__device__ __forceinline__ void qkt(f32x16& p0, f32x16& p1, const char* Ks, const bf16x8* qr, int r32, int hi) {
  p0 = f32x16{}; p1 = f32x16{};
#pragma unroll
  for (int d0 = 0; d0 < 8; ++d0) { int cb = (d0 * 16 + hi * 8) * 2;
    bf16x8 b0 = *reinterpret_cast<const bf16x8*>(Ks + KSWZ(r32, cb));
    bf16x8 b1 = *reinterpret_cast<const bf16x8*>(Ks + KSWZ(32 + r32, cb));
    p0 = __builtin_amdgcn_mfma_f32_32x32x16_bf16(b0, qr[d0], p0, 0, 0, 0);
    p1 = __builtin_amdgcn_mfma_f32_32x32x16_bf16(b1, qr[d0], p1, 0, 0, 0); }
}
__device__ __forceinline__ int v_st(int k, int c) { const int kk = (k & ~0xC) | ((k & 4) << 1) | ((k & 8) >> 1); return ((kk >> 3) * 4 + (c >> 5)) * 512 + ((kk & 7) * 32 + (c & 31)) * 2; }
__device__ __forceinline__ int v_rd_base(int lane) { return ((lane & 3) << 3) | (((lane >> 2) & 3) << 6) | (((lane >> 4) & 1) << 5) | (((lane >> 5) & 1) << 8); }
constexpr int v_rd_off(int d0, int ks, int half) { return d0 * 512 + ks * 4096 + half * 2048; }
template <int OFF> __device__ __forceinline__ s16x4 tr_read(int vb) { s16x4 r; asm volatile("ds_read_b64_tr_b16 %0, %1 offset:%2" : "=&v"(r) : "v"(vb), "i"(OFF) : "memory"); return r; }
template <int D0> __device__ __forceinline__ void pv_one(f32x16& od, int vb, bf16x8 pa0, bf16x8 pa1, bf16x8 pa2, bf16x8 pa3) {
  const s16x4 l0 = tr_read<v_rd_off(D0, 0, 0)>(vb), h0 = tr_read<v_rd_off(D0, 0, 1)>(vb), l1 = tr_read<v_rd_off(D0, 1, 0)>(vb), h1 = tr_read<v_rd_off(D0, 1, 1)>(vb);
  const s16x4 l2 = tr_read<v_rd_off(D0, 2, 0)>(vb), h2 = tr_read<v_rd_off(D0, 2, 1)>(vb), l3 = tr_read<v_rd_off(D0, 3, 0)>(vb), h3 = tr_read<v_rd_off(D0, 3, 1)>(vb);
  asm volatile("s_waitcnt lgkmcnt(0)" ::: "memory"); SBAR();
#define PK(L, H) (bf16x8){L[0], L[1], L[2], L[3], H[0], H[1], H[2], H[3]}
  od = __builtin_amdgcn_mfma_f32_32x32x16_bf16(pa0, PK(l0, h0), od, 0, 0, 0);
  od = __builtin_amdgcn_mfma_f32_32x32x16_bf16(pa1, PK(l1, h1), od, 0, 0, 0);
  od = __builtin_amdgcn_mfma_f32_32x32x16_bf16(pa2, PK(l2, h2), od, 0, 0, 0);
  od = __builtin_amdgcn_mfma_f32_32x32x16_bf16(pa3, PK(l3, h3), od, 0, 0, 0);
#undef PK
}
__device__ __forceinline__ void pv_d0(f32x16* o, int vb, bf16x8 pa0, bf16x8 pa1, bf16x8 pa2, bf16x8 pa3) {
  pv_one<0>(o[0], vb, pa0, pa1, pa2, pa3); pv_one<1>(o[1], vb, pa0, pa1, pa2, pa3); pv_one<2>(o[2], vb, pa0, pa1, pa2, pa3); pv_one<3>(o[3], vb, pa0, pa1, pa2, pa3);
}
__device__ __forceinline__ void attn_unit(const bf16_t* __restrict__ Qb, const bf16_t* __restrict__ Kh, const bf16_t* __restrict__ Vh, const unsigned* __restrict__ Mb,
                                          bf16_t* __restrict__ Ob, int seq, char* lds) {
  constexpr int LDQ = NP, LDK = NP, LDO = DM;
  int tid_ = threadIdx.x; asm volatile("" : "+v"(tid_));
  const int tid = tid_, wid = tid >> 6, lane = tid & 63, r32 = lane & 31, hi = lane >> 5;
  char* V_lds = lds; char* K_lds = lds + 2 * SHM_V;
  float* wsf = (float*)(lds + 2 * SHM_V + 2 * SHM_K) + wid * 64; float* li_l = wsf; float* al_l = wsf + 32;
  float m_reg = -1e30f, l_reg = 0; f32x16 o[4] = {}; bf16x8 qr[8];
  const bf16_t* Qw = Qb + (long)(wid * QBLK + r32) * LDQ + hi * 8;
#pragma unroll
  for (int d0 = 0; d0 < 8; ++d0) qr[d0] = *reinterpret_cast<const bf16x8*>(Qw + d0 * 16);
  const unsigned* Mw = Mb + (long)(wid * QBLK + r32) * 128;
  const int sh = 4 * hi;
  const int sr = tid >> 4, sc = (tid & 15) * 8, vst0 = v_st(sr, sc), vst1 = v_st(32 + sr, sc);
  const int vb0 = (int)(uintptr_t)V_lds + v_rd_base(lane);
  struct { bf16x8 vs0, vs1, ks0, ks1; } sr_[2];
#define SLOAD(i, k0) do { sr_[i].vs0 = *(const bf16x8*)(&Vh[(long)((k0) + sr) * LDK + sc]); sr_[i].vs1 = *(const bf16x8*)(&Vh[(long)((k0) + 32 + sr) * LDK + sc]); \
    sr_[i].ks0 = *(const bf16x8*)(&Kh[(long)((k0) + sr) * LDK + sc]); sr_[i].ks1 = *(const bf16x8*)(&Kh[(long)((k0) + 32 + sr) * LDK + sc]); } while (0)
#define SWRITE(b, i) do { *(bf16x8*)(V_lds + (b) * SHM_V + vst0) = sr_[i].vs0;          \
    *(bf16x8*)(V_lds + (b) * SHM_V + vst1) = sr_[i].vs1; int kc = sc * 2;               \
    *(bf16x8*)(K_lds + (b) * SHM_K + KSWZ(sr, kc)) = sr_[i].ks0;                       \
    *(bf16x8*)(K_lds + (b) * SHM_K + KSWZ(32 + sr, kc)) = sr_[i].ks1; } while (0)
#define SWAIT() asm volatile("s_waitcnt vmcnt(4)" ::: "memory")
#define RESC(a) do { if (__any((a) < 1.f)) { if (hi == 0) al_l[r32] = (a); asm volatile("s_waitcnt lgkmcnt(0)" ::: "memory"); \
    _Pragma("unroll") for (int d = 0; d < 4; ++d) _Pragma("unroll") for (int r = 0; r < 16; ++r) o[d][r] *= al_l[crow(r, hi)]; } } while (0)
#define MLOAD(j) ({ u32x2 _m = *(const u32x2*)(Mw + 2 * (j)); _m.x >>= sh; _m.y >>= sh; _m; })
  f32x16 pA0, pA1, pB0, pB1; float mnA, mnB, alA, alB; bf16x8 pa0, pa1, pa2, pa3; const int NT = seq / KVBLK;
  constexpr int SE = 0, SO = 1;
  u32x2 mkA = MLOAD(0), mkB = MLOAD(1);
  SLOAD(SE, 0); asm volatile("s_waitcnt vmcnt(0)" ::: "memory"); SWRITE(0, SE); __syncthreads();
  qkt(pA0, pA1, K_lds, qr, r32, hi); partialSM(pA0, pA1, mkA, m_reg, mnA, alA);
  SLOAD(SO, KVBLK); if (2 < NT) SLOAD(SE, 2 * KVBLK);
  SWAIT(); SWRITE(1, SO); __syncthreads();
  for (int j = 1; j + 1 < NT; j += 2) {
    mkA = MLOAD(j + 1);
    SBAR(); qkt(pB0, pB1, K_lds + SHM_K, qr, r32, hi);
    finishSM(pA0, pA1, alA, l_reg, pa0, pa1, pa2, pa3); SBAR();
    SLOAD(SO, (j + 2) * KVBLK); SBAR();
    pv_d0(o, vb0, pa0, pa1, pa2, pa3); partialSM(pB0, pB1, mkB, m_reg, mnB, alB);
    __syncthreads(); SWAIT(); SWRITE(0, SE);
    RESC(alB); __syncthreads();
    mkB = MLOAD(j + 2);
    SBAR(); qkt(pA0, pA1, K_lds, qr, r32, hi);
    finishSM(pB0, pB1, alB, l_reg, pa0, pa1, pa2, pa3); SBAR();
    if (j + 3 < NT) SLOAD(SE, (j + 3) * KVBLK); SBAR();
    pv_d0(o, vb0 + (int)SHM_V, pa0, pa1, pa2, pa3); partialSM(pA0, pA1, mkA, m_reg, mnA, alA);
    __syncthreads(); SWAIT(); SWRITE(1, SO);
    RESC(alA); __syncthreads();
  }
  SBAR(); qkt(pB0, pB1, K_lds + SHM_K, qr, r32, hi);
  finishSM(pA0, pA1, alA, l_reg, pa0, pa1, pa2, pa3); SBAR();
  pv_d0(o, vb0, pa0, pa1, pa2, pa3); partialSM(pB0, pB1, mkB, m_reg, mnB, alB);
  __syncthreads(); RESC(alB);
  finishSM(pB0, pB1, alB, l_reg, pa0, pa1, pa2, pa3); SBAR();
  pv_d0(o, vb0 + (int)SHM_V, pa0, pa1, pa2, pa3);
  if (hi == 0) li_l[r32] = l_reg; asm volatile("s_waitcnt lgkmcnt(0)" ::: "memory");
  float rli[16];
#pragma unroll
  for (int r = 0; r < 16; ++r) rli[r] = __builtin_amdgcn_rcpf(li_l[crow(r, hi)]);
  bf16_t* Ow = Ob + (long)(wid * QBLK) * LDO;
#pragma unroll
  for (int r = 0; r < 16; ++r) { int orow = crow(r, hi);
#pragma unroll
    for (int d0 = 0; d0 < 4; ++d0) Ow[(long)orow * LDO + d0 * 32 + r32] = (bf16_t)f2bf(o[d0][r] * rli[r]); }
  __syncthreads();
#undef SLOAD
#undef SWRITE
#undef SWAIT
#undef RESC
#undef MLOAD
}
__device__ __forceinline__ void attn_phase(Frame& F) {
  const bf16_t* P = (const bf16_t*)(F.ws + WS_P); const unsigned* MSK = (const unsigned*)(F.ws + WS_MSK); bf16_t* Y = (bf16_t*)(F.ws + WS_YCAT);
  for (int u = F.vcu; u < 512; u += F.G) {
    const int pairi = u & 255, second = u >> 8; const int bh = pairi >> 3, ql = pairi & 7; const int qb = second ? ql : 15 - ql;
    const int b = bh >> 3, hd = bh & 7; const long t0 = (long)b * SEQ + qb * 256;
    attn_unit(P + t0 * NP + PQ + hd * 128, P + (long)b * SEQ * NP + PK + hd * 128, P + (long)b * SEQ * NP + PV + hd * 128, MSK + t0 * 128, Y + t0 * DM + hd * 128, (qb + 1) * 256, (char*)F.ldsg);
  }
}
#undef KSWZ
#undef SBAR
}

__device__ __forceinline__ void phase_score_passb(Frame& F, const bool dry, const int qw) {
    if (F.G >= 256) { if ((F.vcu & 3) == 0 && (F.vcu >> 2) < 64) rw::pass_b_block(F, F.vcu >> 2, dry); }
    else { for (int bh = F.vcu; bh < 64; bh += F.G) rw::pass_b_block(F, bh, dry); }
    volatile LAS int* qs = (volatile LAS int*)(F.lds + MISC_OFF + 64);
    const bf16_t* P = (const bf16_t*)(F.ws + WS_P);
    const int r = F.lane & 31, h = F.lane >> 5;
    if (F.tid == 0) qs[0] = (int)atomicAdd(F.ctl + CW_QIDX + 64 * qw, 1u);
    __syncthreads();
    int cu = qs[0], it = 0;
    if (cu >= NSCU2) return;
    int b, i, st, st1; idx_decode(cu, b, i, st, st1);
    IdxQ qv[4];
#pragma unroll
    for (int g = 0; g < 4; ++g) idxq_load(qv[g], P, b * SEQ + i * 64 + 16 * g + 2 * F.wave, r, h);
    idx_stage(F, b, st, 0);
    for (;;) {
        const bool same = st < st1;
        if (!same && F.tid == 0) qs[1 + (it & 1)] = (int)atomicAdd(F.ctl + CW_QIDX + 64 * qw, 1u);
        __syncthreads();
        int nu = cu, nb = b, ni = i, nst = st + 1, nst1 = st1;
        if (!same) { nu = qs[1 + (it & 1)]; if (nu < NSCU2) idx_decode(nu, nb, ni, nst, nst1); }
        if (nu < NSCU2) idx_stage(F, nb, nst, (it + 1) & 1);
        idx_score_tile(F, qv, b, i, st, it & 1);
        if (nu >= NSCU2) break;
        if (!same) {
#pragma unroll
            for (int g = 0; g < 4; ++g) idxq_load(qv[g], P, nb * SEQ + ni * 64 + 16 * g + 2 * F.wave, r, h);
        }
        cu = nu; b = nb; i = ni; st = nst; st1 = nst1; ++it;
    }
}
__device__ __forceinline__ void phase_select_passb(Frame& F, const bool dry) {
    const int nw = F.G * 8, w = F.vcu * 8 + F.wave;
    for (int idx = w; idx < T / 2; idx += nw) { const int b = idx >> 11, p = idx & 2047; u32x4 ra[8], rb[8]; idx_row_load(F, b, p, ra); idx_row_load(F, b, 4095 - p, rb); idx_select_row(F, b, p, ra); idx_select_row(F, b, 4095 - p, rb); }
}

struct RouteRec { int cls, pos; float g_lo, g_hi, rstd; int pad0, pad1, pad2; };
__device__ __forceinline__ void phase7(Frame& F, const bool dry, const int mode = 3) {
    const int gw = F.vcu * 8 + F.wave, NGW = F.G * 8, lane = F.lane;
    { int* rowtok = (int*)(F.ws + WS_ROWTOK); for (int i = gw * 64 + lane; i < MPAD; i += NGW * 64) rowtok[i] = -1; }
    if (mode & 1) { LAS float* scr = (LAS float*)(F.lds + F.wave * 16384);
      bf16_t* WGU = (bf16_t*)(F.ws + WS_WGU); bf16_t* WDN = (bf16_t*)(F.ws + WS_WDN);
      constexpr int IG = (DM / 64) * (512 / 32), ID = (512 / 64) * (DM / 32);
      for (int it = gw; it < 16 * (2 * IG + ID); it += NGW) { const int e = it / (2 * IG + ID); int r = it % (2 * IG + ID);
          if (r < IG) transpose_item<2>(F.in[I_WEG] + (size_t)e * DM * 512, 512, WGU + (size_t)e * 1024 * DM, DM, scr, r / 16, r % 16, lane);
          else if (r < 2 * IG) { r -= IG; transpose_item<3>(F.in[I_WEU] + (size_t)e * DM * 512, 512, WGU + (size_t)e * 1024 * DM, DM, scr, r / 16, r % 16, lane); }
          else { r -= 2 * IG; transpose_item<0>(F.in[I_WED] + (size_t)e * 512 * DM, DM, WDN + (size_t)e * DM * 512, 512, scr, r / 64, r % 64, lane); } } }
    if (mode & 2) {
    const float* x1 = F.out; const bf16_t* WRH = (const bf16_t*)(F.ws + WS_WRT); const bf16_t* WRL = WRH + 32 * DM;
    RouteRec* rr = (RouteRec*)(F.ws + WS_ROUTE); unsigned* cnt = F.ctl + CW_CNT;
    const int r = lane & 31, h = lane >> 5;
    __syncthreads();
    const int grp = F.wave >> 2, kq = F.wave & 3;
    LAS float* part = (LAS float*)F.lds;
    for (int tbase = F.vcu * 2; tbase < T / 32; tbase += F.G * 2) {
        const int task = tbase + grp;
        const int t = task * 32 + r;
        const float* xp = x1 + (size_t)t * DM + 512 * kq + 8 * h; const bf16_t* ah = WRH + (size_t)r * DM + 512 * kq + 8 * h; const bf16_t* al = WRL + (size_t)r * DM + 512 * kq + 8 * h;
        f32x16 acc = {0.f, 0.f, 0.f, 0.f, 0.f, 0.f, 0.f, 0.f, 0.f, 0.f, 0.f, 0.f, 0.f, 0.f, 0.f, 0.f};
        float ssq = 0.f;
#pragma unroll 4
        for (int s = 0; s < 512 / 16; ++s) {
            const f32x4 x0 = *(const f32x4*)(xp + 16 * s), x4 = *(const f32x4*)(xp + 16 * s + 4);
            const bf16x8 wh = *(const bf16x8*)(ah + 16 * s), wl = *(const bf16x8*)(al + 16 * s);
            ssq += (x0.x * x0.x + x0.y * x0.y) + (x0.z * x0.z + x0.w * x0.w) + (x4.x * x4.x + x4.y * x4.y) + (x4.z * x4.z + x4.w * x4.w);
            u32x4 xh, xl;
            xh.x = pk2(x0.x, x0.y); xh.y = pk2(x0.z, x0.w); xh.z = pk2(x4.x, x4.y); xh.w = pk2(x4.z, x4.w);
            xl.x = pk2(x0.x - bflo(xh.x), x0.y - bfhi(xh.x)); xl.y = pk2(x0.z - bflo(xh.y), x0.w - bfhi(xh.y)); xl.z = pk2(x4.x - bflo(xh.z), x4.y - bfhi(xh.z)); xl.w = pk2(x4.z - bflo(xh.w), x4.w - bfhi(xh.w));
            acc = __builtin_amdgcn_mfma_f32_32x32x16_bf16(wh, __builtin_bit_cast(bf16x8, xh), acc, 0, 0, 0);
            acc = __builtin_amdgcn_mfma_f32_32x32x16_bf16(wl, __builtin_bit_cast(bf16x8, xh), acc, 0, 0, 0);
            acc = __builtin_amdgcn_mfma_f32_32x32x16_bf16(wh, __builtin_bit_cast(bf16x8, xl), acc, 0, 0, 0);
        }
        { LAS float* pp = part + ((grp * 4 + kq) * 64 + lane) * 17;
#pragma unroll
          for (int e = 0; e < 12; ++e) pp[e] = acc[e];
          pp[16] = ssq; }
        __syncthreads();
        if (kq == 0) {
#pragma unroll
            for (int q = 1; q < 4; ++q) { const LAS float* pp = part + ((grp * 4 + q) * 64 + lane) * 17;
#pragma unroll
                for (int e = 0; e < 12; ++e) acc[e] += pp[e];
                ssq += pp[16]; }
        }
        __syncthreads();
        if (kq != 0 || task >= T / 32) continue;
        ssq += __shfl_xor(ssq, 32);
        const float rstd = rsqrtf(ssq * (1.f / DM) + NORM_EPS);
        float ot[8];
#pragma unroll
        for (int e = 0; e < 8; ++e) ot[e] = __shfl_xor(acc[e], 32);
        float lg[20];
#pragma unroll
        for (int q = 0; q < 4; ++q) { lg[q] = acc[q] * rstd; lg[8 + q] = acc[4 + q] * rstd; lg[16 + q] = acc[8 + q] * rstd; lg[4 + q] = ot[q] * rstd; lg[12 + q] = ot[4 + q] * rstd; }
        float gl[4]; float gm = -INFINITY;
#pragma unroll
        for (int o = 0; o < 4; ++o) { gl[o] = lg[o] + F.in[I_BRG][o]; gm = fmaxf(gm, gl[o]); }
        float gs = 0.f; int gsel = 0; float gbest = -INFINITY;
#pragma unroll
        for (int o = 0; o < 4; ++o) { gs += __expf(gl[o] - gm); if (gl[o] > gbest) { gbest = gl[o]; gsel = o; } }
        const float pgrp = __expf(gbest - gm) / gs;
        float el[4]; float em = -INFINITY;
#pragma unroll
        for (int q = 0; q < 4; ++q) { float vsel = 0.f;
#pragma unroll
            for (int g2 = 0; g2 < 4; ++g2) vsel = (gsel == g2) ? lg[4 + 4 * g2 + q] + F.in[I_BRE][4 * g2 + q] : vsel;
            el[q] = vsel; em = fmaxf(em, vsel); }
        int i1 = 0; float b1 = -INFINITY;
#pragma unroll
        for (int q = 0; q < 4; ++q) if (el[q] > b1) { b1 = el[q]; i1 = q; }
        int i2 = 0; float b2 = -INFINITY;
#pragma unroll
        for (int q = 0; q < 4; ++q) if (q != i1 && el[q] > b2) { b2 = el[q]; i2 = q; }
        const float p1 = __expf(b1 - em), p2 = __expf(b2 - em); const float inv = 1.0f / (p1 + p2);
        const float gw1 = pgrp * p1 * inv, gw2 = pgrp * p2 * inv;
        const int elo = i1 < i2 ? i1 : i2, ehi = i1 < i2 ? i2 : i1; const float glo = i1 < i2 ? gw1 : gw2, ghi = i1 < i2 ? gw2 : gw1;
        const int pair = (elo == 0) ? (ehi - 1) : (elo == 1 ? ehi + 1 : 5);
        const int cls = gsel * 6 + pair;
        if (h == 0 && !dry) { const unsigned pos = atomicAdd(&cnt[cls], 1u); RouteRec rc; rc.cls = cls; rc.pos = (int)pos; rc.g_lo = glo; rc.g_hi = ghi; rc.rstd = rstd; rc.pad0 = rc.pad1 = rc.pad2 = 0; rr[t] = rc; }
    }
    }
}

__device__ __forceinline__ void class_bases(Frame& F, volatile LAS int* tb) {
    if (F.tid == 0) { int acc = 0; for (int c = 0; c < NCLS; ++c) { tb[c] = acc; const int n = (int)__hip_atomic_load(F.ctl + CW_CNT + c, __ATOMIC_RELAXED, __HIP_MEMORY_SCOPE_AGENT); acc += (n + 255) & ~255; } tb[NCLS] = acc; }
    __syncthreads();
}

__device__ __forceinline__ void phase8(Frame& F) {
    const int gw = F.vcu * 8 + F.wave, NGW = F.G * 8, lane = F.lane;
    volatile LAS int* tb = (volatile LAS int*)(F.lds + MISC_OFF + 128);
    class_bases(F, tb);
    const float* x1 = F.out; const float* gf = F.in[I_GFFN];
    const RouteRec* rr = (const RouteRec*)(F.ws + WS_ROUTE); int* rowtok = (int*)(F.ws + WS_ROWTOK); float* gates = (float*)(F.ws + WS_ROWTOK + 128 * 1024);
    bf16_t* H2S = (bf16_t*)(F.ws + WS_H2S);
    f32x4 gv[8];
#pragma unroll
    for (int j = 0; j < 8; ++j) gv[j] = ((const f32x4*)gf)[64 * j + lane];
    for (int t2 = gw; t2 < T / 2; t2 += NGW) {
        const RouteRec r0 = rr[2 * t2], r1 = rr[2 * t2 + 1];
        f32x4 v[2][8];
#pragma unroll
        for (int u = 0; u < 2; ++u) { const f32x4* xr = (const f32x4*)(x1 + (size_t)(2 * t2 + u) * DM) + lane;
#pragma unroll
            for (int j = 0; j < 8; ++j) v[u][j] = xr[64 * j]; }
#pragma unroll
        for (int u = 0; u < 2; ++u) { const RouteRec r = u ? r1 : r0; const int t = 2 * t2 + u; const int row = tb[r.cls] + r.pos;
            u32x2* o = (u32x2*)(H2S + (size_t)row * DM) + lane;
#pragma unroll
            for (int j = 0; j < 8; ++j) { u32x2 w; w.x = pk2(v[u][j].x * r.rstd * gv[j].x, v[u][j].y * r.rstd * gv[j].y); w.y = pk2(v[u][j].z * r.rstd * gv[j].z, v[u][j].w * r.rstd * gv[j].w); o[64 * j] = w; }
            if (lane == 0) { rowtok[row] = t; gates[2 * row] = r.g_lo; gates[2 * row + 1] = r.g_hi; } }
    }
    for (int idx = gw; idx < NCLS * 256; idx += NGW) { const int c = idx >> 8, off = idx & 255; const int n = (int)__hip_atomic_load(F.ctl + CW_CNT + c, __ATOMIC_RELAXED, __HIP_MEMORY_SCOPE_AGENT);
        const int row = tb[c] + n + off;
        if (row < tb[c + 1]) { u32x2* o = (u32x2*)(H2S + (size_t)row * DM) + lane;
#pragma unroll
            for (int j = 0; j < 8; ++j) o[64 * j] = (u32x2){0u, 0u};
            if (lane == 0) { gates[2 * row] = 0.f; gates[2 * row + 1] = 0.f; } } }
}

__device__ __forceinline__ int class_of_tile(volatile LAS int* tb, int rt) { int c = 0; const int r0 = rt * 256; for (int k = 1; k < NCLS; ++k) c = (r0 >= tb[k]) ? k : c; return c; }
__device__ __forceinline__ int class_expert(int cls, int half) { const int g = cls / 6, p = cls % 6; const int elo = p < 3 ? 0 : (p < 5 ? 1 : 2); const int ehi = p < 3 ? p + 1 : (p < 5 ? p - 1 : 3); return 4 * g + (half ? ehi : elo); }
__device__ __forceinline__ void class_tables(Frame& F, volatile LAS int* tb, volatile LAS int* te) {
    if (F.wave == 0) {
        const int c = F.lane; const int n = (c < NCLS) ? (int)__hip_atomic_load(F.ctl + CW_CNT + c, __ATOMIC_RELAXED, __HIP_MEMORY_SCOPE_AGENT) : 0;
        int base = 0;
#pragma unroll
        for (int j = 0; j < NCLS; ++j) { const int nj = __builtin_amdgcn_readlane(n, j); base += (j < c) ? ((nj + 255) & ~255) : 0; }
        if (c < NCLS) { tb[c] = base; const int ee = class_expert(c, 0) | (class_expert(c, 1) << 8); const int nt = (n + 255) >> 8; for (int f = 0; f < nt; ++f) te[(base >> 8) + f] = ee; }
        if (c == NCLS - 1) tb[NCLS] = base + ((n + 255) & ~255);
    }
    __syncthreads();
}
struct Moe1Sched {
    volatile LAS int* te; const char* A; const char* B; int G, c, nu;
    __device__ bool seg(int i, pg8::Seg& s) const { const int L = i * G + c; if (L >= nu) return false; const int rt = L >> 3, pn = L & 7; const int ee = te[rt]; const int e = (pn >> 2) ? (ee >> 8) : (ee & 255);
        s.A = A + (size_t)rt * 256 * DM * 2; s.B = B + ((size_t)e * 1024 + (pn & 3) * 256) * DM * 2; s.u.pm = rt; s.u.pn = pn; s.u.aux = 0; s.last = 1; s.nt = DM / 64; return true; }
    unsigned* cnt;
    static constexpr bool GATED = false, PUBLISH = true;
    __device__ __forceinline__ unsigned peek(const pg8::Unit&) const { return 0u; }
    __device__ __forceinline__ void wait(const pg8::Unit&, unsigned) const {}
    __device__ __forceinline__ void done(const pg8::Unit& u) const { asm volatile("s_waitcnt vmcnt(0)" ::: "memory"); if ((threadIdx.x & 63) == 0) (void)__hip_atomic_fetch_add(cnt + 16 * u.pm, 1u, __ATOMIC_RELAXED, __HIP_MEMORY_SCOPE_AGENT); }
};
struct Moe2Sched {
    volatile LAS int* te; const char* A; const char* B; int G, c, nu;
    __device__ bool seg(int i, pg8::Seg& s) const { const int ui = i >> 1, half = i & 1; const int L = ui * G + c; if (L >= nu) return false; const int rt = L >> 3, pn = L & 7; const int ee = te[rt]; const int e = half ? (ee >> 8) : (ee & 255);
        s.A = A + ((size_t)rt * 256 * 1024 + half * 512) * 2; s.B = B + ((size_t)e * DM + pn * 256) * 512 * 2; s.u.pm = rt; s.u.pn = pn; s.u.aux = 0; s.last = half; s.nt = 512 / 64; return true; }
    unsigned* cnt;
    static constexpr bool GATED = true, PUBLISH = false;
    __device__ __forceinline__ unsigned peek(const pg8::Unit& u) const { return __hip_atomic_load(cnt + 16 * u.pm, __ATOMIC_RELAXED, __HIP_MEMORY_SCOPE_AGENT); }
    __device__ __forceinline__ void wait(const pg8::Unit& u, unsigned v) const {
        unsigned sp = 0u;
        while ((unsigned)__builtin_amdgcn_readfirstlane(v) < 64u) { __builtin_amdgcn_s_sleep(2); if (++sp > (1u << 22)) break; v = __hip_atomic_load(cnt + 16 * u.pm, __ATOMIC_RELAXED, __HIP_MEMORY_SCOPE_AGENT); }
        __builtin_amdgcn_fence(__ATOMIC_ACQUIRE, "agent");
    }
    __device__ __forceinline__ void done(const pg8::Unit&) const {}
};

constexpr int NPHASE = 12;
__global__ void __launch_bounds__(512, 2) fwd_kernel(Args args) {
    extern __shared__ __attribute__((aligned(16))) unsigned char lds_raw[];
    Frame F;
    F.lds = (LAS unsigned char*)lds_raw; F.ldsg = lds_raw;
    F.tid = threadIdx.x; F.lane = F.tid & 63; F.wave = __builtin_amdgcn_readfirstlane(F.tid >> 6);
    F.G = gridDim.x; { const int bx = blockIdx.x; F.vcu = (F.G % 8 == 0) ? (bx % 8) * (F.G / 8) + bx / 8 : bx; }
    F.in = args.in; F.out = args.out; F.ws = args.ws; F.ctl = (unsigned*)(args.ws + WS_CTL);
    volatile LAS unsigned* MISC = (volatile LAS unsigned*)(F.lds + MISC_OFF);
    for (int u = F.tid; u < (LDS_BYTES - LDSCTL_OFF) / 4; u += 512) ((LAS unsigned*)(F.lds + LDSCTL_OFF))[u] = 0u;
    __syncthreads();
    const int lo = args.ph_lo, hi = args.ph_hi;
    const bool DRY_T = (args.ph_hi != 999), DRY_F = (args.ph_hi == 999);
    const bool multi = (hi - lo) > 1;
    XcdBarrier bar; bar.bar = F.ctl + CW_BAR; bar.x = 0; bar.st = nullptr;
    if (multi) bar = xcd_barrier_post(F.ctl + CW_BAR, MISC + 8);
#ifndef PH_MASK
#define PH_MASK 0xfff
#endif
#define IN(k) (((PH_MASK >> (k)) & 1) && lo <= (k) && (k) < hi)
#define STAMP(k) do { if (PROBE_K >= 0 && blockIdx.x == 0 && F.tid == 0) ((volatile unsigned long long*)(F.ctl + CW_TS))[(k)] = __builtin_amdgcn_s_memrealtime(); } while (0)
#define SEAM(k) do { if (IN(k) && IN((k) + 1)) xcd_barrier(bar); STAMP((k) + 1); } while (0)
#ifndef DUP_MASK
#define DUP_MASK 0
#endif
#ifndef DUP_MODE
#define DUP_MODE 3
#endif
    unsigned char* ws = args.ws;
    bf16_t* P = (bf16_t*)(ws + WS_P);
    STAMP(0);

    if (IN(0)) { phase0(F); SEAM(0); }
    if (IN(1)) {
        pg8::InSched S; S.init((const bf16_t*)(ws + WS_HN), (const bf16_t*)(ws + WS_WIN), F.G, (int)blockIdx.x);
        pg8::EpiIn E{P, NP, F.out};
        pg8::gemm_phase<pg8::EpiIn, pg8::InSched, true>(F.lds, DM, DM, DM / 64, S, E);
        SEAM(1);
    }
    if (IN(2)) { if ((DUP_MASK >> 2) & 1) { phase2(F, DRY_T); if (multi) xcd_barrier(bar); } phase2(F, DRY_F); SEAM(2); }
    if (IN(3)) {
        pg8::LoraSched S; S.init((const bf16_t*)(ws + WS_ALORA), (const bf16_t*)(ws + WS_WLORA), F.G, (int)blockIdx.x);
        pg8::EpiLora E{(bf16_t*)(ws + WS_L3), F.in[I_W0], F.in[I_A0]};
        pg8::gemm_phase<pg8::EpiLora, pg8::LoraSched, true>(F.lds, KL, KL, KL / 64, S, E);
        SEAM(3);
    }
    if (IN(4)) { rw::pass_a(F); SEAM(4); }
    if (IN(5)) { if ((DUP_MASK >> 5) & 1) { phase_score_passb(F, DRY_T, 1); if (multi) xcd_barrier(bar); phase_select_passb(F, DRY_T); if (multi) xcd_barrier(bar); }
                 phase_score_passb(F, DRY_F, 0); if (multi) xcd_barrier(bar); STAMP(13); phase_select_passb(F, DRY_F); SEAM(5); }
    if (IN(6)) { att::attn_phase(F); if (PROBE_K >= 0) { xcd_barrier(bar); STAMP(14); } rw::pass_c(F); SEAM(6); }
    if (IN(7)) {
        pg8::PlainSched S; S.init((const bf16_t*)(ws + WS_YCAT), (const bf16_t*)(ws + WS_WOUT), T, DM, DM, DM, F.G, (int)blockIdx.x, DM / 64);
        pg8::EpiResF32 E{F.in[I_X], F.out, DM};
        pg8::gemm_phase<pg8::EpiResF32, pg8::PlainSched, true>(F.lds, DM, DM, DM / 64, S, E);
        SEAM(7);
    }
    if (IN(8)) { if ((DUP_MASK >> 8) & 1) { phase7(F, DRY_T, DUP_MODE); if (multi) xcd_barrier(bar); } phase7(F, DRY_F); SEAM(8); }
    if (IN(9)) { if ((DUP_MASK >> 9) & 1) { phase8(F); if (multi) xcd_barrier(bar); } phase8(F); SEAM(9); }
    if (IN(10)) {
        volatile LAS int* tb = (volatile LAS int*)(F.lds + MISC_OFF + 128); volatile LAS int* te = (volatile LAS int*)(F.lds + MISC_OFF + 256);
        class_tables(F, tb, te);
        Moe1Sched S; S.te = te; S.A = (const char*)(ws + WS_H2S); S.B = (const char*)(ws + WS_WGU); S.G = F.G; S.c = (int)blockIdx.x; S.nu = (tb[NCLS] >> 8) * 8; S.cnt = F.ctl + CW_HSCNT;
        pg8::EpiMoe1 E{(bf16_t*)(ws + WS_HS), (const float*)(ws + WS_ROWTOK + 128 * 1024)};
        pg8::gemm_phase<pg8::EpiMoe1, Moe1Sched, true>(F.lds, DM, DM, DM / 64, S, E);
        STAMP(11);
    }
    if (IN(11)) {
        volatile LAS int* tb = (volatile LAS int*)(F.lds + MISC_OFF + 128); volatile LAS int* te = (volatile LAS int*)(F.lds + MISC_OFF + 256);
        class_tables(F, tb, te);
        Moe2Sched S; S.te = te; S.A = (const char*)(ws + WS_HS); S.B = (const char*)(ws + WS_WDN); S.G = F.G; S.nu = (tb[NCLS] >> 8) * 8; S.cnt = F.ctl + CW_HSCNT;
        S.c = ((int)blockIdx.x + F.G - S.nu % F.G) % F.G;
        if ((DUP_MASK >> 11) & 1) { pg8::EpiMoe2 E0{F.out, (const int*)(ws + WS_ROWTOK), DRY_T ? 1 : 0}; pg8::gemm_phase<pg8::EpiMoe2, Moe2Sched, true>(F.lds, 1024, 512, 512 / 64, S, E0); if (multi) xcd_barrier(bar); }
        pg8::EpiMoe2 E{F.out, (const int*)(ws + WS_ROWTOK), DRY_F ? 1 : 0};
        pg8::gemm_phase<pg8::EpiMoe2, Moe2Sched, true>(F.lds, 1024, 512, 512 / 64, S, E);
    }
    if (PROBE_K >= 0) {
        xcd_barrier(bar); STAMP(12); xcd_barrier(bar);
        const volatile unsigned long long* ts = (const volatile unsigned long long*)(F.ctl + CW_TS);
        constexpr int K = PROBE_K;
        constexpr int ka = K == 20 ? 5 : K == 21 ? 13 : K == 22 ? 6 : K == 23 ? 14 : K == 30 ? 0 : K;
        constexpr int kb = K == 20 ? 13 : K == 21 ? 6 : K == 22 ? 14 : K == 23 ? 7 : K == 30 ? 12 : K + 1;
        const float tau = (float)(long long)(ts[kb] - ts[ka]) * 1.25e-6f;
        f32x4* o = (f32x4*)F.out;
        for (size_t i = (size_t)blockIdx.x * 512 + F.tid; i < (size_t)T * DM / 4; i += (size_t)F.G * 512) { f32x4 v = o[i]; v = v * (1.0f + tau); o[i] = v; }
    }
#undef IN
#undef SEAM
}

extern "C" void kernel_launch(void* const* d_in, const int* in_sizes, int n_in, void* d_out, int out_size, void* d_ws, size_t ws_size, hipStream_t stream) {
    static int grid = 0;
    if (grid == 0) {
        if (n_in != 25 || in_sizes[0] != T * DM || out_size != T * DM || ws_size < WS_END) { fprintf(stderr, "kernel_launch: unexpected shapes (n_in %d, in0 %d, out %d, ws %zu)\n", n_in, n_in > 0 ? in_sizes[0] : -1, out_size, ws_size); grid = -1; return; }
        int dev = 0, cus = 0, per_cu = 0;
        if (hipGetDevice(&dev) != hipSuccess || hipDeviceGetAttribute(&cus, hipDeviceAttributeMultiprocessorCount, dev) != hipSuccess) { grid = -1; return; }
        if (hipFuncSetAttribute((const void*)fwd_kernel, hipFuncAttributeMaxDynamicSharedMemorySize, LDS_BYTES) != hipSuccess) { fprintf(stderr, "kernel_launch: hipFuncSetAttribute failed\n"); grid = -1; return; }
        if (hipOccupancyMaxActiveBlocksPerMultiprocessor(&per_cu, (const void*)fwd_kernel, 512, LDS_BYTES) != hipSuccess || per_cu < 1) { fprintf(stderr, "kernel_launch: occupancy query says %d blocks per CU\n", per_cu); (void)hipGetLastError(); grid = -1; return; }
        grid = cus;
    }
    if (grid < 0) return;
    (void)hipMemsetAsync((char*)d_ws + WS_CTL, 0, CTL_ZERO_BYTES, stream);
    Args a{};
    for (int i = 0; i < 25; ++i) a.in[i] = (const float*)d_in[i];
    a.out = (float*)d_out; a.ws = (unsigned char*)d_ws;
#if MK_SINGLE
    a.ph_lo = 0; a.ph_hi = NPHASE;
    void* kargs[] = {&a};
    hipError_t e = hipLaunchCooperativeKernel((const void*)fwd_kernel, dim3(grid), dim3(512), kargs, LDS_BYTES, stream);
    if (e != hipSuccess) fprintf(stderr, "kernel_launch: cooperative launch failed: %s (grid %d)\n", hipGetErrorString(e), grid);
#else
    for (int p = 0; p < NPHASE; ++p) { a.ph_lo = p; a.ph_hi = p + 1; hipLaunchKernelGGL(fwd_kernel, dim3(grid), dim3(512), LDS_BYTES, stream, a); }
#endif
}
```

```cpp
#include <hip/hip_runtime.h>
#include <hip/hip_cooperative_groups.h>
#include <cstdio>
#include <cstdint>
#include <cmath>

#ifndef PROBE_K
#define PROBE_K -1
#endif
#ifndef MK_SINGLE
#define MK_SINGLE 1
#endif

#define GAS __attribute__((address_space(1)))
#define LAS __attribute__((address_space(3)))
typedef unsigned short bf16_t;
typedef short bf16x8 __attribute__((ext_vector_type(8)));
typedef float f32x4 __attribute__((ext_vector_type(4)));
typedef float f32x16 __attribute__((ext_vector_type(16)));
typedef float f32x2 __attribute__((ext_vector_type(2)));
typedef unsigned u32x4 __attribute__((ext_vector_type(4)));
typedef unsigned u32x2 __attribute__((ext_vector_type(2)));

constexpr int BATCH = 4, SEQ = 4096, DM = 2048, T = BATCH * SEQ;
constexpr int NP = 7680;
constexpr int PQ = 0, PK = 1024, PV = 2048, PQI = 3072, PKI = 4096, PWI = 4160, PDW = 4224, PDA = 4288, PR = 4352, PKR = 5376, PVR = 6400, PDG = 7424;
constexpr int IN_COLS = 7536, DSA_COLS = 4176;
constexpr int KL = 384, NL = 3072;
constexpr int MPAD = 22528;
constexpr int NCLS = 24;
constexpr float NORM_EPS = 1e-6f, GN_EPS = 64e-5f;
constexpr float QSCALE = 0.08838834764831845f * 1.4426950408889634f;

constexpr size_t MiB = 1u << 20;
constexpr size_t WS_CTL = 0, CTL_ZERO_BYTES = 32 * 1024;
constexpr size_t WS_WLORA = 1 * MiB;
constexpr size_t WS_WOUT = 4 * MiB;
constexpr size_t WS_MSK = 12 * MiB;
constexpr size_t WS_KI = 20 * MiB;
constexpr size_t WS_ROUTE = 22 * MiB;
constexpr size_t WS_ROWTOK = 23 * MiB;
constexpr size_t WS_WRT = 23 * MiB + 512 * 1024;
constexpr size_t WS_ALORA = 24 * MiB;
constexpr size_t WS_WIN = 36 * MiB;
constexpr size_t WS_HN = 66 * MiB;
constexpr size_t WS_YCAT = WS_HN;
constexpr size_t WS_L3 = 130 * MiB;
constexpr size_t WS_P = 226 * MiB;
constexpr size_t WS_H2S = 226 * MiB;
constexpr size_t WS_HS = 314 * MiB;
constexpr size_t WS_WGU = 358 * MiB;
constexpr size_t WS_WDN = 422 * MiB;
constexpr size_t WS_MT = 24 * MiB;
constexpr size_t WS_BON = 56 * MiB;
constexpr size_t WS_SA = 466 * MiB;
constexpr size_t WS_SC = 57 * MiB;
constexpr size_t WS_XS = 498 * MiB;
constexpr size_t WS_SINK = 499 * MiB;
constexpr size_t WS_END = 500 * MiB;
constexpr int CW_CNT = 2432;
constexpr int CW_TS = 512;
constexpr int CW_BAR = 4096;
constexpr int CW_HSCNT = 1024;

constexpr int RING_BYTES = 131072;
constexpr int LDSCTL_OFF = RING_BYTES, MISC_OFF = LDSCTL_OFF + 320;
constexpr int LDS_BYTES = 147456;

#define LDS_WAIT() asm volatile("s_waitcnt lgkmcnt(0)" ::: "memory")
#define VM_WAIT() asm volatile("s_waitcnt vmcnt(0)" ::: "memory")
typedef __bf16 hwbf16x2 __attribute__((ext_vector_type(2)));
__device__ __forceinline__ unsigned pk2(float lo, float hi) { const f32x2 v = {lo, hi}; return __builtin_bit_cast(unsigned, __builtin_convertvector(v, hwbf16x2)); }
__device__ __forceinline__ unsigned f2bf(float f) { return pk2(f, 0.f) & 0xffffu; }
__device__ __forceinline__ float bf2f(unsigned short h) { return __builtin_bit_cast(float, (unsigned)h << 16); }
__device__ __forceinline__ float bflo(unsigned w) { return __builtin_bit_cast(float, w << 16); }
__device__ __forceinline__ float bfhi(unsigned w) { return __builtin_bit_cast(float, w & 0xffff0000u); }
#define DPP_ADD(v, ctrl, rm) (v) += __builtin_bit_cast(float, __builtin_amdgcn_update_dpp(0, __builtin_bit_cast(int, (v)), (ctrl), (rm), 0xF, false))
__device__ __forceinline__ float row_sum16(float v) {
    DPP_ADD(v, 0xB1, 0xF); DPP_ADD(v, 0x4E, 0xF); DPP_ADD(v, 0x141, 0xF); DPP_ADD(v, 0x140, 0xF); return v;
}
__device__ __forceinline__ float wave_sum(float v) {
    v = row_sum16(v); DPP_ADD(v, 0x142, 0xA); DPP_ADD(v, 0x143, 0xC);
    return __builtin_bit_cast(float, __builtin_amdgcn_readlane(__builtin_bit_cast(int, v), 63));
}
__device__ __forceinline__ float half_sum(float v) {
    v = row_sum16(v); DPP_ADD(v, 0x142, 0xA);
    const float lo = __builtin_bit_cast(float, __builtin_amdgcn_readlane(__builtin_bit_cast(int, v), 31)), hi = __builtin_bit_cast(float, __builtin_amdgcn_readlane(__builtin_bit_cast(int, v), 63));
    return (threadIdx.x & 32) ? hi : lo;
}
__device__ __forceinline__ float sigmoidf_(float x) { return __builtin_amdgcn_rcpf(1.0f + __expf(-x)); }

namespace pg8 {
constexpr int BM = 256, BK = 64, HALF = 128, HTB = HALF * BK * 2, STAGE_BYTES = 8 * HTB, NXCD = 8, WGM = 8;
__host__ __device__ __forceinline__ int lds_byte(int r, int c) { const int st = (r >> 4) * 2 + (c >> 5), rr = r & 15, cc = c & 31, ob = rr * 64 + cc * 2; return st * 1024 + (ob ^ (((ob >> 9) & 1) << 5)); }
__host__ __device__ __forceinline__ void stage_rc(int b, int& R, int& C) { const int st = b / 1024, sb = b % 1024, swz = sb ^ (((sb >> 9) & 1) << 5); R = (st >> 1) * 16 + swz / 64; C = (st & 1) * 32 + (swz % 64) / 2; }
__host__ __device__ __forceinline__ int perm32(int rho) { const int n = rho >> 4, i = rho & 15; return 8 * (i >> 2) + 4 * n + (i & 3); }

struct Unit { int pm, pn, aux; };
struct Seg { const char* A; const char* B; Unit u; int last, nt; };

struct TileOrder {
    int nM, nN, nwg, G, c;
    __device__ void init(int nM_, int nN_, int G_, int c_) { nM = nM_; nN = nN_; nwg = nM * nN; G = G_; c = c_; }
    __device__ bool next(int i, int& pm, int& pn) const {
        const long L = (long)i * G + c; if (L >= nwg) return false;
        int wgid = (int)L; { const int q = nwg / NXCD, r = nwg % NXCD, xcd = wgid % NXCD, off = wgid / NXCD; wgid = (xcd < r ? xcd * (q + 1) : r * (q + 1) + (xcd - r) * q) + off; }
        const int nig = WGM * nN, gid = wgid / nig, fm = gid * WGM, gsz = (nM - fm) < WGM ? (nM - fm) : WGM;
        pm = fm + ((wgid % nig) % gsz); pn = (wgid % nig) / gsz; return true;
    }
};
struct PlainSched {
    TileOrder o; const char* A; const char* B; size_t tA, tB; int nt, i0, ni;
    __device__ void init(const bf16_t* A_, const bf16_t* B_, int M, int N, int lda, int ldb, int G, int c, int nt_) { o.init(M / BM, N / BM, G, c); A = (const char*)A_; B = (const char*)B_; tA = (size_t)BM * lda * 2; tB = (size_t)BM * ldb * 2; nt = nt_; i0 = 0; ni = 1 << 30; }
    __device__ bool seg(int i, Seg& s) const { int pm, pn; if (i >= ni || !o.next(i + i0, pm, pn)) return false; s.A = A + pm * tA; s.B = B + pn * tB; s.u.pm = pm; s.u.pn = pn; s.u.aux = 0; s.last = 1; s.nt = nt; return true; }
    static constexpr bool GATED = false, PUBLISH = false;
    __device__ __forceinline__ unsigned peek(const Unit&) const { return 0u; }
    __device__ __forceinline__ void wait(const Unit&, unsigned) const {}
    __device__ __forceinline__ void done(const Unit&) const {}
};
struct LoraSched {
    TileOrder o; const char* A; const char* B;
    __device__ void init(const bf16_t* A_, const bf16_t* B_, int G, int c) { o.init(T / BM, NL / BM, G, c); A = (const char*)A_; B = (const char*)B_; }
    __device__ bool seg(int i, Seg& s) const { int pm, pn; if (!o.next(i, pm, pn)) return false; const int gate = pn >= 8; s.A = A + (size_t)pm * BM * KL * 2 + (gate ? 256 : 0); s.B = B + (size_t)pn * BM * KL * 2 + (gate ? 256 : 0); s.u.pm = pm; s.u.pn = pn; s.u.aux = 0; s.last = 1; s.nt = gate ? 4 : 2; return true; }
    static constexpr bool GATED = false, PUBLISH = false;
    __device__ __forceinline__ unsigned peek(const Unit&) const { return 0u; }
    __device__ __forceinline__ void wait(const Unit&, unsigned) const {}
    __device__ __forceinline__ void done(const Unit&) const {}
};

struct InSched {
    TileOrder o; const char* A; const char* B; size_t tA, tB; int G, c;
    __device__ void init(const bf16_t* A_, const bf16_t* B_, int G_, int c_) { o.init(T / BM, 28, G_, c_); A = (const char*)A_; B = (const char*)B_; tA = (size_t)BM * DM * 2; tB = (size_t)BM * DM * 2; G = G_; c = c_; }
    __device__ bool seg(int i, Seg& s) const { int pm, q; s.last = 1;
        if (o.next(i, pm, q)) { const int pn = q + (q >= 16); s.A = A + pm * tA; s.B = B + pn * tB; s.u.pm = pm; s.u.pn = pn; s.u.aux = 0; s.nt = DM / 64; return true; }
        const int L = i * G + c - 28 * (T / BM); if (L >= 4 * (T / BM)) return false;
        const int j = (G == 256) ? (L & 7) * 32 + (L >> 3) : L;
        pm = j >> 2; const int ct = j & 1, kh = (j >> 1) & 1, pn = ct ? 29 : 16;
        s.A = A + pm * tA + kh * (DM / 2) * 2; s.B = B + pn * tB + kh * (DM / 2) * 2; s.u.pm = pm; s.u.pn = pn; s.u.aux = 1 + ct + 2 * kh; s.nt = DM / 128; return true; }
    static constexpr bool GATED = false, PUBLISH = false;
    __device__ __forceinline__ unsigned peek(const Unit&) const { return 0u; }
    __device__ __forceinline__ void wait(const Unit&, unsigned) const {}
    __device__ __forceinline__ void done(const Unit&) const {}
};

__device__ __forceinline__ unsigned cvt_pk_bf16(float lo, float hi) { unsigned r; asm volatile("v_cvt_pk_bf16_f32 %0, %1, %2" : "=v"(r) : "v"(lo), "v"(hi)); return r; }

typedef f32x4 Acc[2][2][4][2];

template <class Epi, class Sched, bool ALIGN_EPI>
__device__ __forceinline__ void gemm_phase(LAS unsigned char* lds, const int lda, const int ldb, const int nt, const Sched& S, const Epi& E) {
    const int tid = threadIdx.x, wid = __builtin_amdgcn_readfirstlane(tid >> 6), lane = tid & 63, wr = wid >> 2, wc = wid & 3, fr = lane & 15, fq = lane >> 4;
    unsigned voffA[2], voffB[2];
#pragma unroll
    for (int i = 0; i < 2; ++i) { int R, C; stage_rc(tid * 16 + i * 8192, R, C); const int Rb = Epi::PERM ? ((R & ~31) + perm32(R & 31)) : R;
        voffA[i] = (unsigned)(R * lda + C) * 2u; voffB[i] = (unsigned)(Rb * ldb + C) * 2u; }
    const size_t kstep = (size_t)(BK * 2);
    const size_t hstepA = (size_t)HALF * lda * 2, hstepB = (size_t)HALF * ldb * 2;
    const unsigned ldsw = (unsigned)wid * 1024u;
    const int aoff = lds_byte(wr * 64 + fr, fq * 8), boff = lds_byte(wc * 32 + fr, fq * 8);
#define PG8_SA(b, h) (((b) * 2 + (h)) * HTB)
#define PG8_SB(b, h) ((4 + (b) * 2 + (h)) * HTB)
#define PG8_STAGE(bufoff, gbase, voff) do { _Pragma("unroll") for (int _i = 0; _i < 2; ++_i) \
        __builtin_amdgcn_global_load_lds((const unsigned*)((const char*)(gbase) + (voff)[_i]), (LAS unsigned*)(lds + (bufoff) + ldsw + _i * 8192), 16, 0, 0); } while (0)
#define PG8_LDA(dst, b, h) do { _Pragma("unroll") for (int m = 0; m < 4; ++m) _Pragma("unroll") for (int k = 0; k < 2; ++k) dst[m][k] = *(const LAS bf16x8*)(lds + PG8_SA(b, h) + aoff + m * 2048 + k * 1024); } while (0)
#define PG8_LDB(dst, b, h) do { _Pragma("unroll") for (int n = 0; n < 2; ++n) _Pragma("unroll") for (int k = 0; k < 2; ++k) dst[n][k] = *(const LAS bf16x8*)(lds + PG8_SB(b, h) + boff + n * 2048 + k * 1024); } while (0)
#define PG8_MMA(ai, bj, At, Bt) do { __builtin_amdgcn_s_setprio(1); _Pragma("unroll") for (int m = 0; m < 4; ++m) _Pragma("unroll") for (int n = 0; n < 2; ++n) _Pragma("unroll") for (int k = 0; k < 2; ++k) \
        acc[ai][bj][m][n] = __builtin_amdgcn_mfma_f32_16x16x32_bf16(Bt[n][k], At[m][k], acc[ai][bj][m][n], 0, 0, 0); __builtin_amdgcn_s_setprio(0); } while (0)
#define PG8_WAIT_V(n) asm volatile("s_waitcnt vmcnt(" #n ")" ::: "memory")
#define PG8_WAIT_L(n) asm volatile("s_waitcnt lgkmcnt(" #n ")" ::: "memory")
#define PG8_BAR __builtin_amdgcn_s_barrier()
#define PG8_SCHED __builtin_amdgcn_sched_barrier(0)
#define PG8_ZERO() do { _Pragma("unroll") for (int a = 0; a < 2; ++a) _Pragma("unroll") for (int b = 0; b < 2; ++b) _Pragma("unroll") for (int m = 0; m < 4; ++m) _Pragma("unroll") for (int n = 0; n < 2; ++n) acc[a][b][m][n] = (f32x4){0.f, 0.f, 0.f, 0.f}; } while (0)
    Seg cur, nxt; int qi = 0;
    if (!S.seg(0, cur)) return;
    Acc acc;
    PG8_ZERO();
    bf16x8 At[4][2], B0[2][2], B1[2][2];
    const char* cA = cur.A; const char* cB = cur.B;
    if constexpr (Sched::GATED) S.wait(cur.u, S.peek(cur.u));
    PG8_STAGE(PG8_SB(0, 0), cB, voffB); PG8_STAGE(PG8_SB(0, 1), cB + hstepB, voffB); PG8_STAGE(PG8_SA(0, 0), cA, voffA); PG8_STAGE(PG8_SA(0, 1), cA + hstepA, voffA);
    if (wr == 1) PG8_BAR;
    PG8_WAIT_V(2); PG8_BAR;
    PG8_STAGE(PG8_SB(1, 0), cB + kstep, voffB); PG8_STAGE(PG8_SA(1, 0), cA + kstep, voffA); PG8_STAGE(PG8_SB(1, 1), cB + hstepB + kstep, voffB);
    PG8_WAIT_V(6); PG8_BAR;
    for (;;) {
        bool has_next; const char* nA; const char* nB;
        for (;;) {
        has_next = S.seg(qi + 1, nxt);
        nA = has_next ? nxt.A : cA; nB = has_next ? nxt.B : cB;
        const int nt_ = cur.nt;
        const bool gate = Sched::GATED && has_next && cur.last;
        unsigned rdy; if constexpr (Sched::GATED) { if (gate) rdy = S.peek(nxt.u); }
#pragma unroll 1
        for (int t = 0; t < nt_; t += 2) {
            const bool last = (t == nt_ - 2);
            if constexpr (Sched::GATED) { if (last && gate) S.wait(nxt.u, rdy); }
            const char* a1 = cA + (size_t)(t + 1) * kstep;
            const char* a2 = last ? nA : cA + (size_t)(t + 2) * kstep; const char* b2 = last ? nB : cB + (size_t)(t + 2) * kstep;
            const char* a3 = a2 + kstep; const char* b3 = b2 + kstep;
            PG8_LDB(B0, 0, 0); PG8_LDB(B1, 0, 1); PG8_SCHED; PG8_LDA(At, 0, 0); PG8_STAGE(PG8_SA(1, 1), a1 + hstepA, voffA);
            PG8_WAIT_V(8); PG8_WAIT_L(0); PG8_BAR; PG8_MMA(0, 0, At, B0); PG8_MMA(0, 1, At, B1); PG8_BAR; PG8_SCHED;
            PG8_LDA(At, 0, 1); PG8_STAGE(PG8_SB(0, 0), b2, voffB); PG8_STAGE(PG8_SB(0, 1), b2 + hstepB, voffB); PG8_STAGE(PG8_SA(0, 0), a2, voffA);
            PG8_WAIT_V(8); PG8_WAIT_L(0); PG8_BAR; PG8_MMA(1, 0, At, B0); PG8_MMA(1, 1, At, B1); PG8_BAR; PG8_SCHED;
            PG8_LDB(B0, 1, 0); PG8_LDB(B1, 1, 1); PG8_SCHED; PG8_LDA(At, 1, 0); PG8_STAGE(PG8_SA(0, 1), a2 + hstepA, voffA);
            PG8_WAIT_V(8); PG8_WAIT_L(0); PG8_BAR; PG8_MMA(0, 0, At, B0); PG8_MMA(0, 1, At, B1); PG8_BAR; PG8_SCHED;
            PG8_LDA(At, 1, 1); PG8_STAGE(PG8_SB(1, 0), b3, voffB); PG8_STAGE(PG8_SB(1, 1), b3 + hstepB, voffB); PG8_STAGE(PG8_SA(1, 0), a3, voffA);
            PG8_WAIT_V(8); PG8_WAIT_L(0); PG8_BAR; PG8_MMA(1, 0, At, B0); PG8_MMA(1, 1, At, B1); PG8_BAR; PG8_SCHED;
        }
        if (cur.last || !has_next) break;
        cur = nxt; cA = nA; cB = nB; ++qi;
        }
        if constexpr (ALIGN_EPI) { if (wr == 0) PG8_BAR; }
        E(acc, cur.u, wr, wc, fr, fq);
        if constexpr (Sched::PUBLISH) S.done(cur.u);
        if (!has_next) break;
        PG8_ZERO();
        cur = nxt; cA = nA; cB = nB; ++qi;
        if constexpr (ALIGN_EPI) { if (wr == 1) PG8_BAR; }
    }
    PG8_WAIT_V(0);
    if constexpr (!ALIGN_EPI) { if (wr == 0) PG8_BAR; }
    PG8_BAR;
#undef PG8_SA
#undef PG8_SB
#undef PG8_STAGE
#undef PG8_LDA
#undef PG8_LDB
#undef PG8_MMA
#undef PG8_WAIT_V
#undef PG8_WAIT_L
#undef PG8_BAR
#undef PG8_SCHED
#undef PG8_ZERO
}

struct EpiBf16 {
    static constexpr bool PERM = true;
    bf16_t* O; int ldc;
    __device__ __forceinline__ void operator()(const Acc& acc, const Unit& u, int wr, int wc, int fr, int fq) const {
        const int row0 = u.pm * BM + wr * 64 + fr; const int col0 = u.pn * BM + wc * 32 + 8 * fq;
#pragma unroll
        for (int ai = 0; ai < 2; ++ai)
#pragma unroll
            for (int m = 0; m < 4; ++m) { bf16_t* rowp = O + (size_t)(row0 + ai * HALF + m * 16) * ldc + col0;
#pragma unroll
                for (int bj = 0; bj < 2; ++bj) { const f32x4 v0 = acc[ai][bj][m][0], v1 = acc[ai][bj][m][1];
                    u32x4 w; w.x = cvt_pk_bf16(v0[0], v0[1]); w.y = cvt_pk_bf16(v0[2], v0[3]); w.z = cvt_pk_bf16(v1[0], v1[1]); w.w = cvt_pk_bf16(v1[2], v1[3]);
                    *(u32x4*)(rowp + bj * HALF) = w; } }
    }
};
struct EpiIn {
    static constexpr bool PERM = true;
    bf16_t* O; int ldc; float* part;
    __device__ __forceinline__ void operator()(const Acc& acc, const Unit& u, int wr, int wc, int fr, int fq) const {
        const int row0 = u.pm * BM + wr * 64 + fr;
        if (u.aux == 0) {
            const int col0 = u.pn * BM + wc * 32 + 8 * fq;
#pragma unroll
            for (int ai = 0; ai < 2; ++ai)
#pragma unroll
                for (int m = 0; m < 4; ++m) { bf16_t* rowp = O + (size_t)(row0 + ai * HALF + m * 16) * ldc + col0;
#pragma unroll
                    for (int bj = 0; bj < 2; ++bj) { const f32x4 v0 = acc[ai][bj][m][0], v1 = acc[ai][bj][m][1];
                        u32x4 w; w.x = cvt_pk_bf16(v0[0], v0[1]); w.y = cvt_pk_bf16(v0[2], v0[3]); w.z = cvt_pk_bf16(v1[0], v1[1]); w.w = cvt_pk_bf16(v1[2], v1[3]);
                        *(u32x4*)(rowp + bj * HALF) = w; } }
        } else {
            const int ct = (u.aux - 1) & 1, kh = (u.aux - 1) >> 1;
            float* pp = part + (size_t)kh * T * 512 + ct * 256 + wc * 32 + 8 * fq;
#pragma unroll
            for (int ai = 0; ai < 2; ++ai)
#pragma unroll
                for (int m = 0; m < 4; ++m) { float* rowp = pp + (size_t)(row0 + ai * HALF + m * 16) * 512;
#pragma unroll
                    for (int bj = 0; bj < 2; ++bj) { *(f32x4*)(rowp + bj * HALF) = acc[ai][bj][m][0]; *(f32x4*)(rowp + bj * HALF + 4) = acc[ai][bj][m][1]; } }
        }
    }
};
struct EpiLora {
    static constexpr bool PERM = true;
    bf16_t* O; const float* w0; const float* a0;
    __device__ __forceinline__ void operator()(const Acc& acc, const Unit& u, int wr, int wc, int fr, int fq) const {
        const int row0 = u.pm * BM + wr * 64 + fr; const int col0 = u.pn * BM + wc * 32 + 8 * fq; const int typ = u.pn >> 2;
        if (typ == 2) {
#pragma unroll
            for (int bj = 0; bj < 2; ++bj)
#pragma unroll
                for (int ai = 0; ai < 2; ++ai)
#pragma unroll
                    for (int m = 0; m < 4; ++m) { const f32x4 v0 = acc[ai][bj][m][0], v1 = acc[ai][bj][m][1];
                        u32x4 w; w.x = cvt_pk_bf16(v0.x, v0.y); w.y = cvt_pk_bf16(v0.z, v0.w); w.z = cvt_pk_bf16(v1.x, v1.y); w.w = cvt_pk_bf16(v1.z, v1.w);
                        *(u32x4*)(O + (size_t)(row0 + ai * HALF + m * 16) * NL + col0 + bj * HALF) = w; }
            return;
        }
        const float* bsrc = (typ == 0) ? w0 : a0;
        const float mul = (typ == 0) ? -0.6065306597126334f : 1.0f;
#pragma unroll
        for (int bj = 0; bj < 2; ++bj) {
            const int ch = (col0 + bj * HALF) & 1023;
            const f32x4 b0 = *(const f32x4*)(bsrc + ch), b1 = *(const f32x4*)(bsrc + ch + 4);
#pragma unroll
            for (int ai = 0; ai < 2; ++ai)
#pragma unroll
                for (int m = 0; m < 4; ++m) {
                    f32x4 v0 = acc[ai][bj][m][0], v1 = acc[ai][bj][m][1];
                    {
                        const f32x4 s0 = v0 + b0, s1 = v1 + b1;
                        v0.x = mul * sigmoidf_(s0.x); v0.y = mul * sigmoidf_(s0.y); v0.z = mul * sigmoidf_(s0.z); v0.w = mul * sigmoidf_(s0.w);
                        v1.x = mul * sigmoidf_(s1.x); v1.y = mul * sigmoidf_(s1.y); v1.z = mul * sigmoidf_(s1.z); v1.w = mul * sigmoidf_(s1.w);
                    }
                    u32x4 w; w.x = cvt_pk_bf16(v0.x, v0.y); w.y = cvt_pk_bf16(v0.z, v0.w); w.z = cvt_pk_bf16(v1.x, v1.y); w.w = cvt_pk_bf16(v1.z, v1.w);
                    *(u32x4*)(O + (size_t)(row0 + ai * HALF + m * 16) * NL + col0 + bj * HALF) = w;
                    asm volatile("" ::: "memory"); }
        }
    }
};
struct EpiResF32 {
    static constexpr bool PERM = false;
    const float* base; float* out; int ldc;
    __device__ __forceinline__ void operator()(const Acc& acc, const Unit& u, int wr, int wc, int fr, int fq) const {
        const int col0 = u.pn * BM + wc * 32 + 4 * fq;
        f32x4 v[4][2][2], s0[4][2][2];
#pragma unroll
        for (int m = 0; m < 4; ++m) { const size_t off = (size_t)(u.pm * BM + wr * 64 + m * 16 + fr) * ldc + col0;
#pragma unroll
            for (int bj = 0; bj < 2; ++bj)
#pragma unroll
                for (int n = 0; n < 2; ++n) v[m][bj][n] = *(const f32x4*)(base + off + bj * HALF + n * 16); }
        asm volatile("" ::: "memory");
#pragma unroll
        for (int m = 0; m < 4; ++m)
#pragma unroll
            for (int bj = 0; bj < 2; ++bj)
#pragma unroll
                for (int n = 0; n < 2; ++n) s0[m][bj][n] = v[m][bj][n] + acc[0][bj][m][n];
        asm volatile("" ::: "memory");
#pragma unroll
        for (int m = 0; m < 4; ++m) { const size_t off = (size_t)(u.pm * BM + HALF + wr * 64 + m * 16 + fr) * ldc + col0;
#pragma unroll
            for (int bj = 0; bj < 2; ++bj)
#pragma unroll
                for (int n = 0; n < 2; ++n) v[m][bj][n] = *(const f32x4*)(base + off + bj * HALF + n * 16); }
        asm volatile("" ::: "memory");
#pragma unroll
        for (int m = 0; m < 4; ++m) { const size_t off = (size_t)(u.pm * BM + wr * 64 + m * 16 + fr) * ldc + col0;
#pragma unroll
            for (int bj = 0; bj < 2; ++bj)
#pragma unroll
                for (int n = 0; n < 2; ++n) *(f32x4*)(out + off + bj * HALF + n * 16) = s0[m][bj][n]; }
        asm volatile("" ::: "memory");
#pragma unroll
        for (int m = 0; m < 4; ++m) { const size_t off = (size_t)(u.pm * BM + HALF + wr * 64 + m * 16 + fr) * ldc + col0;
#pragma unroll
            for (int bj = 0; bj < 2; ++bj)
#pragma unroll
                for (int n = 0; n < 2; ++n) *(f32x4*)(out + off + bj * HALF + n * 16) = v[m][bj][n] + acc[1][bj][m][n]; }
        asm volatile("" ::: "memory");
    }
};
struct EpiMoe1 {
    static constexpr bool PERM = true;
    bf16_t* O; const float* gates;
    __device__ __forceinline__ void operator()(const Acc& acc, const Unit& u, int wr, int wc, int fr, int fq) const {
        const int row0 = u.pm * BM + wr * 64 + fr; const int half = u.pn >> 2; const int col0 = half * 512 + (u.pn & 3) * 128 + wc * 32 + 8 * fq;
        const __amdgpu_buffer_rsrc_t rs = __builtin_amdgcn_make_buffer_rsrc(O, 0, MPAD * 1024 * 2, 0x00020000);
#pragma unroll
        for (int ai = 0; ai < 2; ++ai)
#pragma unroll
            for (int m = 0; m < 4; ++m) { const int row = row0 + ai * HALF + m * 16; const float gw = gates[(size_t)row * 2 + half];
                float v[8];
#pragma unroll
                for (int e = 0; e < 8; ++e) { const float g = acc[ai][0][m][e >> 2][e & 3], up = acc[ai][1][m][e >> 2][e & 3]; v[e] = g * sigmoidf_(g) * up * gw; }
                u32x4 w; w.x = cvt_pk_bf16(v[0], v[1]); w.y = cvt_pk_bf16(v[2], v[3]); w.z = cvt_pk_bf16(v[4], v[5]); w.w = cvt_pk_bf16(v[6], v[7]);
                __builtin_amdgcn_raw_buffer_store_b128(w, rs, (unsigned)(row * 1024 + col0) * 2u, 0, 16); }
    }
};
struct EpiMoe2 {
    static constexpr bool PERM = false;
    float* out; const int* rowtok; int dry;
    __device__ __forceinline__ void operator()(const Acc& acc, const Unit& u, int wr, int wc, int fr, int fq) const {
        const int col0 = u.pn * BM + wc * 32 + 4 * fq;
#pragma unroll
        for (int ai = 0; ai < 2; ++ai) {
            int tok[4]; f32x4 v[4][2][2];
#pragma unroll
            for (int m = 0; m < 4; ++m) tok[m] = rowtok[u.pm * BM + ai * HALF + wr * 64 + m * 16 + fr];
#pragma unroll
            for (int m = 0; m < 4; ++m) { const float* o = out + (size_t)(tok[m] < 0 ? 0 : tok[m]) * DM + col0;
#pragma unroll
                for (int bj = 0; bj < 2; ++bj)
#pragma unroll
                    for (int n = 0; n < 2; ++n) v[m][bj][n] = *(const f32x4*)(o + bj * HALF + n * 16); }
            asm volatile("" ::: "memory");
#pragma unroll
            for (int m = 0; m < 4; ++m) { if (tok[m] >= 0 && !dry) { float* o = out + (size_t)tok[m] * DM + col0;
#pragma unroll
                for (int bj = 0; bj < 2; ++bj)
#pragma unroll
                    for (int n = 0; n < 2; ++n) *(f32x4*)(o + bj * HALF + n * 16) = v[m][bj][n] + acc[ai][bj][m][n]; } }
            asm volatile("" ::: "memory");
        }
    }
};
}

#define XB_TMO      128
#define XB_XCNT(j)  (256  + 64 * (j))
#define XB_XSUB(j)  (1280 + 64 * (j))
#define XB_XGEN(j)  (2304 + 64 * (j))
#define XB_TOP      3328
#define XB_TOPGEN   3392
#define XCD_BAR_WORDS 3456
#define XB_SPIN_CAP (1u << 20)
__device__ __forceinline__ unsigned xb_ld(unsigned* p)              { return __hip_atomic_load(p, __ATOMIC_RELAXED, __HIP_MEMORY_SCOPE_AGENT); }
__device__ __forceinline__ unsigned xb_add(unsigned* p, unsigned v) { return __hip_atomic_fetch_add(p, v, __ATOMIC_RELAXED, __HIP_MEMORY_SCOPE_AGENT); }
__device__ __forceinline__ unsigned xb_xcc_id() { return (unsigned)__builtin_amdgcn_s_getreg((3 << 11) | 20) & 0xFu; }
#define XB_SPIN(cond, bar) do { unsigned _sp = 0; while (cond) { __builtin_amdgcn_s_sleep(1); \
    if ((++_sp & 255u) == 0u) { if (xb_ld(&(bar)[XB_TMO])) break; if (_sp > XB_SPIN_CAP) { atomicAdd(&(bar)[XB_TMO], 1u); break; } } } } while (0)
struct XcdBarrier { unsigned* bar; unsigned x; volatile LAS unsigned* st; };
__device__ __forceinline__ XcdBarrier xcd_barrier_post(unsigned* bar, volatile LAS unsigned* st) {
    XcdBarrier b; b.bar = bar; b.x = xb_xcc_id(); b.st = st;
    if (threadIdx.x == 0) (void)xb_add(&bar[XB_XCNT(b.x)], 1u);
    return b;
}
__device__ __forceinline__ void xcd_barrier_complete(unsigned* bar, unsigned x, unsigned& nloc, unsigned& nx) {
    const unsigned G = gridDim.x * gridDim.y * gridDim.z;
    unsigned sum, cnt, mine, sp = 0u;
    for (;;) {
        sum = 0u; cnt = 0u; mine = 0u;
#pragma unroll
        for (unsigned j = 0; j < 16; ++j) { const unsigned c = xb_ld(&bar[XB_XCNT(j)]); sum += c; cnt += (c > 0u) ? 1u : 0u; mine = (j == x) ? c : mine; }
        if (sum == G) break;
        __builtin_amdgcn_s_sleep(1);
        if ((++sp & 255u) == 0u) { if (xb_ld(&bar[XB_TMO])) break; if (sp > XB_SPIN_CAP) { atomicAdd(&bar[XB_TMO], 1u); break; } }
    }
    nloc = mine > 0u ? mine : 1u; nx = cnt > 0u ? cnt : 1u;
}
__device__ __forceinline__ void xcd_barrier(const XcdBarrier& b) {
    asm volatile("s_waitcnt vmcnt(0)" ::: "memory");
    __syncthreads();
    if (threadIdx.x == 0) {
        unsigned* bar = b.bar;
        __builtin_amdgcn_s_waitcnt(0);
        unsigned nloc = b.st[0], nx = b.st[1];
        if (nloc == 0u) { xcd_barrier_complete(bar, b.x, nloc, nx); b.st[0] = nloc; b.st[1] = nx; }
        const unsigned old = xb_add(&bar[XB_XSUB(b.x)], 1u);
        const unsigned gen = old / nloc;
        if (old + 1u == (gen + 1u) * nloc) {
            __builtin_amdgcn_fence(__ATOMIC_RELEASE, "agent");
            asm volatile("s_waitcnt vmcnt(0)" ::: "memory");
            const unsigned og = xb_add(&bar[XB_TOP], 1u);
            const unsigned tg = og / nx;
            if (og + 1u == (tg + 1u) * nx) xb_add(&bar[XB_TOPGEN], 1u);
            else XB_SPIN(xb_ld(&bar[XB_TOPGEN]) == tg, bar);
            __builtin_amdgcn_fence(__ATOMIC_ACQUIRE, "agent");
            xb_add(&bar[XB_XGEN(b.x)], 1u);
            asm volatile("s_waitcnt vmcnt(0)" ::: "memory");
        } else {
            XB_SPIN(xb_ld(&bar[XB_XGEN(b.x)]) == gen, bar);
            __builtin_amdgcn_fence(__ATOMIC_ACQUIRE, "agent");
            asm volatile("s_waitcnt vmcnt(0)" ::: "memory");
        }
    }
    __syncthreads();
}

struct Args { const float* in[25]; float* out; unsigned char* ws; int ph_lo, ph_hi; };
enum { I_X = 0, I_GMIX, I_WIN, I_MIX, I_QG, I_KG, I_W0, I_WDEC, I_A0, I_WAICL, I_WGATE, I_KK, I_KA, I_RK, I_LNW, I_LNB, I_WOUT, I_GFFN, I_WRG, I_BRG, I_WRE, I_BRE, I_WEG, I_WEU, I_WED };

struct Frame {
    LAS unsigned char* lds; unsigned char* ldsg;
    unsigned* ctl;
    int tid, lane, wave, vcu, G;
    const float* const* in; float* out; unsigned char* ws;
};

__device__ __forceinline__ int win_dmap(int n) {
    if (n < DSA_COLS) return n;
    const int m = n - DSA_COLS;
    if (m < 1024) return PR + m;
    if (m < 1088) return PDW + (m - 1024);
    if (m < 2112) return PKR + (m - 1088);
    if (m < 3136) return PVR + (m - 2112);
    if (m < 3200) return PDA + (m - 3136);
    return PDG + (m - 3200);
}
template <int MODE, int KMAX = (1 << 30)>
__device__ __forceinline__ void transpose_item(const float* W, int N, bf16_t* WT, int ldd, LAS float* scr, int kb, int nb, int lane) {
    const int k0 = 64 * kb, n0 = 32 * nb;
    const int nn = n0 + (lane & 31);
    float tv[32];
#pragma unroll
    for (int i = 0; i < 32; ++i) { const int kk = 2 * i + (lane >> 5); tv[i] = (nn < N && (KMAX == (1 << 30) || k0 + kk < KMAX)) ? W[(size_t)(k0 + kk) * N + nn] : 0.f; }
#pragma unroll
    for (int i = 0; i < 32; ++i) { const int kk = 2 * i + (lane >> 5); scr[kk * 33 + (lane & 31)] = tv[i]; }
    LDS_WAIT(); asm volatile("" ::: "memory");
    const int c = lane & 7;
#pragma unroll
    for (int j = 0; j < 4; ++j) { const int nl = (lane >> 3) + 8 * j; const int n = n0 + nl; const LAS float* s = scr + (8 * c) * 33 + nl;
        u32x4 o; o.x = pk2(s[0 * 33], s[1 * 33]); o.y = pk2(s[2 * 33], s[3 * 33]); o.z = pk2(s[4 * 33], s[5 * 33]); o.w = pk2(s[6 * 33], s[7 * 33]);
        int dr = n;
        if (MODE == 1) dr = win_dmap(n);
        if (MODE == 2) dr = (n >> 7) * 256 + (n & 127);
        if (MODE == 3) dr = (n >> 7) * 256 + 128 + (n & 127);
        if (n < N) *(u32x4*)(WT + (size_t)dr * ldd + k0 + 8 * c) = o; }
    LDS_WAIT(); asm volatile("" ::: "memory");
}

__device__ __forceinline__ void phase0(Frame& F) {
    LAS float* scr = (LAS float*)(F.lds + F.wave * 16384);
    const int gw = F.vcu * 8 + F.wave, NGW = F.G * 8, lane = F.lane;
    constexpr int NB_IN = (IN_COLS + 31) / 32;
    constexpr int I_IN = (DM / 64) * NB_IN, I_OUT = (DM / 64) * (DM / 32);
    bf16_t* WIN = (bf16_t*)(F.ws + WS_WIN); bf16_t* WOUT = (bf16_t*)(F.ws + WS_WOUT);
    bf16_t* WL = (bf16_t*)(F.ws + WS_WLORA);
    for (int it = gw; it < I_IN; it += NGW) transpose_item<1>(F.in[I_WIN], IN_COLS, WIN, DM, scr, it / NB_IN, it % NB_IN, lane);
    for (int i = gw * 64 + lane; i < NL * 8; i += NGW * 64) { const int n = i >> 3, q = i & 7, typ = n >> 10; const int col = (typ == 0 ? 64 : (typ == 1 ? 0 : 320)) + 8 * q;
        *(u32x4*)(WL + (size_t)n * KL + col) = (u32x4){0u, 0u, 0u, 0u}; }
    for (int i = gw; i < 144 * 4; i += NGW) { const int r = i >> 2, q = i & 3; const int row = r < 48 ? 4176 + r : 7584 + (r - 48);
        *(u32x4*)(WIN + (size_t)row * DM + q * 512 + lane * 8) = (u32x4){0u, 0u, 0u, 0u}; }
    { bf16_t* WRH = (bf16_t*)(F.ws + WS_WRT); bf16_t* WRL = WRH + 32 * DM; const float* wrg = F.in[I_WRG]; const float* wre = F.in[I_WRE]; const float* gf = F.in[I_GFFN];
      for (int i = gw * 64 + lane; i < 32 * DM; i += NGW * 64) { const int o = i / DM, k = i % DM; float v = 0.f;
          if (o < 4) v = gf[k] * wrg[k * 4 + o]; else if (o < 20) v = gf[k] * wre[k * 16 + (o - 4)];
          const unsigned hb = f2bf(v); const float lo = v - bf2f((unsigned short)hb);
          const int idx = ((((k >> 9) * 32 + ((k & 511) >> 4)) * 64 + o + 32 * ((k & 15) >> 3)) << 3) + (k & 7);
          WRH[idx] = (bf16_t)hb; WRL[idx] = (bf16_t)f2bf(lo); } }
    { const float* x = F.in[I_X]; const float* g = F.in[I_GMIX]; bf16_t* HN = (bf16_t*)(F.ws + WS_HN);
      f32x4 gv[8];
#pragma unroll
      for (int j = 0; j < 8; ++j) gv[j] = ((const f32x4*)g)[64 * j + lane];
      for (int m2 = gw; m2 < T / 2; m2 += NGW) {
          f32x4 v[2][8]; float s2[2] = {0.f, 0.f};
#pragma unroll
          for (int u = 0; u < 2; ++u) { const f32x4* xr = (const f32x4*)(x + (size_t)(2 * m2 + u) * DM) + lane;
#pragma unroll
              for (int j = 0; j < 8; ++j) v[u][j] = xr[64 * j]; }
#pragma unroll
          for (int u = 0; u < 2; ++u) {
#pragma unroll
              for (int j = 0; j < 8; ++j) s2[u] += (v[u][j].x * v[u][j].x + v[u][j].y * v[u][j].y) + (v[u][j].z * v[u][j].z + v[u][j].w * v[u][j].w);
              const float rstd = rsqrtf(wave_sum(s2[u]) * (1.f / DM) + NORM_EPS);
              u32x2* o = (u32x2*)(HN + (size_t)(2 * m2 + u) * DM) + lane;
#pragma unroll
              for (int j = 0; j < 8; ++j) { u32x2 w; w.x = pk2(v[u][j].x * rstd * gv[j].x, v[u][j].y * rstd * gv[j].y); w.y = pk2(v[u][j].z * rstd * gv[j].z, v[u][j].w * rstd * gv[j].w); o[64 * j] = w; } } } }
}

__device__ __forceinline__ void late_weight_items(Frame& F) {
    LAS float* scr = (LAS float*)(F.lds + F.wave * 16384); const int gw = F.vcu * 8 + F.wave, NGW = F.G * 8, lane = F.lane;
    constexpr int I_OUT = (DM / 64) * (DM / 32);
    bf16_t* WOUT = (bf16_t*)(F.ws + WS_WOUT); bf16_t* WL = (bf16_t*)(F.ws + WS_WLORA);
    for (int r = gw; r < I_OUT + 160; r += NGW) {
        if (r < I_OUT) transpose_item<0>(F.in[I_WOUT], DM, WOUT, DM, scr, r / (DM / 32), r % (DM / 32), lane);
        else { const int q = r - I_OUT;
            if (q < 32) transpose_item<0>(F.in[I_WDEC], 1024, WL, KL, scr, 0, q, lane);
            else if (q < 64) transpose_item<0>(F.in[I_WAICL], 1024, WL + (size_t)1024 * KL + 64, KL, scr, 0, q - 32, lane);
            else transpose_item<0, 160>(F.in[I_WGATE], 1024, WL + (size_t)2048 * KL + 128, KL, scr, (q - 64) >> 5, (q - 64) & 31, lane); } }
}

__device__ __forceinline__ void rope4(float& y0, float& y1, float& y2, float& y3, float c0, float s0, float c1, float s1) {
    const float o0 = y0 * c0 - y2 * s0, o2 = y2 * c0 + y0 * s0, o1 = y1 * c1 - y3 * s1, o3 = y3 * c1 + y1 * s1; y0 = o0; y1 = o1; y2 = o2; y3 = o3;
}
__device__ __forceinline__ void phase2(Frame& F, const bool dry) {
    const int gw = F.vcu * 8 + F.wave, NGW = F.G * 8, lane = F.lane;
    bf16_t* P = (bf16_t*)(F.ws + WS_P); bf16_t* KI = (bf16_t*)(F.ws + WS_KI); bf16_t* AL = (bf16_t*)(F.ws + WS_ALORA);
    const float* mix = F.in[I_MIX];
    const int l5 = lane & 31, hsel = lane >> 5, l4 = lane & 15, hq = lane >> 4;
    float qg[4], kg[4];
    { const float* a = F.in[I_QG]; const float* b = F.in[I_KG];
      qg[0] = a[2 * l5]; qg[1] = a[2 * l5 + 1]; qg[2] = a[64 + 2 * l5]; qg[3] = a[65 + 2 * l5];
      kg[0] = b[2 * l5]; kg[1] = b[2 * l5 + 1]; kg[2] = b[64 + 2 * l5]; kg[3] = b[65 + 2 * l5]; }
    const float L2T = 13.287712379549449f;
    const float inv128_0 = exp2f(-(float)(2 * l5) * (1.0f / 64.0f) * L2T), inv128_1 = exp2f(-(float)(2 * l5 + 1) * (1.0f / 64.0f) * L2T);
    const float inv64_0 = exp2f(-(float)(2 * l4) * (1.0f / 32.0f) * L2T), inv64_1 = exp2f(-(float)(2 * l4 + 1) * (1.0f / 32.0f) * L2T);
    const float mu_dw = mix[1024 + lane], mu_da = mix[3136 + lane], mu_g0 = mix[3200 + lane], mu_g1 = mix[3264 + lane], mu_g2 = (lane < 32) ? mix[3328 + lane] : 0.f;
    for (int tp = gw; tp < T / 2; tp += NGW) {
        unsigned qa[2][4], qb[2][4], ka[2][4], kb[2][4], ia[2][4], ib[2][4];
        float ap[2][5], apv[2][5], xk[2][4], wsum[2];
#pragma unroll
        for (int u = 0; u < 2; ++u) {
            const int t = 2 * tp + u; const int pos = t & (SEQ - 1);
            const bf16_t* row = P + (size_t)t * NP;
#pragma unroll
            for (int hh = 0; hh < 4; ++hh) {
                const unsigned* bq = (const unsigned*)(row + PQ + (2 * hh + hsel) * 128); const unsigned* bk = (const unsigned*)(row + PK + (2 * hh + hsel) * 128);
                qa[u][hh] = bq[l5]; qb[u][hh] = bq[32 + l5]; ka[u][hh] = bk[l5]; kb[u][hh] = bk[32 + l5];
                const unsigned* bi = (const unsigned*)(row + PQI + (4 * hh + hq) * 64);
                ia[u][hh] = bi[l4]; ib[u][hh] = bi[16 + l4];
            }
            const float* s0 = F.out + (size_t)t * 512; const float* s1 = s0 + (size_t)T * 512;
            { const f32x2 a0 = *(const f32x2*)(s0 + 2 * l4), a1 = *(const f32x2*)(s1 + 2 * l4), b0 = *(const f32x2*)(s0 + 32 + 2 * l4), b1 = *(const f32x2*)(s1 + 32 + 2 * l4);
              xk[u][0] = a0.x + a1.x; xk[u][1] = a0.y + a1.y; xk[u][2] = b0.x + b1.x; xk[u][3] = b0.y + b1.y; }
            wsum[u] = s0[64 + lane] + s1[64 + lane];
            const bool hp = pos > 0;
            ap[u][0] = s0[128 + lane] + s1[128 + lane]; ap[u][1] = s0[192 + lane] + s1[192 + lane]; ap[u][2] = s0[256 + lane] + s1[256 + lane]; ap[u][3] = s0[320 + lane] + s1[320 + lane];
            ap[u][4] = (lane < 32) ? s0[384 + lane] + s1[384 + lane] : 0.f;
            apv[u][0] = hp ? s0[128 + lane - 512] + s1[128 + lane - 512] : 0.f; apv[u][1] = hp ? s0[192 + lane - 512] + s1[192 + lane - 512] : 0.f; apv[u][2] = hp ? s0[256 + lane - 512] + s1[256 + lane - 512] : 0.f;
            apv[u][3] = hp ? s0[320 + lane - 512] + s1[320 + lane - 512] : 0.f; apv[u][4] = (hp && lane < 32) ? s0[384 + lane - 512] + s1[384 + lane - 512] : 0.f;
        }
        asm volatile("" ::: "memory");
#pragma unroll
        for (int u = 0; u < 2; ++u) {
            const int t = 2 * tp + u; const int pos = t & (SEQ - 1); const float fp = (float)pos;
            bf16_t* row = P + (size_t)t * NP;
            float c0, s0, c1, s1, d0, e0, d1, e1;
            { const float a0 = fp * inv128_0, a1 = fp * inv128_1, a2 = fp * inv64_0, a3 = fp * inv64_1;
              const float r0 = __builtin_amdgcn_fractf(a0 * 0.15915494309189535f), r1 = __builtin_amdgcn_fractf(a1 * 0.15915494309189535f), r2 = __builtin_amdgcn_fractf(a2 * 0.15915494309189535f), r3 = __builtin_amdgcn_fractf(a3 * 0.15915494309189535f);
              s0 = __builtin_amdgcn_sinf(r0); c0 = __builtin_amdgcn_cosf(r0); s1 = __builtin_amdgcn_sinf(r1); c1 = __builtin_amdgcn_cosf(r1);
              e0 = __builtin_amdgcn_sinf(r2); d0 = __builtin_amdgcn_cosf(r2); e1 = __builtin_amdgcn_sinf(r3); d1 = __builtin_amdgcn_cosf(r3); }
#pragma unroll
            for (int which = 0; which < 2; ++which) {
#pragma unroll
                for (int hh = 0; hh < 4; ++hh) {
                    unsigned* base = (unsigned*)(row + (which ? PK : PQ) + (2 * hh + hsel) * 128);
                    const unsigned a = which ? ka[u][hh] : qa[u][hh], b = which ? kb[u][hh] : qb[u][hh];
                    float y0 = bflo(a), y1 = bfhi(a), y2 = bflo(b), y3 = bfhi(b);
                    const float ss = half_sum((y0 * y0 + y1 * y1) + (y2 * y2 + y3 * y3));
                    const float rstd = rsqrtf(ss * (1.0f / 128.0f) + NORM_EPS) * (which ? 1.0f : QSCALE);
                    const float* gg = which ? kg : qg;
                    y0 *= rstd * gg[0]; y1 *= rstd * gg[1]; y2 *= rstd * gg[2]; y3 *= rstd * gg[3];
                    rope4(y0, y1, y2, y3, c0, s0, c1, s1);
                    if (!dry) { base[l5] = pk2(y0, y1); base[32 + l5] = pk2(y2, y3); }
                }
            }
#pragma unroll
            for (int it = 0; it < 4; ++it) {
                unsigned* base = (unsigned*)(row + PQI + (4 * it + hq) * 64);
                float y0 = bflo(ia[u][it]), y1 = bfhi(ia[u][it]), y2 = bflo(ib[u][it]), y3 = bfhi(ib[u][it]);
                rope4(y0, y1, y2, y3, d0, e0, d1, e1);
                if (!dry) { base[l4] = pk2(y0, y1); base[16 + l4] = pk2(y2, y3); }
            }
            if (lane < 16 && !dry) {
                float y0 = xk[u][0], y1 = xk[u][1], y2 = xk[u][2], y3 = xk[u][3];
                rope4(y0, y1, y2, y3, d0, e0, d1, e1);
                unsigned* o = (unsigned*)(KI + (size_t)t * 64);
                o[l4] = pk2(y0, y1); o[16 + l4] = pk2(y2, y3);
                row[PWI + lane] = (bf16_t)f2bf(wsum[u]);
            }
            if (!dry) {
                bf16_t* al = AL + (size_t)t * KL;
                float sh;
                sh = ap[u][0] + (apv[u][0] - ap[u][0]) * mu_dw; al[lane] = (bf16_t)f2bf(1.0f - 2.0f * __builtin_amdgcn_rcpf(1.0f + __expf(2.0f * sh)));
                sh = ap[u][1] + (apv[u][1] - ap[u][1]) * mu_da; al[64 + lane] = (bf16_t)f2bf(sh);
                sh = ap[u][2] + (apv[u][2] - ap[u][2]) * mu_g0; al[128 + lane] = (bf16_t)f2bf(sigmoidf_(sh));
                sh = ap[u][3] + (apv[u][3] - ap[u][3]) * mu_g1; al[192 + lane] = (bf16_t)f2bf(sigmoidf_(sh));
                if (lane < 32) { sh = ap[u][4] + (apv[u][4] - ap[u][4]) * mu_g2; al[256 + lane] = (bf16_t)f2bf(sigmoidf_(sh)); }
                al[288 + lane] = 0; if (lane < 32) al[352 + lane] = 0;
            }
        }
    }
}

__device__ __forceinline__ unsigned fkey(float f) { const unsigned u = __builtin_bit_cast(unsigned, f); return (u & 0x80000000u) ? ~u : (u | 0x80000000u); }
constexpr int CW_QIDX = 192;
constexpr int IDX_BUF = 256 * 128;
constexpr int SC_BATCH = 4096 * 2080;
constexpr int NSCU = 4 * 544;
__device__ __forceinline__ size_t sc_row_off(int b, int i, int q) { return (size_t)b * SC_BATCH + (size_t)2048 * i * (i + 1) + (size_t)q * 64 * (i + 1); }
typedef _Float16 h16x2 __attribute__((ext_vector_type(2)));
struct IdxQ { bf16x8 a[4]; h16x2 wq[8]; };
__device__ __forceinline__ void idxq_load(IdxQ& d, const bf16_t* P, int tq, int r, int h) {
    const bf16_t* ap = P + (size_t)(tq + ((r >> 2) & 1)) * NP + PQI + ((r & 3) + 4 * (r >> 3)) * 64 + 8 * h;
#pragma unroll
    for (int s = 0; s < 4; ++s) d.a[s] = *(const bf16x8*)(ap + 16 * s);
    const u32x4* wp = (const u32x4*)(P + (size_t)(tq + h) * NP + PWI);
    const u32x4 w0 = wp[0], w1 = wp[1];
#pragma unroll
    for (int e = 0; e < 8; ++e) { const unsigned w = e < 4 ? w0[e] : w1[e - 4]; d.wq[e].x = (_Float16)(bflo(w) * (1.0f / 32.0f)); d.wq[e].y = (_Float16)(bfhi(w) * (1.0f / 32.0f)); }
}
constexpr int NSCU2 = 640;
__device__ __forceinline__ void idx_decode(int u, int& b, int& i, int& st0, int& st1) {
    b = u / 160; const int v = 159 - (u % 160);
    const int band = v < 16 ? 0 : (v < 48 ? 1 : (v < 96 ? 2 : 3)), cum = band == 0 ? 0 : (band == 1 ? 16 : (band == 2 ? 48 : 96));
    const int rem = v - cum; i = 16 * band + rem / (band + 1); const int sg = rem % (band + 1);
    const int nst = (i >> 2) + 1; st0 = 4 * sg; st1 = (4 * sg + 3 < nst - 1) ? 4 * sg + 3 : nst - 1;
}
__device__ __forceinline__ void idx_stage(Frame& F, int b, int st, int buf) {
    const int lane = F.lane, wave = F.wave;
    const unsigned char* kg = F.ws + WS_KI + ((size_t)b * SEQ + 256 * st) * 128 + (size_t)(wave * 8 + (lane >> 3)) * 128 + (size_t)(((lane & 7) ^ (lane >> 3)) * 16);
#pragma unroll
    for (int q = 0; q < 4; ++q) __builtin_amdgcn_global_load_lds((const unsigned*)(kg + q * 8192), (LAS unsigned*)(F.lds + buf * IDX_BUF + (q * 8 + wave) * 1024), 16, 0, 0);
}
__device__ __forceinline__ void idx_score_tile(Frame& F, const IdxQ (&qv)[4], int b, int i, int st, int buf) {
    int lane_ = F.lane; asm volatile("" : "+v"(lane_));
    const int lane = lane_, wave = F.wave, r = lane & 31, h = lane >> 5;
    _Float16* SC = (_Float16*)(F.ws + WS_SC);
    const int nvb = (2 * (i + 1) - 8 * st) < 8 ? (2 * (i + 1) - 8 * st) : 8;
    const LAS unsigned char* kb = F.lds + buf * IDX_BUF + r * 128; const int sw = r & 7;
    _Float16* dummy = (_Float16*)(F.ws + WS_SINK) + (blockIdx.x * 512 + threadIdx.x) % 32768;
    _Float16* srow0 = SC + sc_row_off(b, i, 2 * wave + h) + 256 * st + r; const size_t gstr = (size_t)1024 * (i + 1);
    float res[4][8];
#pragma unroll
    for (int jb = 0; jb < 8; ++jb) {
        bf16x8 kf[4];
#pragma unroll
        for (int s = 0; s < 4; ++s) kf[s] = *(const LAS bf16x8*)(kb + jb * 4096 + (((2 * s + h) ^ sw) * 16));
#pragma unroll
        for (int g = 0; g < 4; ++g) {
            f32x16 acc = {0.f, 0.f, 0.f, 0.f, 0.f, 0.f, 0.f, 0.f, 0.f, 0.f, 0.f, 0.f, 0.f, 0.f, 0.f, 0.f};
#pragma unroll
            for (int s = 0; s < 4; ++s) acc = __builtin_amdgcn_mfma_f32_32x32x16_bf16(qv[g].a[s], kf[s], acc, 0, 0, 0);
            float sum = 0.f, sum1 = 0.f;
#pragma unroll
            for (int e = 0; e < 16; ++e) { const float rl = __builtin_amdgcn_fmed3f(acc[e], 0.f, 3.0e38f);
                const unsigned wpk = __builtin_bit_cast(unsigned, qv[g].wq[e >> 1]);
                if (e & 1) asm("v_fma_mix_f32 %0, %1, %2, %0 op_sel:[1,0,0] op_sel_hi:[1,0,0]" : "+v"(sum1) : "v"(wpk), "v"(rl));
                else asm("v_fma_mix_f32 %0, %1, %2, %0 op_sel:[0,0,0] op_sel_hi:[1,0,0]" : "+v"(sum) : "v"(wpk), "v"(rl)); }
            res[g][jb] = sum + sum1;
        }
        __builtin_amdgcn_sched_barrier(0);
    }
#pragma unroll
    for (int g = 0; g < 4; ++g)
#pragma unroll
        for (int jb = 0; jb < 8; ++jb) { _Float16* dst = (jb < nvb) ? srow0 + g * gstr + 32 * jb : dummy; *dst = (_Float16)res[g][jb]; }
}
__device__ __forceinline__ unsigned pk_lt(unsigned cand2, unsigned k2) {
    unsigned d; asm("v_pk_sub_u16 %0, %1, %2 clamp" : "=v"(d) : "v"(cand2), "v"(k2)); asm("v_pk_min_u16 %0, %1, %2" : "=v"(d) : "v"(d), "v"(0x00010001u)); return d;
}
__device__ __forceinline__ int wave_sum_i(int v) {
#define DPP_ADDI(v, ctrl, rm) (v) += __builtin_amdgcn_update_dpp(0, (v), (ctrl), (rm), 0xF, false)
    DPP_ADDI(v, 0xB1, 0xF); DPP_ADDI(v, 0x4E, 0xF); DPP_ADDI(v, 0x141, 0xF); DPP_ADDI(v, 0x140, 0xF); DPP_ADDI(v, 0x142, 0xA); DPP_ADDI(v, 0x143, 0xC);
#undef DPP_ADDI
    return __builtin_amdgcn_readlane(v, 63);
}
__device__ __forceinline__ int wave_excl_prefix_i(int v, int lane) {
    int x = v;
#pragma unroll
    for (int o = 1; o < 64; o <<= 1) { const int y = __shfl_up(x, o); x += (lane >= o) ? y : 0; }
    return x - v;
}
__device__ __forceinline__ void idx_row_load(Frame& F, int b, int pos, u32x4 (&raw)[8]) {
    const int lane = F.lane, i = pos >> 6, q0 = pos & 63, n = 64 * (i + 1), nch = (n + 511) >> 9;
    const u32x4* sp = (const u32x4*)((const unsigned short*)(F.ws + WS_SC) + sc_row_off(b, i, q0)) + lane;
#pragma unroll
    for (int q = 0; q < 8; ++q) { raw[q] = (u32x4){0u, 0u, 0u, 0u}; if (q < nch && i >= 4) raw[q] = sp[64 * q]; }
}
__device__ __forceinline__ void idx_select_row(Frame& F, int b, int pos, const u32x4 (&raw)[8]) {
    const int lane = F.lane, i = pos >> 6, nj = i + 1, n = 64 * nj, t = b * SEQ + pos;
    unsigned* MSK = (unsigned*)(F.ws + WS_MSK) + (size_t)t * 128;
    if (nj <= 4) { MSK[lane] = (lane < 2 * nj) ? 0xFFFFFFFFu : 0u; MSK[64 + lane] = 0u; return; }
    const int nch = (n + 511) >> 9;
    unsigned k2[32];
#pragma unroll
    for (int q = 0; q < 8; ++q) {
        const u32x4 v = raw[q];
        const bool ok = (512 * q + 8 * lane) < n;
#pragma unroll
        for (int e = 0; e < 4; ++e) { const unsigned x = v[e]; unsigned m; asm("v_pk_ashrrev_i16 %0, %1, %2" : "=v"(m) : "v"(0x000F000Fu), "v"(x)); m |= 0x80008000u; k2[4 * q + e] = ok ? (x ^ m) : 0u; }
    }
    unsigned thr; int ngt, nge;
    {
        LAS unsigned* H = (LAS unsigned*)(F.lds + F.wave * 5120);
        const int cb = (lane & 3) * 264, dmy = 256 + ((lane >> 2) & 7), total = 512 * nch;
        int need = 256; unsigned hiB = 0u;
#pragma unroll
        for (int pass = 0; pass < 2; ++pass) {
#pragma unroll
            for (int j = 0; j < 5; ++j) *(LAS u32x4*)(H + 4 * lane + 256 * j) = (u32x4){0u, 0u, 0u, 0u};
            LDS_WAIT(); asm volatile("" ::: "memory");
#pragma unroll
            for (int q = 0; q < 8; ++q) { if (q < nch) {
#pragma unroll
                for (int e = 0; e < 4; ++e) { const unsigned x = k2[4 * q + e];
                    unsigned b0, b1;
                    if (pass == 0) { b0 = (x >> 8) & 255u; b1 = x >> 24; }
                    else { b0 = (((x >> 8) & 255u) == hiB) ? (x & 255u) : (unsigned)dmy; b1 = ((x >> 24) == hiB) ? ((x >> 16) & 255u) : (unsigned)dmy; }
                    (void)__hip_atomic_fetch_add(H + cb + b0, 1u, __ATOMIC_RELAXED, __HIP_MEMORY_SCOPE_WORKGROUP);
                    (void)__hip_atomic_fetch_add(H + cb + b1, 1u, __ATOMIC_RELAXED, __HIP_MEMORY_SCOPE_WORKGROUP); } } }
            LDS_WAIT(); asm volatile("" ::: "memory");
            u32x4 c = *(const LAS u32x4*)(H + 4 * lane);
#pragma unroll
            for (int k = 1; k < 4; ++k) { const u32x4 d = *(const LAS u32x4*)(H + 264 * k + 4 * lane); c.x += d.x; c.y += d.y; c.z += d.z; c.w += d.w; }
            const int T4 = (int)(c.x + c.y + c.z + c.w);
            const int tot = (pass == 0) ? total : wave_sum_i(T4);
            const int above_l = tot - wave_excl_prefix_i(T4, lane) - T4;
            const int s3 = above_l + (int)c.w, s2 = s3 + (int)c.z, s1 = s2 + (int)c.y;
            const bool mine = (above_l < need) && (above_l + T4 >= need);
            const int jsel = s3 >= need ? 3 : (s2 >= need ? 2 : (s1 >= need ? 1 : 0));
            const int abv = jsel == 3 ? above_l : (jsel == 2 ? s3 : (jsel == 1 ? s2 : s1));
            const unsigned long long bal = __ballot(mine);
            const int src = (int)__builtin_ctzll(bal | (1ull << 63));
            const unsigned dig = (unsigned)__builtin_amdgcn_readlane(4 * lane + jsel, src);
            const int abvu = __builtin_amdgcn_readlane(abv, src);
            if (pass == 0) { hiB = dig; need -= abvu; }
            else { thr = (hiB << 8) | dig; const int csel = jsel == 3 ? (int)c.w : (jsel == 2 ? (int)c.z : (jsel == 1 ? (int)c.y : (int)c.x));
                   ngt = (256 - need) + abvu; nge = ngt + __builtin_amdgcn_readlane(csel, src); }
        }
    }
    const unsigned t2 = thr * 0x00010001u, t2p = (thr + 1u) * 0x00010001u;
    const bool alltied = (nge == 256);
    int tiebase = 0, need = 256 - ngt;
#pragma unroll
    for (int q = 0; q < 8; ++q) {
        if (q < nch) {
            unsigned byte_ge = 0u;
#pragma unroll
            for (int e = 0; e < 4; ++e) { const unsigned g0 = pk_lt(t2, k2[4 * q + e]) ^ 0x00010001u;
                byte_ge |= ((g0 & 1u) << (2 * e)) | ((g0 >> 16) << (2 * e + 1)); }
            unsigned sel = byte_ge;
            if (!alltied) {
                unsigned byte_gt = 0u;
#pragma unroll
                for (int e = 0; e < 4; ++e) { const unsigned g1 = pk_lt(t2p, k2[4 * q + e]) ^ 0x00010001u;
                    byte_gt |= ((g1 & 1u) << (2 * e)) | ((g1 >> 16) << (2 * e + 1)); }
                const unsigned tie = byte_ge & ~byte_gt;
                sel = byte_gt;
                if (__ballot(tie != 0u) != 0ull) {
                    const int nt = __popc(tie);
                    const int pre = tiebase + wave_excl_prefix_i(nt, lane);
                    unsigned keep = 0u; int rank = pre;
#pragma unroll
                    for (int tt = 0; tt < 8; ++tt) { const unsigned bit = (tie >> tt) & 1u; keep |= (bit && rank < need) ? (1u << tt) : 0u; rank += (int)bit; }
                    sel = byte_gt | keep; tiebase += wave_sum_i(nt);
                }
            }
            unsigned w = sel << (8 * (lane & 3));
            w |= (unsigned)__builtin_amdgcn_update_dpp(0, (int)w, 0xB1, 0xF, 0xF, false);
            w |= (unsigned)__builtin_amdgcn_update_dpp(0, (int)w, 0x4E, 0xF, 0xF, false);
            if ((lane & 3) == 0) MSK[16 * q + (lane >> 2)] = w;
        } else if ((lane & 3) == 0) MSK[16 * q + (lane >> 2)] = 0u;
    }
}

__device__ __forceinline__ void attn_task_naive(Frame& F, int task, unsigned char* wl) {
    const int lane = F.lane;
    const bf16_t* P = (const bf16_t*)(F.ws + WS_P); const unsigned* MSK = (const unsigned*)(F.ws + WS_MSK); bf16_t* Y = (bf16_t*)(F.ws + WS_YCAT);
    int* list = (int*)wl; float* qs = (float*)(wl + 1024); float* ps = (float*)(wl + 1536);
    const int t = task >> 3, hd = task & 7, b = t >> 12, i = (t & (SEQ - 1)) >> 6;
    const int ntile = i + 1;
    int cnt = 0;
    for (int jj = 0; jj < ntile; ++jj) {
        const unsigned w0 = MSK[(size_t)t * 128 + 2 * jj], w1 = MSK[(size_t)t * 128 + 2 * jj + 1];
        const unsigned long long m = (unsigned long long)w0 | ((unsigned long long)w1 << 32);
        const int pre = __popcll(m & ((1ull << lane) - 1ull));
        if (((m >> lane) & 1ull) && (cnt + pre < 256)) list[cnt + pre] = 64 * jj + lane;
        cnt += __popcll(m);
    }
    const int nsel = cnt < 256 ? cnt : 256;
    { const bf16_t* qp = P + (size_t)t * NP + PQ + hd * 128; qs[lane] = bf2f(qp[lane]); qs[64 + lane] = bf2f(qp[64 + lane]); }
    LDS_WAIT(); asm volatile("" ::: "memory");
    float lg[4]; float mx = -INFINITY;
#pragma unroll
    for (int rr = 0; rr < 4; ++rr) {
        const int e = lane + 64 * rr; lg[rr] = -INFINITY;
        if (e < nsel) { const int key = list[e]; const u32x4* kp = (const u32x4*)(P + ((size_t)b * SEQ + key) * NP + PK + hd * 128); float d = 0.f;
#pragma unroll
            for (int c = 0; c < 16; ++c) { const u32x4 kv = kp[c]; const float* q = qs + 8 * c;
                d += q[0] * bflo(kv.x) + q[1] * bfhi(kv.x) + q[2] * bflo(kv.y) + q[3] * bfhi(kv.y) + q[4] * bflo(kv.z) + q[5] * bfhi(kv.z) + q[6] * bflo(kv.w) + q[7] * bfhi(kv.w); }
            lg[rr] = d; mx = fmaxf(mx, d); }
    }
#pragma unroll
    for (int o = 1; o < 64; o <<= 1) mx = fmaxf(mx, __shfl_xor(mx, o));
    float sum = 0.f;
#pragma unroll
    for (int rr = 0; rr < 4; ++rr) { const int e = lane + 64 * rr; const float p = (e < nsel) ? exp2f(lg[rr] - mx) : 0.f; ps[e] = p; sum += p; }
    sum = wave_sum(sum);
    LDS_WAIT(); asm volatile("" ::: "memory");
    float o0 = 0.f, o1 = 0.f;
    const bf16_t* vb = P + (size_t)b * SEQ * NP + PV + hd * 128 + 2 * lane;
    for (int e = 0; e < nsel; ++e) { const int key = list[e]; const float p = ps[e]; const unsigned v = *(const unsigned*)(vb + (size_t)key * NP); o0 += p * bflo(v); o1 += p * bfhi(v); }
    const float inv = 1.0f / sum;
    *(unsigned*)(Y + (size_t)t * DM + hd * 128 + 2 * lane) = pk2(o0 * inv, o1 * inv);
    LDS_WAIT(); asm volatile("" ::: "memory");
}

__device__ __forceinline__ void rwkv_scan_naive(Frame& F, int bh, unsigned char* wl) {
    const int lane = F.lane, b = bh >> 4, hd = bh & 15, ch = hd * 64 + lane;
    const bf16_t* P = (const bf16_t*)(F.ws + WS_P); const bf16_t* L3 = (const bf16_t*)(F.ws + WS_L3); bf16_t* Y = (bf16_t*)(F.ws + WS_YCAT);
    const float* mix = F.in[I_MIX];
    const float mu_r = mix[ch], mu_k = mix[1088 + ch], mu_v = mix[2112 + ch];
    const float kkc = F.in[I_KK][ch], kac = F.in[I_KA][ch], rkc = F.in[I_RK][ch], lnw = F.in[I_LNW][ch], lnb = F.in[I_LNB][ch];
    float* vec = (float*)wl;
    f32x4 S4[16];
#pragma unroll
    for (int k = 0; k < 16; ++k) S4[k] = (f32x4){0.f, 0.f, 0.f, 0.f};
    float prev_r = 0.f, prev_k = 0.f, prev_v = 0.f;
    constexpr int PF = 4;
    float in_r[PF], in_k[PF], in_v[PF], in_ld[PF], in_a[PF], in_g[PF];
    const bf16_t* prow = P + (size_t)b * SEQ * NP + ch; const bf16_t* lrow = L3 + (size_t)b * SEQ * NL + ch;
#pragma unroll
    for (int j = 0; j < PF; ++j) { const bf16_t* pr = prow + (size_t)j * NP; const bf16_t* lr = lrow + (size_t)j * NL;
        in_r[j] = bf2f(pr[PR]); in_k[j] = bf2f(pr[PKR]); in_v[j] = bf2f(pr[PVR]); in_ld[j] = bf2f(lr[0]); in_a[j] = bf2f(lr[1024]); in_g[j] = bf2f(lr[2048]); }
    const f32x4* vec4 = (const f32x4*)vec;
    for (int tb = 0; tb < SEQ; tb += PF) {
        float c_r[PF], c_k[PF], c_v[PF], c_ld[PF], c_a[PF], c_g[PF];
#pragma unroll
        for (int j = 0; j < PF; ++j) { c_r[j] = in_r[j]; c_k[j] = in_k[j]; c_v[j] = in_v[j]; c_ld[j] = in_ld[j]; c_a[j] = in_a[j]; c_g[j] = in_g[j]; }
        {
            const int tn = (tb + PF < SEQ) ? tb + PF : tb;
#pragma unroll
            for (int j = 0; j < PF; ++j) { const bf16_t* pr = prow + (size_t)(tn + j) * NP; const bf16_t* lr = lrow + (size_t)(tn + j) * NL;
                in_r[j] = bf2f(pr[PR]); in_k[j] = bf2f(pr[PKR]); in_v[j] = bf2f(pr[PVR]); in_ld[j] = bf2f(lr[0]); in_a[j] = bf2f(lr[1024]); in_g[j] = bf2f(lr[2048]); }
        }
#pragma unroll
        for (int j = 0; j < PF; ++j) {
            const float r_t = c_r[j] + (prev_r - c_r[j]) * mu_r, k_t = c_k[j] + (prev_k - c_k[j]) * mu_k, v_t = c_v[j] + (prev_v - c_v[j]) * mu_v;
            prev_r = c_r[j]; prev_k = c_k[j]; prev_v = c_v[j];
            const float a = c_a[j];
            const float kkr = k_t * kkc; const float n2 = wave_sum(kkr * kkr); const float kk = kkr * (1.0f / fmaxf(sqrtf(n2), 1e-12f));
            const float kp = k_t * (1.0f + (a - 1.0f) * kac); const float w = __expf(c_ld[j]); const float bb = kk * a;
            vec[lane] = -kk; vec[64 + lane] = w; vec[128 + lane] = bb; vec[192 + lane] = kp; vec[256 + lane] = r_t;
            LDS_WAIT(); asm volatile("" ::: "memory");
            f32x4 sa4 = (f32x4){0.f, 0.f, 0.f, 0.f};
#pragma unroll
            for (int k = 0; k < 16; ++k) { sa4 += S4[k] * vec4[k]; if ((k & 3) == 3) asm volatile("" ::: "memory"); }
            const float sa = (sa4.x + sa4.y) + (sa4.z + sa4.w);
            f32x4 y4 = (f32x4){0.f, 0.f, 0.f, 0.f};
#pragma unroll
            for (int k = 0; k < 16; ++k) {
                const f32x4 wv = vec4[16 + k], bv = vec4[32 + k], kv = vec4[48 + k], rv = vec4[64 + k];
                S4[k] = S4[k] * wv + bv * sa + kv * v_t; y4 += S4[k] * rv;
                if (k & 1) asm volatile("" ::: "memory"); }
            const float y = (y4.x + y4.y) + (y4.z + y4.w);
            const float mean = wave_sum(y) * (1.0f / 64.0f); const float dv = y - mean; const float var = wave_sum(dv * dv) * (1.0f / 64.0f);
            const float yn = dv * rsqrtf(var + GN_EPS) * lnw + lnb;
            const float bonus = wave_sum(r_t * kp * rkc) * v_t;
            const float o = (yn + bonus) * c_g[j];
            Y[((size_t)b * SEQ + tb + j) * DM + 1024 + ch] = (bf16_t)f2bf(o);
            asm volatile("" ::: "memory");
        }
    }
}


namespace rw {
constexpr int TP = 72, TILE_B = 64 * TP * 2;
enum { T_ATM = 0, T_RTM, T_BTM, T_KTM, T_ACM, T_VCM, T_BCM, T_KCM, T_MAB, T_MAK, T_MRB, T_MRK, T_TINV, NTILE };
constexpr int T_G1 = T_ATM, T_AP = T_BTM, T_U0 = T_KTM;
constexpr int OFF_X11T = NTILE * TILE_B, OFF_T1T = OFF_X11T + 2560, OFF_SEG = OFF_T1T + 2560, OFF_PC = OFF_SEG + 2048, LDS_END = OFF_PC + 256;
static_assert(LDS_END <= RING_BYTES, "rwkv pass A LDS");
__device__ __forceinline__ int crow(int e, int h) { return (e & 3) + 8 * (e >> 2) + 4 * h; }
__device__ __forceinline__ f32x16 zero16() { return (f32x16){0.f, 0.f, 0.f, 0.f, 0.f, 0.f, 0.f, 0.f, 0.f, 0.f, 0.f, 0.f, 0.f, 0.f, 0.f, 0.f}; }
template <int KS>
__device__ __forceinline__ f32x16 mmt(const LAS bf16_t* A, int ap, int ar0, int ac0, const LAS bf16_t* B, int bp, int br0, int bc0, f32x16 acc, int r, int h) {
    const LAS bf16_t* pa = A + (ar0 + r) * ap + ac0 + 8 * h; const LAS bf16_t* pb = B + (br0 + r) * bp + bc0 + 8 * h;
#pragma unroll
    for (int s = 0; s < KS; ++s) acc = __builtin_amdgcn_mfma_f32_32x32x16_bf16(*(const LAS bf16x8*)(pa + 16 * s), *(const LAS bf16x8*)(pb + 16 * s), acc, 0, 0, 0);
    return acc;
}
__device__ __forceinline__ void store_rm(LAS bf16_t* D, int r0, int c0, const f32x16& acc, int r, int h) {
#pragma unroll
    for (int e = 0; e < 16; ++e) D[(r0 + crow(e, h)) * TP + c0 + r] = (bf16_t)f2bf(acc[e]);
}
__device__ __forceinline__ u32x4 pack8(const f32x16& a, int s) { u32x4 w; w.x = pk2(a[8 * s], a[8 * s + 1]); w.y = pk2(a[8 * s + 2], a[8 * s + 3]); w.z = pk2(a[8 * s + 4], a[8 * s + 5]); w.w = pk2(a[8 * s + 6], a[8 * s + 7]); return w; }
__device__ __forceinline__ void unpack8(const u32x4 w, f32x16& a, int s) { a[8 * s] = bflo(w.x); a[8 * s + 1] = bfhi(w.x); a[8 * s + 2] = bflo(w.y); a[8 * s + 3] = bfhi(w.y); a[8 * s + 4] = bflo(w.z); a[8 * s + 5] = bfhi(w.z); a[8 * s + 6] = bflo(w.w); a[8 * s + 7] = bfhi(w.w); }
__device__ __forceinline__ unsigned char* l3_slot(unsigned char* l3, int tg0, int col0, int bo) { return l3 + ((size_t)(tg0 + (bo >> 7)) * NL + col0) * 2 + (bo & 127); }

__device__ __forceinline__ void pass_a(Frame& F) {
    const int lane = F.lane, wave = F.wave, r = lane & 31, h = lane >> 5;
    LAS bf16_t* tiles = (LAS bf16_t*)F.lds;
#define TL(i) (tiles + (i) * (TILE_B / 2))
    LAS bf16_t* X11T = (LAS bf16_t*)(F.lds + OFF_X11T); LAS bf16_t* T1T = (LAS bf16_t*)(F.lds + OFF_T1T);
    LAS float* seg = (LAS float*)(F.lds + OFF_SEG); LAS float* pc = (LAS float*)(F.lds + OFF_PC);
    const bf16_t* P = (const bf16_t*)(F.ws + WS_P); unsigned char* L3 = F.ws + WS_L3;
    bf16_t* MT = (bf16_t*)(F.ws + WS_MT); bf16_t* SA = (bf16_t*)(F.ws + WS_SA); float* BON = (float*)(F.ws + WS_BON);
    unsigned char* REC = (unsigned char*)F.out;
    const float* mix = F.in[I_MIX];
    struct Raw { float pr, pk, pv, cr[8], ck[8], cv[8], l[8], a[8]; };
    auto load_raw = [&](int unit, Raw& w) {
        const int b = unit >> 10, hd = (unit >> 6) & 15, ci = unit & 63, tg0 = b * SEQ + ci * 64, ch = hd * 64 + lane;
        const bf16_t* p0 = P + (size_t)(tg0 + 8 * wave) * NP + ch; const bf16_t* l0 = (const bf16_t*)L3 + (size_t)(tg0 + 8 * wave) * NL + ch;
        if (ci == 0 && wave == 0) { w.pr = 0.f; w.pk = 0.f; w.pv = 0.f; } else { w.pr = bf2f(p0[PR - NP]); w.pk = bf2f(p0[PKR - NP]); w.pv = bf2f(p0[PVR - NP]); }
#pragma unroll
        for (int j = 0; j < 8; ++j) { w.cr[j] = bf2f(p0[(size_t)j * NP + PR]); w.ck[j] = bf2f(p0[(size_t)j * NP + PKR]); w.cv[j] = bf2f(p0[(size_t)j * NP + PVR]);
            w.l[j] = bf2f(l0[(size_t)j * NL]); w.a[j] = bf2f(l0[(size_t)j * NL + 1024]); }
    };
    Raw cur;
    if (F.vcu < 4096) load_raw(F.vcu, cur);
    for (int unit = F.vcu; unit < 4096; unit += F.G) {
        const int b = unit >> 10, hd = (unit >> 6) & 15, ci = unit & 63, tg0 = b * SEQ + ci * 64;
        Raw nxt;
        {
            const int c = lane, ch = hd * 64 + c, sg = wave;
            const float mu_r = mix[ch], mu_k = mix[1088 + ch], mu_v = mix[2112 + ch];
            const float kkc = F.in[I_KK][ch], kac = F.in[I_KA][ch], rkc = F.in[I_RK][ch];
            float pr = cur.pr, pk = cur.pk, pv = cur.pv;
            float rr[8], kp[8], vv[8], kk[8], bb[8], ld[8], cl[8];
            float run = 0.f;
#pragma unroll
            for (int j = 0; j < 8; ++j) {
                const float cr = cur.cr[j], ck = cur.ck[j], cv = cur.cv[j];
                const float l = cur.l[j], a = cur.a[j];
                const float r_t = cr + (pr - cr) * mu_r, k_t = ck + (pk - ck) * mu_k, v_t = cv + (pv - cv) * mu_v; pr = cr; pk = ck; pv = cv;
                const float kkr = k_t * kkc; const float n2 = wave_sum(kkr * kkr); const float kkn = kkr * __builtin_amdgcn_rsqf(fmaxf(n2, 1e-24f));
                const float kpp = k_t * (1.0f + (a - 1.0f) * kac);
                const float bon = wave_sum(r_t * kpp * rkc);
                if (lane == 0) BON[(size_t)(tg0 + 8 * sg + j) * 16 + hd] = bon;
                run += l; rr[j] = r_t; kp[j] = kpp; vv[j] = v_t; kk[j] = kkn; bb[j] = kkn * a; ld[j] = l; cl[j] = run;
            }
            seg[sg * 64 + c] = run;
            __syncthreads();
            float off = 0.f, tot = 0.f;
#pragma unroll
            for (int q = 0; q < 8; ++q) { const float v = seg[q * 64 + c]; tot += v; off += (q < sg) ? v : 0.f; }
            if (sg == 0) pc[c] = __expf(tot);
            float ta[8], tr[8], tb[8], tk[8];
#pragma unroll
            for (int j = 0; j < 8; ++j) { const float lp = off + cl[j]; const float ep = __expf(lp), em = __builtin_amdgcn_rcpf(ep), epm = __expf(lp - ld[j]);
                ta[j] = -kk[j] * epm; tr[j] = rr[j] * ep; tb[j] = bb[j] * em; tk[j] = kp[j] * em; }
#pragma unroll
            for (int j = 0; j < 8; ++j) { const int o = (8 * sg + j) * TP + c;
                TL(T_ATM)[o] = (bf16_t)f2bf(ta[j]); TL(T_RTM)[o] = (bf16_t)f2bf(tr[j]); TL(T_BTM)[o] = (bf16_t)f2bf(tb[j]); TL(T_KTM)[o] = (bf16_t)f2bf(tk[j]); }
            { const int o = c * TP + 8 * sg;
              *(LAS u32x4*)(TL(T_ACM) + o) = (u32x4){pk2(ta[0], ta[1]), pk2(ta[2], ta[3]), pk2(ta[4], ta[5]), pk2(ta[6], ta[7])};
              *(LAS u32x4*)(TL(T_VCM) + o) = (u32x4){pk2(vv[0], vv[1]), pk2(vv[2], vv[3]), pk2(vv[4], vv[5]), pk2(vv[6], vv[7])};
              *(LAS u32x4*)(TL(T_BCM) + o) = (u32x4){pk2(tb[0], tb[1]), pk2(tb[2], tb[3]), pk2(tb[4], tb[5]), pk2(tb[6], tb[7])};
              *(LAS u32x4*)(TL(T_KCM) + o) = (u32x4){pk2(tk[0], tk[1]), pk2(tk[2], tk[3]), pk2(tk[4], tk[5]), pk2(tk[6], tk[7])}; }
        }
        __syncthreads();
#pragma unroll
        for (int q = 0; q < 2; ++q) {
            const int id = 2 * wave + q, rt = id >> 2, ct = id & 3;
            const LAS bf16_t* Z = (rt < 2) ? TL(T_ATM) : TL(T_RTM); const LAS bf16_t* X = (ct < 2) ? TL(T_BTM) : TL(T_KTM);
            LAS bf16_t* D = (rt < 2) ? ((ct < 2) ? TL(T_MAB) : TL(T_MAK)) : ((ct < 2) ? TL(T_MRB) : TL(T_MRK));
            const int zr0 = (rt & 1) * 32, xr0 = (ct & 1) * 32; const bool strict = rt < 2;
            f32x16 acc = zero16();
            if (xr0 <= zr0) acc = mmt<4>(Z, TP, zr0, 0, X, TP, xr0, 0, acc, r, h);
#pragma unroll
            for (int e = 0; e < 16; ++e) { const int t = zr0 + crow(e, h), i = xr0 + r; const bool keep = strict ? (i < t) : (i <= t); D[t * TP + i] = keep ? (bf16_t)f2bf(acc[e]) : (bf16_t)0; }
            if (rt < 2 && ct < 2 && zr0 == xr0) {
                LAS bf16_t* LT = zr0 ? T1T : X11T;
#pragma unroll
                for (int g = 0; g < 4; ++g) { float v[4];
#pragma unroll
                    for (int k = 0; k < 4; ++k) v[k] = (r < crow(4 * g + k, h)) ? acc[4 * g + k] : 0.f;
                    *(LAS u32x2*)(LT + r * 40 + 8 * g + 4 * h) = (u32x2){pk2(v[0], v[1]), pk2(v[2], v[3])}; }
            }
        }
        __syncthreads();
        if (unit + F.G < 4096) load_raw(unit + F.G, nxt); else nxt = cur;
        if (wave < 2) {
            const LAS bf16_t* Lm = TL(T_MAB); LAS bf16_t* TI = TL(T_TINV);
            const int o = 32 * wave;
            LAS bf16_t* Pt = (wave ? TL(T_U0) : TL(T_AP)); LAS bf16_t* Ss = Pt + 1280; LAS bf16_t* STs = Pt + 2560;
            f32x16 accP;
#pragma unroll
            for (int e = 0; e < 16; ++e) { accP[e] = (crow(e, h) == r) ? 1.0f : 0.0f; Pt[crow(e, h) * 40 + r] = (crow(e, h) == r) ? (bf16_t)0x3F80 : (bf16_t)0; }
            LDS_WAIT(); asm volatile("" ::: "memory");
            const LAS bf16_t* Sa = Lm + o * TP + o; int sap = TP;
            const LAS bf16_t* Sb = wave ? T1T : X11T; int sbp = 40;
#pragma unroll
            for (int k = 0; k < 5; ++k) {
                accP = mmt<2>(Pt, 40, 0, 0, Sb, sbp, 0, 0, accP, r, h);
                f32x16 accS = zero16();
                if (k < 4) accS = mmt<2>(Sa, sap, 0, 0, Sb, sbp, 0, 0, accS, r, h);
                LDS_WAIT(); asm volatile("" ::: "memory");
#pragma unroll
                for (int e = 0; e < 16; ++e) Pt[crow(e, h) * 40 + r] = (bf16_t)f2bf(accP[e]);
                if (k < 4) {
#pragma unroll
                    for (int e = 0; e < 16; ++e) Ss[crow(e, h) * 40 + r] = (bf16_t)f2bf(accS[e]);
#pragma unroll
                    for (int g = 0; g < 4; ++g) *(LAS u32x2*)(STs + r * 40 + 8 * g + 4 * h) = (u32x2){pk2(accS[4 * g], accS[4 * g + 1]), pk2(accS[4 * g + 2], accS[4 * g + 3])};
                    Sa = Ss; sap = 40; Sb = STs; sbp = 40;
                }
                LDS_WAIT(); asm volatile("" ::: "memory");
            }
            store_rm(TI, o, o, accP, r, h);
            if (wave == 0) {
#pragma unroll
                for (int e = 0; e < 16; ++e) TI[crow(e, h) * TP + 32 + r] = (bf16_t)0;
#pragma unroll
                for (int g = 0; g < 4; ++g) *(LAS u32x2*)(X11T + r * 40 + 8 * g + 4 * h) = (u32x2){pk2(accP[4 * g], accP[4 * g + 1]), pk2(accP[4 * g + 2], accP[4 * g + 3])};
                LDS_WAIT(); asm volatile("" ::: "memory");
                f32x16 t1 = mmt<2>(Lm, TP, 32, 0, X11T, 40, 0, 0, zero16(), r, h);
#pragma unroll
                for (int g = 0; g < 4; ++g) *(LAS u32x2*)(Ss + r * 40 + 8 * g + 4 * h) = (u32x2){pk2(t1[4 * g], t1[4 * g + 1]), pk2(t1[4 * g + 2], t1[4 * g + 3])};
            }
        } else if (wave >= 4) {
            const int mi = (wave - 4) >> 1, ni = (wave - 4) & 1;
            f32x16 acc = mmt<4>(TL(T_VCM), TP, 32 * mi, 0, TL(T_MAK), TP, 32 * ni, 0, zero16(), r, h);
            store_rm(TL(T_G1), 32 * mi, 32 * ni, acc, r, h);
        }
        __syncthreads();
        if (wave == 0) {
            LAS bf16_t* TI = TL(T_TINV);
            f32x16 x21 = mmt<2>(TI, TP, 32, 32, TL(T_AP) + 1280, 40, 0, 0, zero16(), r, h);
            store_rm(TI, 32, 0, x21, r, h);
        }
        __syncthreads();
        {
            const int w4 = wave & 3, mi = w4 >> 1, ni = w4 & 1;
            if (wave < 4) { f32x16 acc = mmt<4>(TL(T_ACM), TP, 32 * mi, 0, TL(T_TINV), TP, 32 * ni, 0, zero16(), r, h); store_rm(TL(T_AP), 32 * mi, 32 * ni, acc, r, h); }
            else { f32x16 acc = mmt<4>(TL(T_G1), TP, 32 * mi, 0, TL(T_TINV), TP, 32 * ni, 0, zero16(), r, h); store_rm(TL(T_U0), 32 * mi, 32 * ni, acc, r, h); }
        }
        __syncthreads();
#pragma unroll
        for (int q = 0; q < 2; ++q) {
            const int id = 2 * wave + q, typ = id >> 2, xx = (id >> 1) & 1, yy = id & 1;
            if (typ == 0) {
                f32x16 acc = mmt<4>(TL(T_AP), TP, 32 * xx, 0, TL(T_MRB), TP, 32 * yy, 0, zero16(), r, h);
#pragma unroll
                for (int g = 0; g < 4; ++g) { const u32x2 w = *(const LAS u32x2*)(TL(T_RTM) + (32 * yy + r) * TP + 32 * xx + 8 * g + 4 * h);
                    acc[4 * g] += bflo(w.x); acc[4 * g + 1] += bfhi(w.x); acc[4 * g + 2] += bflo(w.y); acc[4 * g + 3] += bfhi(w.y); }
#pragma unroll
                for (int s = 0; s < 2; ++s) *(u32x4*)(REC + (size_t)unit * 16384 + (((xx * 2 + s) * 2 + yy) * 64 + lane) * 16) = pack8(acc, s);
            } else if (typ == 1) {
                f32x16 acc = mmt<4>(TL(T_U0), TP, 32 * xx, 0, TL(T_MRB), TP, 32 * yy, 0, zero16(), r, h);
                acc = mmt<4>(TL(T_VCM), TP, 32 * xx, 0, TL(T_MRK), TP, 32 * yy, 0, acc, r, h);
#pragma unroll
                for (int s = 0; s < 2; ++s) *(u32x4*)(REC + (size_t)unit * 16384 + 8192 + ((xx * 2 + yy) * 64 + lane) * 32 + 16 * s) = pack8(acc, s);
            } else if (typ == 2) {
                f32x16 acc = mmt<4>(TL(T_AP), TP, 32 * xx, 0, TL(T_BCM), TP, 32 * yy, 0, zero16(), r, h);
                const float pcc = pc[32 * yy + r];
#pragma unroll
                for (int e = 0; e < 16; ++e) acc[e] = (acc[e] + ((32 * xx + crow(e, h) == 32 * yy + r) ? 1.0f : 0.0f)) * pcc;
#pragma unroll
                for (int s = 0; s < 2; ++s) *(u32x4*)(MT + (size_t)unit * 4096 + (((yy * 2 + xx) * 2 + s) * 64 + lane) * 8) = pack8(acc, s);
            } else {
                f32x16 acc = mmt<4>(TL(T_BCM), TP, 32 * xx, 0, TL(T_U0), TP, 32 * yy, 0, zero16(), r, h);
                acc = mmt<4>(TL(T_KCM), TP, 32 * xx, 0, TL(T_VCM), TP, 32 * yy, 0, acc, r, h);
#pragma unroll
                for (int e = 0; e < 16; ++e) acc[e] *= pc[32 * xx + crow(e, h)];
#pragma unroll
                for (int s = 0; s < 2; ++s) *(u32x4*)(SA + (size_t)unit * 4096 + ((yy * 2 + xx) * 64 + lane) * 16 + 8 * s) = pack8(acc, s);
            }
        }
        __syncthreads();
        cur = nxt;
    }
#undef TL
}

struct PbSet { bf16x8 A[8]; u32x4 S[4]; };
__device__ __forceinline__ void pb_load(PbSet& d, const bf16_t* MT, const bf16_t* SA, int c, int lane) {
    const int cc = c < 64 ? c : 63;
    const char* mb = (const char*)MT + (size_t)cc * 8192; const char* sb = (const char*)SA + (size_t)cc * 8192;
    const unsigned lo16 = (unsigned)lane * 16u, lo32 = (unsigned)lane * 32u;
#pragma unroll
    for (int f = 0; f < 8; ++f) d.A[f] = *(const bf16x8*)(mb + lo16 + f * 1024);
#pragma unroll
    for (int q = 0; q < 4; ++q) d.S[q] = *(const u32x4*)(sb + lo32 + (q >> 1) * 2048 + 16 * (q & 1));
}
__device__ __forceinline__ void pb_step(const PbSet& d, f32x16 (&X)[2], bf16_t* SA, int c, int lane, const bool dry) {
    bf16x8 Bf[4];
#pragma unroll
    for (int kt = 0; kt < 2; ++kt)
#pragma unroll
        for (int s = 0; s < 2; ++s) { const u32x4 w = pack8(X[kt], s); Bf[kt * 2 + s] = __builtin_bit_cast(bf16x8, w); if (!dry) *(u32x4*)((char*)SA + (size_t)c * 8192 + (unsigned)lane * 16u + (kt * 2 + s) * 1024) = w; }
    f32x16 D[2];
#pragma unroll
    for (int ip = 0; ip < 2; ++ip) { unpack8(d.S[2 * ip], D[ip], 0); unpack8(d.S[2 * ip + 1], D[ip], 1);
#pragma unroll
        for (int ks = 0; ks < 4; ++ks) D[ip] = __builtin_amdgcn_mfma_f32_32x32x16_bf16(d.A[ip * 4 + ks], Bf[ks], D[ip], 0, 0, 0); }
    X[0] = D[0]; X[1] = D[1];
}
__device__ __forceinline__ void pass_b(Frame& F, int bh, int j, const bool dry, const int part) {
    const int lane = F.lane;
    const bf16_t* MT = (const bf16_t*)(F.ws + WS_MT) + (size_t)bh * 64 * 4096; bf16_t* SA = (bf16_t*)(F.ws + WS_SA) + (size_t)bh * 64 * 4096 + j * 2048;
    f32x4* XS = (f32x4*)(F.ws + WS_XS) + (size_t)(bh * 2 + j) * 512 + lane * 8;
    f32x16 X[2] = {zero16(), zero16()};
    const int c0 = part ? 33 : 0, c1 = part ? 63 : 33;
    if (part) {
#pragma unroll
        for (int q = 0; q < 8; ++q) { const f32x4 v = XS[q]; X[q >> 2][4 * (q & 3)] = v.x; X[q >> 2][4 * (q & 3) + 1] = v.y; X[q >> 2][4 * (q & 3) + 2] = v.z; X[q >> 2][4 * (q & 3) + 3] = v.w; }
    }
    PbSet s0, s1, s2;
    pb_load(s0, MT, SA, c0, lane); pb_load(s1, MT, SA, c0 + 1, lane);
    for (int c = c0; c < c1; c += 3) {
        pb_load(s2, MT, SA, c + 2, lane); pb_step(s0, X, SA, c, lane, dry);
        pb_load(s0, MT, SA, c + 3, lane); pb_step(s1, X, SA, c + 1, lane, dry);
        pb_load(s1, MT, SA, c + 4, lane); pb_step(s2, X, SA, c + 2, lane, dry);
    }
    if (part) pb_step(s0, X, SA, 63, lane, dry);
    else if (!dry) {
#pragma unroll
        for (int q = 0; q < 8; ++q) XS[q] = (f32x4){X[q >> 2][4 * (q & 3)], X[q >> 2][4 * (q & 3) + 1], X[q >> 2][4 * (q & 3) + 2], X[q >> 2][4 * (q & 3) + 3]};
    }
}

__device__ __forceinline__ void pass_b_block(Frame& F, int bh, const bool dry) {
    const int lane = F.lane, wave = F.wave;
    const unsigned char* MTg = F.ws + WS_MT + (size_t)bh * 64 * 8192; unsigned char* SAg = F.ws + WS_SA + (size_t)bh * 64 * 8192;
    constexpr int DEP = 6;
#define PB_ISSUE(c_) do { const int cc_ = (c_) < 64 ? (c_) : 63; const int sl_ = (c_) & 7; _Pragma("unroll") for (int q = 0; q < 4; ++q) { const int p_ = 4 * (wave - 4) + q; \
        const unsigned char* src_ = (p_ < 8 ? MTg + (size_t)cc_ * 8192 + p_ * 1024 : SAg + (size_t)cc_ * 8192 + (p_ - 8) * 1024) + lane * 16; \
        __builtin_amdgcn_global_load_lds((const unsigned*)src_, (LAS unsigned*)(F.lds + sl_ * 16384 + p_ * 1024), 16, 0, 0); } } while (0)
    if (wave >= 4) {
#pragma unroll
        for (int c = 0; c < DEP; ++c) PB_ISSUE(c);
        asm volatile("s_waitcnt vmcnt(20)" ::: "memory");
    }
    asm volatile("s_waitcnt lgkmcnt(0)\n\ts_barrier" ::: "memory");
    f32x16 X[2] = {zero16(), zero16()};
    for (int c = 0; c < 64; ++c) {
        if (wave >= 4) { PB_ISSUE(c + DEP); asm volatile("s_waitcnt vmcnt(20)" ::: "memory"); }
        if (wave < 2) {
            const int j = wave;
            const LAS unsigned char* base = F.lds + (c & 7) * 16384;
            bf16x8 Af[8]; u32x4 Sd[4];
#pragma unroll
            for (int f = 0; f < 8; ++f) Af[f] = *(const LAS bf16x8*)(base + f * 1024 + lane * 16);
#pragma unroll
            for (int q = 0; q < 4; ++q) Sd[q] = *(const LAS u32x4*)(base + 8192 + j * 4096 + (q >> 1) * 2048 + lane * 32 + 16 * (q & 1));
            bf16x8 Bf[4];
#pragma unroll
            for (int kt = 0; kt < 2; ++kt)
#pragma unroll
                for (int s2 = 0; s2 < 2; ++s2) { const u32x4 w = pack8(X[kt], s2); Bf[kt * 2 + s2] = __builtin_bit_cast(bf16x8, w);
                    if (!dry) *(u32x4*)(SAg + (size_t)c * 8192 + j * 4096 + (kt * 2 + s2) * 1024 + lane * 16) = w; }
            f32x16 D[2];
#pragma unroll
            for (int ip = 0; ip < 2; ++ip) { unpack8(Sd[2 * ip], D[ip], 0); unpack8(Sd[2 * ip + 1], D[ip], 1);
#pragma unroll
                for (int ks = 0; ks < 4; ++ks) D[ip] = __builtin_amdgcn_mfma_f32_32x32x16_bf16(Af[ip * 4 + ks], Bf[ks], D[ip], 0, 0, 0); }
            X[0] = D[0]; X[1] = D[1];
        }
        asm volatile("s_waitcnt lgkmcnt(0)\n\ts_barrier" ::: "memory");
    }
#undef PB_ISSUE
    asm volatile("s_waitcnt vmcnt(0)" ::: "memory");
    __syncthreads();
}

__device__ __forceinline__ void pass_c(Frame& F) {
    const int lane = F.lane, r = lane & 31, h = lane >> 5;
    const int gw = F.vcu * 8 + F.wave, NGW = F.G * 8;
    const bf16_t* P = (const bf16_t*)(F.ws + WS_P); unsigned char* L3 = F.ws + WS_L3; const bf16_t* SA = (const bf16_t*)(F.ws + WS_SA); const float* BON = (const float*)(F.ws + WS_BON);
    bf16_t* Y = (bf16_t*)(F.ws + WS_YCAT); const float* mix = F.in[I_MIX]; const unsigned char* REC = (const unsigned char*)F.out;
    LAS float* cst = (LAS float*)F.lds;
    for (int i = F.tid; i < 1024; i += 512) { cst[i] = mix[2112 + i]; cst[1024 + i] = F.in[I_LNW][i]; cst[2048 + i] = F.in[I_LNB][i]; }
    __syncthreads();
    LAS bf16_t* wt = (LAS bf16_t*)(F.lds + 12288 + F.wave * 9472);
    const int lrow = lane >> 3, lpc = (lane & 7) * 8;
    for (int unit = gw; unit < 4096; unit += NGW) {
        const int b = unit >> 10, hd = (unit >> 6) & 15, ci = unit & 63, tg0 = b * SEQ + ci * 64;
        bf16x8 Af[8], Bf[8];
#pragma unroll
        for (int f = 0; f < 8; ++f) Af[f] = *(const bf16x8*)(SA + (size_t)unit * 4096 + (f * 64 + lane) * 8);
#pragma unroll
        for (int f = 0; f < 8; ++f) Bf[f] = *(const bf16x8*)(REC + (size_t)unit * 16384 + (f * 64 + lane) * 16);
        f32x16 acc[2][2];
#pragma unroll
        for (int j = 0; j < 2; ++j)
#pragma unroll
            for (int tt = 0; tt < 2; ++tt) {
#pragma unroll
                for (int s = 0; s < 2; ++s) unpack8(*(const u32x4*)(REC + (size_t)unit * 16384 + 8192 + ((j * 2 + tt) * 64 + lane) * 32 + 16 * s), acc[j][tt], s);
#pragma unroll
                for (int ks = 0; ks < 4; ++ks) acc[j][tt] = __builtin_amdgcn_mfma_f32_32x32x16_bf16(Af[j * 4 + ks], Bf[ks * 2 + tt], acc[j][tt], 0, 0, 0);
            }
        asm volatile("" ::: "memory");
        u32x4 vr[9];
        { const GAS bf16_t* vp = (const GAS bf16_t*)(P + (size_t)(tg0 - 1 + lrow) * NP + PVR + hd * 64 + lpc);
#pragma unroll
          for (int it = 0; it < 9; ++it) { const int row = 8 * it + lrow; vr[it] = (u32x4){0u, 0u, 0u, 0u};
              if (row < 65 && (row > 0 || ci > 0)) vr[it] = *(const GAS u32x4*)vp;
              vp += 8 * NP; asm volatile("" : "+v"(vp)); } }
        u32x4 gr[8];
        { const GAS bf16_t* gp = (const GAS bf16_t*)((const bf16_t*)L3 + (size_t)(tg0 + lrow) * NL + 2048 + hd * 64 + lpc);
#pragma unroll
          for (int it = 0; it < 8; ++it) { gr[it] = *(const GAS u32x4*)gp; gp += 8 * NL; asm volatile("" : "+v"(gp)); } }
        const float bon0 = BON[(size_t)(tg0 + r) * 16 + hd], bon1 = BON[(size_t)(tg0 + 32 + r) * 16 + hd];
#pragma unroll
        for (int it = 0; it < 9; ++it) { const int row = 8 * it + lrow; if (row < 65) *(LAS u32x4*)(wt + row * 72 + lpc) = vr[it]; }
        LDS_WAIT(); asm volatile("" ::: "memory");
        u32x2 cvq[2][8], pvq[2][8];
#pragma unroll
        for (int tt = 0; tt < 2; ++tt)
#pragma unroll
            for (int q = 0; q < 8; ++q) { const int v0 = 32 * (q >> 2) + 8 * (q & 3) + 4 * h; cvq[tt][q] = *(const LAS u32x2*)(wt + (1 + 32 * tt + r) * 72 + v0); pvq[tt][q] = *(const LAS u32x2*)(wt + (32 * tt + r) * 72 + v0); }
        LDS_WAIT(); asm volatile("" ::: "memory");
#pragma unroll
        for (int it = 0; it < 8; ++it) *(LAS u32x4*)(wt + (8 * it + lrow) * 72 + lpc) = gr[it];
        LDS_WAIT(); asm volatile("" ::: "memory");
#pragma unroll
        for (int tt = 0; tt < 2; ++tt) {
            float sm = 0.f;
#pragma unroll
            for (int e = 0; e < 16; ++e) sm += acc[0][tt][e] + acc[1][tt][e];
            sm += __shfl_xor(sm, 32); const float mean = sm * (1.0f / 64.0f);
            float sq = 0.f;
#pragma unroll
            for (int e = 0; e < 16; ++e) { const float d0 = acc[0][tt][e] - mean, d1 = acc[1][tt][e] - mean; sq += d0 * d0 + d1 * d1; }
            sq += __shfl_xor(sq, 32); const float rstd = rsqrtf(sq * (1.0f / 64.0f) + GN_EPS);
            const float bon = tt ? bon1 : bon0;
#pragma unroll
            for (int q = 0; q < 8; ++q) { const int j = q >> 2, g = q & 3; const int v0 = 32 * j + 8 * g + 4 * h, ch = hd * 64 + v0;
                const u32x2 cv = cvq[tt][q], pv = pvq[tt][q]; const u32x2 gg = *(const LAS u32x2*)(wt + (32 * tt + r) * 72 + v0);
                const f32x4 mu = *(const LAS f32x4*)(cst + ch), lw = *(const LAS f32x4*)(cst + 1024 + ch), lb = *(const LAS f32x4*)(cst + 2048 + ch);
                const float c0 = bflo(cv.x), c1 = bfhi(cv.x), c2 = bflo(cv.y), c3 = bfhi(cv.y);
                const float v_0 = c0 + (bflo(pv.x) - c0) * mu.x, v_1 = c1 + (bfhi(pv.x) - c1) * mu.y, v_2 = c2 + (bflo(pv.y) - c2) * mu.z, v_3 = c3 + (bfhi(pv.y) - c3) * mu.w;
                const float o0 = ((acc[j][tt][4 * g] - mean) * rstd * lw.x + lb.x + bon * v_0) * bflo(gg.x);
                const float o1 = ((acc[j][tt][4 * g + 1] - mean) * rstd * lw.y + lb.y + bon * v_1) * bfhi(gg.x);
                const float o2 = ((acc[j][tt][4 * g + 2] - mean) * rstd * lw.z + lb.z + bon * v_2) * bflo(gg.y);
                const float o3 = ((acc[j][tt][4 * g + 3] - mean) * rstd * lw.w + lb.w + bon * v_3) * bfhi(gg.y);
                *(LAS u32x2*)(wt + (32 * tt + r) * 72 + v0) = (u32x2){pk2(o0, o1), pk2(o2, o3)};
                asm volatile("" ::: "memory"); }
        }
        LDS_WAIT(); asm volatile("" ::: "memory");
#pragma unroll
        for (int it = 0; it < 8; ++it) *(u32x4*)(Y + (size_t)(tg0 + 8 * it + lrow) * DM + 1024 + hd * 64 + lpc) = *(const LAS u32x4*)(wt + (8 * it + lrow) * 72 + lpc);
        LDS_WAIT(); asm volatile("" ::: "memory");
    }
    __syncthreads();
}
}


namespace att {
using s16x4 = __attribute__((ext_vector_type(4))) short;
constexpr int D = 128, NW = 8, QBLK = 32, KVBLK = 64;
constexpr float THRL = 8.0f * 1.4426950408889634f;
constexpr size_t SHM_V = KVBLK * D * 2, SHM_K = KVBLK * D * 2, SHM_ATTN = 2 * SHM_V + 2 * SHM_K + NW * 64 * 4;
static_assert(SHM_ATTN <= RING_BYTES, "attention LDS");
#define KSWZ(row, colB) ((row) * 256 + ((colB) ^ (((row) & 7) << 4)))
#define SBAR() __builtin_amdgcn_sched_barrier(0)
__device__ __forceinline__ int crow(int r, int hi) { return (r & 3) + 8 * (r >> 2) + 4 * hi; }
__device__ __forceinline__ unsigned cvtpk(float lo, float hi) { unsigned r; asm volatile("v_cvt_pk_bf16_f32 %0, %1, %2" : "=v"(r) : "v"(lo), "v"(hi)); return r; }
__device__ __forceinline__ void partialSM(f32x16& p0, f32x16& p1, const u32x2 mk, float& m_reg, float& mn, float& alpha) {
#pragma unroll
  for (int r = 0; r < 16; ++r) { const int pos = (r & 3) + 8 * (r >> 2);
    const unsigned t0 = (unsigned)(((int)(mk.x << (31 - pos))) >> 31), t1 = (unsigned)(((int)(mk.y << (31 - pos))) >> 31);
    p0[r] = __uint_as_float((t0 & __float_as_uint(p0[r])) | (~t0 & 0xFF800000u)); p1[r] = __uint_as_float((t1 & __float_as_uint(p1[r])) | (~t1 & 0xFF800000u)); }
  float pmax = p0[0];
#pragma unroll
  for (int r = 1; r < 16; ++r) pmax = fmaxf(pmax, p0[r]);
#pragma unroll
  for (int r = 0; r < 16; ++r) pmax = fmaxf(pmax, p1[r]);
  { auto rr = __builtin_amdgcn_permlane32_swap(__float_as_uint(pmax), __float_as_uint(pmax), false, false);
    pmax = fmaxf(__uint_as_float(rr[0]), __uint_as_float(rr[1])); }
  if (__builtin_expect(__all(pmax - m_reg <= THRL), 1)) { mn = m_reg; alpha = 1.f; }
  else { mn = fmaxf(m_reg, pmax); alpha = __builtin_amdgcn_exp2f(m_reg - mn); m_reg = mn; }
#pragma unroll
  for (int r = 0; r < 16; ++r) { p0[r] = __builtin_amdgcn_exp2f(p0[r] - mn); p1[r] = p1[r] - mn; }
}
__device__ __forceinline__ void finishSM(f32x16& p0, f32x16& p1, float alpha, float& l_reg, bf16x8& pa0, bf16x8& pa1, bf16x8& pa2, bf16x8& pa3) {
#pragma unroll
  for (int r = 0; r < 16; ++r) p1[r] = __builtin_amdgcn_exp2f(p1[r]);
  float ps = 0;
#pragma unroll
  for (int r = 0; r < 16; ++r) ps += p0[r];
#pragma unroll
  for (int r = 0; r < 16; ++r) ps += p1[r];
  { auto rr = __builtin_amdgcn_permlane32_swap(__float_as_uint(ps), __float_as_uint(ps), false, false);
    ps = __uint_as_float(rr[0]) + __uint_as_float(rr[1]); }
  l_reg = l_reg * alpha + ps;
#define PK4(P, BASE, OUT) do { unsigned a0 = cvtpk(P[BASE + 0], P[BASE + 1]), a1 = cvtpk(P[BASE + 2], P[BASE + 3]);   \
    unsigned b0 = cvtpk(P[BASE + 4], P[BASE + 5]), b1 = cvtpk(P[BASE + 6], P[BASE + 7]);                              \
    auto r0 = __builtin_amdgcn_permlane32_swap(a0, b0, false, false); auto r1 = __builtin_amdgcn_permlane32_swap(a1, b1, false, false); \
    u32x4 w = {r0[0], r1[0], r0[1], r1[1]}; OUT = __builtin_bit_cast(bf16x8, w); } while (0)
  PK4(p0, 0, pa0); PK4(p0, 8, pa1); PK4(p1, 0, pa2); PK4(p1, 8, pa3);
#undef PK4
}
__device__ __forceinline__ void qkt(f32x16& p0, f32x16& p1, const char* Ks, const bf16x8* qr, int r32, int hi) {
  p0 = f32x16{}; p1 = f32x16{};
#pragma unroll
  for (int d0 = 0; d0 < 8; ++d0) { int cb = (d0 * 16 + hi * 8) * 2;
    bf16x8 b0 = *reinterpret_cast<const bf16x8*>(Ks + KSWZ(r32, cb));
    bf16x8 b1 = *reinterpret_cast<const bf16x8*>(Ks + KSWZ(32 + r32, cb));
    p0 = __builtin_amdgcn_mfma_f32_32x32x16_bf16(b0, qr[d0], p0, 0, 0, 0);
    p1 = __builtin_amdgcn_mfma_f32_32x32x16_bf16(b1, qr[d0], p1, 0, 0, 0); }
}
__device__ __forceinline__ int v_st(int k, int c) { const int kk = (k & ~0xC) | ((k & 4) << 1) | ((k & 8) >> 1); return ((kk >> 3) * 4 + (c >> 5)) * 512 + ((kk & 7) * 32 + (c & 31)) * 2; }
__device__ __forceinline__ int v_rd_base(int lane) { return ((lane & 3) << 3) | (((lane >> 2) & 3) << 6) | (((lane >> 4) & 1) << 5) | (((lane >> 5) & 1) << 8); }
constexpr int v_rd_off(int d0, int ks, int half) { return d0 * 512 + ks * 4096 + half * 2048; }
template <int OFF> __device__ __forceinline__ s16x4 tr_read(int vb) { s16x4 r; asm volatile("ds_read_b64_tr_b16 %0, %1 offset:%2" : "=&v"(r) : "v"(vb), "i"(OFF) : "memory"); return r; }
template <int D0> __device__ __forceinline__ void pv_one(f32x16& od, int vb, bf16x8 pa0, bf16x8 pa1, bf16x8 pa2, bf16x8 pa3) {
  const s16x4 l0 = tr_read<v_rd_off(D0, 0, 0)>(vb), h0 = tr_read<v_rd_off(D0, 0, 1)>(vb), l1 = tr_read<v_rd_off(D0, 1, 0)>(vb), h1 = tr_read<v_rd_off(D0, 1, 1)>(vb);
  const s16x4 l2 = tr_read<v_rd_off(D0, 2, 0)>(vb), h2 = tr_read<v_rd_off(D0, 2, 1)>(vb), l3 = tr_read<v_rd_off(D0, 3, 0)>(vb), h3 = tr_read<v_rd_off(D0, 3, 1)>(vb);
  asm volatile("s_waitcnt lgkmcnt(0)" ::: "memory"); SBAR();
#define PK(L, H) (bf16x8){L[0], L[1], L[2], L[3], H[0], H[1], H[2], H[3]}
  od = __builtin_amdgcn_mfma_f32_32x32x16_bf16(pa0, PK(l0, h0), od, 0, 0, 0);
  od = __builtin_amdgcn_mfma_f32_32x32x16_bf16(pa1, PK(l1, h1), od, 0, 0, 0);
  od = __builtin_amdgcn_mfma_f32_32x32x16_bf16(pa2, PK(l2, h2), od, 0, 0, 0);
  od = __builtin_amdgcn_mfma_f32_32x32x16_bf16(pa3, PK(l3, h3), od, 0, 0, 0);
#undef PK
}
__device__ __forceinline__ void pv_d0(f32x16* o, int vb, bf16x8 pa0, bf16x8 pa1, bf16x8 pa2, bf16x8 pa3) {
  pv_one<0>(o[0], vb, pa0, pa1, pa2, pa3); pv_one<1>(o[1], vb, pa0, pa1, pa2, pa3); pv_one<2>(o[2], vb, pa0, pa1, pa2, pa3); pv_one<3>(o[3], vb, pa0, pa1, pa2, pa3);
}
__device__ __forceinline__ void attn_unit(const bf16_t* __restrict__ Qb, const bf16_t* __restrict__ Kh, const bf16_t* __restrict__ Vh, const unsigned* __restrict__ Mb,
                                          bf16_t* __restrict__ Ob, int seq, char* lds) {
  constexpr int LDQ = NP, LDK = NP, LDO = DM;
  int tid_ = threadIdx.x; asm volatile("" : "+v"(tid_));
  const int tid = tid_, wid = tid >> 6, lane = tid & 63, r32 = lane & 31, hi = lane >> 5;
  char* V_lds = lds; char* K_lds = lds + 2 * SHM_V;
  float* wsf = (float*)(lds + 2 * SHM_V + 2 * SHM_K) + wid * 64; float* li_l = wsf; float* al_l = wsf + 32;
  float m_reg = -1e30f, l_reg = 0; f32x16 o[4] = {}; bf16x8 qr[8];
  const bf16_t* Qw = Qb + (long)(wid * QBLK + r32) * LDQ + hi * 8;
#pragma unroll
  for (int d0 = 0; d0 < 8; ++d0) qr[d0] = *reinterpret_cast<const bf16x8*>(Qw + d0 * 16);
  const unsigned* Mw = Mb + (long)(wid * QBLK + r32) * 128;
  const int sh = 4 * hi;
  const int sr = tid >> 4, sc = (tid & 15) * 8, vst0 = v_st(sr, sc), vst1 = v_st(32 + sr, sc);
  const int vb0 = (int)(uintptr_t)V_lds + v_rd_base(lane);
  struct { bf16x8 vs0, vs1, ks0, ks1; } sr_[2];
#define SLOAD(i, k0) do { sr_[i].vs0 = *(const bf16x8*)(&Vh[(long)((k0) + sr) * LDK + sc]); sr_[i].vs1 = *(const bf16x8*)(&Vh[(long)((k0) + 32 + sr) * LDK + sc]); \
    sr_[i].ks0 = *(const bf16x8*)(&Kh[(long)((k0) + sr) * LDK + sc]); sr_[i].ks1 = *(const bf16x8*)(&Kh[(long)((k0) + 32 + sr) * LDK + sc]); } while (0)
#define SWRITE(b, i) do { *(bf16x8*)(V_lds + (b) * SHM_V + vst0) = sr_[i].vs0;          \
    *(bf16x8*)(V_lds + (b) * SHM_V + vst1) = sr_[i].vs1; int kc = sc * 2;               \
    *(bf16x8*)(K_lds + (b) * SHM_K + KSWZ(sr, kc)) = sr_[i].ks0;                       \
    *(bf16x8*)(K_lds + (b) * SHM_K + KSWZ(32 + sr, kc)) = sr_[i].ks1; } while (0)
#define SWAIT() asm volatile("s_waitcnt vmcnt(4)" ::: "memory")
#define RESC(a) do { if (__any((a) < 1.f)) { if (hi == 0) al_l[r32] = (a); asm volatile("s_waitcnt lgkmcnt(0)" ::: "memory"); \
    _Pragma("unroll") for (int d = 0; d < 4; ++d) _Pragma("unroll") for (int r = 0; r < 16; ++r) o[d][r] *= al_l[crow(r, hi)]; } } while (0)
#define MLOAD(j) ({ u32x2 _m = *(const u32x2*)(Mw + 2 * (j)); _m.x >>= sh; _m.y >>= sh; _m; })
  f32x16 pA0, pA1, pB0, pB1; float mnA, mnB, alA, alB; bf16x8 pa0, pa1, pa2, pa3; const int NT = seq / KVBLK;
  constexpr int SE = 0, SO = 1;
  u32x2 mkA = MLOAD(0), mkB = MLOAD(1);
  SLOAD(SE, 0); asm volatile("s_waitcnt vmcnt(0)" ::: "memory"); SWRITE(0, SE); __syncthreads();
  qkt(pA0, pA1, K_lds, qr, r32, hi); partialSM(pA0, pA1, mkA, m_reg, mnA, alA);
  SLOAD(SO, KVBLK); if (2 < NT) SLOAD(SE, 2 * KVBLK);
  SWAIT(); SWRITE(1, SO); __syncthreads();
  for (int j = 1; j + 1 < NT; j += 2) {
    mkA = MLOAD(j + 1);
    SBAR(); qkt(pB0, pB1, K_lds + SHM_K, qr, r32, hi);
    finishSM(pA0, pA1, alA, l_reg, pa0, pa1, pa2, pa3); SBAR();
    SLOAD(SO, (j + 2) * KVBLK); SBAR();
    pv_d0(o, vb0, pa0, pa1, pa2, pa3); partialSM(pB0, pB1, mkB, m_reg, mnB, alB);
    __syncthreads(); SWAIT(); SWRITE(0, SE);
    RESC(alB); __syncthreads();
    mkB = MLOAD(j + 2);
    SBAR(); qkt(pA0, pA1, K_lds, qr, r32, hi);
    finishSM(pB0, pB1, alB, l_reg, pa0, pa1, pa2, pa3); SBAR();
    if (j + 3 < NT) SLOAD(SE, (j + 3) * KVBLK); SBAR();
    pv_d0(o, vb0 + (int)SHM_V, pa0, pa1, pa2, pa3); partialSM(pA0, pA1, mkA, m_reg, mnA, alA);
    __syncthreads(); SWAIT(); SWRITE(1, SO);
    RESC(alA); __syncthreads();
  }
  SBAR(); qkt(pB0, pB1, K_lds + SHM_K, qr, r32, hi);
  finishSM(pA0, pA1, alA, l_reg, pa0, pa1, pa2, pa3); SBAR();
  pv_d0(o, vb0, pa0, pa1, pa2, pa3); partialSM(pB0, pB1, mkB, m_reg, mnB, alB);
  __syncthreads(); RESC(alB);
  finishSM(pB0, pB1, alB, l_reg, pa0, pa1, pa2, pa3); SBAR();
  pv_d0(o, vb0 + (int)SHM_V, pa0, pa1, pa2, pa3);
  if (hi == 0) li_l[r32] = l_reg; asm volatile("s_waitcnt lgkmcnt(0)" ::: "memory");
  float rli[16];
#pragma unroll
  for (int r = 0; r < 16; ++r) rli[r] = __builtin_amdgcn_rcpf(li_l[crow(r, hi)]);
  bf16_t* Ow = Ob + (long)(wid * QBLK) * LDO;
#pragma unroll
  for (int r = 0; r < 16; ++r) { int orow = crow(r, hi);
#pragma unroll
    for (int d0 = 0; d0 < 4; ++d0) Ow[(long)orow * LDO + d0 * 32 + r32] = (bf16_t)f2bf(o[d0][r] * rli[r]); }
  __syncthreads();
#undef SLOAD
#undef SWRITE
#undef SWAIT
#undef RESC
#undef MLOAD
}
__device__ __forceinline__ void attn_phase(Frame& F) {
  const bf16_t* P = (const bf16_t*)(F.ws + WS_P); const unsigned* MSK = (const unsigned*)(F.ws + WS_MSK); bf16_t* Y = (bf16_t*)(F.ws + WS_YCAT);
  for (int u = F.vcu; u < 512; u += F.G) {
    const int pairi = u & 255, second = u >> 8; const int bh = pairi >> 3, ql = pairi & 7; const int qb = second ? ql : 15 - ql;
    const int b = bh >> 3, hd = bh & 7; const long t0 = (long)b * SEQ + qb * 256;
    attn_unit(P + t0 * NP + PQ + hd * 128, P + (long)b * SEQ * NP + PK + hd * 128, P + (long)b * SEQ * NP + PV + hd * 128, MSK + t0 * 128, Y + t0 * DM + hd * 128, (qb + 1) * 256, (char*)F.ldsg);
  }
}
#undef KSWZ
#undef SBAR
}

__device__ __forceinline__ void phase_score_passb(Frame& F, const bool dry, const int qw) {
    if (F.G >= 256) { if ((F.vcu & 3) == 0 && (F.vcu >> 2) < 64) rw::pass_b_block(F, F.vcu >> 2, dry); }
    else { for (int bh = F.vcu; bh < 64; bh += F.G) rw::pass_b_block(F, bh, dry); }
    volatile LAS int* qs = (volatile LAS int*)(F.lds + MISC_OFF + 64);
    const bf16_t* P = (const bf16_t*)(F.ws + WS_P);
    const int r = F.lane & 31, h = F.lane >> 5;
    if (F.tid == 0) qs[0] = (int)atomicAdd(F.ctl + CW_QIDX + 64 * qw, 1u);
    __syncthreads();
    int cu = qs[0], it = 0;
    if (cu >= NSCU2) return;
    int b, i, st, st1; idx_decode(cu, b, i, st, st1);
    IdxQ qv[4];
#pragma unroll
    for (int g = 0; g < 4; ++g) idxq_load(qv[g], P, b * SEQ + i * 64 + 16 * g + 2 * F.wave, r, h);
    idx_stage(F, b, st, 0);
    for (;;) {
        const bool same = st < st1;
        if (!same && F.tid == 0) qs[1 + (it & 1)] = (int)atomicAdd(F.ctl + CW_QIDX + 64 * qw, 1u);
        __syncthreads();
        int nu = cu, nb = b, ni = i, nst = st + 1, nst1 = st1;
        if (!same) { nu = qs[1 + (it & 1)]; if (nu < NSCU2) idx_decode(nu, nb, ni, nst, nst1); }
        if (nu < NSCU2) idx_stage(F, nb, nst, (it + 1) & 1);
        idx_score_tile(F, qv, b, i, st, it & 1);
        if (nu >= NSCU2) break;
        if (!same) {
#pragma unroll
            for (int g = 0; g < 4; ++g) idxq_load(qv[g], P, nb * SEQ + ni * 64 + 16 * g + 2 * F.wave, r, h);
        }
        cu = nu; b = nb; i = ni; st = nst; st1 = nst1; ++it;
    }
}
__device__ __forceinline__ void phase_select_passb(Frame& F, const bool dry) {
    const int nw = F.G * 8, w = F.vcu * 8 + F.wave;
    for (int idx = w; idx < T / 2; idx += nw) { const int b = idx >> 11, p = idx & 2047; u32x4 ra[8], rb[8]; idx_row_load(F, b, p, ra); idx_row_load(F, b, 4095 - p, rb); idx_select_row(F, b, p, ra); idx_select_row(F, b, 4095 - p, rb); }
}

constexpr int MOE_IG = (DM / 64) * (512 / 32), MOE_ID = (512 / 64) * (DM / 32), MOE_ITEMS = 16 * (2 * MOE_IG + MOE_ID);
constexpr int MOE_EARLY_PER_WAVE = 12, MOE_EARLY = 2048 * MOE_EARLY_PER_WAVE;
__device__ __forceinline__ void moe_weight_items(Frame& F, int w, int nw, int it0, int it1) {
    LAS float* scr = (LAS float*)(F.lds + F.wave * 16384); const int lane = F.lane;
    bf16_t* WGU = (bf16_t*)(F.ws + WS_WGU); bf16_t* WDN = (bf16_t*)(F.ws + WS_WDN);
    for (int it = it0 + w; it < it1; it += nw) { const int e = it / (2 * MOE_IG + MOE_ID); int r = it % (2 * MOE_IG + MOE_ID);
        if (r < MOE_IG) transpose_item<2>(F.in[I_WEG] + (size_t)e * DM * 512, 512, WGU + (size_t)e * 1024 * DM, DM, scr, r / 16, r % 16, lane);
        else if (r < 2 * MOE_IG) { r -= MOE_IG; transpose_item<3>(F.in[I_WEU] + (size_t)e * DM * 512, 512, WGU + (size_t)e * 1024 * DM, DM, scr, r / 16, r % 16, lane); }
        else { r -= 2 * MOE_IG; transpose_item<0>(F.in[I_WED] + (size_t)e * 512 * DM, DM, WDN + (size_t)e * DM * 512, 512, scr, r / 64, r % 64, lane); } }
}
struct RouteRec { int cls, pos; float g_lo, g_hi, rstd; int pad0, pad1, pad2; };
__device__ __forceinline__ void phase7(Frame& F, const bool dry, const int mode = 3) {
    const int gw = F.vcu * 8 + F.wave, NGW = F.G * 8, lane = F.lane;
    { int* rowtok = (int*)(F.ws + WS_ROWTOK); for (int i = gw * 64 + lane; i < MPAD; i += NGW * 64) rowtok[i] = -1; }
    if (mode & 1) moe_weight_items(F, gw, NGW, (F.G == 256) ? MOE_EARLY : 0, MOE_ITEMS);
    if (mode & 2) {
    const float* x1 = F.out; const bf16_t* WRH = (const bf16_t*)(F.ws + WS_WRT); const bf16_t* WRL = WRH + 32 * DM;
    RouteRec* rr = (RouteRec*)(F.ws + WS_ROUTE); unsigned* cnt = F.ctl + CW_CNT;
    const int r = lane & 31, h = lane >> 5;
    __syncthreads();
    const int grp = F.wave >> 2, kq = F.wave & 3;
    LAS float* XB = (LAS float*)(F.lds + F.wave * 16384); LAS float* part = XB + 32 * 68;
    const int ltok = lane >> 4, lk = (lane & 15) * 4;
    for (int tbase = F.vcu * 2; tbase < T / 32; tbase += F.G * 2) {
        const int task = tbase + grp;
        const int t = task * 32 + r;
        const float* xs = x1 + (size_t)(task * 32 + ltok) * DM + 512 * kq + lk;
        const bf16_t* ah = WRH + ((size_t)(kq * 32) * 64 + lane) * 8; const bf16_t* al = WRL + ((size_t)(kq * 32) * 64 + lane) * 8;
        f32x16 acc = {0.f, 0.f, 0.f, 0.f, 0.f, 0.f, 0.f, 0.f, 0.f, 0.f, 0.f, 0.f, 0.f, 0.f, 0.f, 0.f};
        float ssq = 0.f;
        f32x4 Xn[8]; bf16x8 Whn[4], Wln[4];
#pragma unroll
        for (int j = 0; j < 8; ++j) Xn[j] = *(const f32x4*)(xs + (size_t)(4 * j) * DM);
#pragma unroll
        for (int q = 0; q < 4; ++q) { Whn[q] = *(const bf16x8*)(ah + 512 * q); Wln[q] = *(const bf16x8*)(al + 512 * q); }
#pragma unroll 1
        for (int st = 0; st < 8; ++st) {
#pragma unroll
            for (int j = 0; j < 8; ++j) *(LAS f32x4*)(XB + (4 * j + ltok) * 68 + lk) = Xn[j];
            bf16x8 Wh[4], Wl[4];
#pragma unroll
            for (int q = 0; q < 4; ++q) { Wh[q] = Whn[q]; Wl[q] = Wln[q]; }
            { const int sn = st + 1 < 8 ? st + 1 : 7;
#pragma unroll
              for (int j = 0; j < 8; ++j) Xn[j] = *(const f32x4*)(xs + (size_t)(4 * j) * DM + 64 * sn);
#pragma unroll
              for (int q = 0; q < 4; ++q) { Whn[q] = *(const bf16x8*)(ah + 512 * (4 * sn + q)); Wln[q] = *(const bf16x8*)(al + 512 * (4 * sn + q)); } }
            LDS_WAIT(); asm volatile("" ::: "memory");
#pragma unroll
            for (int q = 0; q < 4; ++q) {
                const f32x4 x0 = *(const LAS f32x4*)(XB + r * 68 + 16 * q + 8 * h), x4 = *(const LAS f32x4*)(XB + r * 68 + 16 * q + 8 * h + 4);
                ssq += (x0.x * x0.x + x0.y * x0.y) + (x0.z * x0.z + x0.w * x0.w) + (x4.x * x4.x + x4.y * x4.y) + (x4.z * x4.z + x4.w * x4.w);
                u32x4 xh, xl;
                xh.x = pk2(x0.x, x0.y); xh.y = pk2(x0.z, x0.w); xh.z = pk2(x4.x, x4.y); xh.w = pk2(x4.z, x4.w);
                xl.x = pk2(x0.x - bflo(xh.x), x0.y - bfhi(xh.x)); xl.y = pk2(x0.z - bflo(xh.y), x0.w - bfhi(xh.y)); xl.z = pk2(x4.x - bflo(xh.z), x4.y - bfhi(xh.z)); xl.w = pk2(x4.z - bflo(xh.w), x4.w - bfhi(xh.w));
                acc = __builtin_amdgcn_mfma_f32_32x32x16_bf16(Wh[q], __builtin_bit_cast(bf16x8, xh), acc, 0, 0, 0);
                acc = __builtin_amdgcn_mfma_f32_32x32x16_bf16(Wl[q], __builtin_bit_cast(bf16x8, xh), acc, 0, 0, 0);
                acc = __builtin_amdgcn_mfma_f32_32x32x16_bf16(Wh[q], __builtin_bit_cast(bf16x8, xl), acc, 0, 0, 0);
            }
            LDS_WAIT(); asm volatile("" ::: "memory");
        }
        { LAS float* pp = part + lane * 17;
#pragma unroll
          for (int e = 0; e < 12; ++e) pp[e] = acc[e];
          pp[16] = ssq; }
        __syncthreads();
        if (kq == 0) {
#pragma unroll
            for (int q = 1; q < 4; ++q) { const LAS float* pp = (const LAS float*)(F.lds + (grp * 4 + q) * 16384) + 32 * 68 + lane * 17;
#pragma unroll
                for (int e = 0; e < 12; ++e) acc[e] += pp[e];
                ssq += pp[16]; }
        }
        __syncthreads();
        if (kq != 0 || task >= T / 32) continue;
        ssq += __shfl_xor(ssq, 32);
        const float rstd = rsqrtf(ssq * (1.f / DM) + NORM_EPS);
        float ot[8];
#pragma unroll
        for (int e = 0; e < 8; ++e) ot[e] = __shfl_xor(acc[e], 32);
        float lg[20];
#pragma unroll
        for (int q = 0; q < 4; ++q) { lg[q] = acc[q] * rstd; lg[8 + q] = acc[4 + q] * rstd; lg[16 + q] = acc[8 + q] * rstd; lg[4 + q] = ot[q] * rstd; lg[12 + q] = ot[4 + q] * rstd; }
        float gl[4]; float gm = -INFINITY;
#pragma unroll
        for (int o = 0; o < 4; ++o) { gl[o] = lg[o] + F.in[I_BRG][o]; gm = fmaxf(gm, gl[o]); }
        float gs = 0.f; int gsel = 0; float gbest = -INFINITY;
#pragma unroll
        for (int o = 0; o < 4; ++o) { gs += __expf(gl[o] - gm); if (gl[o] > gbest) { gbest = gl[o]; gsel = o; } }
        const float pgrp = __expf(gbest - gm) / gs;
        float el[4]; float em = -INFINITY;
#pragma unroll
        for (int q = 0; q < 4; ++q) { float vsel = 0.f;
#pragma unroll
            for (int g2 = 0; g2 < 4; ++g2) vsel = (gsel == g2) ? lg[4 + 4 * g2 + q] + F.in[I_BRE][4 * g2 + q] : vsel;
            el[q] = vsel; em = fmaxf(em, vsel); }
        int i1 = 0; float b1 = -INFINITY;
#pragma unroll
        for (int q = 0; q < 4; ++q) if (el[q] > b1) { b1 = el[q]; i1 = q; }
        int i2 = 0; float b2 = -INFINITY;
#pragma unroll
        for (int q = 0; q < 4; ++q) if (q != i1 && el[q] > b2) { b2 = el[q]; i2 = q; }
        const float p1 = __expf(b1 - em), p2 = __expf(b2 - em); const float inv = 1.0f / (p1 + p2);
        const float gw1 = pgrp * p1 * inv, gw2 = pgrp * p2 * inv;
        const int elo = i1 < i2 ? i1 : i2, ehi = i1 < i2 ? i2 : i1; const float glo = i1 < i2 ? gw1 : gw2, ghi = i1 < i2 ? gw2 : gw1;
        const int pair = (elo == 0) ? (ehi - 1) : (elo == 1 ? ehi + 1 : 5);
        const int cls = gsel * 6 + pair;
        if (h == 0 && !dry) { const unsigned pos = atomicAdd(&cnt[64 * cls], 1u); RouteRec rc; rc.cls = cls; rc.pos = (int)pos; rc.g_lo = glo; rc.g_hi = ghi; rc.rstd = rstd; rc.pad0 = rc.pad1 = rc.pad2 = 0; rr[t] = rc; }
    }
    }
}

__device__ __forceinline__ void class_bases(Frame& F, volatile LAS int* tb) {
    if (F.wave == 0) {
        const int c = F.lane; const int n = (c < NCLS) ? (int)__hip_atomic_load(F.ctl + CW_CNT + 64 * c, __ATOMIC_RELAXED, __HIP_MEMORY_SCOPE_AGENT) : 0;
        int base = 0;
#pragma unroll
        for (int j = 0; j < NCLS; ++j) { const int nj = __builtin_amdgcn_readlane(n, j); base += (j < c) ? ((nj + 255) & ~255) : 0; }
        if (c < NCLS) tb[c] = base;
        if (c == NCLS - 1) tb[NCLS] = base + ((n + 255) & ~255);
    }
    __syncthreads();
}

__device__ __forceinline__ void phase8(Frame& F) {
    const int gw = F.vcu * 8 + F.wave, NGW = F.G * 8, lane = F.lane;
    volatile LAS int* tb = (volatile LAS int*)(F.lds + MISC_OFF + 128);
    class_bases(F, tb);
    const float* x1 = F.out; const float* gf = F.in[I_GFFN];
    const RouteRec* rr = (const RouteRec*)(F.ws + WS_ROUTE); int* rowtok = (int*)(F.ws + WS_ROWTOK); float* gates = (float*)(F.ws + WS_ROWTOK + 128 * 1024);
    bf16_t* H2S = (bf16_t*)(F.ws + WS_H2S);
    f32x4 gv[8];
#pragma unroll
    for (int j = 0; j < 8; ++j) gv[j] = ((const f32x4*)gf)[64 * j + lane];
    for (int t2 = gw; t2 < T / 2; t2 += NGW) {
        const RouteRec r0 = rr[2 * t2], r1 = rr[2 * t2 + 1];
        f32x4 v[2][8];
#pragma unroll
        for (int u = 0; u < 2; ++u) { const f32x4* xr = (const f32x4*)(x1 + (size_t)(2 * t2 + u) * DM) + lane;
#pragma unroll
            for (int j = 0; j < 8; ++j) v[u][j] = xr[64 * j]; }
#pragma unroll
        for (int u = 0; u < 2; ++u) { const RouteRec r = u ? r1 : r0; const int t = 2 * t2 + u; const int row = tb[r.cls] + r.pos;
            u32x2* o = (u32x2*)(H2S + (size_t)row * DM) + lane;
#pragma unroll
            for (int j = 0; j < 8; ++j) { u32x2 w; w.x = pk2(v[u][j].x * r.rstd * gv[j].x, v[u][j].y * r.rstd * gv[j].y); w.y = pk2(v[u][j].z * r.rstd * gv[j].z, v[u][j].w * r.rstd * gv[j].w); o[64 * j] = w; }
            if (lane == 0) { rowtok[row] = t; gates[2 * row] = r.g_lo; gates[2 * row + 1] = r.g_hi; } }
    }
    for (int idx = gw; idx < NCLS * 256; idx += NGW) { const int c = idx >> 8, off = idx & 255; const int n = (int)__hip_atomic_load(F.ctl + CW_CNT + 64 * c, __ATOMIC_RELAXED, __HIP_MEMORY_SCOPE_AGENT);
        const int row = tb[c] + n + off;
        if (row < tb[c + 1]) { u32x2* o = (u32x2*)(H2S + (size_t)row * DM) + lane;
#pragma unroll
            for (int j = 0; j < 8; ++j) o[64 * j] = (u32x2){0u, 0u};
            if (lane == 0) { gates[2 * row] = 0.f; gates[2 * row + 1] = 0.f; } } }
}

__device__ __forceinline__ int class_of_tile(volatile LAS int* tb, int rt) { int c = 0; const int r0 = rt * 256; for (int k = 1; k < NCLS; ++k) c = (r0 >= tb[k]) ? k : c; return c; }
__device__ __forceinline__ int class_expert(int cls, int half) { const int g = cls / 6, p = cls % 6; const int elo = p < 3 ? 0 : (p < 5 ? 1 : 2); const int ehi = p < 3 ? p + 1 : (p < 5 ? p - 1 : 3); return 4 * g + (half ? ehi : elo); }
__device__ __forceinline__ void class_tables(Frame& F, volatile LAS int* tb, volatile LAS int* te) {
    if (F.wave == 0) {
        const int c = F.lane; const int n = (c < NCLS) ? (int)__hip_atomic_load(F.ctl + CW_CNT + 64 * c, __ATOMIC_RELAXED, __HIP_MEMORY_SCOPE_AGENT) : 0;
        int base = 0;
#pragma unroll
        for (int j = 0; j < NCLS; ++j) { const int nj = __builtin_amdgcn_readlane(n, j); base += (j < c) ? ((nj + 255) & ~255) : 0; }
        if (c < NCLS) { tb[c] = base; const int ee = class_expert(c, 0) | (class_expert(c, 1) << 8); const int nt = (n + 255) >> 8; for (int f = 0; f < nt; ++f) te[(base >> 8) + f] = ee; }
        if (c == NCLS - 1) tb[NCLS] = base + ((n + 255) & ~255);
    }
    __syncthreads();
}
struct Moe1Sched {
    volatile LAS int* te; const char* A; const char* B; int G, c, nu;
    __device__ bool seg(int i, pg8::Seg& s) const { const int L = i * G + c; if (L >= nu) return false; const int rt = L >> 3, pn = L & 7; const int ee = te[rt]; const int e = (pn >> 2) ? (ee >> 8) : (ee & 255);
        s.A = A + (size_t)rt * 256 * DM * 2; s.B = B + ((size_t)e * 1024 + (pn & 3) * 256) * DM * 2; s.u.pm = rt; s.u.pn = pn; s.u.aux = 0; s.last = 1; s.nt = DM / 64; return true; }
    unsigned* cnt;
    static constexpr bool GATED = false, PUBLISH = true;
    __device__ __forceinline__ unsigned peek(const pg8::Unit&) const { return 0u; }
    __device__ __forceinline__ void wait(const pg8::Unit&, unsigned) const {}
    __device__ __forceinline__ void done(const pg8::Unit& u) const { asm volatile("s_waitcnt vmcnt(0)" ::: "memory"); if ((threadIdx.x & 63) == 0) (void)__hip_atomic_fetch_add(cnt + 16 * u.pm, 1u, __ATOMIC_RELAXED, __HIP_MEMORY_SCOPE_AGENT); }
};
struct Moe2Sched {
    volatile LAS int* te; const char* A; const char* B; int G, c, nu;
    __device__ bool seg(int i, pg8::Seg& s) const { const int ui = i >> 1, half = i & 1; const int L = ui * G + c; if (L >= nu) return false; const int rt = L >> 3, pn = L & 7; const int ee = te[rt]; const int e = half ? (ee >> 8) : (ee & 255);
        s.A = A + ((size_t)rt * 256 * 1024 + half * 512) * 2; s.B = B + ((size_t)e * DM + pn * 256) * 512 * 2; s.u.pm = rt; s.u.pn = pn; s.u.aux = 0; s.last = half; s.nt = 512 / 64; return true; }
    unsigned* cnt;
    static constexpr bool GATED = true, PUBLISH = false;
    __device__ __forceinline__ unsigned peek(const pg8::Unit& u) const { return __hip_atomic_load(cnt + 16 * u.pm, __ATOMIC_RELAXED, __HIP_MEMORY_SCOPE_AGENT); }
    __device__ __forceinline__ void wait(const pg8::Unit& u, unsigned v) const {
        unsigned sp = 0u;
        while ((unsigned)__builtin_amdgcn_readfirstlane(v) < 64u) { __builtin_amdgcn_s_sleep(2); if (++sp > (1u << 22)) break; v = __hip_atomic_load(cnt + 16 * u.pm, __ATOMIC_RELAXED, __HIP_MEMORY_SCOPE_AGENT); }
        __builtin_amdgcn_fence(__ATOMIC_ACQUIRE, "agent");
    }
    __device__ __forceinline__ void done(const pg8::Unit&) const {}
};

constexpr int NPHASE = 12;
__global__ void __launch_bounds__(512, 2) fwd_kernel(Args args) {
    extern __shared__ __attribute__((aligned(16))) unsigned char lds_raw[];
    Frame F;
    F.lds = (LAS unsigned char*)lds_raw; F.ldsg = lds_raw;
    F.tid = threadIdx.x; F.lane = F.tid & 63; F.wave = __builtin_amdgcn_readfirstlane(F.tid >> 6);
    F.G = gridDim.x; { const int bx = blockIdx.x; F.vcu = (F.G % 8 == 0) ? (bx % 8) * (F.G / 8) + bx / 8 : bx; }
    F.in = args.in; F.out = args.out; F.ws = args.ws; F.ctl = (unsigned*)(args.ws + WS_CTL);
    volatile LAS unsigned* MISC = (volatile LAS unsigned*)(F.lds + MISC_OFF);
    for (int u = F.tid; u < (LDS_BYTES - LDSCTL_OFF) / 4; u += 512) ((LAS unsigned*)(F.lds + LDSCTL_OFF))[u] = 0u;
    __syncthreads();
    const int lo = args.ph_lo, hi = args.ph_hi;
    const bool DRY_T = (args.ph_hi != 999), DRY_F = (args.ph_hi == 999);
    const bool multi = (hi - lo) > 1;
    XcdBarrier bar; bar.bar = F.ctl + CW_BAR; bar.x = 0; bar.st = nullptr;
    if (multi) bar = xcd_barrier_post(F.ctl + CW_BAR, MISC + 8);
#ifndef PH_MASK
#define PH_MASK 0xfff
#endif
#define IN(k) (((PH_MASK >> (k)) & 1) && lo <= (k) && (k) < hi)
#define STAMP(k) do { if (PROBE_K >= 0 && blockIdx.x == 0 && F.tid == 0) ((volatile unsigned long long*)(F.ctl + CW_TS))[(k)] = __builtin_amdgcn_s_memrealtime(); } while (0)
#define SEAM(k) do { if (IN(k) && IN((k) + 1)) xcd_barrier(bar); STAMP((k) + 1); } while (0)
#ifndef DUP_MASK
#define DUP_MASK 0
#endif
#ifndef DUP_MODE
#define DUP_MODE 3
#endif
    unsigned char* ws = args.ws;
    bf16_t* P = (bf16_t*)(ws + WS_P);
    STAMP(0);

    if (IN(0)) { phase0(F); SEAM(0); }
    if (IN(1)) {
        pg8::InSched S; S.init((const bf16_t*)(ws + WS_HN), (const bf16_t*)(ws + WS_WIN), F.G, (int)blockIdx.x);
        pg8::EpiIn E{P, NP, F.out};
        const bool late_first = (((int)blockIdx.x >> 3) & 1) != 0;
        if (late_first) { late_weight_items(F); __syncthreads(); }
        pg8::gemm_phase<pg8::EpiIn, pg8::InSched, true>(F.lds, DM, DM, DM / 64, S, E);
        if (!late_first) late_weight_items(F);
        SEAM(1);
    }
    if (IN(2)) { if ((DUP_MASK >> 2) & 1) { phase2(F, DRY_T); if (multi) xcd_barrier(bar); } phase2(F, DRY_F); SEAM(2); }
    if (IN(3)) {
        pg8::LoraSched S; S.init((const bf16_t*)(ws + WS_ALORA), (const bf16_t*)(ws + WS_WLORA), F.G, (int)blockIdx.x);
        pg8::EpiLora E{(bf16_t*)(ws + WS_L3), F.in[I_W0], F.in[I_A0]};
        pg8::gemm_phase<pg8::EpiLora, pg8::LoraSched, true>(F.lds, KL, KL, KL / 64, S, E);
        SEAM(3);
    }
    if (IN(4)) { rw::pass_a(F); SEAM(4); }
    if (IN(5)) { if ((DUP_MASK >> 5) & 1) { phase_score_passb(F, DRY_T, 1); if (multi) xcd_barrier(bar); phase_select_passb(F, DRY_T); if (multi) xcd_barrier(bar); }
                 phase_score_passb(F, DRY_F, 0); if (multi) xcd_barrier(bar); STAMP(13); phase_select_passb(F, DRY_F); SEAM(5); }
    if (IN(6)) {
        if (PROBE_K >= 0) { att::attn_phase(F); xcd_barrier(bar); STAMP(14); rw::pass_c(F); }
        else if (((int)blockIdx.x >> 3) & 1) { rw::pass_c(F); __syncthreads(); att::attn_phase(F); }
        else { att::attn_phase(F); __syncthreads(); rw::pass_c(F); }
        SEAM(6); }
    if (IN(7)) {
        pg8::PlainSched S; S.init((const bf16_t*)(ws + WS_YCAT), (const bf16_t*)(ws + WS_WOUT), T, DM, DM, DM, F.G, (int)blockIdx.x, DM / 64);
        pg8::EpiResF32 E{F.in[I_X], F.out, DM};
        if (F.G == 256) {
            const int cls = ((int)blockIdx.x >> 3) & 3, gw = F.vcu * 8 + F.wave;
            const int na = cls == 0 ? 10 : (cls == 1 ? 0 : (cls == 2 ? 4 : 7)), nb = cls == 1 ? 8 : (cls == 2 ? 2 : 0);
            moe_weight_items(F, gw, 2048, 0, 2048 * na); __syncthreads();
            if (nb) { S.i0 = 0; S.ni = 1; pg8::gemm_phase<pg8::EpiResF32, pg8::PlainSched, true>(F.lds, DM, DM, DM / 64, S, E);
                      moe_weight_items(F, gw, 2048, 2048 * na, 2048 * (na + nb)); __syncthreads();
                      S.i0 = 1; S.ni = 1; pg8::gemm_phase<pg8::EpiResF32, pg8::PlainSched, true>(F.lds, DM, DM, DM / 64, S, E); }
            else pg8::gemm_phase<pg8::EpiResF32, pg8::PlainSched, true>(F.lds, DM, DM, DM / 64, S, E);
            moe_weight_items(F, gw, 2048, 2048 * (na + nb), MOE_EARLY);
        } else pg8::gemm_phase<pg8::EpiResF32, pg8::PlainSched, true>(F.lds, DM, DM, DM / 64, S, E);
        SEAM(7);
    }
    if (IN(8)) { if ((DUP_MASK >> 8) & 1) { phase7(F, DRY_T, DUP_MODE); if (multi) xcd_barrier(bar); } phase7(F, DRY_F); SEAM(8); }
    if (IN(9)) { if ((DUP_MASK >> 9) & 1) { phase8(F); if (multi) xcd_barrier(bar); } phase8(F); SEAM(9); }
    if (IN(10)) {
        volatile LAS int* tb = (volatile LAS int*)(F.lds + MISC_OFF + 128); volatile LAS int* te = (volatile LAS int*)(F.lds + MISC_OFF + 256);
        class_tables(F, tb, te);
        Moe1Sched S; S.te = te; S.A = (const char*)(ws + WS_H2S); S.B = (const char*)(ws + WS_WGU); S.G = F.G; S.c = (int)blockIdx.x; S.nu = (tb[NCLS] >> 8) * 8; S.cnt = F.ctl + CW_HSCNT;
        pg8::EpiMoe1 E{(bf16_t*)(ws + WS_HS), (const float*)(ws + WS_ROWTOK + 128 * 1024)};
        pg8::gemm_phase<pg8::EpiMoe1, Moe1Sched, true>(F.lds, DM, DM, DM / 64, S, E);
        STAMP(11);
    }
    if (IN(11)) {
        volatile LAS int* tb = (volatile LAS int*)(F.lds + MISC_OFF + 128); volatile LAS int* te = (volatile LAS int*)(F.lds + MISC_OFF + 256);
        class_tables(F, tb, te);
        Moe2Sched S; S.te = te; S.A = (const char*)(ws + WS_HS); S.B = (const char*)(ws + WS_WDN); S.G = F.G; S.nu = (tb[NCLS] >> 8) * 8; S.cnt = F.ctl + CW_HSCNT;
        S.c = ((int)blockIdx.x + F.G - S.nu % F.G) % F.G;
        if ((DUP_MASK >> 11) & 1) { pg8::EpiMoe2 E0{F.out, (const int*)(ws + WS_ROWTOK), DRY_T ? 1 : 0}; pg8::gemm_phase<pg8::EpiMoe2, Moe2Sched, true>(F.lds, 1024, 512, 512 / 64, S, E0); if (multi) xcd_barrier(bar); }
        pg8::EpiMoe2 E{F.out, (const int*)(ws + WS_ROWTOK), DRY_F ? 1 : 0};
        pg8::gemm_phase<pg8::EpiMoe2, Moe2Sched, true>(F.lds, 1024, 512, 512 / 64, S, E);
    }
    if (PROBE_K >= 0) {
        xcd_barrier(bar); STAMP(12); xcd_barrier(bar);
        const volatile unsigned long long* ts = (const volatile unsigned long long*)(F.ctl + CW_TS);
        constexpr int K = PROBE_K;
        constexpr int ka = K == 20 ? 5 : K == 21 ? 13 : K == 22 ? 6 : K == 23 ? 14 : K == 30 ? 0 : K;
        constexpr int kb = K == 20 ? 13 : K == 21 ? 6 : K == 22 ? 14 : K == 23 ? 7 : K == 30 ? 12 : K + 1;
        const float tau = (float)(long long)(ts[kb] - ts[ka]) * 1.25e-6f;
        f32x4* o = (f32x4*)F.out;
        for (size_t i = (size_t)blockIdx.x * 512 + F.tid; i < (size_t)T * DM / 4; i += (size_t)F.G * 512) { f32x4 v = o[i]; v = v * (1.0f + tau); o[i] = v; }
    }
#undef IN
#undef SEAM
}

extern "C" void kernel_launch(void* const* d_in, const int* in_sizes, int n_in, void* d_out, int out_size, void* d_ws, size_t ws_size, hipStream_t stream) {
    static int grid = 0;
    if (grid == 0) {
        if (n_in != 25 || in_sizes[0] != T * DM || out_size != T * DM || ws_size < WS_END) { fprintf(stderr, "kernel_launch: unexpected shapes (n_in %d, in0 %d, out %d, ws %zu)\n", n_in, n_in > 0 ? in_sizes[0] : -1, out_size, ws_size); grid = -1; return; }
        int dev = 0, cus = 0, per_cu = 0;
        if (hipGetDevice(&dev) != hipSuccess || hipDeviceGetAttribute(&cus, hipDeviceAttributeMultiprocessorCount, dev) != hipSuccess) { grid = -1; return; }
        if (hipFuncSetAttribute((const void*)fwd_kernel, hipFuncAttributeMaxDynamicSharedMemorySize, LDS_BYTES) != hipSuccess) { fprintf(stderr, "kernel_launch: hipFuncSetAttribute failed\n"); grid = -1; return; }
        if (hipOccupancyMaxActiveBlocksPerMultiprocessor(&per_cu, (const void*)fwd_kernel, 512, LDS_BYTES) != hipSuccess || per_cu < 1) { fprintf(stderr, "kernel_launch: occupancy query says %d blocks per CU\n", per_cu); (void)hipGetLastError(); grid = -1; return; }
        grid = cus;
    }
    if (grid < 0) return;
    (void)hipMemsetAsync((char*)d_ws + WS_CTL, 0, CTL_ZERO_BYTES, stream);
    Args a{};
    for (int i = 0; i < 25; ++i) a.in[i] = (const float*)d_in[i];
    a.out = (float*)d_out; a.ws = (unsigned char*)d_ws;
#if MK_SINGLE
    a.ph_lo = 0; a.ph_hi = NPHASE;
    void* kargs[] = {&a};
    hipError_t e = hipLaunchCooperativeKernel((const void*)fwd_kernel, dim3(grid), dim3(512), kargs, LDS_BYTES, stream);
    if (e != hipSuccess) fprintf(stderr, "kernel_launch: cooperative launch failed: %s (grid %d)\n", hipGetErrorString(e), grid);
#else
    for (int p = 0; p < NPHASE; ++p) { a.ph_lo = p; a.ph_hi = p + 1; hipLaunchKernelGGL(fwd_kernel, dim3(grid), dim3(512), LDS_BYTES, stream, a); }
#endif
}
```
